# Optimizing an MI355X kernel written in HIP

```python
import jax, jax.numpy as jnp
from jax import lax
import numpy as np

D_MODEL = 2048
BATCH = 4
SEQ = 4096
DEPTH = 2

GRID_W = 64
HEAD_DIM = 128
A_HEADS = 4
WIN_H_MAX = 8
WIN_W = 16
B_HEADS = 8
B_KV_HEADS = 2
C_HEADS = 4
C_Q_RANK = 512
C_KV_RANK = 256
C_NOPE = 128
C_ROPE = 64
C_V = 128
A_WIDTH = A_HEADS * HEAD_DIM
B_WIDTH = B_HEADS * HEAD_DIM
B_KV_WIDTH = B_KV_HEADS * HEAD_DIM
C_WIDTH = C_HEADS * C_V
D_MIX = A_WIDTH + B_WIDTH + C_WIDTH
D_IN = 3 * A_WIDTH + B_WIDTH + 2 * B_KV_WIDTH + C_Q_RANK + C_KV_RANK + C_ROPE
D_FF_DENSE = 5632
N_EXPERTS = 8
TOP_K = 2
D_FF_EXPERT = 7168
N_DENSE = (DEPTH + 1) // 2
N_MOE = DEPTH // 2
Q_BLOCK = 128
ROPE_THETA = 10000.0
EPS = 1e-6

kernel_name = 'hymba_style_natten_gqa_mla_moe_encoder'


def rms_norm(x, g):
    xf = x.astype(jnp.float32)
    y = xf * lax.rsqrt(jnp.mean(xf * xf, axis=-1, keepdims=True) + EPS)
    return (y * g.astype(jnp.float32)).astype(x.dtype)


def rope_1d(x, pos):
    half = x.shape[-1] // 2
    freqs = ROPE_THETA ** (-jnp.arange(half, dtype=jnp.float32) / half)
    ang = pos.astype(jnp.float32)[:, None] * freqs[None, :]
    cos = jnp.cos(ang)[None, :, None, :]
    sin = jnp.sin(ang)[None, :, None, :]
    xf = x.astype(jnp.float32)
    x1, x2 = xf[..., :half], xf[..., half:]
    return jnp.concatenate([x1 * cos - x2 * sin, x2 * cos + x1 * sin], axis=-1).astype(x.dtype)


def rope_2d(x, rows, cols):
    d = x.shape[-1]
    return jnp.concatenate([rope_1d(x[..., : d // 2], rows), rope_1d(x[..., d // 2 :], cols)], axis=-1)


def blocked_attention(q, k, v):
    B, S, Hq, dq = q.shape
    Hkv, dv = k.shape[2], v.shape[-1]
    G = Hq // Hkv
    scale = dq ** -0.5
    qb = q.reshape(B, S // Q_BLOCK, Q_BLOCK, Hkv, G, dq).transpose(1, 0, 2, 3, 4, 5)

    def one_block(q_blk):
        s = jnp.einsum('bqhgd,bkhd->bhgqk', q_blk, k, preferred_element_type=jnp.float32) * scale
        p = jax.nn.softmax(s, axis=-1)
        return jnp.einsum('bhgqk,bkhd->bqhgd', p.astype(v.dtype), v)

    out = lax.map(one_block, qb)
    return out.transpose(1, 0, 2, 3, 4, 5).reshape(B, S, Hq, dv)


def neighbourhood_attention(q, k, v, rpb):
    B, S, H, d = q.shape
    rows = S // GRID_W
    kh = min(WIN_H_MAX, rows)
    scale = d ** -0.5
    qg = q.reshape(B, rows, GRID_W, H, d)
    kg = k.reshape(B, rows, GRID_W, H, d)
    vg = v.reshape(B, rows, GRID_W, H, d)
    cols = jnp.arange(GRID_W)
    c0 = jnp.clip(cols - WIN_W // 2, 0, GRID_W - WIN_W)
    col_idx = c0[:, None] + jnp.arange(WIN_W)[None, :]
    col_bias_idx = col_idx - cols[:, None] + (WIN_W - 1)

    def one_row(args):
        r, q_row = args
        r0 = jnp.clip(r - kh // 2, 0, rows - kh)
        k_rows = lax.dynamic_slice_in_dim(kg, r0, kh, axis=1)
        v_rows = lax.dynamic_slice_in_dim(vg, r0, kh, axis=1)
        k_win = k_rows[:, :, col_idx]
        v_win = v_rows[:, :, col_idx]
        s = jnp.einsum('bchd,bicjhd->bhcij', q_row, k_win, preferred_element_type=jnp.float32) * scale
        row_bias_idx = r0 + jnp.arange(kh) - r + (WIN_H_MAX - 1)
        bias = rpb[:, row_bias_idx[:, None, None], col_bias_idx[None, :, :]]
        s = s + bias.transpose(0, 2, 1, 3)[None].astype(jnp.float32)
        p = jax.nn.softmax(s, axis=(-2, -1))
        return jnp.einsum('bhcij,bicjhd->bchd', p.astype(v.dtype), v_win)

    out = lax.map(one_row, (jnp.arange(rows), qg.transpose(1, 0, 2, 3, 4)))
    return out.transpose(1, 0, 2, 3, 4).reshape(B, S, H, d)


def split_columns(proj):
    sizes = (A_WIDTH, A_WIDTH, A_WIDTH, B_WIDTH, B_KV_WIDTH, B_KV_WIDTH, C_Q_RANK, C_KV_RANK, C_ROPE)
    idx, acc = [], 0
    for s in sizes[:-1]:
        acc += s
        idx.append(acc)
    return jnp.split(proj, idx, axis=-1)


def hybrid_mixer(h, rows, cols, w_in, rpb, qn_a, kn_a, qn_b, kn_b, cq_norm, ckv_norm,
                 w_uq, w_ukv, qn_c, kn_c, on_a, on_b, on_c, w_out):
    B, S, _ = h.shape
    proj = h @ w_in
    q_a, k_a, v_a, q_b, k_b, v_b, cq, ckv, kpe = split_columns(proj)

    q_a = rms_norm(q_a.reshape(B, S, A_HEADS, HEAD_DIM), qn_a)
    k_a = rms_norm(k_a.reshape(B, S, A_HEADS, HEAD_DIM), kn_a)
    v_a = v_a.reshape(B, S, A_HEADS, HEAD_DIM)
    o_a = neighbourhood_attention(q_a, k_a, v_a, rpb).reshape(B, S, A_WIDTH)

    q_b = rope_2d(rms_norm(q_b.reshape(B, S, B_HEADS, HEAD_DIM), qn_b), rows, cols)
    k_b = rope_2d(rms_norm(k_b.reshape(B, S, B_KV_HEADS, HEAD_DIM), kn_b), rows, cols)
    v_b = v_b.reshape(B, S, B_KV_HEADS, HEAD_DIM)
    o_b = blocked_attention(q_b, k_b, v_b).reshape(B, S, B_WIDTH)

    cq = rms_norm(cq, cq_norm)
    q_c = (cq @ w_uq).reshape(B, S, C_HEADS, C_NOPE + C_ROPE)
    ckv = rms_norm(ckv, ckv_norm)
    kv = (ckv @ w_ukv).reshape(B, S, C_HEADS, C_NOPE + C_V)
    k_nope, v_c = kv[..., :C_NOPE], kv[..., C_NOPE:]
    q_nope = rms_norm(q_c[..., :C_NOPE], qn_c[:C_NOPE])
    q_pe = rope_2d(rms_norm(q_c[..., C_NOPE:], qn_c[C_NOPE:]), rows, cols)
    k_nope = rms_norm(k_nope, kn_c[:C_NOPE])
    k_pe = rope_2d(rms_norm(kpe.reshape(B, S, 1, C_ROPE), kn_c[C_NOPE:]), rows, cols)
    q_full = jnp.concatenate([q_nope, q_pe], axis=-1)
    k_full = jnp.concatenate([k_nope, jnp.broadcast_to(k_pe, (B, S, C_HEADS, C_ROPE))], axis=-1)
    o_c = blocked_attention(q_full, k_full, v_c).reshape(B, S, C_WIDTH)

    o = jnp.concatenate([rms_norm(o_a, on_a), rms_norm(o_b, on_b), rms_norm(o_c, on_c)], axis=-1)
    return o @ w_out


def swiglu(t, w_gate, w_up, w_down):
    return (jax.nn.silu(t @ w_gate) * (t @ w_up)) @ w_down


def moe_swiglu(h, router, we_gate, we_up, we_down):
    B, S, D = h.shape
    t = h.reshape(B * S, D)
    logits = (t @ router).astype(jnp.float32)
    top_vals, top_idx = lax.top_k(logits, TOP_K)
    top_w = jax.nn.softmax(top_vals, axis=-1)
    gates = jnp.sum(jax.nn.one_hot(top_idx, N_EXPERTS, dtype=jnp.float32) * top_w[..., None], axis=1)
    out = jnp.zeros_like(t)
    for e in range(N_EXPERTS):
        out = out + gates[:, e:e + 1].astype(t.dtype) * swiglu(t, we_gate[e], we_up[e], we_down[e])
    return out.reshape(B, S, D)


def setup_inputs(seed: int = 0) -> dict:
    key = jax.random.key(seed)
    ks = jax.random.split(key, 26)

    def nrm(k, shape, scale):
        return jax.random.normal(k, shape, dtype=jnp.float32) * scale

    def gain(k, shape):
        return 1.0 + 0.02 * jax.random.normal(k, shape, dtype=jnp.float32)

    return {
        'x': nrm(ks[0], (BATCH, SEQ, D_MODEL), 1.0),
        'mix_norm': gain(ks[1], (DEPTH, D_MODEL)),
        'w_in': nrm(ks[2], (DEPTH, D_MODEL, D_IN), D_MODEL ** -0.5),
        'rpb': nrm(ks[3], (DEPTH, A_HEADS, 2 * WIN_H_MAX - 1, 2 * WIN_W - 1), 0.1),
        'qn_a': gain(ks[4], (DEPTH, HEAD_DIM)),
        'kn_a': gain(ks[5], (DEPTH, HEAD_DIM)),
        'qn_b': gain(ks[6], (DEPTH, HEAD_DIM)),
        'kn_b': gain(ks[7], (DEPTH, HEAD_DIM)),
        'cq_norm': gain(ks[8], (DEPTH, C_Q_RANK)),
        'ckv_norm': gain(ks[9], (DEPTH, C_KV_RANK)),
        'w_uq': nrm(ks[10], (DEPTH, C_Q_RANK, C_HEADS * (C_NOPE + C_ROPE)), C_Q_RANK ** -0.5),
        'w_ukv': nrm(ks[11], (DEPTH, C_KV_RANK, C_HEADS * (C_NOPE + C_V)), C_KV_RANK ** -0.5),
        'qn_c': gain(ks[12], (DEPTH, C_NOPE + C_ROPE)),
        'kn_c': gain(ks[13], (DEPTH, C_NOPE + C_ROPE)),
        'on_a': gain(ks[14], (DEPTH, A_WIDTH)),
        'on_b': gain(ks[15], (DEPTH, B_WIDTH)),
        'on_c': gain(ks[16], (DEPTH, C_WIDTH)),
        'w_out': nrm(ks[17], (DEPTH, D_MIX, D_MODEL), D_MIX ** -0.5),
        'ffn_norm': gain(ks[18], (DEPTH, D_MODEL)),
        'w_gate': nrm(ks[19], (N_DENSE, D_MODEL, D_FF_DENSE), D_MODEL ** -0.5),
        'w_up': nrm(ks[20], (N_DENSE, D_MODEL, D_FF_DENSE), D_MODEL ** -0.5),
        'w_down': nrm(ks[21], (N_DENSE, D_FF_DENSE, D_MODEL), D_FF_DENSE ** -0.5),
        'router': nrm(ks[22], (N_MOE, D_MODEL, N_EXPERTS), D_MODEL ** -0.5),
        'we_gate': nrm(ks[23], (N_MOE, N_EXPERTS, D_MODEL, D_FF_EXPERT), D_MODEL ** -0.5),
        'we_up': nrm(ks[24], (N_MOE, N_EXPERTS, D_MODEL, D_FF_EXPERT), D_MODEL ** -0.5),
        'we_down': nrm(ks[25], (N_MOE, N_EXPERTS, D_FF_EXPERT, D_MODEL), D_FF_EXPERT ** -0.5),
    }


def reference(x, mix_norm, w_in, rpb, qn_a, kn_a, qn_b, kn_b, cq_norm, ckv_norm, w_uq, w_ukv,
              qn_c, kn_c, on_a, on_b, on_c, w_out, ffn_norm, w_gate, w_up, w_down,
              router, we_gate, we_up, we_down):
    S = x.shape[1]
    pos = jnp.arange(S, dtype=jnp.int32)
    rows = pos // GRID_W
    cols = pos % GRID_W
    for l in range(DEPTH):
        h = rms_norm(x, mix_norm[l])
        x = x + hybrid_mixer(h, rows, cols, w_in[l], rpb[l], qn_a[l], kn_a[l], qn_b[l], kn_b[l],
                             cq_norm[l], ckv_norm[l], w_uq[l], w_ukv[l], qn_c[l], kn_c[l],
                             on_a[l], on_b[l], on_c[l], w_out[l])
        h = rms_norm(x, ffn_norm[l])
        if l % 2 == 0:
            x = x + swiglu(h, w_gate[l // 2], w_up[l // 2], w_down[l // 2])
        else:
            x = x + moe_swiglu(h, router[l // 2], we_gate[l // 2], we_up[l // 2], we_down[l // 2])
    return x
```

```cpp
#include <hip/hip_runtime.h>
#include <cstdio>
#include <cstdint>
namespace pg8 {
#define PG8_LAS __attribute__((address_space(3)))
typedef unsigned short bf16_t;
typedef short bf16x8 __attribute__((ext_vector_type(8)));
typedef float f32x4 __attribute__((ext_vector_type(4)));
typedef unsigned u32x4 __attribute__((ext_vector_type(4)));
constexpr int BM = 256, BK = 64, HALF = 128, HTB = HALF * BK * 2  , STAGE_BYTES = 8 * HTB, NXCD = 8, WGM = 8;

__host__ __device__ __forceinline__ int lds_byte(int r, int c) { const int st = (r >> 4) * 2 + (c >> 5), rr = r & 15, cc = c & 31, ob = rr * 64 + cc * 2; return st * 1024 + (ob ^ (((ob >> 9) & 1) << 5)); }
__host__ __device__ __forceinline__ void stage_rc(int b, int& R, int& C) { const int st = b / 1024, sb = b % 1024, swz = sb ^ (((sb >> 9) & 1) << 5); R = (st >> 1) * 16 + swz / 64; C = (st & 1) * 32 + (swz % 64) / 2; }
__host__ __device__ __forceinline__ int perm32(int rho) { const int n = rho >> 4, i = rho & 15; return 8 * (i >> 2) + 4 * n + (i & 3); }


struct Unit { int pm, pn, pc; };
struct Gemm { const bf16_t* A; const bf16_t* Bt; int M, N, K; };

struct StaticOrder {
    int nM, nN, nwg, G, c;
    __device__ __forceinline__ void init(int M, int N, int G_, int c_) { nM = M / BM; nN = N / BM; nwg = nM * nN; G = G_; c = c_; }
    __device__ __forceinline__ bool next(int i, Unit& u) const {
        const long L = (long)i * G + c; if (L >= nwg) return false;
        int wgid = (int)L; { const int q = nwg / NXCD, r = nwg % NXCD, xcd = wgid % NXCD, off = wgid / NXCD; wgid = (xcd < r ? xcd * (q + 1) : r * (q + 1) + (xcd - r) * q) + off; }
        const int nig = WGM * nN, gid = wgid / nig, fm = gid * WGM, gsz = (nM - fm) < WGM ? (nM - fm) : WGM;
        u.pm = fm + ((wgid % nig) % gsz); u.pn = (wgid % nig) / gsz; u.pc = u.pn; return true;
    }
    __device__ __forceinline__ void a_ready(const Unit&) const {}
    __device__ __forceinline__ void done(const Unit&) const {}
};
struct GroupedOrder : StaticOrder {
    int tb[7]; int nct;
    __device__ __forceinline__ bool next(int i, Unit& u) const {
        if (!StaticOrder::next(i, u)) return false;
        int e = 0;
#pragma unroll
        for (int k = 0; k < 7; ++k) e += (u.pm >= tb[k]) ? 1 : 0;
        u.pc = u.pn; u.pn += e * nct; return true;
    }
};

__device__ __forceinline__ unsigned cvt_pk_bf16(float lo, float hi) { unsigned r; asm volatile("v_cvt_pk_bf16_f32 %0, %1, %2" : "=v"(r) : "v"(lo), "v"(hi)); return r; }

struct EpiBf16 {
    static constexpr bool PERM = true, AFTER_DRAIN = false;
    bf16_t* O; int ldc;
    __device__ __forceinline__ void operator()(const f32x4 (&acc)[2][2][4][2], const Unit& u, int wr, int wc, int fr, int fq) const {
        const int row0 = u.pm * BM + wr * 64 + fr, col0 = u.pc * BM + wc * 32 + 8 * fq;
#pragma unroll
        for (int ai = 0; ai < 2; ++ai)
#pragma unroll
            for (int m = 0; m < 4; ++m) { bf16_t* rowp = O + (size_t)(row0 + ai * HALF + m * 16) * ldc + col0;
#pragma unroll
                for (int bj = 0; bj < 2; ++bj) { const f32x4 v0 = acc[ai][bj][m][0], v1 = acc[ai][bj][m][1];
                    u32x4 w; w.x = cvt_pk_bf16(v0[0], v0[1]); w.y = cvt_pk_bf16(v0[2], v0[3]); w.z = cvt_pk_bf16(v1[0], v1[1]); w.w = cvt_pk_bf16(v1[2], v1[3]);
                    *(u32x4*)(rowp + bj * HALF) = w; } }
    }
};
struct EpiScaleBf16 {
    static constexpr bool PERM = true, AFTER_DRAIN = false;
    bf16_t* O; int ldc; const float* rs;
    __device__ __forceinline__ void operator()(const f32x4 (&acc)[2][2][4][2], const Unit& u, int wr, int wc, int fr, int fq) const {
        const int row0 = u.pm * BM + wr * 64 + fr, col0 = u.pc * BM + wc * 32 + 8 * fq;
#pragma unroll
        for (int ai = 0; ai < 2; ++ai)
#pragma unroll
            for (int m = 0; m < 4; ++m) { const int row = row0 + ai * HALF + m * 16; const float s = rs[row]; bf16_t* rowp = O + (size_t)row * ldc + col0;
#pragma unroll
                for (int bj = 0; bj < 2; ++bj) { const f32x4 v0 = acc[ai][bj][m][0] * s, v1 = acc[ai][bj][m][1] * s;
                    u32x4 w; w.x = cvt_pk_bf16(v0[0], v0[1]); w.y = cvt_pk_bf16(v0[2], v0[3]); w.z = cvt_pk_bf16(v1[0], v1[1]); w.w = cvt_pk_bf16(v1[2], v1[3]);
                    *(u32x4*)(rowp + bj * HALF) = w; } }
    }
};
struct EpiResF32 {
    static constexpr bool PERM = false, AFTER_DRAIN = false;
    const float* base; float* out; int ldc;
    __device__ __forceinline__ void operator()(const f32x4 (&acc)[2][2][4][2], const Unit& u, int wr, int wc, int fr, int fq) const {
        const int row0 = u.pm * BM + wr * 64 + fr, col0 = u.pc * BM + wc * 32 + 4 * fq;
#pragma unroll
        for (int ai = 0; ai < 2; ++ai)
#pragma unroll
            for (int m = 0; m < 4; ++m) { const size_t off = (size_t)(row0 + ai * HALF + m * 16) * ldc + col0;
                f32x4 b[2][2];
#pragma unroll
                for (int bj = 0; bj < 2; ++bj)
#pragma unroll
                    for (int n = 0; n < 2; ++n) b[bj][n] = *(const f32x4*)(base + off + bj * HALF + n * 16);
#pragma unroll
                for (int bj = 0; bj < 2; ++bj)
#pragma unroll
                    for (int n = 0; n < 2; ++n) *(f32x4*)(out + off + bj * HALF + n * 16) = b[bj][n] + acc[ai][bj][m][n];
                asm volatile("" ::: "memory"); }
    }
};
__device__ __forceinline__ float silu_mul(float g, float u) { return g * u * __builtin_amdgcn_rcpf(1.0f + __builtin_amdgcn_exp2f(-1.44269504089f * g)); }
struct EpiSwiglu {
    static constexpr bool PERM = true, AFTER_DRAIN = false;
    bf16_t* O; int ldc;
    __device__ __forceinline__ void operator()(const f32x4 (&acc)[2][2][4][2], const Unit& u, int wr, int wc, int fr, int fq) const {
        const int row0 = u.pm * BM + wr * 64 + fr, col0 = u.pc * HALF + wc * 32 + 8 * fq;
#pragma unroll
        for (int ai = 0; ai < 2; ++ai)
#pragma unroll
            for (int m = 0; m < 4; ++m) { bf16_t* rowp = O + (size_t)(row0 + ai * HALF + m * 16) * ldc + col0;
                const f32x4 g0 = acc[ai][0][m][0], g1 = acc[ai][0][m][1], u0 = acc[ai][1][m][0], u1 = acc[ai][1][m][1];
                u32x4 w; w.x = cvt_pk_bf16(silu_mul(g0[0], u0[0]), silu_mul(g0[1], u0[1])); w.y = cvt_pk_bf16(silu_mul(g0[2], u0[2]), silu_mul(g0[3], u0[3]));
                w.z = cvt_pk_bf16(silu_mul(g1[0], u1[0]), silu_mul(g1[1], u1[1])); w.w = cvt_pk_bf16(silu_mul(g1[2], u1[2]), silu_mul(g1[3], u1[3]));
                *(u32x4*)rowp = w; }
    }
};

template <class Epi, class Sched, bool ALIGN_EPI = false, bool SP2 = false>
__device__ __forceinline__ void gemm_phase(PG8_LAS unsigned char* lds, const Gemm g, const Sched& S, const Epi& E) {
    int tid_ = threadIdx.x; asm volatile("" : "+v"(tid_));
    const int tid = tid_, wid = __builtin_amdgcn_readfirstlane(tid >> 6), lane = tid & 63, wr = wid >> 2, wc = wid & 3, fr = lane & 15, fq = lane >> 4;
    const int K = g.K, nt = K / BK;
    unsigned voffA[2], voffB[2];
#pragma unroll
    for (int i = 0; i < 2; ++i) { int R, C; stage_rc(tid * 16 + i * 8192, R, C); const int Rb = Epi::PERM ? ((R & ~31) + perm32(R & 31)) : R;
        voffA[i] = (unsigned)(R * K + C) * 2u; voffB[i] = (unsigned)(Rb * K + C) * 2u; }
    const size_t kstep = (size_t)(BK * 2);
    const size_t hstep = (size_t)HALF * K * 2;
    const size_t tstep = 2 * hstep;
    const unsigned ldsw = (unsigned)wid * 1024u;
    const int aoff = lds_byte(wr * 64 + fr, fq * 8), boff = lds_byte(wc * 32 + fr, fq * 8);
#define PG8_SA(b, h) (((b) * 2 + (h)) * HTB)
#define PG8_SB(b, h) ((4 + (b) * 2 + (h)) * HTB)
#define PG8_STAGE(bufoff, gbase, voff) do { _Pragma("unroll") for (int _i = 0; _i < 2; ++_i) \
        __builtin_amdgcn_global_load_lds((const unsigned*)((const char*)(gbase) + (voff)[_i]), (PG8_LAS unsigned*)(lds + (bufoff) + ldsw + _i * 8192), 16, 0, 0); } while (0)
#define PG8_LDA(dst, b, h) do { _Pragma("unroll") for (int m = 0; m < 4; ++m) _Pragma("unroll") for (int k = 0; k < 2; ++k) dst[m][k] = *(const PG8_LAS bf16x8*)(lds + PG8_SA(b, h) + aoff + m * 2048 + k * 1024); } while (0)
#define PG8_LDB(dst, b, h) do { _Pragma("unroll") for (int n = 0; n < 2; ++n) _Pragma("unroll") for (int k = 0; k < 2; ++k) dst[n][k] = *(const PG8_LAS bf16x8*)(lds + PG8_SB(b, h) + boff + n * 2048 + k * 1024); } while (0)
#define PG8_MMA(ai, bj, At, Bt) do { __builtin_amdgcn_s_setprio(1); _Pragma("unroll") for (int m = 0; m < 4; ++m) _Pragma("unroll") for (int n = 0; n < 2; ++n) _Pragma("unroll") for (int k = 0; k < 2; ++k) \
        acc[ai][bj][m][n] = __builtin_amdgcn_mfma_f32_16x16x32_bf16(Bt[n][k], At[m][k], acc[ai][bj][m][n], 0, 0, 0); __builtin_amdgcn_s_setprio(0); } while (0)
#define PG8_WAIT_V(n) asm volatile("s_waitcnt vmcnt(" #n ")" ::: "memory")
#define PG8_WAIT_L(n) asm volatile("s_waitcnt lgkmcnt(" #n ")" ::: "memory")
#define PG8_BAR __builtin_amdgcn_s_barrier()
#define PG8_SCHED __builtin_amdgcn_sched_barrier(0)
    Unit cur, nxt; int ui = 0;
    if (!S.next(0, cur)) return;
    f32x4 acc[2][2][4][2];
#pragma unroll
    for (int a = 0; a < 2; ++a)
#pragma unroll
        for (int b = 0; b < 2; ++b)
#pragma unroll
            for (int m = 0; m < 4; ++m)
#pragma unroll
                for (int n = 0; n < 2; ++n) acc[a][b][m][n] = (f32x4){0.f, 0.f, 0.f, 0.f};
    bf16x8 At[4][2], B0[2][2], B1[2][2];
    const char* cA = (const char*)g.A + (size_t)cur.pm * tstep; const char* cB = (const char*)g.Bt + (size_t)cur.pn * tstep;
    S.a_ready(cur);
    if constexpr (SP2) {
        PG8_STAGE(PG8_SB(0, 0), cB, voffB); PG8_STAGE(PG8_SB(0, 1), cB + hstep, voffB); PG8_STAGE(PG8_SA(0, 0), cA, voffA); PG8_STAGE(PG8_SA(0, 1), cA + hstep, voffA);
        if (wr == 1) PG8_BAR;
        PG8_WAIT_V(2); PG8_BAR;
        PG8_STAGE(PG8_SB(1, 0), cB + kstep, voffB); PG8_STAGE(PG8_SA(1, 0), cA + kstep, voffA); PG8_STAGE(PG8_SB(1, 1), cB + hstep + kstep, voffB);
        PG8_WAIT_V(6); PG8_BAR;
    } else {
        PG8_STAGE(PG8_SB(0, 0), cB, voffB); PG8_STAGE(PG8_SA(0, 0), cA, voffA); PG8_STAGE(PG8_SB(0, 1), cB + hstep, voffB); PG8_STAGE(PG8_SA(0, 1), cA + hstep, voffA);
        if (wr == 1) PG8_BAR;
        PG8_WAIT_V(4); PG8_BAR;
        PG8_STAGE(PG8_SB(1, 0), cB + kstep, voffB); PG8_STAGE(PG8_SA(1, 0), cA + kstep, voffA); PG8_STAGE(PG8_SB(1, 1), cB + hstep + kstep, voffB);
        PG8_WAIT_V(6); PG8_BAR;
    }
    for (;;) {
        const bool has_next = S.next(ui + 1, nxt);
        const char* nA = has_next ? (const char*)g.A + (size_t)nxt.pm * tstep : cA; const char* nB = has_next ? (const char*)g.Bt + (size_t)nxt.pn * tstep : cB;
        for (int t = 0; t < nt; t += 2) {
            const bool last = (t == nt - 2);
            const char* a1 = cA + (size_t)(t + 1) * kstep;
            const char* a2 = last ? nA : cA + (size_t)(t + 2) * kstep; const char* b2 = last ? nB : cB + (size_t)(t + 2) * kstep;
            const char* a3 = a2 + kstep; const char* b3 = b2 + kstep;
            if (last && has_next) S.a_ready(nxt);
            if constexpr (SP2) {
            PG8_LDB(B0, 0, 0); PG8_LDB(B1, 0, 1); PG8_SCHED; PG8_LDA(At, 0, 0); PG8_STAGE(PG8_SA(1, 1), a1 + hstep, voffA);
            PG8_WAIT_V(8); PG8_WAIT_L(0); PG8_BAR; PG8_MMA(0, 0, At, B0); PG8_MMA(0, 1, At, B1); PG8_BAR; PG8_SCHED;
            PG8_LDA(At, 0, 1); PG8_STAGE(PG8_SB(0, 0), b2, voffB); PG8_STAGE(PG8_SB(0, 1), b2 + hstep, voffB); PG8_STAGE(PG8_SA(0, 0), a2, voffA);
            PG8_WAIT_V(8); PG8_WAIT_L(0); PG8_BAR; PG8_MMA(1, 0, At, B0); PG8_MMA(1, 1, At, B1); PG8_BAR; PG8_SCHED;
            PG8_LDB(B0, 1, 0); PG8_LDB(B1, 1, 1); PG8_SCHED; PG8_LDA(At, 1, 0); PG8_STAGE(PG8_SA(0, 1), a2 + hstep, voffA);
            PG8_WAIT_V(8); PG8_WAIT_L(0); PG8_BAR; PG8_MMA(0, 0, At, B0); PG8_MMA(0, 1, At, B1); PG8_BAR; PG8_SCHED;
            PG8_LDA(At, 1, 1); PG8_STAGE(PG8_SB(1, 0), b3, voffB); PG8_STAGE(PG8_SB(1, 1), b3 + hstep, voffB); PG8_STAGE(PG8_SA(1, 0), a3, voffA);
            PG8_WAIT_V(8); PG8_WAIT_L(0); PG8_BAR; PG8_MMA(1, 0, At, B0); PG8_MMA(1, 1, At, B1); PG8_BAR; PG8_SCHED;
            } else {
            PG8_LDB(B0, 0, 0); PG8_SCHED; PG8_LDA(At, 0, 0); PG8_STAGE(PG8_SA(1, 1), a1 + hstep, voffA);
            PG8_WAIT_L(8); PG8_BAR; PG8_WAIT_L(0); PG8_MMA(0, 0, At, B0); PG8_BAR; PG8_SCHED;
            PG8_LDB(B1, 0, 1); PG8_STAGE(PG8_SB(0, 0), b2, voffB);
            PG8_BAR; PG8_WAIT_L(0); PG8_MMA(0, 1, At, B1); PG8_BAR;
            PG8_LDA(At, 0, 1); PG8_STAGE(PG8_SA(0, 0), a2, voffA);
            PG8_BAR; PG8_WAIT_L(0); PG8_MMA(1, 0, At, B0); PG8_BAR; PG8_SCHED;
            PG8_STAGE(PG8_SB(0, 1), b2 + hstep, voffB);
            PG8_WAIT_V(6); PG8_BAR; PG8_MMA(1, 1, At, B1); PG8_BAR;
            PG8_LDB(B0, 1, 0); PG8_SCHED; PG8_LDA(At, 1, 0); PG8_STAGE(PG8_SA(0, 1), a2 + hstep, voffA);
            PG8_WAIT_L(8); PG8_BAR; PG8_WAIT_L(0); PG8_MMA(0, 0, At, B0); PG8_BAR; PG8_SCHED;
            PG8_LDB(B1, 1, 1); PG8_STAGE(PG8_SB(1, 0), b3, voffB);
            PG8_BAR; PG8_WAIT_L(0); PG8_MMA(0, 1, At, B1); PG8_BAR;
            PG8_LDA(At, 1, 1); PG8_STAGE(PG8_SA(1, 0), a3, voffA);
            PG8_BAR; PG8_WAIT_L(0); PG8_MMA(1, 0, At, B0); PG8_BAR; PG8_SCHED;
            PG8_STAGE(PG8_SB(1, 1), b3 + hstep, voffB);
            PG8_WAIT_V(6); PG8_BAR; PG8_MMA(1, 1, At, B1); PG8_BAR;
            }
        }
        if constexpr (ALIGN_EPI) { if (wr == 0) PG8_BAR; }
        if constexpr (!Epi::AFTER_DRAIN) { E(acc, cur, wr, wc, fr, fq); S.done(cur); }
        if (!has_next) break;
#pragma unroll
        for (int a = 0; a < 2; ++a)
#pragma unroll
            for (int b = 0; b < 2; ++b)
#pragma unroll
                for (int m = 0; m < 4; ++m)
#pragma unroll
                    for (int n = 0; n < 2; ++n) acc[a][b][m][n] = (f32x4){0.f, 0.f, 0.f, 0.f};
        cur = nxt; cA = nA; cB = nB; ++ui;
        if constexpr (ALIGN_EPI) { if (wr == 1) PG8_BAR; }
    }
    PG8_WAIT_V(0);
    if constexpr (!ALIGN_EPI) { if (wr == 0) PG8_BAR; }
    PG8_BAR;
    if constexpr (Epi::AFTER_DRAIN) { E.fused(acc, cur, wr, wc, fr, fq, lds, wid, lane); S.done(cur); }
#undef PG8_SA
#undef PG8_SB
#undef PG8_STAGE
#undef PG8_LDA
#undef PG8_LDB
#undef PG8_MMA
#undef PG8_WAIT_V
#undef PG8_WAIT_L
#undef PG8_BAR
#undef PG8_SCHED
}
}

namespace att {
typedef unsigned short bf16;
using bf16x8 = __attribute__((ext_vector_type(8))) short;
using s16x4  = __attribute__((ext_vector_type(4))) short;
using f32x16 = __attribute__((ext_vector_type(16))) float;
using u32x4  = __attribute__((ext_vector_type(4))) unsigned;
constexpr int NW = 8, QBLK = 32, KVBLK = 64, DV = 128;
constexpr float THR = 8.f;
constexpr int SHM_V = KVBLK * DV * 2;
#define ATT_SBAR() __builtin_amdgcn_sched_barrier(0)
__device__ __forceinline__ int crow(int r, int hi) { return (r & 3) + 8 * (r >> 2) + 4 * hi; }
__device__ __forceinline__ unsigned cvtpk(float lo, float hi) { unsigned r; asm volatile("v_cvt_pk_bf16_f32 %0, %1, %2" : "=v"(r) : "v"(lo), "v"(hi)); return r; }
template <int DQ> struct Cst { static constexpr float SCALE = (DQ == 128) ? 0.088388347648318440f : 0.072168783648703220f; static constexpr int SHM_K = KVBLK * DQ * 2, ROWB = DQ * 2; };

template <int DQ>
__device__ __forceinline__ void partialSM(f32x16& p0, f32x16& p1, float& m_reg, float& mn, float& alpha) {
  constexpr float SCALE = Cst<DQ>::SCALE, C = SCALE * 1.4426950408889634f;
  float pmax = p0[0];
#pragma unroll
  for (int r = 1; r < 16; ++r) pmax = fmaxf(pmax, p0[r]);
#pragma unroll
  for (int r = 0; r < 16; ++r) pmax = fmaxf(pmax, p1[r]);
  { auto rr = __builtin_amdgcn_permlane32_swap(__float_as_uint(pmax), __float_as_uint(pmax), false, false);
    pmax = fmaxf(__uint_as_float(rr[0]), __uint_as_float(rr[1])); }
  if (__builtin_expect(__all(pmax - m_reg <= THR / SCALE), 1)) { mn = m_reg; alpha = 1.f; }
  else { mn = fmaxf(m_reg, pmax); alpha = __builtin_amdgcn_exp2f((m_reg - mn) * C); m_reg = mn; }
  const float mnC = -mn * C;
#pragma unroll
  for (int r = 0; r < 16; ++r) p0[r] = fmaf(p0[r], C, mnC);
#pragma unroll
  for (int r = 0; r < 16; ++r) p1[r] = fmaf(p1[r], C, mnC);
#pragma unroll
  for (int r = 0; r < 16; ++r) p0[r] = __builtin_amdgcn_exp2f(p0[r]);
}
__device__ __forceinline__ void finishSM(f32x16& p0, f32x16& p1, float alpha, float& l_reg, bf16x8& pa0, bf16x8& pa1, bf16x8& pa2, bf16x8& pa3) {
#pragma unroll
  for (int r = 0; r < 16; ++r) p1[r] = __builtin_amdgcn_exp2f(p1[r]);
  float ps = 0;
#pragma unroll
  for (int r = 0; r < 16; ++r) ps += p0[r];
#pragma unroll
  for (int r = 0; r < 16; ++r) ps += p1[r];
  { auto rr = __builtin_amdgcn_permlane32_swap(__float_as_uint(ps), __float_as_uint(ps), false, false);
    ps = __uint_as_float(rr[0]) + __uint_as_float(rr[1]); }
  l_reg = l_reg * alpha + ps;
#define ATT_PK4(P, BASE, OUT) do { unsigned a0 = cvtpk(P[BASE + 0], P[BASE + 1]), a1 = cvtpk(P[BASE + 2], P[BASE + 3]);   \
    unsigned b0 = cvtpk(P[BASE + 4], P[BASE + 5]), b1 = cvtpk(P[BASE + 6], P[BASE + 7]);                              \
    auto r0 = __builtin_amdgcn_permlane32_swap(a0, b0, false, false); auto r1 = __builtin_amdgcn_permlane32_swap(a1, b1, false, false); \
    u32x4 w = {r0[0], r1[0], r0[1], r1[1]}; OUT = *reinterpret_cast<bf16x8*>(&w); } while (0)
  ATT_PK4(p0, 0, pa0); ATT_PK4(p0, 8, pa1); ATT_PK4(p1, 0, pa2); ATT_PK4(p1, 8, pa3);
#undef ATT_PK4
}
template <int DQ, int NREG>
__device__ __forceinline__ void qkt(f32x16& p0, f32x16& p1, const char* Ks, const bf16x8* qr, const char* qpark, int r32, int hi) {
  constexpr int ROWB = Cst<DQ>::ROWB;
  p0 = f32x16{}; p1 = f32x16{};
#pragma unroll
  for (int d0 = 0; d0 < DQ / 16; ++d0) { const int cb = (d0 * 16 + hi * 8) * 2;
    bf16x8 b0 = *reinterpret_cast<const bf16x8*>(Ks + (r32 * ROWB + (cb ^ ((r32 & 7) << 4))));
    bf16x8 b1 = *reinterpret_cast<const bf16x8*>(Ks + ((32 + r32) * ROWB + (cb ^ ((r32 & 7) << 4))));
    bf16x8 q; if constexpr (true) { if (d0 < NREG) q = qr[d0 < NREG ? d0 : 0]; else q = *reinterpret_cast<const bf16x8*>(qpark + (d0 - NREG) * 1024); }
    p0 = __builtin_amdgcn_mfma_f32_32x32x16_bf16(b0, q, p0, 0, 0, 0);
    p1 = __builtin_amdgcn_mfma_f32_32x32x16_bf16(b1, q, p1, 0, 0, 0); }
}
__device__ __forceinline__ int v_st(int k, int c) { const int kk = (k & ~0xC) | ((k & 4) << 1) | ((k & 8) >> 1); return ((kk >> 3) * 4 + (c >> 5)) * 512 + ((kk & 7) * 32 + (c & 31)) * 2; }
__device__ __forceinline__ int v_rd_base(int lane) { return ((lane & 3) << 3) | (((lane >> 2) & 3) << 6) | (((lane >> 4) & 1) << 5) | (((lane >> 5) & 1) << 8); }
constexpr int v_rd_off(int d0, int ks, int half) { return d0 * 512 + ks * 4096 + half * 2048; }
template <int OFF> __device__ __forceinline__ s16x4 tr_read(int vb) {
  s16x4 r; asm volatile("ds_read_b64_tr_b16 %0, %1 offset:%2" : "=&v"(r) : "v"(vb), "i"(OFF) : "memory"); return r;
}
template <int D0> __device__ __forceinline__ void pv_one(f32x16& od, int vb, bf16x8 pa0, bf16x8 pa1, bf16x8 pa2, bf16x8 pa3) {
  const s16x4 l0 = tr_read<v_rd_off(D0, 0, 0)>(vb), h0 = tr_read<v_rd_off(D0, 0, 1)>(vb), l1 = tr_read<v_rd_off(D0, 1, 0)>(vb), h1 = tr_read<v_rd_off(D0, 1, 1)>(vb);
  const s16x4 l2 = tr_read<v_rd_off(D0, 2, 0)>(vb), h2 = tr_read<v_rd_off(D0, 2, 1)>(vb), l3 = tr_read<v_rd_off(D0, 3, 0)>(vb), h3 = tr_read<v_rd_off(D0, 3, 1)>(vb);
  asm volatile("s_waitcnt lgkmcnt(0)" ::: "memory"); ATT_SBAR();
#define ATT_PK(L, H) (bf16x8){L[0], L[1], L[2], L[3], H[0], H[1], H[2], H[3]}
  od = __builtin_amdgcn_mfma_f32_32x32x16_bf16(pa0, ATT_PK(l0, h0), od, 0, 0, 0);
  od = __builtin_amdgcn_mfma_f32_32x32x16_bf16(pa1, ATT_PK(l1, h1), od, 0, 0, 0);
  od = __builtin_amdgcn_mfma_f32_32x32x16_bf16(pa2, ATT_PK(l2, h2), od, 0, 0, 0);
  od = __builtin_amdgcn_mfma_f32_32x32x16_bf16(pa3, ATT_PK(l3, h3), od, 0, 0, 0);
#undef ATT_PK
}
__device__ __forceinline__ void pv_d0(f32x16* o, int vb, bf16x8 pa0, bf16x8 pa1, bf16x8 pa2, bf16x8 pa3) {
  pv_one<0>(o[0], vb, pa0, pa1, pa2, pa3); pv_one<1>(o[1], vb, pa0, pa1, pa2, pa3); pv_one<2>(o[2], vb, pa0, pa1, pa2, pa3); pv_one<3>(o[3], vb, pa0, pa1, pa2, pa3);
}
__device__ __forceinline__ void natten_mod(f32x16& p0, f32x16& p1, int kr, int rq, int qc, const float* biasT, int hi) {
  const int r0 = min(max(rq - 4, 0), 56), c0 = min(max(qc - 8, 0), 48);
  const float NEG = -__builtin_inff();
  if (kr < r0 || kr >= r0 + 8) {
#pragma unroll
    for (int r = 0; r < 16; ++r) { p0[r] = NEG; p1[r] = NEG; }
  } else {
    const float* bl = biasT + (kr - rq + 7) * 128 + (63 - qc + 4 * hi);
    const int t = 4 * hi - c0;
#pragma unroll
    for (int r = 0; r < 16; ++r) {
      const int kcc = (r & 3) + 8 * (r >> 2);
      const bool ok0 = (unsigned)(t + kcc) < 16u, ok1 = (unsigned)(t + kcc + 32) < 16u;
      const float b0 = bl[kcc], b1 = bl[kcc + 32];
      p0[r] = ok0 ? p0[r] + b0 : NEG; p1[r] = ok1 ? p1[r] + b1 : NEG;
      if ((r & 3) == 3) __builtin_amdgcn_sched_barrier(0);
    }
  }
}

template <int DQ, int LDQ, int LDK, int LDV, int LDO, int MODE, int SDEPTH, int NREG>
__device__ __forceinline__ void attn_body(const bf16* __restrict__ Qb, const bf16* __restrict__ Kh, const bf16* __restrict__ Vh, bf16* __restrict__ Ob, const int NT, char* lds,
                                          const int rq0, const int kr_lo, const float* biasT) {
  constexpr int SHM_K = Cst<DQ>::SHM_K, ROWB = Cst<DQ>::ROWB;
  int tid_ = threadIdx.x; asm volatile("" : "+v"(tid_));
  const int tid = tid_, wid = tid >> 6, lane = tid & 63, r32 = lane & 31, hi = lane >> 5;
  char* V_lds = lds; char* K_lds = lds + 2 * SHM_V;
  float* ws = (float*)(lds + 2 * SHM_V + 2 * SHM_K) + wid * 64; float* li_l = ws; float* al_l = ws + 32;
  float m_reg = -1e30f, l_reg = 0; f32x16 o[4] = {}; bf16x8 qr[NREG > 0 ? NREG : 1];
  const bf16* Qw = Qb + (long)(wid * QBLK + r32) * LDQ + hi * 8;
  char* qpark = lds + 2 * SHM_V + 2 * SHM_K + NW * 64 * 4 + wid * ((DQ / 16 - NREG) * 1024) + hi * 512 + r32 * 16;
#pragma unroll
  for (int d0 = 0; d0 < DQ / 16; ++d0) { const bf16x8 qv = *reinterpret_cast<const bf16x8*>(Qw + d0 * 16); if (d0 < NREG) qr[d0 < NREG ? d0 : 0] = qv; else *reinterpret_cast<bf16x8*>(qpark + (d0 - NREG) * 1024) = qv; }
  const int nrq = rq0 + (wid >> 1), nqc = (wid & 1) * 32 + r32;
  const int sr = tid >> 4, sc = (tid & 15) * 8, vst0 = v_st(sr, sc), vst1 = v_st(32 + sr, sc);
  const int kr3 = tid >> 3, kc3 = 128 + (tid & 7) * 8;
  const int vb0 = (int)(uintptr_t)V_lds + v_rd_base(lane);
  struct { bf16x8 vs0, vs1, ks0, ks1, ks2; } sr_[SDEPTH];
#define ATT_LD8(p) (*reinterpret_cast<const bf16x8*>(p))
#define ATT_SLOAD(i, k0) do { sr_[i].vs0 = ATT_LD8(&Vh[(long)((k0) + sr) * LDV + sc]); sr_[i].vs1 = ATT_LD8(&Vh[(long)((k0) + 32 + sr) * LDV + sc]); \
    sr_[i].ks0 = ATT_LD8(&Kh[(long)((k0) + sr) * LDK + sc]); sr_[i].ks1 = ATT_LD8(&Kh[(long)((k0) + 32 + sr) * LDK + sc]); \
    if constexpr (DQ == 192) sr_[i].ks2 = ATT_LD8(&Kh[(long)((k0) + kr3) * LDK + kc3]); } while (0)
#define ATT_SWRITE(b, i) do { *(bf16x8*)(V_lds + (b) * SHM_V + vst0) = sr_[i].vs0;          \
    *(bf16x8*)(V_lds + (b) * SHM_V + vst1) = sr_[i].vs1; const int kc = sc * 2;               \
    *(bf16x8*)(K_lds + (b) * SHM_K + sr * ROWB + (kc ^ ((sr & 7) << 4))) = sr_[i].ks0;                       \
    *(bf16x8*)(K_lds + (b) * SHM_K + (32 + sr) * ROWB + (kc ^ ((sr & 7) << 4))) = sr_[i].ks1; \
    if constexpr (DQ == 192) *(bf16x8*)(K_lds + (b) * SHM_K + kr3 * ROWB + ((kc3 * 2) ^ ((kr3 & 7) << 4))) = sr_[i].ks2; } while (0)
#define ATT_SWAIT() do { if constexpr (SDEPTH == 2) { if constexpr (DQ == 192) asm volatile("s_waitcnt vmcnt(5)" ::: "memory"); else asm volatile("s_waitcnt vmcnt(4)" ::: "memory"); } \
    else asm volatile("s_waitcnt vmcnt(0)" ::: "memory"); } while (0)
#define ATT_RESC(a) do { if (__any((a) < 1.f)) { if (hi == 0) al_l[r32] = (a); asm volatile("s_waitcnt lgkmcnt(0)" ::: "memory"); \
    _Pragma("unroll") for (int d = 0; d < 4; ++d) _Pragma("unroll") for (int r = 0; r < 16; ++r) o[d][r] *= al_l[crow(r, hi)]; } } while (0)
#define ATT_MOD(P0, P1, J) do { if constexpr (MODE == 1) natten_mod(P0, P1, kr_lo + (J), nrq, nqc, biasT, hi); } while (0)
  f32x16 pA0, pA1, pB0, pB1; float mnA, mnB, alA, alB; bf16x8 pa0, pa1, pa2, pa3;
  constexpr int SE = 0, SO = SDEPTH - 1;
  ATT_SLOAD(SE, 0); asm volatile("s_waitcnt vmcnt(0)" ::: "memory"); ATT_SWRITE(0, SE); __syncthreads();
  qkt<DQ, NREG>(pA0, pA1, K_lds, qr, qpark, r32, hi); ATT_MOD(pA0, pA1, 0); partialSM<DQ>(pA0, pA1, m_reg, mnA, alA);
  ATT_SLOAD(SO, KVBLK); if constexpr (SDEPTH == 2) { if (2 < NT) ATT_SLOAD(SE, 2 * KVBLK); }
  ATT_SWAIT(); ATT_SWRITE(1, SO); __syncthreads();
  for (int j = 1; j + 1 < NT; j += 2) {
    ATT_SBAR(); qkt<DQ, NREG>(pB0, pB1, K_lds + SHM_K, qr, qpark, r32, hi); ATT_MOD(pB0, pB1, j);
    finishSM(pA0, pA1, alA, l_reg, pa0, pa1, pa2, pa3); ATT_SBAR();
    ATT_SLOAD(SO, (j + SDEPTH) * KVBLK); ATT_SBAR();
    pv_d0(o, vb0, pa0, pa1, pa2, pa3); partialSM<DQ>(pB0, pB1, m_reg, mnB, alB);
    __syncthreads(); ATT_SWAIT(); ATT_SWRITE(0, SE);
    ATT_RESC(alB); __syncthreads();
    ATT_SBAR(); qkt<DQ, NREG>(pA0, pA1, K_lds, qr, qpark, r32, hi); ATT_MOD(pA0, pA1, j + 1);
    finishSM(pB0, pB1, alB, l_reg, pa0, pa1, pa2, pa3); ATT_SBAR();
    if (SDEPTH == 1 || j + 3 < NT) ATT_SLOAD(SE, (j + 1 + SDEPTH) * KVBLK); ATT_SBAR();
    pv_d0(o, vb0 + SHM_V, pa0, pa1, pa2, pa3); partialSM<DQ>(pA0, pA1, m_reg, mnA, alA);
    __syncthreads(); ATT_SWAIT(); ATT_SWRITE(1, SO);
    ATT_RESC(alA); __syncthreads();
  }
  ATT_SBAR(); qkt<DQ, NREG>(pB0, pB1, K_lds + SHM_K, qr, qpark, r32, hi); ATT_MOD(pB0, pB1, NT - 1);
  finishSM(pA0, pA1, alA, l_reg, pa0, pa1, pa2, pa3); ATT_SBAR();
  pv_d0(o, vb0, pa0, pa1, pa2, pa3); partialSM<DQ>(pB0, pB1, m_reg, mnB, alB);
  __syncthreads(); ATT_RESC(alB);
  finishSM(pB0, pB1, alB, l_reg, pa0, pa1, pa2, pa3); ATT_SBAR();
  pv_d0(o, vb0 + SHM_V, pa0, pa1, pa2, pa3);
  if (hi == 0) li_l[r32] = l_reg; asm volatile("s_waitcnt lgkmcnt(0)" ::: "memory");
  float rli[16];
#pragma unroll
  for (int r = 0; r < 16; ++r) rli[r] = __builtin_amdgcn_rcpf(li_l[crow(r, hi)]);
  bf16* Ow = Ob + (long)(wid * QBLK) * LDO;
#pragma unroll
  for (int r = 0; r < 16; ++r) { const int orow = crow(r, hi);
#pragma unroll
    for (int d0 = 0; d0 < 4; d0 += 1) { const unsigned w = cvtpk(o[d0][r] * rli[r], 0.f); Ow[(long)orow * LDO + d0 * 32 + r32] = (bf16)(w & 0xffffu); } }
#undef ATT_LD8
#undef ATT_SLOAD
#undef ATT_SWRITE
#undef ATT_SWAIT
#undef ATT_RESC
#undef ATT_MOD
}
}

#ifndef PH_MASK
#define PH_MASK 0xFFFFFFFFu
#endif
#define PHON(k) (((PH_MASK) >> (k)) & 1u)
constexpr int NWAVES = 8;
constexpr int DM = 2048, BATCH = 4, SEQ = 4096, NTOK = BATCH * SEQ, DEPTH = 2;
constexpr int DIN = 3904, DINP = 4096;
constexpr int DFF = 5632, NE = 8, DFE = 7168;
constexpr int PC_QA = 0, PC_KA = 512, PC_VA = 1024, PC_QB = 1536, PC_KB = 2560, PC_VB = 2816, PC_CQ = 3072, PC_CKV = 3584, PC_KPE = 3840;
constexpr float EPS = 1e-6f;
constexpr int MAXTILES = 136;
constexpr int MAXSLOTS = MAXTILES * 256;

constexpr size_t MiB = 1u << 20;
constexpr size_t WS_CTL = 0, CTL_ZERO_BYTES = 1 * MiB;
constexpr size_t WS_WIN = 1 * MiB;
constexpr size_t WS_WUQ = WS_WIN + 32 * MiB;
constexpr size_t WS_WUKV = WS_WUQ + 2 * MiB;
constexpr size_t WS_WOUT = WS_WUKV + 1 * MiB;
constexpr size_t WS_WGU = WS_WOUT + 16 * MiB;
constexpr size_t WS_WD = WS_WGU + 44 * MiB;
constexpr size_t WS_WEGU = WS_WD + 22 * MiB;
constexpr size_t WS_WED = WS_WEGU + 448 * MiB;
constexpr size_t WS_H = WS_WED + 224 * MiB;
constexpr size_t WS_ACT0 = WS_H + 64 * MiB;
constexpr size_t WS_PROJ = WS_ACT0;
constexpr size_t WS_QA = WS_PROJ + 128 * MiB;
constexpr size_t WS_KA = WS_QA + 16 * MiB;
constexpr size_t WS_QB = WS_KA + 16 * MiB;
constexpr size_t WS_KB = WS_QB + 32 * MiB;
constexpr size_t WS_CQN = WS_KB + 8 * MiB;
constexpr size_t WS_CKVN = WS_CQN + 16 * MiB;
constexpr size_t WS_KPE = WS_CKVN + 8 * MiB;
constexpr size_t WS_QCR = WS_KPE + 2 * MiB;
constexpr size_t WS_KVR = WS_QCR + 24 * MiB;
constexpr size_t WS_QC = WS_KVR + 32 * MiB;
constexpr size_t WS_KC = WS_QC + 24 * MiB;
constexpr size_t WS_O = WS_KC + 24 * MiB;
constexpr size_t WS_ON = WS_O + 64 * MiB;
constexpr size_t WS_ATT_END = WS_ON + 64 * MiB;
constexpr size_t WS_ACT = WS_ACT0;
constexpr size_t WS_HG = WS_ACT0;
constexpr size_t WS_ACTM = WS_HG + 136 * MiB;
constexpr size_t WS_Y = WS_ACTM + 476 * MiB;
constexpr size_t WS_RGATE = WS_Y + 136 * MiB;
constexpr size_t WS_TOKE = WS_RGATE + 1 * MiB;
constexpr size_t WS_TOKP = WS_TOKE + 1 * MiB;
constexpr size_t WS_TOKW = WS_TOKP + 1 * MiB;
constexpr size_t WS_END = WS_TOKW + 1 * MiB;
static_assert(WS_ATT_END <= WS_END, "map");
constexpr int CW_CNT = 64;
constexpr int CW_BAR = 4096;

constexpr int RING_BYTES = 131072;
constexpr int LDS_BYTES = 147456;
constexpr int MISC_OFF = LDS_BYTES - 256;

#define GAS __attribute__((address_space(1)))
#define LAS __attribute__((address_space(3)))
typedef unsigned short bf16;
typedef unsigned v4u __attribute__((ext_vector_type(4)));
typedef unsigned v2u __attribute__((ext_vector_type(2)));
typedef float f32x4 __attribute__((ext_vector_type(4)));
typedef float f32x2 __attribute__((ext_vector_type(2)));
__device__ __forceinline__ unsigned pk2(float lo, float hi) { unsigned r; asm volatile("v_cvt_pk_bf16_f32 %0, %1, %2" : "=v"(r) : "v"(lo), "v"(hi)); return r; }
__device__ __forceinline__ float bf_lo(unsigned w) { return __uint_as_float(w << 16); }
__device__ __forceinline__ float bf_hi(unsigned w) { return __uint_as_float(w & 0xffff0000u); }
__device__ __forceinline__ float wave_sum(float v) {
#pragma unroll
    for (int o = 1; o < 64; o <<= 1) v += __shfl_xor(v, o);
    return v;
}
__device__ __forceinline__ float rsq(float x) { return __builtin_amdgcn_rsqf(x); }
#define XB_TMO      128
#define XB_XCNT(j)  (256  + 64 * (j))
#define XB_XSUB(j)  (1280 + 64 * (j))
#define XB_XGEN(j)  (2304 + 64 * (j))
#define XB_TOP      3328
#define XB_TOPGEN   3392
#define XCD_BAR_WORDS 3456
#define XB_SPIN_CAP (1u << 18)

__device__ __forceinline__ unsigned xb_ld(unsigned* p)              { return __hip_atomic_load(p, __ATOMIC_RELAXED, __HIP_MEMORY_SCOPE_AGENT); }
__device__ __forceinline__ unsigned xb_add(unsigned* p, unsigned v) { return __hip_atomic_fetch_add(p, v, __ATOMIC_RELAXED, __HIP_MEMORY_SCOPE_AGENT); }
__device__ __forceinline__ unsigned xb_xcc_id() { return (unsigned)__builtin_amdgcn_s_getreg((3 << 11) | 20) & 0xFu; }
#define XB_SPIN(cond, bar) do { unsigned _sp = 0; while (cond) { __builtin_amdgcn_s_sleep(1); \
    if ((++_sp & 255u) == 0u) { if (xb_ld(&(bar)[XB_TMO])) break; if (_sp > XB_SPIN_CAP) { atomicAdd(&(bar)[XB_TMO], 1u); break; } } } } while (0)

struct XcdBarrier {
    unsigned* bar; unsigned x;
    volatile LAS unsigned* st;
};

__device__ __forceinline__ XcdBarrier xcd_barrier_post(unsigned* bar, volatile LAS unsigned* st) {
    XcdBarrier b; b.bar = bar; b.x = xb_xcc_id(); b.st = st;
    if (threadIdx.x == 0) (void)xb_add(&bar[XB_XCNT(b.x)], 1u);
    return b;
}
__device__ __forceinline__ void xcd_barrier_complete(unsigned* bar, unsigned x, unsigned& nloc, unsigned& nx) {
    const unsigned G = gridDim.x * gridDim.y * gridDim.z;
    unsigned sum, cnt, mine, sp = 0u;
    for (;;) {
        sum = 0u; cnt = 0u; mine = 0u;
#pragma unroll
        for (unsigned j = 0; j < 16; ++j) { const unsigned c = xb_ld(&bar[XB_XCNT(j)]); sum += c; cnt += (c > 0u) ? 1u : 0u; mine = (j == x) ? c : mine; }
        if (sum == G) break;
        __builtin_amdgcn_s_sleep(1);
        if ((++sp & 255u) == 0u) { if (xb_ld(&bar[XB_TMO])) break; if (sp > XB_SPIN_CAP) { atomicAdd(&bar[XB_TMO], 1u); break; } }
    }
    nloc = mine > 0u ? mine : 1u; nx = cnt > 0u ? cnt : 1u;
}

__device__ __forceinline__ void xcd_barrier(const XcdBarrier& b) {
    asm volatile("s_waitcnt vmcnt(0)" ::: "memory");
    __syncthreads();
    if (threadIdx.x == 0) {
        unsigned* bar = b.bar;
        __builtin_amdgcn_s_waitcnt(0);
        unsigned nloc = b.st[0], nx = b.st[1];
        if (nloc == 0u) { xcd_barrier_complete(bar, b.x, nloc, nx); b.st[0] = nloc; b.st[1] = nx; }
        const unsigned old = xb_add(&bar[XB_XSUB(b.x)], 1u);
        const unsigned gen = old / nloc;
        if (old + 1u == (gen + 1u) * nloc) {
            __builtin_amdgcn_fence(__ATOMIC_RELEASE, "agent");
            asm volatile("s_waitcnt vmcnt(0)" ::: "memory");
            const unsigned og = xb_add(&bar[XB_TOP], 1u);
            const unsigned tg = og / nx;
            if (og + 1u == (tg + 1u) * nx) xb_add(&bar[XB_TOPGEN], 1u);
            else XB_SPIN(xb_ld(&bar[XB_TOPGEN]) == tg, bar);
            __builtin_amdgcn_fence(__ATOMIC_ACQUIRE, "agent");
            xb_add(&bar[XB_XGEN(b.x)], 1u);
            asm volatile("s_waitcnt vmcnt(0)" ::: "memory");
        } else {
            XB_SPIN(xb_ld(&bar[XB_XGEN(b.x)]) == gen, bar);
            __builtin_amdgcn_fence(__ATOMIC_ACQUIRE, "agent");
            asm volatile("s_waitcnt vmcnt(0)" ::: "memory");
        }
    }
    __syncthreads();
}

struct Args { const float* in[26]; float* out; unsigned char* ws; int ph_lo, ph_hi; };
enum { I_X = 0, I_MIXN, I_WIN, I_RPB, I_QNA, I_KNA, I_QNB, I_KNB, I_CQN, I_CKVN, I_WUQ, I_WUKV, I_QNC, I_KNC, I_ONA, I_ONB, I_ONC, I_WOUT, I_FFNN, I_WG, I_WU, I_WDN, I_ROUTER, I_WEG, I_WEU, I_WED };
struct Frame {
    LAS unsigned char* lds; unsigned char* ws; unsigned* ctl;
    int wave, G, bid, gw, ngw;
};

__device__ __forceinline__ void transpose_item(const float* __restrict__ W, int K, int N, bf16* __restrict__ WT, int row_off, int mode, LAS float* scr, int item, int lane) {
    const int nblk = N >> 6, kb = item / nblk, nb = item - kb * nblk, k0 = kb << 6, n0 = nb << 6;
    const int lk = lane >> 4, ln = (lane & 15) << 2;
    f32x4 v[16];
#pragma unroll
    for (int i = 0; i < 16; ++i) v[i] = *(const f32x4*)(W + (size_t)(k0 + lk + 4 * i) * N + n0 + ln);
#pragma unroll
    for (int i = 0; i < 16; ++i) { LAS float* s = scr + (lk + 4 * i) * 65 + ln; s[0] = v[i][0]; s[1] = v[i][1]; s[2] = v[i][2]; s[3] = v[i][3]; }
    asm volatile("s_waitcnt lgkmcnt(0)" ::: "memory");
    const int drow0 = (mode == 0) ? (row_off + n0) : (row_off + (n0 >> 7) * 256 + (mode - 1) * 128 + (n0 & 127));
    const int c = lane & 7;
#pragma unroll
    for (int j = 0; j < 8; ++j) { const int n = 8 * j + (lane >> 3); const LAS float* s = scr + (8 * c) * 65 + n;
        v4u o; o.x = pk2(s[0 * 65], s[1 * 65]); o.y = pk2(s[2 * 65], s[3 * 65]); o.z = pk2(s[4 * 65], s[5 * 65]); o.w = pk2(s[6 * 65], s[7 * 65]);
        *(v4u*)(WT + (size_t)(drow0 + n) * K + k0 + 8 * c) = o; }
    asm volatile("s_waitcnt lgkmcnt(0)" ::: "memory");
}

__device__ __forceinline__ void phase_rmsnorm(const Frame& F, const float* __restrict__ src, const float* __restrict__ gain, bf16* __restrict__ dst) {
    int tid_ = threadIdx.x; asm volatile("" : "+v"(tid_)); const int tid = tid_, lane = tid & 63; (void)tid; (void)lane;
    f32x4 g[8];
#pragma unroll
    for (int j = 0; j < 8; ++j) g[j] = ((const f32x4*)gain)[64 * j + lane];
    for (int m = F.gw; m < NTOK; m += F.ngw) {
        const f32x4* xr = (const f32x4*)(src + (size_t)m * DM) + lane; f32x4 v[8]; float s = 0.f;
#pragma unroll
        for (int j = 0; j < 8; ++j) { v[j] = xr[64 * j]; s += (v[j][0] * v[j][0] + v[j][1] * v[j][1]) + (v[j][2] * v[j][2] + v[j][3] * v[j][3]); }
        const float rstd = rsq(wave_sum(s) * (1.f / DM) + EPS);
        v2u* o8 = (v2u*)(dst + (size_t)m * DM) + lane;
#pragma unroll
        for (int j = 0; j < 8; ++j) { v2u w; w.x = pk2(v[j][0] * rstd * g[j][0], v[j][1] * rstd * g[j][1]); w.y = pk2(v[j][2] * rstd * g[j][2], v[j][3] * rstd * g[j][3]); o8[64 * j] = w; }
    }
}

__device__ __forceinline__ float rope_apply(float v, float c, float s, float sgn) { const float p = __shfl_xor(v, 16); return v * c + sgn * p * s; }
__device__ __forceinline__ void sincos_rev(float ang, float& s, float& c) { const float r = ang * 0.15915494309189535f; const float f = r - floorf(r); s = __builtin_amdgcn_sinf(f); c = __builtin_amdgcn_cosf(f); }

__device__ __forceinline__ void phase_postproj(const Frame& F, const Args& a, int l) {
    int tid_ = threadIdx.x; asm volatile("" : "+v"(tid_)); const int tid = tid_, lane = tid & 63; (void)tid; (void)lane;
    const bf16* PROJ = (const bf16*)(F.ws + WS_PROJ);
    bf16* QA = (bf16*)(F.ws + WS_QA); bf16* KA = (bf16*)(F.ws + WS_KA); bf16* QB = (bf16*)(F.ws + WS_QB); bf16* KB = (bf16*)(F.ws + WS_KB);
    bf16* CQN = (bf16*)(F.ws + WS_CQN); bf16* CKVN = (bf16*)(F.ws + WS_CKVN); bf16* KPE = (bf16*)(F.ws + WS_KPE);
    const f32x2 gqa = ((const f32x2*)(a.in[I_QNA] + l * 128))[lane], gka = ((const f32x2*)(a.in[I_KNA] + l * 128))[lane];
    const f32x2 gqb = ((const f32x2*)(a.in[I_QNB] + l * 128))[lane], gkb = ((const f32x2*)(a.in[I_KNB] + l * 128))[lane];
    const f32x4 gcq0 = ((const f32x4*)(a.in[I_CQN] + l * 512))[2 * lane], gcq1 = ((const f32x4*)(a.in[I_CQN] + l * 512))[2 * lane + 1];
    const f32x4 gckv = ((const f32x4*)(a.in[I_CKVN] + l * 256))[lane];
    const float gkpe = a.in[I_KNC][l * 192 + 128 + lane];
    constexpr float LOG2T = 13.287712379549449f;
    const int q = lane & 15;
    const float f128a = __builtin_amdgcn_exp2f(-(float)(2 * q) * (LOG2T / 32.f)), f128b = __builtin_amdgcn_exp2f(-(float)(2 * q + 1) * (LOG2T / 32.f));
    const float f64 = __builtin_amdgcn_exp2f(-(float)q * (LOG2T / 16.f));
    const float sgn = (lane & 16) ? 1.f : -1.f;
    for (int t = F.gw; t < NTOK; t += F.ngw) {
        const int pos = t & (SEQ - 1); const float p = (float)((lane & 32) ? (pos & 63) : (pos >> 6));
        float s0, c0, s1, c1, s2, c2; sincos_rev(p * f128a, s0, c0); sincos_rev(p * f128b, s1, c1); sincos_rev(p * f64, s2, c2);
        const bf16* pr = PROJ + (size_t)t * DINP;
        unsigned hv[18];
#pragma unroll
        for (int i = 0; i < 8; ++i) hv[i] = ((const unsigned*)(pr + i * 128))[lane];
#pragma unroll
        for (int i = 8; i < 18; ++i) hv[i] = ((const unsigned*)(pr + PC_QB + (i - 8) * 128))[lane];
        const v4u cqv = ((const v4u*)(pr + PC_CQ))[lane]; const v2u ckvv = ((const v2u*)(pr + PC_CKV))[lane]; const unsigned kpev = (unsigned)pr[PC_KPE + lane];
#pragma unroll
        for (int i = 0; i < 18; ++i) {
            float v0 = bf_lo(hv[i]), v1 = bf_hi(hv[i]);
            const float rstd = rsq(wave_sum(v0 * v0 + v1 * v1) * (1.f / 128.f) + EPS);
            const f32x2 g = (i < 4) ? gqa : (i < 8) ? gka : (i < 16) ? gqb : gkb;
            v0 = v0 * rstd * g[0]; v1 = v1 * rstd * g[1];
            if (i >= 8) { v0 = rope_apply(v0, c0, s0, sgn); v1 = rope_apply(v1, c1, s1, sgn); }
            bf16* dst = (i < 4) ? (QA + (size_t)t * 512 + i * 128) : (i < 8) ? (KA + (size_t)t * 512 + (i - 4) * 128) : (i < 16) ? (QB + (size_t)t * 1024 + (i - 8) * 128) : (KB + (size_t)t * 256 + (i - 16) * 128);
            ((unsigned*)dst)[lane] = pk2(v0, v1);
        }
        {
            float x[8] = {bf_lo(cqv.x), bf_hi(cqv.x), bf_lo(cqv.y), bf_hi(cqv.y), bf_lo(cqv.z), bf_hi(cqv.z), bf_lo(cqv.w), bf_hi(cqv.w)}; float s = 0.f;
#pragma unroll
            for (int i = 0; i < 8; ++i) s += x[i] * x[i];
            const float rstd = rsq(wave_sum(s) * (1.f / 512.f) + EPS);
            v4u w; w.x = pk2(x[0] * rstd * gcq0[0], x[1] * rstd * gcq0[1]); w.y = pk2(x[2] * rstd * gcq0[2], x[3] * rstd * gcq0[3]);
            w.z = pk2(x[4] * rstd * gcq1[0], x[5] * rstd * gcq1[1]); w.w = pk2(x[6] * rstd * gcq1[2], x[7] * rstd * gcq1[3]);
            ((v4u*)(CQN + (size_t)t * 512))[lane] = w;
        }
        {
            const float x0 = bf_lo(ckvv.x), x1 = bf_hi(ckvv.x), x2 = bf_lo(ckvv.y), x3 = bf_hi(ckvv.y);
            const float rstd = rsq(wave_sum((x0 * x0 + x1 * x1) + (x2 * x2 + x3 * x3)) * (1.f / 256.f) + EPS);
            v2u w; w.x = pk2(x0 * rstd * gckv[0], x1 * rstd * gckv[1]); w.y = pk2(x2 * rstd * gckv[2], x3 * rstd * gckv[3]);
            ((v2u*)(CKVN + (size_t)t * 256))[lane] = w;
        }
        {
            float x = bf_lo(kpev);
            const float rstd = rsq(wave_sum(x * x) * (1.f / 64.f) + EPS);
            x = rope_apply(x * rstd * gkpe, c2, s2, sgn);
            KPE[(size_t)t * 64 + lane] = (bf16)(pk2(x, 0.f) & 0xffffu);
        }
    }
}

__device__ __forceinline__ void phase_postmla(const Frame& F, const Args& a, int l) {
    int tid_ = threadIdx.x; asm volatile("" : "+v"(tid_)); const int tid = tid_, lane = tid & 63; (void)tid; (void)lane;
    const bf16* QCR = (const bf16*)(F.ws + WS_QCR); const bf16* KVR = (const bf16*)(F.ws + WS_KVR); const bf16* KPE = (const bf16*)(F.ws + WS_KPE);
    bf16* QC = (bf16*)(F.ws + WS_QC); bf16* KC = (bf16*)(F.ws + WS_KC);
    const f32x2 gqn = ((const f32x2*)(a.in[I_QNC] + l * 192))[lane], gkn = ((const f32x2*)(a.in[I_KNC] + l * 192))[lane];
    const float gqpe = a.in[I_QNC][l * 192 + 128 + lane];
    constexpr float LOG2T = 13.287712379549449f;
    const float f64 = __builtin_amdgcn_exp2f(-(float)(lane & 15) * (LOG2T / 16.f));
    const float sgn = (lane & 16) ? 1.f : -1.f;
    for (int t = F.gw; t < NTOK; t += F.ngw) {
        const int pos = t & (SEQ - 1); const float p = (float)((lane & 32) ? (pos & 63) : (pos >> 6));
        float s2, c2; sincos_rev(p * f64, s2, c2);
        const bf16* qr = QCR + (size_t)t * 768; const bf16* kr = KVR + (size_t)t * 1024;
        unsigned qn[4], kn[4]; unsigned qp[4];
#pragma unroll
        for (int h = 0; h < 4; ++h) { qn[h] = ((const unsigned*)(qr + h * 192))[lane]; qp[h] = (unsigned)qr[h * 192 + 128 + lane]; kn[h] = ((const unsigned*)(kr + h * 256))[lane]; }
        const bf16 kpe = KPE[(size_t)t * 64 + lane];
#pragma unroll
        for (int h = 0; h < 4; ++h) {
            { float v0 = bf_lo(qn[h]), v1 = bf_hi(qn[h]); const float rstd = rsq(wave_sum(v0 * v0 + v1 * v1) * (1.f / 128.f) + EPS);
              ((unsigned*)(QC + (size_t)t * 768 + h * 192))[lane] = pk2(v0 * rstd * gqn[0], v1 * rstd * gqn[1]); }
            { float x = bf_lo(qp[h]); const float rstd = rsq(wave_sum(x * x) * (1.f / 64.f) + EPS); x = rope_apply(x * rstd * gqpe, c2, s2, sgn);
              QC[(size_t)t * 768 + h * 192 + 128 + lane] = (bf16)(pk2(x, 0.f) & 0xffffu); }
            { float v0 = bf_lo(kn[h]), v1 = bf_hi(kn[h]); const float rstd = rsq(wave_sum(v0 * v0 + v1 * v1) * (1.f / 128.f) + EPS);
              ((unsigned*)(KC + (size_t)t * 768 + h * 192))[lane] = pk2(v0 * rstd * gkn[0], v1 * rstd * gkn[1]); }
            KC[(size_t)t * 768 + h * 192 + 128 + lane] = kpe;
        }
    }
}

__device__ __forceinline__ void phase_groupnorm(const Frame& F, const Args& a, int l) {
    int tid_ = threadIdx.x; asm volatile("" : "+v"(tid_)); const int tid = tid_, lane = tid & 63; (void)tid; (void)lane;
    const bf16* O = (const bf16*)(F.ws + WS_O); bf16* ON = (bf16*)(F.ws + WS_ON);
    f32x4 g[4][2];
    { const f32x4* ga = (const f32x4*)(a.in[I_ONA] + l * 512); const f32x4* gb = (const f32x4*)(a.in[I_ONB] + l * 1024); const f32x4* gc = (const f32x4*)(a.in[I_ONC] + l * 512);
      g[0][0] = ga[2 * lane]; g[0][1] = ga[2 * lane + 1]; g[1][0] = gb[2 * lane]; g[1][1] = gb[2 * lane + 1]; g[2][0] = gb[128 + 2 * lane]; g[2][1] = gb[128 + 2 * lane + 1]; g[3][0] = gc[2 * lane]; g[3][1] = gc[2 * lane + 1]; }
    for (int t = F.gw; t < NTOK; t += F.ngw) {
        const v4u* orow = (const v4u*)(O + (size_t)t * DM) + lane; float x[4][8]; float ss[4];
#pragma unroll
        for (int j = 0; j < 4; ++j) { const v4u w = orow[64 * j]; x[j][0] = bf_lo(w.x); x[j][1] = bf_hi(w.x); x[j][2] = bf_lo(w.y); x[j][3] = bf_hi(w.y); x[j][4] = bf_lo(w.z); x[j][5] = bf_hi(w.z); x[j][6] = bf_lo(w.w); x[j][7] = bf_hi(w.w);
            float s = 0.f;
#pragma unroll
            for (int i = 0; i < 8; ++i) s += x[j][i] * x[j][i];
            ss[j] = s; }
        const float ra = rsq(wave_sum(ss[0]) * (1.f / 512.f) + EPS), rb = rsq(wave_sum(ss[1] + ss[2]) * (1.f / 1024.f) + EPS), rc = rsq(wave_sum(ss[3]) * (1.f / 512.f) + EPS);
        v4u* nrow = (v4u*)(ON + (size_t)t * DM) + lane;
#pragma unroll
        for (int j = 0; j < 4; ++j) { const float r = (j == 0) ? ra : (j == 3) ? rc : rb; v4u w;
            w.x = pk2(x[j][0] * r * g[j][0][0], x[j][1] * r * g[j][0][1]); w.y = pk2(x[j][2] * r * g[j][0][2], x[j][3] * r * g[j][0][3]);
            w.z = pk2(x[j][4] * r * g[j][1][0], x[j][5] * r * g[j][1][1]); w.w = pk2(x[j][6] * r * g[j][1][2], x[j][7] * r * g[j][1][3]); nrow[64 * j] = w; }
    }
}

constexpr int ROUTER_LDS = 0;
constexpr int MOE_LDS_CNT = 65536;
constexpr int MOE_LDS_REC = 65536 + 64;
__device__ __forceinline__ void phase_ffnnorm_route(const Frame& F, const Args& a, const float* __restrict__ src, const float* __restrict__ gain, bf16* __restrict__ dst) {
    int tid_ = threadIdx.x; asm volatile("" : "+v"(tid_)); const int tid = tid_, lane = tid & 63; (void)tid; (void)lane;
    LAS float* rt = (LAS float*)(F.lds + ROUTER_LDS); LAS unsigned* lcnt = (LAS unsigned*)(F.lds + MOE_LDS_CNT); LAS int* rec = (LAS int*)(F.lds + MOE_LDS_REC);
    const float* router = a.in[I_ROUTER];
    for (int i = tid; i < DM * NE / 4; i += NWAVES * 64) ((LAS f32x4*)rt)[i] = ((const f32x4*)router)[i];
    if (tid < 16) lcnt[tid] = 0u;
    __syncthreads();
    const int t0 = (int)(((long)F.bid * NTOK) / F.G), t1 = (int)(((long)(F.bid + 1) * NTOK) / F.G);
    f32x4 g[8];
#pragma unroll
    for (int j = 0; j < 8; ++j) g[j] = ((const f32x4*)gain)[64 * j + lane];
    for (int m = t0 + F.wave; m < t1; m += NWAVES) {
        const f32x4* xr = (const f32x4*)(src + (size_t)m * DM) + lane; f32x4 v[8]; float s = 0.f;
#pragma unroll
        for (int j = 0; j < 8; ++j) { v[j] = xr[64 * j]; s += (v[j][0] * v[j][0] + v[j][1] * v[j][1]) + (v[j][2] * v[j][2] + v[j][3] * v[j][3]); }
        const float rstd = rsq(wave_sum(s) * (1.f / DM) + EPS);
        v2u* o8 = (v2u*)(dst + (size_t)m * DM) + lane;
        float lg[8] = {0.f, 0.f, 0.f, 0.f, 0.f, 0.f, 0.f, 0.f};
#pragma unroll
        for (int j = 0; j < 8; ++j) {
            f32x4 h; h[0] = v[j][0] * rstd * g[j][0]; h[1] = v[j][1] * rstd * g[j][1]; h[2] = v[j][2] * rstd * g[j][2]; h[3] = v[j][3] * rstd * g[j][3];
            v2u w; w.x = pk2(h[0], h[1]); w.y = pk2(h[2], h[3]); o8[64 * j] = w;
            const int k0 = 256 * j + 4 * lane;
#pragma unroll
            for (int i = 0; i < 4; ++i) { const f32x4 r0 = ((const LAS f32x4*)(rt + (k0 + i) * 8))[0], r1 = ((const LAS f32x4*)(rt + (k0 + i) * 8))[1];
                lg[0] += h[i] * r0[0]; lg[1] += h[i] * r0[1]; lg[2] += h[i] * r0[2]; lg[3] += h[i] * r0[3]; lg[4] += h[i] * r1[0]; lg[5] += h[i] * r1[1]; lg[6] += h[i] * r1[2]; lg[7] += h[i] * r1[3]; }
        }
#pragma unroll
        for (int e = 0; e < 8; ++e) lg[e] = wave_sum(lg[e]);
        int e0 = 0; float v0 = lg[0];
#pragma unroll
        for (int e = 1; e < 8; ++e) if (lg[e] > v0) { v0 = lg[e]; e0 = e; }
        int e1 = -1; float v1 = -3.0e38f;
#pragma unroll
        for (int e = 0; e < 8; ++e) if (e != e0 && lg[e] > v1) { v1 = lg[e]; e1 = e; }
        const float ex = __expf(v1 - v0), w0 = 1.f / (1.f + ex), w1 = ex * w0;
        if (lane == 0) { const int li = m - t0; const unsigned p0 = atomicAdd((unsigned*)&lcnt[e0], 1u), p1 = atomicAdd((unsigned*)&lcnt[e1], 1u);
            rec[li * 6 + 0] = e0; rec[li * 6 + 1] = e1; rec[li * 6 + 2] = (int)p0; rec[li * 6 + 3] = (int)p1; ((LAS float*)rec)[li * 6 + 4] = w0; ((LAS float*)rec)[li * 6 + 5] = w1; }
    }
    __syncthreads();
    if (tid < 8) lcnt[8 + tid] = __hip_atomic_fetch_add(F.ctl + CW_CNT + tid, lcnt[tid], __ATOMIC_RELAXED, __HIP_MEMORY_SCOPE_AGENT);
    __syncthreads();
    int* toke = (int*)(F.ws + WS_TOKE); int* tokp = (int*)(F.ws + WS_TOKP); float* tokw = (float*)(F.ws + WS_TOKW);
    for (int i = tid; i < (t1 - t0) * 2; i += NWAVES * 64) { const int li = i >> 1, k = i & 1, e = rec[li * 6 + k];
        toke[(size_t)(t0 + li) * 2 + k] = e; tokp[(size_t)(t0 + li) * 2 + k] = rec[li * 6 + 2 + k] + (int)lcnt[8 + e]; tokw[(size_t)(t0 + li) * 2 + k] = ((LAS float*)rec)[li * 6 + 4 + k]; }
    __syncthreads();
}
__device__ __forceinline__ void moe_tiles(const Frame& F, int (&tb)[9], int (&cnt)[8]) {
    int acc = 0;
#pragma unroll
    for (int e = 0; e < 8; ++e) { cnt[e] = (int)__hip_atomic_load(F.ctl + CW_CNT + e, __ATOMIC_RELAXED, __HIP_MEMORY_SCOPE_AGENT); tb[e] = acc; acc += (cnt[e] + 255) >> 8; }
    tb[8] = acc;
}
__device__ __forceinline__ void phase_gather(const Frame& F) {
    int tid_ = threadIdx.x; asm volatile("" : "+v"(tid_)); const int tid = tid_, lane = tid & 63; (void)tid; (void)lane;
    int tb[9], cnt[8]; moe_tiles(F, tb, cnt);
    const bf16* H = (const bf16*)(F.ws + WS_H); bf16* HG = (bf16*)(F.ws + WS_HG); float* rg = (float*)(F.ws + WS_RGATE);
    const int* toke = (const int*)(F.ws + WS_TOKE); int* tokp = (int*)(F.ws + WS_TOKP); const float* tokw = (const float*)(F.ws + WS_TOKW);
    for (int t = F.gw; t < NTOK; t += F.ngw) {
        const v4u* hr = (const v4u*)(H + (size_t)t * DM) + lane; v4u v[4];
#pragma unroll
        for (int j = 0; j < 4; ++j) v[j] = hr[64 * j];
#pragma unroll
        for (int k = 0; k < 2; ++k) { const int e = toke[(size_t)t * 2 + k], p = tokp[(size_t)t * 2 + k]; int base = 0;
#pragma unroll
            for (int q = 0; q < 8; ++q) base = (q == e) ? tb[q] : base;
            const int slot = base * 256 + p; v4u* dr = (v4u*)(HG + (size_t)slot * DM) + lane;
#pragma unroll
            for (int j = 0; j < 4; ++j) dr[64 * j] = v[j];
            if (lane == 0) { rg[slot] = tokw[(size_t)t * 2 + k]; tokp[(size_t)t * 2 + k] = slot; } }
    }
#pragma unroll
    for (int e = 0; e < 8; ++e) { const int r0 = tb[e] * 256 + cnt[e], r1 = tb[e + 1] * 256;
        for (int r = r0 + F.gw; r < r1; r += F.ngw) { v4u* dr = (v4u*)(HG + (size_t)r * DM) + lane; const v4u z = {0u, 0u, 0u, 0u};
#pragma unroll
            for (int j = 0; j < 4; ++j) dr[64 * j] = z;
            if (lane == 0) rg[r] = 0.f; } }
}
__device__ __forceinline__ void phase_combine(const Frame& F, float* __restrict__ out) {
    int tid_ = threadIdx.x; asm volatile("" : "+v"(tid_)); const int tid = tid_, lane = tid & 63; (void)tid; (void)lane;
    const bf16* Y = (const bf16*)(F.ws + WS_Y); const int* tokp = (const int*)(F.ws + WS_TOKP);
    for (int t = F.gw; t < NTOK; t += F.ngw) {
        const int s0 = tokp[(size_t)t * 2], s1 = tokp[(size_t)t * 2 + 1];
        const v4u* y0 = (const v4u*)(Y + (size_t)s0 * DM) + lane; const v4u* y1 = (const v4u*)(Y + (size_t)s1 * DM) + lane;
        f32x4* xr = (f32x4*)(out + (size_t)t * DM) + 2 * lane;
#pragma unroll
        for (int j = 0; j < 4; ++j) { const v4u p = y0[64 * j], q = y1[64 * j]; f32x4 xa = xr[128 * j], xb = xr[128 * j + 1];
            xa[0] += bf_lo(p.x) + bf_lo(q.x); xa[1] += bf_hi(p.x) + bf_hi(q.x); xa[2] += bf_lo(p.y) + bf_lo(q.y); xa[3] += bf_hi(p.y) + bf_hi(q.y);
            xb[0] += bf_lo(p.z) + bf_lo(q.z); xb[1] += bf_hi(p.z) + bf_hi(q.z); xb[2] += bf_lo(p.w) + bf_lo(q.w); xb[3] += bf_hi(p.w) + bf_hi(q.w);
            xr[128 * j] = xa; xr[128 * j + 1] = xb; }
    }
}

__device__ __forceinline__ void phase_attention(const Frame& F, const Args& a, int l) {
    int tid_ = threadIdx.x; asm volatile("" : "+v"(tid_)); const int tid = tid_, lane = tid & 63; (void)tid; (void)lane;
    const bf16* PROJ = (const bf16*)(F.ws + WS_PROJ);
    const bf16* QA = (const bf16*)(F.ws + WS_QA); const bf16* KA = (const bf16*)(F.ws + WS_KA); const bf16* QB = (const bf16*)(F.ws + WS_QB); const bf16* KB = (const bf16*)(F.ws + WS_KB);
    const bf16* KVR = (const bf16*)(F.ws + WS_KVR); const bf16* QC = (const bf16*)(F.ws + WS_QC); const bf16* KC = (const bf16*)(F.ws + WS_KC);
    bf16* O = (bf16*)(F.ws + WS_O);
    char* L = (char*)F.lds;
    if (PHON(16)) for (int Lu = F.bid; Lu < 256; Lu += F.G) {
        const int id = (Lu & 7) * 32 + (Lu >> 3), b = id >> 6, h = (id >> 4) & 3, qb = id & 15; const size_t tq = (size_t)b * SEQ + qb * 256, tk = (size_t)b * SEQ;
        att::attn_body<192, 768, 768, 1024, 2048, 0, 1, 8>(QC + tq * 768 + h * 192, KC + tk * 768 + h * 192, KVR + tk * 1024 + h * 256 + 128, O + tq * DM + 1536 + h * 128, SEQ / 64, L, 0, 0, nullptr);
    }
    if (PHON(17)) for (int Lu = F.bid; Lu < 512; Lu += F.G) {
        const int id = (Lu & 7) * 64 + (Lu >> 3), b = id >> 7, kvh = (id >> 6) & 1, g = (id >> 4) & 3, qb = id & 15, h = kvh * 4 + g; const size_t tq = (size_t)b * SEQ + qb * 256, tk = (size_t)b * SEQ;
        att::attn_body<128, 1024, 256, 4096, 2048, 0, 1, 8>(QB + tq * 1024 + h * 128, KB + tk * 256 + kvh * 128, PROJ + tk * DINP + PC_VB + kvh * 128, O + tq * DM + 512 + h * 128, SEQ / 64, L, 0, 0, nullptr);
    }
    float* biasT = (float*)(L + 136 * 1024);
    if (PHON(18)) for (int Lu = F.bid; Lu < 256; Lu += F.G) {
        const int id = (Lu & 7) * 32 + (Lu >> 3), b = id >> 6, h = (id >> 4) & 3, rb = id & 15; const size_t tq = (size_t)b * SEQ + rb * 256;
        int lo = min(max(rb * 4 - 4, 0), 56), hi = min(max(rb * 4 + 3 - 4, 0), 56) + 8;
        if ((hi - lo) & 1) { if (hi < 64) ++hi; else --lo; }
        __syncthreads();
        const float* rpb = a.in[I_RPB] + ((size_t)l * 4 + h) * 465;
        for (int i = tid; i < 15 * 128; i += NWAVES * 64) { const int bi = i >> 7, bj = (i & 127) - 48; biasT[i] = (bj >= 0 && bj < 31) ? rpb[bi * 31 + bj] * 11.313708498984761f : 0.f; }
        __syncthreads();
        const size_t tk = (size_t)b * SEQ + lo * 64;
        att::attn_body<128, 512, 512, 4096, 2048, 1, 1, 4>(QA + tq * 512 + h * 128, KA + tk * 512 + h * 128, PROJ + tk * DINP + PC_VA + h * 128, O + tq * DM + h * 128, hi - lo, L, rb * 4, lo, biasT);
    }
}

constexpr int NPHASE = 24;
__global__ void __launch_bounds__(NWAVES * 64, 2) mega_fwd(Args args) {
    extern __shared__ __attribute__((aligned(16))) unsigned char lds_raw[];
    Frame F;
    F.lds = (LAS unsigned char*)lds_raw; F.ws = args.ws; F.ctl = (unsigned*)(args.ws + WS_CTL);
    F.wave = __builtin_amdgcn_readfirstlane((int)threadIdx.x >> 6);
    F.G = gridDim.x; F.bid = blockIdx.x; F.gw = F.bid * NWAVES + F.wave; F.ngw = F.G * NWAVES;
    volatile LAS unsigned* MISC = (volatile LAS unsigned*)(F.lds + MISC_OFF);
    if (threadIdx.x < 64) MISC[threadIdx.x] = 0u;
    __syncthreads();
    XcdBarrier bar = xcd_barrier_post(F.ctl + CW_BAR, MISC + 8);
    const int lo = args.ph_lo, hi = args.ph_hi;
#define IN(k) (lo <= (k) && (k) < hi)
#define SEAM(k) do { if (IN(k) && IN((k) + 1)) xcd_barrier(bar); } while (0)
    float* out = args.out;
    LAS unsigned char* ring = F.lds;

    if (PHON(0) && IN(0)) {
        int tid_ = threadIdx.x; asm volatile("" : "+v"(tid_)); const int tid = tid_, lane = tid & 63; (void)tid; (void)lane;
        LAS float* scr = (LAS float*)(F.lds + F.wave * 16640);
        int it = F.gw;
#define TR_RUN(Wp, Kk, Nn, Dp, ROFF, MODE) do { const int cnt_ = ((Kk) >> 6) * ((Nn) >> 6); while (it < cnt_) { transpose_item((Wp), (Kk), (Nn), (Dp), (ROFF), (MODE), scr, it, lane); it += F.ngw; } it -= cnt_; } while (0)
        for (int l = 0; l < DEPTH; ++l) {
            TR_RUN(args.in[I_WIN] + (size_t)l * DM * DIN, DM, DIN, (bf16*)(F.ws + WS_WIN) + (size_t)l * DINP * DM, 0, 0);
            TR_RUN(args.in[I_WUQ] + (size_t)l * 512 * 768, 512, 768, (bf16*)(F.ws + WS_WUQ) + (size_t)l * 768 * 512, 0, 0);
            TR_RUN(args.in[I_WUKV] + (size_t)l * 256 * 1024, 256, 1024, (bf16*)(F.ws + WS_WUKV) + (size_t)l * 1024 * 256, 0, 0);
            TR_RUN(args.in[I_WOUT] + (size_t)l * DM * DM, DM, DM, (bf16*)(F.ws + WS_WOUT) + (size_t)l * DM * DM, 0, 0);
        }
        TR_RUN(args.in[I_WG], DM, DFF, (bf16*)(F.ws + WS_WGU), 0, 1);
        TR_RUN(args.in[I_WU], DM, DFF, (bf16*)(F.ws + WS_WGU), 0, 2);
        TR_RUN(args.in[I_WDN], DFF, DM, (bf16*)(F.ws + WS_WD), 0, 0);
        for (int e = 0; e < NE; ++e) {
            TR_RUN(args.in[I_WEG] + (size_t)e * DM * DFE, DM, DFE, (bf16*)(F.ws + WS_WEGU) + (size_t)e * 2 * DFE * DM, 0, 1);
            TR_RUN(args.in[I_WEU] + (size_t)e * DM * DFE, DM, DFE, (bf16*)(F.ws + WS_WEGU) + (size_t)e * 2 * DFE * DM, 0, 2);
            TR_RUN(args.in[I_WED] + (size_t)e * DFE * DM, DFE, DM, (bf16*)(F.ws + WS_WED) + (size_t)e * DM * DFE, 0, 0);
        }
#undef TR_RUN
        for (int l = 0; l < DEPTH; ++l) { v4u* z = (v4u*)((bf16*)(F.ws + WS_WIN) + ((size_t)l * DINP + DIN) * DM); const v4u zz = {0u, 0u, 0u, 0u};
            for (int i = F.bid * NWAVES * 64 + tid; i < (DINP - DIN) * DM / 8; i += F.G * NWAVES * 64) z[i] = zz; }
        phase_rmsnorm(F, args.in[I_X], args.in[I_MIXN], (bf16*)(F.ws + WS_H));
    }
    SEAM(0);

#pragma nounroll
    for (int l = 0; l < DEPTH; ++l) {
        const int P = 11 * l;
        if (PHON(1) && IN(P + 1)) {
            pg8::Gemm g{(const bf16*)(F.ws + WS_H), (const bf16*)(F.ws + WS_WIN) + (size_t)l * DINP * DM, NTOK, DINP, DM}; pg8::StaticOrder S; S.init(NTOK, DINP, F.G, F.bid);
            pg8::EpiBf16 E{(bf16*)(F.ws + WS_PROJ), DINP};
            pg8::gemm_phase<pg8::EpiBf16, pg8::StaticOrder, true, true>(ring, g, S, E);
        }
        SEAM(P + 1);
        if (PHON(2) && IN(P + 2)) phase_postproj(F, args, l);
        SEAM(P + 2);
        if (PHON(3) && IN(P + 3)) {
            { pg8::Gemm g{(const bf16*)(F.ws + WS_CQN), (const bf16*)(F.ws + WS_WUQ) + (size_t)l * 768 * 512, NTOK, 768, 512}; pg8::StaticOrder S; S.init(NTOK, 768, F.G, F.bid);
              pg8::EpiBf16 E{(bf16*)(F.ws + WS_QCR), 768}; pg8::gemm_phase<pg8::EpiBf16, pg8::StaticOrder, true, true>(ring, g, S, E); }
            { pg8::Gemm g{(const bf16*)(F.ws + WS_CKVN), (const bf16*)(F.ws + WS_WUKV) + (size_t)l * 1024 * 256, NTOK, 1024, 256}; pg8::StaticOrder S; S.init(NTOK, 1024, F.G, F.bid);
              pg8::EpiBf16 E{(bf16*)(F.ws + WS_KVR), 1024}; pg8::gemm_phase<pg8::EpiBf16, pg8::StaticOrder, true, true>(ring, g, S, E); }
        }
        SEAM(P + 3);
        if (PHON(4) && IN(P + 4)) phase_postmla(F, args, l);
        SEAM(P + 4);
        if (PHON(5) && IN(P + 5)) { phase_attention(F, args, l); __syncthreads(); }
        SEAM(P + 5);
        if (PHON(6) && IN(P + 6)) phase_groupnorm(F, args, l);
        SEAM(P + 6);
        if (PHON(7) && IN(P + 7)) {
            pg8::Gemm g{(const bf16*)(F.ws + WS_ON), (const bf16*)(F.ws + WS_WOUT) + (size_t)l * DM * DM, NTOK, DM, DM}; pg8::StaticOrder S; S.init(NTOK, DM, F.G, F.bid);
            pg8::EpiResF32 E{l == 0 ? args.in[I_X] : (const float*)out, out, DM};
            pg8::gemm_phase<pg8::EpiResF32, pg8::StaticOrder, true, true>(ring, g, S, E);
        }
        SEAM(P + 7);
        if (l == 0) {
            if (PHON(8) && IN(P + 8)) phase_rmsnorm(F, out, args.in[I_FFNN] + (size_t)l * DM, (bf16*)(F.ws + WS_H));
            SEAM(P + 8);
            if (PHON(9) && IN(P + 9)) {
                pg8::Gemm g{(const bf16*)(F.ws + WS_H), (const bf16*)(F.ws + WS_WGU), NTOK, 2 * DFF, DM}; pg8::StaticOrder S; S.init(NTOK, 2 * DFF, F.G, F.bid);
                pg8::EpiSwiglu E{(bf16*)(F.ws + WS_ACT), DFF};
                pg8::gemm_phase<pg8::EpiSwiglu, pg8::StaticOrder, true, true>(ring, g, S, E);
            }
            SEAM(P + 9);
            if (PHON(10) && IN(P + 10)) {
                pg8::Gemm g{(const bf16*)(F.ws + WS_ACT), (const bf16*)(F.ws + WS_WD), NTOK, DM, DFF}; pg8::StaticOrder S; S.init(NTOK, DM, F.G, F.bid);
                pg8::EpiResF32 E{out, out, DM};
                pg8::gemm_phase<pg8::EpiResF32, pg8::StaticOrder, true, true>(ring, g, S, E);
            }
            SEAM(P + 10);
            if (PHON(8) && IN(P + 11)) phase_rmsnorm(F, out, args.in[I_MIXN] + (size_t)(l + 1) * DM, (bf16*)(F.ws + WS_H));
            SEAM(P + 11);
        } else {
            if (PHON(11) && IN(P + 8)) phase_ffnnorm_route(F, args, out, args.in[I_FFNN] + (size_t)l * DM, (bf16*)(F.ws + WS_H));
            SEAM(P + 8);
            if (PHON(12) && IN(P + 9)) phase_gather(F);
            SEAM(P + 9);
            if (PHON(13) && IN(P + 10)) {
                int tb[9], cnt[8]; moe_tiles(F, tb, cnt);
                pg8::Gemm g{(const bf16*)(F.ws + WS_HG), (const bf16*)(F.ws + WS_WEGU), tb[8] * 256, 2 * DFE, DM}; pg8::GroupedOrder S; S.init(tb[8] * 256, 2 * DFE, F.G, F.bid);
#pragma unroll
                for (int k = 0; k < 7; ++k) S.tb[k] = tb[k + 1];
                S.nct = 2 * DFE / 256;
                pg8::EpiSwiglu E{(bf16*)(F.ws + WS_ACTM), DFE};
                pg8::gemm_phase<pg8::EpiSwiglu, pg8::GroupedOrder, true, true>(ring, g, S, E);
            }
            SEAM(P + 10);
            if (PHON(14) && IN(P + 11)) {
                int tb[9], cnt[8]; moe_tiles(F, tb, cnt);
                pg8::Gemm g{(const bf16*)(F.ws + WS_ACTM), (const bf16*)(F.ws + WS_WED), tb[8] * 256, DM, DFE}; pg8::GroupedOrder S; S.init(tb[8] * 256, DM, F.G, F.bid);
#pragma unroll
                for (int k = 0; k < 7; ++k) S.tb[k] = tb[k + 1];
                S.nct = DM / 256;
                pg8::EpiScaleBf16 E{(bf16*)(F.ws + WS_Y), DM, (const float*)(F.ws + WS_RGATE)};
                pg8::gemm_phase<pg8::EpiScaleBf16, pg8::GroupedOrder, true, true>(ring, g, S, E);
            }
            SEAM(P + 11);
            if (PHON(15) && IN(P + 12)) phase_combine(F, out);
        }
    }
#undef IN
#undef SEAM
}

extern "C" void kernel_launch(void* const* d_in, const int* in_sizes, int n_in, void* d_out, int out_size, void* d_ws, size_t ws_size, hipStream_t stream) {
    static int grid = 0;
    if (grid == 0) {
        if (n_in != 26 || in_sizes[0] != NTOK * DM || out_size != NTOK * DM || ws_size < WS_END) { fprintf(stderr, "kernel_launch: unexpected shapes (n_in %d, in0 %d, out %d, ws %zu < %zu)\n", n_in, n_in > 0 ? in_sizes[0] : -1, out_size, ws_size, (size_t)WS_END); grid = -1; return; }
        int dev = 0, cus = 0, per_cu = 0;
        if (hipGetDevice(&dev) != hipSuccess || hipDeviceGetAttribute(&cus, hipDeviceAttributeMultiprocessorCount, dev) != hipSuccess) { grid = -1; return; }
        if (hipFuncSetAttribute((const void*)mega_fwd, hipFuncAttributeMaxDynamicSharedMemorySize, LDS_BYTES) != hipSuccess) { fprintf(stderr, "kernel_launch: hipFuncSetAttribute failed\n"); grid = -1; return; }
        if (hipOccupancyMaxActiveBlocksPerMultiprocessor(&per_cu, (const void*)mega_fwd, NWAVES * 64, LDS_BYTES) != hipSuccess || per_cu < 1) fprintf(stderr, "kernel_launch: occupancy query reports %d\n", per_cu);
        (void)hipGetLastError();
        grid = cus;
    }
    if (grid < 0) return;
    if (hipMemsetAsync((char*)d_ws + WS_CTL, 0, CTL_ZERO_BYTES, stream) != hipSuccess) return;
    Args a{};
    for (int i = 0; i < 26; ++i) a.in[i] = (const float*)d_in[i];
    a.out = (float*)d_out; a.ws = (unsigned char*)d_ws;
#ifndef MK_SPLIT
    a.ph_lo = 0; a.ph_hi = NPHASE;
    hipLaunchKernelGGL(mega_fwd, dim3(grid), dim3(NWAVES * 64), LDS_BYTES, stream, a);
#else
    for (int p = 0; p < NPHASE; ++p) { a.ph_lo = p; a.ph_hi = p + 1; hipLaunchKernelGGL(mega_fwd, dim3(grid), dim3(NWAVES * 64), LDS_BYTES, stream, a); }
#endif
}
```

```cpp
#include <hip/hip_runtime.h>
#include <cstdio>
#include <cstdint>
namespace pg8 {
#define PG8_LAS __attribute__((address_space(3)))
typedef unsigned short bf16_t;
typedef short bf16x8 __attribute__((ext_vector_type(8)));
typedef float f32x4 __attribute__((ext_vector_type(4)));
typedef unsigned u32x4 __attribute__((ext_vector_type(4)));
constexpr int BM = 256, BK = 64, HALF = 128, HTB = HALF * BK * 2  , STAGE_BYTES = 8 * HTB, NXCD = 8, WGM = 8;

__host__ __device__ __forceinline__ int lds_byte(int r, int c) { const int st = (r >> 4) * 2 + (c >> 5), rr = r & 15, cc = c & 31, ob = rr * 64 + cc * 2; return st * 1024 + (ob ^ (((ob >> 9) & 1) << 5)); }
__host__ __device__ __forceinline__ void stage_rc(int b, int& R, int& C) { const int st = b / 1024, sb = b % 1024, swz = sb ^ (((sb >> 9) & 1) << 5); R = (st >> 1) * 16 + swz / 64; C = (st & 1) * 32 + (swz % 64) / 2; }
__host__ __device__ __forceinline__ int perm32(int rho) { const int n = rho >> 4, i = rho & 15; return 8 * (i >> 2) + 4 * n + (i & 3); }


struct Unit { int pm, pn, pc; };
struct Gemm { const void* A; const void* Bt; int M, N, K; int sa, sw; };
typedef int i32x4 __attribute__((ext_vector_type(4)));
typedef int i32x8 __attribute__((ext_vector_type(8)));

struct StaticOrder {
    int nM, nN, nwg, G, c;
    __device__ __forceinline__ void init(int M, int N, int G_, int c_) { nM = M / BM; nN = N / BM; nwg = nM * nN; G = G_; c = c_; }
    __device__ __forceinline__ bool next(int i, Unit& u) const {
        const long L = (long)i * G + c; if (L >= nwg) return false;
        int wgid = (int)L; { const int q = nwg / NXCD, r = nwg % NXCD, xcd = wgid % NXCD, off = wgid / NXCD; wgid = (xcd < r ? xcd * (q + 1) : r * (q + 1) + (xcd - r) * q) + off; }
        const int nig = WGM * nN, gid = wgid / nig, fm = gid * WGM, gsz = (nM - fm) < WGM ? (nM - fm) : WGM;
        u.pm = fm + ((wgid % nig) % gsz); u.pn = (wgid % nig) / gsz; u.pc = u.pn; return true;
    }
    __device__ __forceinline__ void a_ready(const Unit&) const {}
    __device__ __forceinline__ void done(const Unit&) const {}
};
struct GroupedOrder : StaticOrder {
    int tb[7]; int nct;
    __device__ __forceinline__ bool next(int i, Unit& u) const {
        if (!StaticOrder::next(i, u)) return false;
        int e = 0;
#pragma unroll
        for (int k = 0; k < 7; ++k) e += (u.pm >= tb[k]) ? 1 : 0;
        u.pc = u.pn; u.pn += e * nct; return true;
    }
};

__device__ __forceinline__ unsigned cvt_pk_bf16(float lo, float hi) { unsigned r; asm volatile("v_cvt_pk_bf16_f32 %0, %1, %2" : "=v"(r) : "v"(lo), "v"(hi)); return r; }

struct EpiBf16 {
    static constexpr bool PERM = true, AFTER_DRAIN = false;
    bf16_t* O; int ldc;
    __device__ __forceinline__ void operator()(const f32x4 (&acc)[2][2][4][2], const Unit& u, int wr, int wc, int fr, int fq) const {
        const int row0 = u.pm * BM + wr * 64 + fr, col0 = u.pc * BM + wc * 32 + 8 * fq;
#pragma unroll
        for (int ai = 0; ai < 2; ++ai)
#pragma unroll
            for (int m = 0; m < 4; ++m) { bf16_t* rowp = O + (size_t)(row0 + ai * HALF + m * 16) * ldc + col0;
#pragma unroll
                for (int bj = 0; bj < 2; ++bj) { const f32x4 v0 = acc[ai][bj][m][0], v1 = acc[ai][bj][m][1];
                    u32x4 w; w.x = cvt_pk_bf16(v0[0], v0[1]); w.y = cvt_pk_bf16(v0[2], v0[3]); w.z = cvt_pk_bf16(v1[0], v1[1]); w.w = cvt_pk_bf16(v1[2], v1[3]);
                    *(u32x4*)(rowp + bj * HALF) = w; } }
    }
};
struct EpiScaleBf16 {
    static constexpr bool PERM = true, AFTER_DRAIN = false;
    bf16_t* O; int ldc; const float* rs;
    __device__ __forceinline__ void operator()(const f32x4 (&acc)[2][2][4][2], const Unit& u, int wr, int wc, int fr, int fq) const {
        const int row0 = u.pm * BM + wr * 64 + fr, col0 = u.pc * BM + wc * 32 + 8 * fq;
#pragma unroll
        for (int ai = 0; ai < 2; ++ai)
#pragma unroll
            for (int m = 0; m < 4; ++m) { const int row = row0 + ai * HALF + m * 16; const float s = rs[row]; bf16_t* rowp = O + (size_t)row * ldc + col0;
#pragma unroll
                for (int bj = 0; bj < 2; ++bj) { const f32x4 v0 = acc[ai][bj][m][0] * s, v1 = acc[ai][bj][m][1] * s;
                    u32x4 w; w.x = cvt_pk_bf16(v0[0], v0[1]); w.y = cvt_pk_bf16(v0[2], v0[3]); w.z = cvt_pk_bf16(v1[0], v1[1]); w.w = cvt_pk_bf16(v1[2], v1[3]);
                    *(u32x4*)(rowp + bj * HALF) = w; } }
    }
};
struct EpiResF32 {
    static constexpr bool PERM = false, AFTER_DRAIN = false;
    const float* base; float* out; int ldc;
    __device__ __forceinline__ void operator()(const f32x4 (&acc)[2][2][4][2], const Unit& u, int wr, int wc, int fr, int fq) const {
        const int row0 = u.pm * BM + wr * 64 + fr, col0 = u.pc * BM + wc * 32 + 4 * fq;
#pragma unroll
        for (int ai = 0; ai < 2; ++ai)
#pragma unroll
            for (int m = 0; m < 4; ++m) { const size_t off = (size_t)(row0 + ai * HALF + m * 16) * ldc + col0;
                f32x4 b[2][2];
#pragma unroll
                for (int bj = 0; bj < 2; ++bj)
#pragma unroll
                    for (int n = 0; n < 2; ++n) b[bj][n] = *(const f32x4*)(base + off + bj * HALF + n * 16);
#pragma unroll
                for (int bj = 0; bj < 2; ++bj)
#pragma unroll
                    for (int n = 0; n < 2; ++n) *(f32x4*)(out + off + bj * HALF + n * 16) = b[bj][n] + acc[ai][bj][m][n];
                asm volatile("" ::: "memory"); }
    }
};
__device__ __forceinline__ float silu_mul(float g, float u) { return g * u * __builtin_amdgcn_rcpf(1.0f + __builtin_amdgcn_exp2f(-1.44269504089f * g)); }
struct EpiSwiglu {
    static constexpr bool PERM = true, AFTER_DRAIN = false;
    bf16_t* O; int ldc;
    __device__ __forceinline__ void operator()(const f32x4 (&acc)[2][2][4][2], const Unit& u, int wr, int wc, int fr, int fq) const {
        const int row0 = u.pm * BM + wr * 64 + fr, col0 = u.pc * HALF + wc * 32 + 8 * fq;
#pragma unroll
        for (int ai = 0; ai < 2; ++ai)
#pragma unroll
            for (int m = 0; m < 4; ++m) { bf16_t* rowp = O + (size_t)(row0 + ai * HALF + m * 16) * ldc + col0;
                const f32x4 g0 = acc[ai][0][m][0], g1 = acc[ai][0][m][1], u0 = acc[ai][1][m][0], u1 = acc[ai][1][m][1];
                u32x4 w; w.x = cvt_pk_bf16(silu_mul(g0[0], u0[0]), silu_mul(g0[1], u0[1])); w.y = cvt_pk_bf16(silu_mul(g0[2], u0[2]), silu_mul(g0[3], u0[3]));
                w.z = cvt_pk_bf16(silu_mul(g1[0], u1[0]), silu_mul(g1[1], u1[1])); w.w = cvt_pk_bf16(silu_mul(g1[2], u1[2]), silu_mul(g1[3], u1[3]));
                *(u32x4*)rowp = w; }
    }
};

__device__ __forceinline__ unsigned cvt_pk4_fp8(float a, float b, float c, float d) { unsigned w = 0u; w = __builtin_amdgcn_cvt_pk_fp8_f32(a, b, w, false); w = __builtin_amdgcn_cvt_pk_fp8_f32(c, d, w, true); return w; }
struct EpiSwigluF8 {
    static constexpr bool PERM = true, AFTER_DRAIN = false;
    unsigned char* O; int ldc; float osc;
    __device__ __forceinline__ void operator()(const f32x4 (&acc)[2][2][4][2], const Unit& u, int wr, int wc, int fr, int fq) const {
        const int row0 = u.pm * BM + wr * 64 + fr, col0 = u.pc * HALF + wc * 32 + 8 * fq;
#pragma unroll
        for (int ai = 0; ai < 2; ++ai)
#pragma unroll
            for (int m = 0; m < 4; ++m) { unsigned char* rowp = O + (size_t)(row0 + ai * HALF + m * 16) * ldc + col0;
                const f32x4 g0 = acc[ai][0][m][0], g1 = acc[ai][0][m][1], u0 = acc[ai][1][m][0] * osc, u1 = acc[ai][1][m][1] * osc;
                typedef unsigned u32x2 __attribute__((ext_vector_type(2)));
                u32x2 w; w.x = cvt_pk4_fp8(silu_mul(g0[0], u0[0]), silu_mul(g0[1], u0[1]), silu_mul(g0[2], u0[2]), silu_mul(g0[3], u0[3]));
                w.y = cvt_pk4_fp8(silu_mul(g1[0], u1[0]), silu_mul(g1[1], u1[1]), silu_mul(g1[2], u1[2]), silu_mul(g1[3], u1[3]));
                *(u32x2*)rowp = w; }
    }
};

template <class Epi, class Sched, bool ALIGN_EPI = false, bool SP2 = false, bool F8 = false>
__device__ __forceinline__ void gemm_phase(PG8_LAS unsigned char* lds, const Gemm g, const Sched& S, const Epi& E) {
    int tid_ = threadIdx.x; asm volatile("" : "+v"(tid_));
    const int tid = tid_, wid = __builtin_amdgcn_readfirstlane(tid >> 6), lane = tid & 63, wr = wid >> 2, wc = wid & 3, fr = lane & 15, fq = lane >> 4;
    const int K = g.K, nt = F8 ? K / (2 * BK) : K / BK, RB = F8 ? K : 2 * K;
    unsigned voffA[2], voffB[2];
#pragma unroll
    for (int i = 0; i < 2; ++i) { int R, C; stage_rc(tid * 16 + i * 8192, R, C); const int Rb = Epi::PERM ? ((R & ~31) + perm32(R & 31)) : R;
        voffA[i] = (unsigned)(R * RB + C * 2); voffB[i] = (unsigned)(Rb * RB + C * 2); }
    const size_t kstep = (size_t)(BK * 2);
    const size_t hstep = (size_t)HALF * RB;
    const size_t tstep = 2 * hstep;
    const unsigned ldsw = (unsigned)wid * 1024u;
    const int aoff = F8 ? lds_byte(wr * 64 + fr, fq * 16) : lds_byte(wr * 64 + fr, fq * 8), boff = F8 ? lds_byte(wc * 32 + fr, fq * 16) : lds_byte(wc * 32 + fr, fq * 8);
#define PG8_SA(b, h) (((b) * 2 + (h)) * HTB)
#define PG8_SB(b, h) ((4 + (b) * 2 + (h)) * HTB)
#define PG8_STAGE(bufoff, gbase, voff) do { _Pragma("unroll") for (int _i = 0; _i < 2; ++_i) \
        __builtin_amdgcn_global_load_lds((const unsigned*)((const char*)(gbase) + (voff)[_i]), (PG8_LAS unsigned*)(lds + (bufoff) + ldsw + _i * 8192), 16, 0, 0); } while (0)
#define PG8_LD16(p) (*(const PG8_LAS i32x4*)(p))
#define PG8_LDA(dst, b, h) do { _Pragma("unroll") for (int m = 0; m < 4; ++m) { if constexpr (F8) { dst##8[m] = __builtin_shufflevector(PG8_LD16(lds + PG8_SA(b, h) + aoff + m * 2048), PG8_LD16(lds + PG8_SA(b, h) + aoff + m * 2048 + 16), 0, 1, 2, 3, 4, 5, 6, 7); } \
        else { _Pragma("unroll") for (int k = 0; k < 2; ++k) dst[m][k] = *(const PG8_LAS bf16x8*)(lds + PG8_SA(b, h) + aoff + m * 2048 + k * 1024); } } } while (0)
#define PG8_LDB(dst, b, h) do { _Pragma("unroll") for (int n = 0; n < 2; ++n) { if constexpr (F8) { dst##8[n] = __builtin_shufflevector(PG8_LD16(lds + PG8_SB(b, h) + boff + n * 2048), PG8_LD16(lds + PG8_SB(b, h) + boff + n * 2048 + 16), 0, 1, 2, 3, 4, 5, 6, 7); } \
        else { _Pragma("unroll") for (int k = 0; k < 2; ++k) dst[n][k] = *(const PG8_LAS bf16x8*)(lds + PG8_SB(b, h) + boff + n * 2048 + k * 1024); } } } while (0)
#define PG8_MMA(ai, bj, At, Bt) do { __builtin_amdgcn_s_setprio(1); _Pragma("unroll") for (int m = 0; m < 4; ++m) _Pragma("unroll") for (int n = 0; n < 2; ++n) { \
        if constexpr (F8) asm volatile("v_mfma_scale_f32_16x16x128_f8f6f4 %0, %1, %2, %0, %3, %4 op_sel_hi:[0,0,0]" : "+v"(acc[ai][bj][m][n]) : "v"(Bt##8[n]), "v"(At##8[m]), "v"(f8sw), "v"(f8sa)); \
        else { _Pragma("unroll") for (int k = 0; k < 2; ++k) acc[ai][bj][m][n] = __builtin_amdgcn_mfma_f32_16x16x32_bf16(Bt[n][k], At[m][k], acc[ai][bj][m][n], 0, 0, 0); } } __builtin_amdgcn_s_setprio(0); } while (0)
#define PG8_WAIT_V(n) asm volatile("s_waitcnt vmcnt(" #n ")" ::: "memory")
#define PG8_WAIT_L(n) asm volatile("s_waitcnt lgkmcnt(" #n ")" ::: "memory")
#define PG8_BAR __builtin_amdgcn_s_barrier()
#define PG8_SCHED __builtin_amdgcn_sched_barrier(0)
    Unit cur, nxt; int ui = 0;
    if (!S.next(0, cur)) return;
    f32x4 acc[2][2][4][2];
#pragma unroll
    for (int a = 0; a < 2; ++a)
#pragma unroll
        for (int b = 0; b < 2; ++b)
#pragma unroll
            for (int m = 0; m < 4; ++m)
#pragma unroll
                for (int n = 0; n < 2; ++n) acc[a][b][m][n] = (f32x4){0.f, 0.f, 0.f, 0.f};
    const int f8sw = g.sw, f8sa = g.sa; (void)f8sw; (void)f8sa;
    bf16x8 At[4][2], B0[2][2], B1[2][2]; i32x8 At8[4], B08[2], B18[2];
    const char* cA = (const char*)g.A + (size_t)cur.pm * tstep; const char* cB = (const char*)g.Bt + (size_t)cur.pn * tstep;
    S.a_ready(cur);
    if constexpr (SP2) {
        PG8_STAGE(PG8_SB(0, 0), cB, voffB); PG8_STAGE(PG8_SB(0, 1), cB + hstep, voffB); PG8_STAGE(PG8_SA(0, 0), cA, voffA); PG8_STAGE(PG8_SA(0, 1), cA + hstep, voffA);
        if (wr == 1) PG8_BAR;
        PG8_WAIT_V(2); PG8_BAR;
        PG8_STAGE(PG8_SB(1, 0), cB + kstep, voffB); PG8_STAGE(PG8_SA(1, 0), cA + kstep, voffA); PG8_STAGE(PG8_SB(1, 1), cB + hstep + kstep, voffB);
        PG8_WAIT_V(6); PG8_BAR;
    } else {
        PG8_STAGE(PG8_SB(0, 0), cB, voffB); PG8_STAGE(PG8_SA(0, 0), cA, voffA); PG8_STAGE(PG8_SB(0, 1), cB + hstep, voffB); PG8_STAGE(PG8_SA(0, 1), cA + hstep, voffA);
        if (wr == 1) PG8_BAR;
        PG8_WAIT_V(4); PG8_BAR;
        PG8_STAGE(PG8_SB(1, 0), cB + kstep, voffB); PG8_STAGE(PG8_SA(1, 0), cA + kstep, voffA); PG8_STAGE(PG8_SB(1, 1), cB + hstep + kstep, voffB);
        PG8_WAIT_V(6); PG8_BAR;
    }
    for (;;) {
        const bool has_next = S.next(ui + 1, nxt);
        const char* nA = has_next ? (const char*)g.A + (size_t)nxt.pm * tstep : cA; const char* nB = has_next ? (const char*)g.Bt + (size_t)nxt.pn * tstep : cB;
        for (int t = 0; t < nt; t += 2) {
            const bool last = (t == nt - 2);
            const char* a1 = cA + (size_t)(t + 1) * kstep;
            const char* a2 = last ? nA : cA + (size_t)(t + 2) * kstep; const char* b2 = last ? nB : cB + (size_t)(t + 2) * kstep;
            const char* a3 = a2 + kstep; const char* b3 = b2 + kstep;
            if (last && has_next) S.a_ready(nxt);
            if constexpr (SP2) {
            PG8_LDB(B0, 0, 0); PG8_LDB(B1, 0, 1); PG8_SCHED; PG8_LDA(At, 0, 0); PG8_STAGE(PG8_SA(1, 1), a1 + hstep, voffA);
            PG8_WAIT_V(8); PG8_WAIT_L(0); PG8_BAR; PG8_MMA(0, 0, At, B0); PG8_MMA(0, 1, At, B1); PG8_BAR; PG8_SCHED;
            PG8_LDA(At, 0, 1); PG8_STAGE(PG8_SB(0, 0), b2, voffB); PG8_STAGE(PG8_SB(0, 1), b2 + hstep, voffB); PG8_STAGE(PG8_SA(0, 0), a2, voffA);
            PG8_WAIT_V(8); PG8_WAIT_L(0); PG8_BAR; PG8_MMA(1, 0, At, B0); PG8_MMA(1, 1, At, B1); PG8_BAR; PG8_SCHED;
            PG8_LDB(B0, 1, 0); PG8_LDB(B1, 1, 1); PG8_SCHED; PG8_LDA(At, 1, 0); PG8_STAGE(PG8_SA(0, 1), a2 + hstep, voffA);
            PG8_WAIT_V(8); PG8_WAIT_L(0); PG8_BAR; PG8_MMA(0, 0, At, B0); PG8_MMA(0, 1, At, B1); PG8_BAR; PG8_SCHED;
            PG8_LDA(At, 1, 1); PG8_STAGE(PG8_SB(1, 0), b3, voffB); PG8_STAGE(PG8_SB(1, 1), b3 + hstep, voffB); PG8_STAGE(PG8_SA(1, 0), a3, voffA);
            PG8_WAIT_V(8); PG8_WAIT_L(0); PG8_BAR; PG8_MMA(1, 0, At, B0); PG8_MMA(1, 1, At, B1); PG8_BAR; PG8_SCHED;
            } else {
            PG8_LDB(B0, 0, 0); PG8_SCHED; PG8_LDA(At, 0, 0); PG8_STAGE(PG8_SA(1, 1), a1 + hstep, voffA);
            PG8_WAIT_L(8); PG8_BAR; PG8_WAIT_L(0); PG8_MMA(0, 0, At, B0); PG8_BAR; PG8_SCHED;
            PG8_LDB(B1, 0, 1); PG8_STAGE(PG8_SB(0, 0), b2, voffB);
            PG8_BAR; PG8_WAIT_L(0); PG8_MMA(0, 1, At, B1); PG8_BAR;
            PG8_LDA(At, 0, 1); PG8_STAGE(PG8_SA(0, 0), a2, voffA);
            PG8_BAR; PG8_WAIT_L(0); PG8_MMA(1, 0, At, B0); PG8_BAR; PG8_SCHED;
            PG8_STAGE(PG8_SB(0, 1), b2 + hstep, voffB);
            PG8_WAIT_V(6); PG8_BAR; PG8_MMA(1, 1, At, B1); PG8_BAR;
            PG8_LDB(B0, 1, 0); PG8_SCHED; PG8_LDA(At, 1, 0); PG8_STAGE(PG8_SA(0, 1), a2 + hstep, voffA);
            PG8_WAIT_L(8); PG8_BAR; PG8_WAIT_L(0); PG8_MMA(0, 0, At, B0); PG8_BAR; PG8_SCHED;
            PG8_LDB(B1, 1, 1); PG8_STAGE(PG8_SB(1, 0), b3, voffB);
            PG8_BAR; PG8_WAIT_L(0); PG8_MMA(0, 1, At, B1); PG8_BAR;
            PG8_LDA(At, 1, 1); PG8_STAGE(PG8_SA(1, 0), a3, voffA);
            PG8_BAR; PG8_WAIT_L(0); PG8_MMA(1, 0, At, B0); PG8_BAR; PG8_SCHED;
            PG8_STAGE(PG8_SB(1, 1), b3 + hstep, voffB);
            PG8_WAIT_V(6); PG8_BAR; PG8_MMA(1, 1, At, B1); PG8_BAR;
            }
        }
        if constexpr (ALIGN_EPI) { if (wr == 0) PG8_BAR; }
        if constexpr (F8) {
            asm volatile("s_nop 15\n\ts_nop 15" : "+v"(acc[0][0][0][0]), "+v"(acc[0][0][0][1]), "+v"(acc[0][0][1][0]), "+v"(acc[0][0][1][1]), "+v"(acc[0][0][2][0]), "+v"(acc[0][0][2][1]), "+v"(acc[0][0][3][0]), "+v"(acc[0][0][3][1]) :: "memory");
            asm volatile("" : "+v"(acc[0][1][0][0]), "+v"(acc[0][1][0][1]), "+v"(acc[0][1][1][0]), "+v"(acc[0][1][1][1]), "+v"(acc[0][1][2][0]), "+v"(acc[0][1][2][1]), "+v"(acc[0][1][3][0]), "+v"(acc[0][1][3][1]) :: "memory");
            asm volatile("" : "+v"(acc[1][0][0][0]), "+v"(acc[1][0][0][1]), "+v"(acc[1][0][1][0]), "+v"(acc[1][0][1][1]), "+v"(acc[1][0][2][0]), "+v"(acc[1][0][2][1]), "+v"(acc[1][0][3][0]), "+v"(acc[1][0][3][1]) :: "memory");
            asm volatile("" : "+v"(acc[1][1][0][0]), "+v"(acc[1][1][0][1]), "+v"(acc[1][1][1][0]), "+v"(acc[1][1][1][1]), "+v"(acc[1][1][2][0]), "+v"(acc[1][1][2][1]), "+v"(acc[1][1][3][0]), "+v"(acc[1][1][3][1]) :: "memory");
        }
        if constexpr (!Epi::AFTER_DRAIN) { E(acc, cur, wr, wc, fr, fq); S.done(cur); }
        if (!has_next) break;
#pragma unroll
        for (int a = 0; a < 2; ++a)
#pragma unroll
            for (int b = 0; b < 2; ++b)
#pragma unroll
                for (int m = 0; m < 4; ++m)
#pragma unroll
                    for (int n = 0; n < 2; ++n) acc[a][b][m][n] = (f32x4){0.f, 0.f, 0.f, 0.f};
        cur = nxt; cA = nA; cB = nB; ++ui;
        if constexpr (ALIGN_EPI) { if (wr == 1) PG8_BAR; }
    }
    PG8_WAIT_V(0);
    if constexpr (!ALIGN_EPI) { if (wr == 0) PG8_BAR; }
    PG8_BAR;
    if constexpr (Epi::AFTER_DRAIN) { E.fused(acc, cur, wr, wc, fr, fq, lds, wid, lane); S.done(cur); }
#undef PG8_SA
#undef PG8_SB
#undef PG8_STAGE
#undef PG8_LDA
#undef PG8_LDB
#undef PG8_MMA
#undef PG8_LD16
#undef PG8_WAIT_V
#undef PG8_WAIT_L
#undef PG8_BAR
#undef PG8_SCHED
}
}

namespace att {
typedef unsigned short bf16;
using bf16x8 = __attribute__((ext_vector_type(8))) short;
using s16x4  = __attribute__((ext_vector_type(4))) short;
using f32x16 = __attribute__((ext_vector_type(16))) float;
using u32x4  = __attribute__((ext_vector_type(4))) unsigned;
constexpr int NW = 8, QBLK = 32, KVBLK = 64, DV = 128;
constexpr float THR = 8.f;
constexpr int SHM_V = KVBLK * DV * 2;
#define ATT_SBAR() __builtin_amdgcn_sched_barrier(0)
__device__ __forceinline__ int crow(int r, int hi) { return (r & 3) + 8 * (r >> 2) + 4 * hi; }
__device__ __forceinline__ unsigned cvtpk(float lo, float hi) { unsigned r; asm volatile("v_cvt_pk_bf16_f32 %0, %1, %2" : "=v"(r) : "v"(lo), "v"(hi)); return r; }
template <int DQ> struct Cst { static constexpr float SCALE = (DQ == 128) ? 0.088388347648318440f : 0.072168783648703220f; static constexpr int SHM_K = KVBLK * DQ * 2, ROWB = DQ * 2; };

template <int DQ>
__device__ __forceinline__ void partialSM(f32x16& p0, f32x16& p1, float& m_reg, float& mn, float& alpha) {
  constexpr float SCALE = Cst<DQ>::SCALE, C = SCALE * 1.4426950408889634f;
  float pmax = p0[0];
#pragma unroll
  for (int r = 1; r < 16; ++r) pmax = fmaxf(pmax, p0[r]);
#pragma unroll
  for (int r = 0; r < 16; ++r) pmax = fmaxf(pmax, p1[r]);
  { auto rr = __builtin_amdgcn_permlane32_swap(__float_as_uint(pmax), __float_as_uint(pmax), false, false);
    pmax = fmaxf(__uint_as_float(rr[0]), __uint_as_float(rr[1])); }
  if (__builtin_expect(__all(pmax - m_reg <= THR / SCALE), 1)) { mn = m_reg; alpha = 1.f; }
  else { mn = fmaxf(m_reg, pmax); alpha = __builtin_amdgcn_exp2f((m_reg - mn) * C); m_reg = mn; }
  const float mnC = -mn * C;
#pragma unroll
  for (int r = 0; r < 16; ++r) p0[r] = fmaf(p0[r], C, mnC);
#pragma unroll
  for (int r = 0; r < 16; ++r) p1[r] = fmaf(p1[r], C, mnC);
#pragma unroll
  for (int r = 0; r < 16; ++r) p0[r] = __builtin_amdgcn_exp2f(p0[r]);
}
__device__ __forceinline__ void finishSM(f32x16& p0, f32x16& p1, float alpha, float& l_reg, bf16x8& pa0, bf16x8& pa1, bf16x8& pa2, bf16x8& pa3) {
#pragma unroll
  for (int r = 0; r < 16; ++r) p1[r] = __builtin_amdgcn_exp2f(p1[r]);
  float ps = 0;
#pragma unroll
  for (int r = 0; r < 16; ++r) ps += p0[r];
#pragma unroll
  for (int r = 0; r < 16; ++r) ps += p1[r];
  { auto rr = __builtin_amdgcn_permlane32_swap(__float_as_uint(ps), __float_as_uint(ps), false, false);
    ps = __uint_as_float(rr[0]) + __uint_as_float(rr[1]); }
  l_reg = l_reg * alpha + ps;
#define ATT_PK4(P, BASE, OUT) do { unsigned a0 = cvtpk(P[BASE + 0], P[BASE + 1]), a1 = cvtpk(P[BASE + 2], P[BASE + 3]);   \
    unsigned b0 = cvtpk(P[BASE + 4], P[BASE + 5]), b1 = cvtpk(P[BASE + 6], P[BASE + 7]);                              \
    auto r0 = __builtin_amdgcn_permlane32_swap(a0, b0, false, false); auto r1 = __builtin_amdgcn_permlane32_swap(a1, b1, false, false); \
    u32x4 w = {r0[0], r1[0], r0[1], r1[1]}; OUT = *reinterpret_cast<bf16x8*>(&w); } while (0)
  ATT_PK4(p0, 0, pa0); ATT_PK4(p0, 8, pa1); ATT_PK4(p1, 0, pa2); ATT_PK4(p1, 8, pa3);
#undef ATT_PK4
}
template <int DQ, int NREG>
__device__ __forceinline__ void qkt(f32x16& p0, f32x16& p1, const char* Ks, const bf16x8* qr, const char* qpark, int r32, int hi) {
  constexpr int ROWB = Cst<DQ>::ROWB;
  p0 = f32x16{}; p1 = f32x16{};
#pragma unroll
  for (int d0 = 0; d0 < DQ / 16; ++d0) { const int cb = (d0 * 16 + hi * 8) * 2;
    bf16x8 b0 = *reinterpret_cast<const bf16x8*>(Ks + (r32 * ROWB + (cb ^ ((r32 & 7) << 4))));
    bf16x8 b1 = *reinterpret_cast<const bf16x8*>(Ks + ((32 + r32) * ROWB + (cb ^ ((r32 & 7) << 4))));
    bf16x8 q; if constexpr (true) { if (d0 < NREG) q = qr[d0 < NREG ? d0 : 0]; else q = *reinterpret_cast<const bf16x8*>(qpark + (d0 - NREG) * 1024); }
    p0 = __builtin_amdgcn_mfma_f32_32x32x16_bf16(b0, q, p0, 0, 0, 0);
    p1 = __builtin_amdgcn_mfma_f32_32x32x16_bf16(b1, q, p1, 0, 0, 0); }
}
__device__ __forceinline__ int v_st(int k, int c) { const int kk = (k & ~0xC) | ((k & 4) << 1) | ((k & 8) >> 1); return ((kk >> 3) * 4 + (c >> 5)) * 512 + ((kk & 7) * 32 + (c & 31)) * 2; }
__device__ __forceinline__ int v_rd_base(int lane) { return ((lane & 3) << 3) | (((lane >> 2) & 3) << 6) | (((lane >> 4) & 1) << 5) | (((lane >> 5) & 1) << 8); }
constexpr int v_rd_off(int d0, int ks, int half) { return d0 * 512 + ks * 4096 + half * 2048; }
template <int OFF> __device__ __forceinline__ s16x4 tr_read(int vb) {
  s16x4 r; asm volatile("ds_read_b64_tr_b16 %0, %1 offset:%2" : "=&v"(r) : "v"(vb), "i"(OFF) : "memory"); return r;
}
template <int D0> __device__ __forceinline__ void pv_one(f32x16& od, int vb, bf16x8 pa0, bf16x8 pa1, bf16x8 pa2, bf16x8 pa3) {
  const s16x4 l0 = tr_read<v_rd_off(D0, 0, 0)>(vb), h0 = tr_read<v_rd_off(D0, 0, 1)>(vb), l1 = tr_read<v_rd_off(D0, 1, 0)>(vb), h1 = tr_read<v_rd_off(D0, 1, 1)>(vb);
  const s16x4 l2 = tr_read<v_rd_off(D0, 2, 0)>(vb), h2 = tr_read<v_rd_off(D0, 2, 1)>(vb), l3 = tr_read<v_rd_off(D0, 3, 0)>(vb), h3 = tr_read<v_rd_off(D0, 3, 1)>(vb);
  asm volatile("s_waitcnt lgkmcnt(0)" ::: "memory"); ATT_SBAR();
#define ATT_PK(L, H) (bf16x8){L[0], L[1], L[2], L[3], H[0], H[1], H[2], H[3]}
  od = __builtin_amdgcn_mfma_f32_32x32x16_bf16(pa0, ATT_PK(l0, h0), od, 0, 0, 0);
  od = __builtin_amdgcn_mfma_f32_32x32x16_bf16(pa1, ATT_PK(l1, h1), od, 0, 0, 0);
  od = __builtin_amdgcn_mfma_f32_32x32x16_bf16(pa2, ATT_PK(l2, h2), od, 0, 0, 0);
  od = __builtin_amdgcn_mfma_f32_32x32x16_bf16(pa3, ATT_PK(l3, h3), od, 0, 0, 0);
#undef ATT_PK
}
__device__ __forceinline__ void pv_d0(f32x16* o, int vb, bf16x8 pa0, bf16x8 pa1, bf16x8 pa2, bf16x8 pa3) {
  pv_one<0>(o[0], vb, pa0, pa1, pa2, pa3); pv_one<1>(o[1], vb, pa0, pa1, pa2, pa3); pv_one<2>(o[2], vb, pa0, pa1, pa2, pa3); pv_one<3>(o[3], vb, pa0, pa1, pa2, pa3);
}
__device__ __forceinline__ void natten_mod(f32x16& p0, f32x16& p1, int kr, int rq, int qc, const float* biasT, int hi) {
  const int r0 = min(max(rq - 4, 0), 56), c0 = min(max(qc - 8, 0), 48);
  const float NEG = -__builtin_inff();
  if (kr < r0 || kr >= r0 + 8) {
#pragma unroll
    for (int r = 0; r < 16; ++r) { p0[r] = NEG; p1[r] = NEG; }
  } else {
    const float* bl = biasT + (kr - rq + 7) * 128 + (63 - qc + 4 * hi);
    const int t = 4 * hi - c0;
#pragma unroll
    for (int r = 0; r < 16; ++r) {
      const int kcc = (r & 3) + 8 * (r >> 2);
      const bool ok0 = (unsigned)(t + kcc) < 16u, ok1 = (unsigned)(t + kcc + 32) < 16u;
      const float b0 = bl[kcc], b1 = bl[kcc + 32];
      p0[r] = ok0 ? p0[r] + b0 : NEG; p1[r] = ok1 ? p1[r] + b1 : NEG;
      if ((r & 3) == 3) __builtin_amdgcn_sched_barrier(0);
    }
  }
}

template <int DQ, int LDQ, int LDK, int LDV, int LDO, int MODE, int SDEPTH, int NREG>
__device__ __forceinline__ void attn_body(const bf16* __restrict__ Qb, const bf16* __restrict__ Kh, const bf16* __restrict__ Vh, bf16* __restrict__ Ob, const int NT, char* lds,
                                          const int rq0, const int kr_lo, const float* biasT) {
  constexpr int SHM_K = Cst<DQ>::SHM_K, ROWB = Cst<DQ>::ROWB;
  int tid_ = threadIdx.x; asm volatile("" : "+v"(tid_));
  const int tid = tid_, wid = tid >> 6, lane = tid & 63, r32 = lane & 31, hi = lane >> 5;
  char* V_lds = lds; char* K_lds = lds + 2 * SHM_V;
  float* ws = (float*)(lds + 2 * SHM_V + 2 * SHM_K) + wid * 64; float* li_l = ws; float* al_l = ws + 32;
  float m_reg = -1e30f, l_reg = 0; f32x16 o[4] = {}; bf16x8 qr[NREG > 0 ? NREG : 1];
  const bf16* Qw = Qb + (long)(wid * QBLK + r32) * LDQ + hi * 8;
  char* qpark = lds + 2 * SHM_V + 2 * SHM_K + NW * 64 * 4 + wid * ((DQ / 16 - NREG) * 1024) + hi * 512 + r32 * 16;
#pragma unroll
  for (int d0 = 0; d0 < DQ / 16; ++d0) { const bf16x8 qv = *reinterpret_cast<const bf16x8*>(Qw + d0 * 16); if (d0 < NREG) qr[d0 < NREG ? d0 : 0] = qv; else *reinterpret_cast<bf16x8*>(qpark + (d0 - NREG) * 1024) = qv; }
  const int nrq = rq0 + (wid >> 1), nqc = (wid & 1) * 32 + r32;
  const int sr = tid >> 4, sc = (tid & 15) * 8, vst0 = v_st(sr, sc), vst1 = v_st(32 + sr, sc);
  const int kr3 = tid >> 3, kc3 = 128 + (tid & 7) * 8;
  const int vb0 = (int)(uintptr_t)V_lds + v_rd_base(lane);
  struct { bf16x8 vs0, vs1, ks0, ks1, ks2; } sr_[SDEPTH];
#define ATT_LD8(p) (*reinterpret_cast<const bf16x8*>(p))
#define ATT_SLOAD(i, k0) do { sr_[i].vs0 = ATT_LD8(&Vh[(long)((k0) + sr) * LDV + sc]); sr_[i].vs1 = ATT_LD8(&Vh[(long)((k0) + 32 + sr) * LDV + sc]); \
    sr_[i].ks0 = ATT_LD8(&Kh[(long)((k0) + sr) * LDK + sc]); sr_[i].ks1 = ATT_LD8(&Kh[(long)((k0) + 32 + sr) * LDK + sc]); \
    if constexpr (DQ == 192) sr_[i].ks2 = ATT_LD8(&Kh[(long)((k0) + kr3) * LDK + kc3]); } while (0)
#define ATT_SWRITE(b, i) do { *(bf16x8*)(V_lds + (b) * SHM_V + vst0) = sr_[i].vs0;          \
    *(bf16x8*)(V_lds + (b) * SHM_V + vst1) = sr_[i].vs1; const int kc = sc * 2;               \
    *(bf16x8*)(K_lds + (b) * SHM_K + sr * ROWB + (kc ^ ((sr & 7) << 4))) = sr_[i].ks0;                       \
    *(bf16x8*)(K_lds + (b) * SHM_K + (32 + sr) * ROWB + (kc ^ ((sr & 7) << 4))) = sr_[i].ks1; \
    if constexpr (DQ == 192) *(bf16x8*)(K_lds + (b) * SHM_K + kr3 * ROWB + ((kc3 * 2) ^ ((kr3 & 7) << 4))) = sr_[i].ks2; } while (0)
#define ATT_SWAIT() do { if constexpr (SDEPTH == 2) { if constexpr (DQ == 192) asm volatile("s_waitcnt vmcnt(5)" ::: "memory"); else asm volatile("s_waitcnt vmcnt(4)" ::: "memory"); } \
    else asm volatile("s_waitcnt vmcnt(0)" ::: "memory"); } while (0)
#define ATT_RESC(a) do { if (__any((a) < 1.f)) { if (hi == 0) al_l[r32] = (a); asm volatile("s_waitcnt lgkmcnt(0)" ::: "memory"); \
    _Pragma("unroll") for (int d = 0; d < 4; ++d) _Pragma("unroll") for (int r = 0; r < 16; ++r) o[d][r] *= al_l[crow(r, hi)]; } } while (0)
#define ATT_MOD(P0, P1, J) do { if constexpr (MODE == 1) natten_mod(P0, P1, kr_lo + (J), nrq, nqc, biasT, hi); } while (0)
  f32x16 pA0, pA1, pB0, pB1; float mnA, mnB, alA, alB; bf16x8 pa0, pa1, pa2, pa3;
  constexpr int SE = 0, SO = SDEPTH - 1;
  ATT_SLOAD(SE, 0); asm volatile("s_waitcnt vmcnt(0)" ::: "memory"); ATT_SWRITE(0, SE); __syncthreads();
  qkt<DQ, NREG>(pA0, pA1, K_lds, qr, qpark, r32, hi); ATT_MOD(pA0, pA1, 0); partialSM<DQ>(pA0, pA1, m_reg, mnA, alA);
  ATT_SLOAD(SO, KVBLK); if constexpr (SDEPTH == 2) { if (2 < NT) ATT_SLOAD(SE, 2 * KVBLK); }
  ATT_SWAIT(); ATT_SWRITE(1, SO); __syncthreads();
  for (int j = 1; j + 1 < NT; j += 2) {
    ATT_SBAR(); qkt<DQ, NREG>(pB0, pB1, K_lds + SHM_K, qr, qpark, r32, hi); ATT_MOD(pB0, pB1, j);
    finishSM(pA0, pA1, alA, l_reg, pa0, pa1, pa2, pa3); ATT_SBAR();
    ATT_SLOAD(SO, (j + SDEPTH) * KVBLK); ATT_SBAR();
    pv_d0(o, vb0, pa0, pa1, pa2, pa3); partialSM<DQ>(pB0, pB1, m_reg, mnB, alB);
    __syncthreads(); ATT_SWAIT(); ATT_SWRITE(0, SE);
    ATT_RESC(alB); __syncthreads();
    ATT_SBAR(); qkt<DQ, NREG>(pA0, pA1, K_lds, qr, qpark, r32, hi); ATT_MOD(pA0, pA1, j + 1);
    finishSM(pB0, pB1, alB, l_reg, pa0, pa1, pa2, pa3); ATT_SBAR();
    if (SDEPTH == 1 || j + 3 < NT) ATT_SLOAD(SE, (j + 1 + SDEPTH) * KVBLK); ATT_SBAR();
    pv_d0(o, vb0 + SHM_V, pa0, pa1, pa2, pa3); partialSM<DQ>(pA0, pA1, m_reg, mnA, alA);
    __syncthreads(); ATT_SWAIT(); ATT_SWRITE(1, SO);
    ATT_RESC(alA); __syncthreads();
  }
  ATT_SBAR(); qkt<DQ, NREG>(pB0, pB1, K_lds + SHM_K, qr, qpark, r32, hi); ATT_MOD(pB0, pB1, NT - 1);
  finishSM(pA0, pA1, alA, l_reg, pa0, pa1, pa2, pa3); ATT_SBAR();
  pv_d0(o, vb0, pa0, pa1, pa2, pa3); partialSM<DQ>(pB0, pB1, m_reg, mnB, alB);
  __syncthreads(); ATT_RESC(alB);
  finishSM(pB0, pB1, alB, l_reg, pa0, pa1, pa2, pa3); ATT_SBAR();
  pv_d0(o, vb0 + SHM_V, pa0, pa1, pa2, pa3);
  if (hi == 0) li_l[r32] = l_reg; asm volatile("s_waitcnt lgkmcnt(0)" ::: "memory");
  float rli[16];
#pragma unroll
  for (int r = 0; r < 16; ++r) rli[r] = __builtin_amdgcn_rcpf(li_l[crow(r, hi)]);
  bf16* Ow = Ob + (long)(wid * QBLK) * LDO;
#pragma unroll
  for (int r = 0; r < 16; ++r) { const int orow = crow(r, hi);
#pragma unroll
    for (int d0 = 0; d0 < 4; d0 += 1) { const unsigned w = cvtpk(o[d0][r] * rli[r], 0.f); Ow[(long)orow * LDO + d0 * 32 + r32] = (bf16)(w & 0xffffu); } }
#undef ATT_LD8
#undef ATT_SLOAD
#undef ATT_SWRITE
#undef ATT_SWAIT
#undef ATT_RESC
#undef ATT_MOD
}
}

#ifndef PH_MASK
#define PH_MASK 0xFFFFFFFFu
#endif
#define PHON(k) (((PH_MASK) >> (k)) & 1u)
constexpr int NWAVES = 8;
constexpr int DM = 2048, BATCH = 4, SEQ = 4096, NTOK = BATCH * SEQ, DEPTH = 2;
constexpr int DIN = 3904, DINP = 4096;
constexpr int DFF = 5632, NE = 8, DFE = 7168;
constexpr int PC_QA = 0, PC_KA = 512, PC_VA = 1024, PC_QB = 1536, PC_KB = 2560, PC_VB = 2816, PC_CQ = 3072, PC_CKV = 3584, PC_KPE = 3840;
constexpr float EPS = 1e-6f;
constexpr int MAXTILES = 136;
constexpr int MAXSLOTS = MAXTILES * 256;

constexpr size_t MiB = 1u << 20;
constexpr size_t WS_CTL = 0, CTL_ZERO_BYTES = 1 * MiB;
constexpr size_t WS_WIN = 1 * MiB;
constexpr size_t WS_WUQ = WS_WIN + 32 * MiB;
constexpr size_t WS_WUKV = WS_WUQ + 2 * MiB;
constexpr size_t WS_WOUT = WS_WUKV + 1 * MiB;
constexpr size_t WS_WGU = WS_WOUT + 16 * MiB;
constexpr size_t WS_WD = WS_WGU + 44 * MiB;
constexpr size_t WS_WEGU = WS_WD + 22 * MiB;
constexpr size_t WS_WED = WS_WEGU + 448 * MiB;
constexpr size_t WS_H = WS_WED + 224 * MiB;
constexpr size_t WS_ACT0 = WS_H + 64 * MiB;
constexpr size_t WS_PROJ = WS_ACT0;
constexpr size_t WS_QA = WS_PROJ + 128 * MiB;
constexpr size_t WS_KA = WS_QA + 16 * MiB;
constexpr size_t WS_QB = WS_KA + 16 * MiB;
constexpr size_t WS_KB = WS_QB + 32 * MiB;
constexpr size_t WS_CQN = WS_KB + 8 * MiB;
constexpr size_t WS_CKVN = WS_CQN + 16 * MiB;
constexpr size_t WS_KPE = WS_CKVN + 8 * MiB;
constexpr size_t WS_QCR = WS_KPE + 2 * MiB;
constexpr size_t WS_KVR = WS_QCR + 24 * MiB;
constexpr size_t WS_QC = WS_KVR + 32 * MiB;
constexpr size_t WS_KC = WS_QC + 24 * MiB;
constexpr size_t WS_O = WS_KC + 24 * MiB;
constexpr size_t WS_ON = WS_O + 64 * MiB;
constexpr size_t WS_ATT_END = WS_ON + 64 * MiB;
constexpr size_t WS_ACT = WS_ACT0;
constexpr size_t WS_HG = WS_ACT0;
constexpr size_t WS_ACTM = WS_HG + 136 * MiB;
constexpr size_t WS_Y = WS_ACTM + 476 * MiB;
constexpr size_t WS_RGATE = WS_Y + 136 * MiB;
constexpr size_t WS_TOKE = WS_RGATE + 1 * MiB;
constexpr size_t WS_TOKP = WS_TOKE + 1 * MiB;
constexpr size_t WS_TOKW = WS_TOKP + 1 * MiB;
constexpr size_t WS_END = WS_TOKW + 1 * MiB;
static_assert(WS_ATT_END <= WS_END, "map");
constexpr int CW_CNT = 64;
constexpr int CW_BAR = 4096;

constexpr int RING_BYTES = 131072;
constexpr int LDS_BYTES = 147456;
constexpr int MISC_OFF = LDS_BYTES - 256;

#define GAS __attribute__((address_space(1)))
#define LAS __attribute__((address_space(3)))
typedef unsigned short bf16;
typedef unsigned v4u __attribute__((ext_vector_type(4)));
typedef unsigned v2u __attribute__((ext_vector_type(2)));
typedef float f32x4 __attribute__((ext_vector_type(4)));
typedef float f32x2 __attribute__((ext_vector_type(2)));
__device__ __forceinline__ unsigned pk2(float lo, float hi) { unsigned r; asm volatile("v_cvt_pk_bf16_f32 %0, %1, %2" : "=v"(r) : "v"(lo), "v"(hi)); return r; }
__device__ __forceinline__ float bf_lo(unsigned w) { return __uint_as_float(w << 16); }
__device__ __forceinline__ float bf_hi(unsigned w) { return __uint_as_float(w & 0xffff0000u); }
__device__ __forceinline__ float wave_sum(float v) {
#pragma unroll
    for (int o = 1; o < 64; o <<= 1) v += __shfl_xor(v, o);
    return v;
}
__device__ __forceinline__ float rsq(float x) { return __builtin_amdgcn_rsqf(x); }
#define XB_TMO      128
#define XB_XCNT(j)  (256  + 64 * (j))
#define XB_XSUB(j)  (1280 + 64 * (j))
#define XB_XGEN(j)  (2304 + 64 * (j))
#define XB_TOP      3328
#define XB_TOPGEN   3392
#define XCD_BAR_WORDS 3456
#define XB_SPIN_CAP (1u << 18)

__device__ __forceinline__ unsigned xb_ld(unsigned* p)              { return __hip_atomic_load(p, __ATOMIC_RELAXED, __HIP_MEMORY_SCOPE_AGENT); }
__device__ __forceinline__ unsigned xb_add(unsigned* p, unsigned v) { return __hip_atomic_fetch_add(p, v, __ATOMIC_RELAXED, __HIP_MEMORY_SCOPE_AGENT); }
__device__ __forceinline__ unsigned xb_xcc_id() { return (unsigned)__builtin_amdgcn_s_getreg((3 << 11) | 20) & 0xFu; }
#define XB_SPIN(cond, bar) do { unsigned _sp = 0; while (cond) { __builtin_amdgcn_s_sleep(1); \
    if ((++_sp & 255u) == 0u) { if (xb_ld(&(bar)[XB_TMO])) break; if (_sp > XB_SPIN_CAP) { atomicAdd(&(bar)[XB_TMO], 1u); break; } } } } while (0)

struct XcdBarrier {
    unsigned* bar; unsigned x;
    volatile LAS unsigned* st;
};

__device__ __forceinline__ XcdBarrier xcd_barrier_post(unsigned* bar, volatile LAS unsigned* st) {
    XcdBarrier b; b.bar = bar; b.x = xb_xcc_id(); b.st = st;
    if (threadIdx.x == 0) (void)xb_add(&bar[XB_XCNT(b.x)], 1u);
    return b;
}
__device__ __forceinline__ void xcd_barrier_complete(unsigned* bar, unsigned x, unsigned& nloc, unsigned& nx) {
    const unsigned G = gridDim.x * gridDim.y * gridDim.z;
    unsigned sum, cnt, mine, sp = 0u;
    for (;;) {
        sum = 0u; cnt = 0u; mine = 0u;
#pragma unroll
        for (unsigned j = 0; j < 16; ++j) { const unsigned c = xb_ld(&bar[XB_XCNT(j)]); sum += c; cnt += (c > 0u) ? 1u : 0u; mine = (j == x) ? c : mine; }
        if (sum == G) break;
        __builtin_amdgcn_s_sleep(1);
        if ((++sp & 255u) == 0u) { if (xb_ld(&bar[XB_TMO])) break; if (sp > XB_SPIN_CAP) { atomicAdd(&bar[XB_TMO], 1u); break; } }
    }
    nloc = mine > 0u ? mine : 1u; nx = cnt > 0u ? cnt : 1u;
}

__device__ __forceinline__ void xcd_barrier(const XcdBarrier& b) {
    asm volatile("s_waitcnt vmcnt(0)" ::: "memory");
    __syncthreads();
    if (threadIdx.x == 0) {
        unsigned* bar = b.bar;
        __builtin_amdgcn_s_waitcnt(0);
        unsigned nloc = b.st[0], nx = b.st[1];
        if (nloc == 0u) { xcd_barrier_complete(bar, b.x, nloc, nx); b.st[0] = nloc; b.st[1] = nx; }
        const unsigned old = xb_add(&bar[XB_XSUB(b.x)], 1u);
        const unsigned gen = old / nloc;
        if (old + 1u == (gen + 1u) * nloc) {
            __builtin_amdgcn_fence(__ATOMIC_RELEASE, "agent");
            asm volatile("s_waitcnt vmcnt(0)" ::: "memory");
            const unsigned og = xb_add(&bar[XB_TOP], 1u);
            const unsigned tg = og / nx;
            if (og + 1u == (tg + 1u) * nx) xb_add(&bar[XB_TOPGEN], 1u);
            else XB_SPIN(xb_ld(&bar[XB_TOPGEN]) == tg, bar);
            __builtin_amdgcn_fence(__ATOMIC_ACQUIRE, "agent");
            xb_add(&bar[XB_XGEN(b.x)], 1u);
            asm volatile("s_waitcnt vmcnt(0)" ::: "memory");
        } else {
            XB_SPIN(xb_ld(&bar[XB_XGEN(b.x)]) == gen, bar);
            __builtin_amdgcn_fence(__ATOMIC_ACQUIRE, "agent");
            asm volatile("s_waitcnt vmcnt(0)" ::: "memory");
        }
    }
    __syncthreads();
}

struct Args { const float* in[26]; float* out; unsigned char* ws; int ph_lo, ph_hi; };
enum { I_X = 0, I_MIXN, I_WIN, I_RPB, I_QNA, I_KNA, I_QNB, I_KNB, I_CQN, I_CKVN, I_WUQ, I_WUKV, I_QNC, I_KNC, I_ONA, I_ONB, I_ONC, I_WOUT, I_FFNN, I_WG, I_WU, I_WDN, I_ROUTER, I_WEG, I_WEU, I_WED };
struct Frame {
    LAS unsigned char* lds; unsigned char* ws; unsigned* ctl;
    int wave, G, bid, gw, ngw;
};

__device__ __forceinline__ void transpose_item(const float* __restrict__ W, int K, int N, bf16* __restrict__ WT, int row_off, int mode, LAS float* scr, int item, int lane) {
    const int nblk = N >> 6, kb = item / nblk, nb = item - kb * nblk, k0 = kb << 6, n0 = nb << 6;
    const int lk = lane >> 4, ln = (lane & 15) << 2;
    f32x4 v[16];
#pragma unroll
    for (int i = 0; i < 16; ++i) v[i] = *(const f32x4*)(W + (size_t)(k0 + lk + 4 * i) * N + n0 + ln);
#pragma unroll
    for (int i = 0; i < 16; ++i) { LAS float* s = scr + (lk + 4 * i) * 65 + ln; s[0] = v[i][0]; s[1] = v[i][1]; s[2] = v[i][2]; s[3] = v[i][3]; }
    asm volatile("s_waitcnt lgkmcnt(0)" ::: "memory");
    const int drow0 = (mode == 0) ? (row_off + n0) : (row_off + (n0 >> 7) * 256 + (mode - 1) * 128 + (n0 & 127));
    const int c = lane & 7;
#pragma unroll
    for (int j = 0; j < 8; ++j) { const int n = 8 * j + (lane >> 3); const LAS float* s = scr + (8 * c) * 65 + n;
        v4u o; o.x = pk2(s[0 * 65], s[1 * 65]); o.y = pk2(s[2 * 65], s[3 * 65]); o.z = pk2(s[4 * 65], s[5 * 65]); o.w = pk2(s[6 * 65], s[7 * 65]);
        *(v4u*)(WT + (size_t)(drow0 + n) * K + k0 + 8 * c) = o; }
    asm volatile("s_waitcnt lgkmcnt(0)" ::: "memory");
}

__device__ __forceinline__ unsigned pk4_fp8(float a, float b, float c, float d) { unsigned w = 0u; w = __builtin_amdgcn_cvt_pk_fp8_f32(a, b, w, false); w = __builtin_amdgcn_cvt_pk_fp8_f32(c, d, w, true); return w; }
__device__ __forceinline__ void transpose_item_f8(const float* __restrict__ W, int K, int N, unsigned char* __restrict__ WT, int row_off, int mode, float wsc, LAS float* scr, int item, int lane) {
    const int nblk = N >> 5, kb = item / nblk, nb = item - kb * nblk, k0 = kb << 7, n0 = nb << 5;
    const int lk = lane >> 3, ln = (lane & 7) << 2;
    f32x4 v[16];
#pragma unroll
    for (int i = 0; i < 16; ++i) v[i] = *(const f32x4*)(W + (size_t)(k0 + lk + 8 * i) * N + n0 + ln);
#pragma unroll
    for (int i = 0; i < 16; ++i) { LAS float* s = scr + (lk + 8 * i) * 33 + ln; s[0] = v[i][0] * wsc; s[1] = v[i][1] * wsc; s[2] = v[i][2] * wsc; s[3] = v[i][3] * wsc; }
    asm volatile("s_waitcnt lgkmcnt(0)" ::: "memory");
    const int drow0 = (mode == 0) ? (row_off + n0) : (row_off + (n0 >> 7) * 256 + (mode - 1) * 128 + (n0 & 127));
    const int c = lane & 7;
#pragma unroll
    for (int j = 0; j < 4; ++j) { const int n = 8 * j + (lane >> 3); const LAS float* s = scr + (16 * c) * 33 + n;
        v4u o; o.x = pk4_fp8(s[0 * 33], s[1 * 33], s[2 * 33], s[3 * 33]); o.y = pk4_fp8(s[4 * 33], s[5 * 33], s[6 * 33], s[7 * 33]);
        o.z = pk4_fp8(s[8 * 33], s[9 * 33], s[10 * 33], s[11 * 33]); o.w = pk4_fp8(s[12 * 33], s[13 * 33], s[14 * 33], s[15 * 33]);
        *(v4u*)(WT + (size_t)(drow0 + n) * K + k0 + 16 * c) = o; }
    asm volatile("s_waitcnt lgkmcnt(0)" ::: "memory");
}

template <bool F8OUT>
__device__ __forceinline__ void phase_rmsnorm(const Frame& F, const float* __restrict__ src, const float* __restrict__ gain, void* __restrict__ dstv, float osc) {
    int tid_ = threadIdx.x; asm volatile("" : "+v"(tid_)); const int tid = tid_, lane = tid & 63; (void)tid; (void)lane;
    f32x4 g[8];
#pragma unroll
    for (int j = 0; j < 8; ++j) g[j] = ((const f32x4*)gain)[64 * j + lane] * osc;
    for (int m = F.gw; m < NTOK; m += F.ngw) {
        const f32x4* xr = (const f32x4*)(src + (size_t)m * DM) + lane; f32x4 v[8]; float s = 0.f;
#pragma unroll
        for (int j = 0; j < 8; ++j) { v[j] = xr[64 * j]; s += (v[j][0] * v[j][0] + v[j][1] * v[j][1]) + (v[j][2] * v[j][2] + v[j][3] * v[j][3]); }
        const float rstd = rsq(wave_sum(s) * (1.f / DM) + EPS);
        if constexpr (F8OUT) { unsigned* o4 = (unsigned*)((unsigned char*)dstv + (size_t)m * DM) + lane;
#pragma unroll
            for (int j = 0; j < 8; ++j) o4[64 * j] = pk4_fp8(v[j][0] * rstd * g[j][0], v[j][1] * rstd * g[j][1], v[j][2] * rstd * g[j][2], v[j][3] * rstd * g[j][3]);
        } else { v2u* o8 = (v2u*)((bf16*)dstv + (size_t)m * DM) + lane;
#pragma unroll
            for (int j = 0; j < 8; ++j) { v2u w; w.x = pk2(v[j][0] * rstd * g[j][0], v[j][1] * rstd * g[j][1]); w.y = pk2(v[j][2] * rstd * g[j][2], v[j][3] * rstd * g[j][3]); o8[64 * j] = w; } }
    }
}

__device__ __forceinline__ float rope_apply(float v, float c, float s, float sgn) { const float p = __shfl_xor(v, 16); return v * c + sgn * p * s; }
__device__ __forceinline__ void sincos_rev(float ang, float& s, float& c) { const float r = ang * 0.15915494309189535f; const float f = r - floorf(r); s = __builtin_amdgcn_sinf(f); c = __builtin_amdgcn_cosf(f); }

__device__ __forceinline__ void phase_postproj(const Frame& F, const Args& a, int l) {
    int tid_ = threadIdx.x; asm volatile("" : "+v"(tid_)); const int tid = tid_, lane = tid & 63; (void)tid; (void)lane;
    const bf16* PROJ = (const bf16*)(F.ws + WS_PROJ);
    bf16* QA = (bf16*)(F.ws + WS_QA); bf16* KA = (bf16*)(F.ws + WS_KA); bf16* QB = (bf16*)(F.ws + WS_QB); bf16* KB = (bf16*)(F.ws + WS_KB);
    bf16* CQN = (bf16*)(F.ws + WS_CQN); bf16* CKVN = (bf16*)(F.ws + WS_CKVN); bf16* KPE = (bf16*)(F.ws + WS_KPE);
    const f32x2 gqa = ((const f32x2*)(a.in[I_QNA] + l * 128))[lane], gka = ((const f32x2*)(a.in[I_KNA] + l * 128))[lane];
    const f32x2 gqb = ((const f32x2*)(a.in[I_QNB] + l * 128))[lane], gkb = ((const f32x2*)(a.in[I_KNB] + l * 128))[lane];
    const f32x4 gcq0 = ((const f32x4*)(a.in[I_CQN] + l * 512))[2 * lane], gcq1 = ((const f32x4*)(a.in[I_CQN] + l * 512))[2 * lane + 1];
    const f32x4 gckv = ((const f32x4*)(a.in[I_CKVN] + l * 256))[lane];
    const float gkpe = a.in[I_KNC][l * 192 + 128 + lane];
    constexpr float LOG2T = 13.287712379549449f;
    const int q = lane & 15;
    const float f128a = __builtin_amdgcn_exp2f(-(float)(2 * q) * (LOG2T / 32.f)), f128b = __builtin_amdgcn_exp2f(-(float)(2 * q + 1) * (LOG2T / 32.f));
    const float f64 = __builtin_amdgcn_exp2f(-(float)q * (LOG2T / 16.f));
    const float sgn = (lane & 16) ? 1.f : -1.f;
    for (int t = F.gw; t < NTOK; t += F.ngw) {
        const int pos = t & (SEQ - 1); const float p = (float)((lane & 32) ? (pos & 63) : (pos >> 6));
        float s0, c0, s1, c1, s2, c2; sincos_rev(p * f128a, s0, c0); sincos_rev(p * f128b, s1, c1); sincos_rev(p * f64, s2, c2);
        const bf16* pr = PROJ + (size_t)t * DINP;
        unsigned hv[18];
#pragma unroll
        for (int i = 0; i < 8; ++i) hv[i] = ((const unsigned*)(pr + i * 128))[lane];
#pragma unroll
        for (int i = 8; i < 18; ++i) hv[i] = ((const unsigned*)(pr + PC_QB + (i - 8) * 128))[lane];
        const v4u cqv = ((const v4u*)(pr + PC_CQ))[lane]; const v2u ckvv = ((const v2u*)(pr + PC_CKV))[lane]; const unsigned kpev = (unsigned)pr[PC_KPE + lane];
#pragma unroll
        for (int i = 0; i < 18; ++i) {
            float v0 = bf_lo(hv[i]), v1 = bf_hi(hv[i]);
            const float rstd = rsq(wave_sum(v0 * v0 + v1 * v1) * (1.f / 128.f) + EPS);
            const f32x2 g = (i < 4) ? gqa : (i < 8) ? gka : (i < 16) ? gqb : gkb;
            v0 = v0 * rstd * g[0]; v1 = v1 * rstd * g[1];
            if (i >= 8) { v0 = rope_apply(v0, c0, s0, sgn); v1 = rope_apply(v1, c1, s1, sgn); }
            bf16* dst = (i < 4) ? (QA + (size_t)t * 512 + i * 128) : (i < 8) ? (KA + (size_t)t * 512 + (i - 4) * 128) : (i < 16) ? (QB + (size_t)t * 1024 + (i - 8) * 128) : (KB + (size_t)t * 256 + (i - 16) * 128);
            ((unsigned*)dst)[lane] = pk2(v0, v1);
        }
        {
            float x[8] = {bf_lo(cqv.x), bf_hi(cqv.x), bf_lo(cqv.y), bf_hi(cqv.y), bf_lo(cqv.z), bf_hi(cqv.z), bf_lo(cqv.w), bf_hi(cqv.w)}; float s = 0.f;
#pragma unroll
            for (int i = 0; i < 8; ++i) s += x[i] * x[i];
            const float rstd = rsq(wave_sum(s) * (1.f / 512.f) + EPS);
            v4u w; w.x = pk2(x[0] * rstd * gcq0[0], x[1] * rstd * gcq0[1]); w.y = pk2(x[2] * rstd * gcq0[2], x[3] * rstd * gcq0[3]);
            w.z = pk2(x[4] * rstd * gcq1[0], x[5] * rstd * gcq1[1]); w.w = pk2(x[6] * rstd * gcq1[2], x[7] * rstd * gcq1[3]);
            ((v4u*)(CQN + (size_t)t * 512))[lane] = w;
        }
        {
            const float x0 = bf_lo(ckvv.x), x1 = bf_hi(ckvv.x), x2 = bf_lo(ckvv.y), x3 = bf_hi(ckvv.y);
            const float rstd = rsq(wave_sum((x0 * x0 + x1 * x1) + (x2 * x2 + x3 * x3)) * (1.f / 256.f) + EPS);
            v2u w; w.x = pk2(x0 * rstd * gckv[0], x1 * rstd * gckv[1]); w.y = pk2(x2 * rstd * gckv[2], x3 * rstd * gckv[3]);
            ((v2u*)(CKVN + (size_t)t * 256))[lane] = w;
        }
        {
            float x = bf_lo(kpev);
            const float rstd = rsq(wave_sum(x * x) * (1.f / 64.f) + EPS);
            x = rope_apply(x * rstd * gkpe, c2, s2, sgn);
            KPE[(size_t)t * 64 + lane] = (bf16)(pk2(x, 0.f) & 0xffffu);
        }
    }
}

__device__ __forceinline__ void phase_postmla(const Frame& F, const Args& a, int l) {
    int tid_ = threadIdx.x; asm volatile("" : "+v"(tid_)); const int tid = tid_, lane = tid & 63; (void)tid; (void)lane;
    const bf16* QCR = (const bf16*)(F.ws + WS_QCR); const bf16* KVR = (const bf16*)(F.ws + WS_KVR); const bf16* KPE = (const bf16*)(F.ws + WS_KPE);
    bf16* QC = (bf16*)(F.ws + WS_QC); bf16* KC = (bf16*)(F.ws + WS_KC);
    const f32x2 gqn = ((const f32x2*)(a.in[I_QNC] + l * 192))[lane], gkn = ((const f32x2*)(a.in[I_KNC] + l * 192))[lane];
    const float gqpe = a.in[I_QNC][l * 192 + 128 + lane];
    constexpr float LOG2T = 13.287712379549449f;
    const float f64 = __builtin_amdgcn_exp2f(-(float)(lane & 15) * (LOG2T / 16.f));
    const float sgn = (lane & 16) ? 1.f : -1.f;
    for (int t = F.gw; t < NTOK; t += F.ngw) {
        const int pos = t & (SEQ - 1); const float p = (float)((lane & 32) ? (pos & 63) : (pos >> 6));
        float s2, c2; sincos_rev(p * f64, s2, c2);
        const bf16* qr = QCR + (size_t)t * 768; const bf16* kr = KVR + (size_t)t * 1024;
        unsigned qn[4], kn[4]; unsigned qp[4];
#pragma unroll
        for (int h = 0; h < 4; ++h) { qn[h] = ((const unsigned*)(qr + h * 192))[lane]; qp[h] = (unsigned)qr[h * 192 + 128 + lane]; kn[h] = ((const unsigned*)(kr + h * 256))[lane]; }
        const bf16 kpe = KPE[(size_t)t * 64 + lane];
#pragma unroll
        for (int h = 0; h < 4; ++h) {
            { float v0 = bf_lo(qn[h]), v1 = bf_hi(qn[h]); const float rstd = rsq(wave_sum(v0 * v0 + v1 * v1) * (1.f / 128.f) + EPS);
              ((unsigned*)(QC + (size_t)t * 768 + h * 192))[lane] = pk2(v0 * rstd * gqn[0], v1 * rstd * gqn[1]); }
            { float x = bf_lo(qp[h]); const float rstd = rsq(wave_sum(x * x) * (1.f / 64.f) + EPS); x = rope_apply(x * rstd * gqpe, c2, s2, sgn);
              QC[(size_t)t * 768 + h * 192 + 128 + lane] = (bf16)(pk2(x, 0.f) & 0xffffu); }
            { float v0 = bf_lo(kn[h]), v1 = bf_hi(kn[h]); const float rstd = rsq(wave_sum(v0 * v0 + v1 * v1) * (1.f / 128.f) + EPS);
              ((unsigned*)(KC + (size_t)t * 768 + h * 192))[lane] = pk2(v0 * rstd * gkn[0], v1 * rstd * gkn[1]); }
            KC[(size_t)t * 768 + h * 192 + 128 + lane] = kpe;
        }
    }
}

__device__ __forceinline__ void phase_groupnorm(const Frame& F, const Args& a, int l) {
    int tid_ = threadIdx.x; asm volatile("" : "+v"(tid_)); const int tid = tid_, lane = tid & 63; (void)tid; (void)lane;
    const bf16* O = (const bf16*)(F.ws + WS_O); bf16* ON = (bf16*)(F.ws + WS_ON);
    f32x4 g[4][2];
    { const f32x4* ga = (const f32x4*)(a.in[I_ONA] + l * 512); const f32x4* gb = (const f32x4*)(a.in[I_ONB] + l * 1024); const f32x4* gc = (const f32x4*)(a.in[I_ONC] + l * 512);
      g[0][0] = ga[2 * lane]; g[0][1] = ga[2 * lane + 1]; g[1][0] = gb[2 * lane]; g[1][1] = gb[2 * lane + 1]; g[2][0] = gb[128 + 2 * lane]; g[2][1] = gb[128 + 2 * lane + 1]; g[3][0] = gc[2 * lane]; g[3][1] = gc[2 * lane + 1]; }
    for (int t = F.gw; t < NTOK; t += F.ngw) {
        const v4u* orow = (const v4u*)(O + (size_t)t * DM) + lane; float x[4][8]; float ss[4];
#pragma unroll
        for (int j = 0; j < 4; ++j) { const v4u w = orow[64 * j]; x[j][0] = bf_lo(w.x); x[j][1] = bf_hi(w.x); x[j][2] = bf_lo(w.y); x[j][3] = bf_hi(w.y); x[j][4] = bf_lo(w.z); x[j][5] = bf_hi(w.z); x[j][6] = bf_lo(w.w); x[j][7] = bf_hi(w.w);
            float s = 0.f;
#pragma unroll
            for (int i = 0; i < 8; ++i) s += x[j][i] * x[j][i];
            ss[j] = s; }
        const float ra = rsq(wave_sum(ss[0]) * (1.f / 512.f) + EPS), rb = rsq(wave_sum(ss[1] + ss[2]) * (1.f / 1024.f) + EPS), rc = rsq(wave_sum(ss[3]) * (1.f / 512.f) + EPS);
        v4u* nrow = (v4u*)(ON + (size_t)t * DM) + lane;
#pragma unroll
        for (int j = 0; j < 4; ++j) { const float r = (j == 0) ? ra : (j == 3) ? rc : rb; v4u w;
            w.x = pk2(x[j][0] * r * g[j][0][0], x[j][1] * r * g[j][0][1]); w.y = pk2(x[j][2] * r * g[j][0][2], x[j][3] * r * g[j][0][3]);
            w.z = pk2(x[j][4] * r * g[j][1][0], x[j][5] * r * g[j][1][1]); w.w = pk2(x[j][6] * r * g[j][1][2], x[j][7] * r * g[j][1][3]); nrow[64 * j] = w; }
    }
}

constexpr int ROUTER_LDS = 0;
constexpr int MOE_LDS_CNT = 65536;
constexpr int MOE_LDS_REC = 65536 + 64;
template <bool F8OUT>
__device__ __forceinline__ void phase_ffnnorm_route(const Frame& F, const Args& a, const float* __restrict__ src, const float* __restrict__ gain, void* __restrict__ dstv, float osc) {
    int tid_ = threadIdx.x; asm volatile("" : "+v"(tid_)); const int tid = tid_, lane = tid & 63; (void)tid; (void)lane;
    LAS float* rt = (LAS float*)(F.lds + ROUTER_LDS); LAS unsigned* lcnt = (LAS unsigned*)(F.lds + MOE_LDS_CNT); LAS int* rec = (LAS int*)(F.lds + MOE_LDS_REC);
    const float* router = a.in[I_ROUTER];
    for (int i = tid; i < DM * NE / 4; i += NWAVES * 64) ((LAS f32x4*)rt)[i] = ((const f32x4*)router)[i];
    if (tid < 16) lcnt[tid] = 0u;
    __syncthreads();
    const int t0 = (int)(((long)F.bid * NTOK) / F.G), t1 = (int)(((long)(F.bid + 1) * NTOK) / F.G);
    f32x4 g[8];
#pragma unroll
    for (int j = 0; j < 8; ++j) g[j] = ((const f32x4*)gain)[64 * j + lane];
    for (int m = t0 + F.wave; m < t1; m += NWAVES) {
        const f32x4* xr = (const f32x4*)(src + (size_t)m * DM) + lane; f32x4 v[8]; float s = 0.f;
#pragma unroll
        for (int j = 0; j < 8; ++j) { v[j] = xr[64 * j]; s += (v[j][0] * v[j][0] + v[j][1] * v[j][1]) + (v[j][2] * v[j][2] + v[j][3] * v[j][3]); }
        const float rstd = rsq(wave_sum(s) * (1.f / DM) + EPS);
        v2u* o8 = (v2u*)((bf16*)dstv + (size_t)m * DM) + lane; unsigned* o4 = (unsigned*)((unsigned char*)dstv + (size_t)m * DM) + lane;
        float lg[8] = {0.f, 0.f, 0.f, 0.f, 0.f, 0.f, 0.f, 0.f};
#pragma unroll
        for (int j = 0; j < 8; ++j) {
            f32x4 h; h[0] = v[j][0] * rstd * g[j][0]; h[1] = v[j][1] * rstd * g[j][1]; h[2] = v[j][2] * rstd * g[j][2]; h[3] = v[j][3] * rstd * g[j][3];
            if constexpr (F8OUT) o4[64 * j] = pk4_fp8(h[0] * osc, h[1] * osc, h[2] * osc, h[3] * osc); else { v2u w; w.x = pk2(h[0], h[1]); w.y = pk2(h[2], h[3]); o8[64 * j] = w; }
            const int k0 = 256 * j + 4 * lane;
#pragma unroll
            for (int i = 0; i < 4; ++i) { const f32x4 r0 = ((const LAS f32x4*)(rt + (k0 + i) * 8))[0], r1 = ((const LAS f32x4*)(rt + (k0 + i) * 8))[1];
                lg[0] += h[i] * r0[0]; lg[1] += h[i] * r0[1]; lg[2] += h[i] * r0[2]; lg[3] += h[i] * r0[3]; lg[4] += h[i] * r1[0]; lg[5] += h[i] * r1[1]; lg[6] += h[i] * r1[2]; lg[7] += h[i] * r1[3]; }
        }
#pragma unroll
        for (int e = 0; e < 8; ++e) lg[e] = wave_sum(lg[e]);
        int e0 = 0; float v0 = lg[0];
#pragma unroll
        for (int e = 1; e < 8; ++e) if (lg[e] > v0) { v0 = lg[e]; e0 = e; }
        int e1 = -1; float v1 = -3.0e38f;
#pragma unroll
        for (int e = 0; e < 8; ++e) if (e != e0 && lg[e] > v1) { v1 = lg[e]; e1 = e; }
        const float ex = __expf(v1 - v0), w0 = 1.f / (1.f + ex), w1 = ex * w0;
        if (lane == 0) { const int li = m - t0; const unsigned p0 = atomicAdd((unsigned*)&lcnt[e0], 1u), p1 = atomicAdd((unsigned*)&lcnt[e1], 1u);
            rec[li * 6 + 0] = e0; rec[li * 6 + 1] = e1; rec[li * 6 + 2] = (int)p0; rec[li * 6 + 3] = (int)p1; ((LAS float*)rec)[li * 6 + 4] = w0; ((LAS float*)rec)[li * 6 + 5] = w1; }
    }
    __syncthreads();
    if (tid < 8) lcnt[8 + tid] = __hip_atomic_fetch_add(F.ctl + CW_CNT + tid, lcnt[tid], __ATOMIC_RELAXED, __HIP_MEMORY_SCOPE_AGENT);
    __syncthreads();
    int* toke = (int*)(F.ws + WS_TOKE); int* tokp = (int*)(F.ws + WS_TOKP); float* tokw = (float*)(F.ws + WS_TOKW);
    for (int i = tid; i < (t1 - t0) * 2; i += NWAVES * 64) { const int li = i >> 1, k = i & 1, e = rec[li * 6 + k];
        toke[(size_t)(t0 + li) * 2 + k] = e; tokp[(size_t)(t0 + li) * 2 + k] = rec[li * 6 + 2 + k] + (int)lcnt[8 + e]; tokw[(size_t)(t0 + li) * 2 + k] = ((LAS float*)rec)[li * 6 + 4 + k]; }
    __syncthreads();
}
__device__ __forceinline__ void moe_tiles(const Frame& F, int (&tb)[9], int (&cnt)[8]) {
    int acc = 0;
#pragma unroll
    for (int e = 0; e < 8; ++e) { cnt[e] = (int)__hip_atomic_load(F.ctl + CW_CNT + e, __ATOMIC_RELAXED, __HIP_MEMORY_SCOPE_AGENT); tb[e] = acc; acc += (cnt[e] + 255) >> 8; }
    tb[8] = acc;
}
template <bool F8ROWS>
__device__ __forceinline__ void phase_gather(const Frame& F) {
    int tid_ = threadIdx.x; asm volatile("" : "+v"(tid_)); const int tid = tid_, lane = tid & 63; (void)tid; (void)lane;
    int tb[9], cnt[8]; moe_tiles(F, tb, cnt);
    constexpr int RBYTES = F8ROWS ? DM : 2 * DM, NCH = RBYTES / 1024;
    const unsigned char* H = (const unsigned char*)(F.ws + WS_H); unsigned char* HG = (unsigned char*)(F.ws + WS_HG); float* rg = (float*)(F.ws + WS_RGATE);
    const int* toke = (const int*)(F.ws + WS_TOKE); int* tokp = (int*)(F.ws + WS_TOKP); const float* tokw = (const float*)(F.ws + WS_TOKW);
    for (int t = F.gw; t < NTOK; t += F.ngw) {
        const v4u* hr = (const v4u*)(H + (size_t)t * RBYTES) + lane; v4u v[NCH];
#pragma unroll
        for (int j = 0; j < NCH; ++j) v[j] = hr[64 * j];
#pragma unroll
        for (int k = 0; k < 2; ++k) { const int e = toke[(size_t)t * 2 + k], p = tokp[(size_t)t * 2 + k]; int base = 0;
#pragma unroll
            for (int q = 0; q < 8; ++q) base = (q == e) ? tb[q] : base;
            const int slot = base * 256 + p; v4u* dr = (v4u*)(HG + (size_t)slot * RBYTES) + lane;
#pragma unroll
            for (int j = 0; j < NCH; ++j) dr[64 * j] = v[j];
            if (lane == 0) { rg[slot] = tokw[(size_t)t * 2 + k]; tokp[(size_t)t * 2 + k] = slot; } }
    }
#pragma unroll
    for (int e = 0; e < 8; ++e) { const int r0 = tb[e] * 256 + cnt[e], r1 = tb[e + 1] * 256;
        for (int r = r0 + F.gw; r < r1; r += F.ngw) { v4u* dr = (v4u*)(HG + (size_t)r * RBYTES) + lane; const v4u z = {0u, 0u, 0u, 0u};
#pragma unroll
            for (int j = 0; j < NCH; ++j) dr[64 * j] = z;
            if (lane == 0) rg[r] = 0.f; } }
}
__device__ __forceinline__ void phase_combine(const Frame& F, float* __restrict__ out) {
    int tid_ = threadIdx.x; asm volatile("" : "+v"(tid_)); const int tid = tid_, lane = tid & 63; (void)tid; (void)lane;
    const bf16* Y = (const bf16*)(F.ws + WS_Y); const int* tokp = (const int*)(F.ws + WS_TOKP);
    for (int t = F.gw; t < NTOK; t += F.ngw) {
        const int s0 = tokp[(size_t)t * 2], s1 = tokp[(size_t)t * 2 + 1];
        const v4u* y0 = (const v4u*)(Y + (size_t)s0 * DM) + lane; const v4u* y1 = (const v4u*)(Y + (size_t)s1 * DM) + lane;
        f32x4* xr = (f32x4*)(out + (size_t)t * DM) + 2 * lane;
#pragma unroll
        for (int j = 0; j < 4; ++j) { const v4u p = y0[64 * j], q = y1[64 * j]; f32x4 xa = xr[128 * j], xb = xr[128 * j + 1];
            xa[0] += bf_lo(p.x) + bf_lo(q.x); xa[1] += bf_hi(p.x) + bf_hi(q.x); xa[2] += bf_lo(p.y) + bf_lo(q.y); xa[3] += bf_hi(p.y) + bf_hi(q.y);
            xb[0] += bf_lo(p.z) + bf_lo(q.z); xb[1] += bf_hi(p.z) + bf_hi(q.z); xb[2] += bf_lo(p.w) + bf_lo(q.w); xb[3] += bf_hi(p.w) + bf_hi(q.w);
            xr[128 * j] = xa; xr[128 * j + 1] = xb; }
    }
}

__device__ __forceinline__ void phase_attention(const Frame& F, const Args& a, int l) {
    int tid_ = threadIdx.x; asm volatile("" : "+v"(tid_)); const int tid = tid_, lane = tid & 63; (void)tid; (void)lane;
    const bf16* PROJ = (const bf16*)(F.ws + WS_PROJ);
    const bf16* QA = (const bf16*)(F.ws + WS_QA); const bf16* KA = (const bf16*)(F.ws + WS_KA); const bf16* QB = (const bf16*)(F.ws + WS_QB); const bf16* KB = (const bf16*)(F.ws + WS_KB);
    const bf16* KVR = (const bf16*)(F.ws + WS_KVR); const bf16* QC = (const bf16*)(F.ws + WS_QC); const bf16* KC = (const bf16*)(F.ws + WS_KC);
    bf16* O = (bf16*)(F.ws + WS_O);
    char* L = (char*)F.lds;
    if (PHON(16)) for (int Lu = F.bid; Lu < 256; Lu += F.G) {
        const int id = (Lu & 7) * 32 + (Lu >> 3), b = id >> 6, h = (id >> 4) & 3, qb = id & 15; const size_t tq = (size_t)b * SEQ + qb * 256, tk = (size_t)b * SEQ;
        att::attn_body<192, 768, 768, 1024, 2048, 0, 1, 8>(QC + tq * 768 + h * 192, KC + tk * 768 + h * 192, KVR + tk * 1024 + h * 256 + 128, O + tq * DM + 1536 + h * 128, SEQ / 64, L, 0, 0, nullptr);
    }
    if (PHON(17)) for (int Lu = F.bid; Lu < 512; Lu += F.G) {
        const int id = (Lu & 7) * 64 + (Lu >> 3), b = id >> 7, kvh = (id >> 6) & 1, g = (id >> 4) & 3, qb = id & 15, h = kvh * 4 + g; const size_t tq = (size_t)b * SEQ + qb * 256, tk = (size_t)b * SEQ;
        att::attn_body<128, 1024, 256, 4096, 2048, 0, 1, 8>(QB + tq * 1024 + h * 128, KB + tk * 256 + kvh * 128, PROJ + tk * DINP + PC_VB + kvh * 128, O + tq * DM + 512 + h * 128, SEQ / 64, L, 0, 0, nullptr);
    }
    float* biasT = (float*)(L + 136 * 1024);
    if (PHON(18)) for (int Lu = F.bid; Lu < 256; Lu += F.G) {
        const int id = (Lu & 7) * 32 + (Lu >> 3), b = id >> 6, h = (id >> 4) & 3, rb = id & 15; const size_t tq = (size_t)b * SEQ + rb * 256;
        int lo = min(max(rb * 4 - 4, 0), 56), hi = min(max(rb * 4 + 3 - 4, 0), 56) + 8;
        if ((hi - lo) & 1) { if (hi < 64) ++hi; else --lo; }
        __syncthreads();
        const float* rpb = a.in[I_RPB] + ((size_t)l * 4 + h) * 465;
        for (int i = tid; i < 15 * 128; i += NWAVES * 64) { const int bi = i >> 7, bj = (i & 127) - 48; biasT[i] = (bj >= 0 && bj < 31) ? rpb[bi * 31 + bj] * 11.313708498984761f : 0.f; }
        __syncthreads();
        const size_t tk = (size_t)b * SEQ + lo * 64;
        att::attn_body<128, 512, 512, 4096, 2048, 1, 1, 4>(QA + tq * 512 + h * 128, KA + tk * 512 + h * 128, PROJ + tk * DINP + PC_VA + h * 128, O + tq * DM + h * 128, hi - lo, L, rb * 4, lo, biasT);
    }
}

#ifndef FFN_F8
#define FFN_F8 2
#endif
constexpr bool F8D = (FFN_F8 & 1) != 0, F8M = (FFN_F8 & 2) != 0;
constexpr float SC_H = 4.f, SC_ACT = 8.f, SC_W = 256.f;
constexpr int E8_H = 0x7D7D7D7D, E8_ACT = 0x7C7C7C7C, E8_W = 0x77777777;
constexpr int NPHASE = 24;
__global__ void __launch_bounds__(NWAVES * 64, 2) mega_fwd(Args args) {
    extern __shared__ __attribute__((aligned(16))) unsigned char lds_raw[];
    Frame F;
    F.lds = (LAS unsigned char*)lds_raw; F.ws = args.ws; F.ctl = (unsigned*)(args.ws + WS_CTL);
    F.wave = __builtin_amdgcn_readfirstlane((int)threadIdx.x >> 6);
    F.G = gridDim.x; F.bid = blockIdx.x; F.gw = F.bid * NWAVES + F.wave; F.ngw = F.G * NWAVES;
    volatile LAS unsigned* MISC = (volatile LAS unsigned*)(F.lds + MISC_OFF);
    if (threadIdx.x < 64) MISC[threadIdx.x] = 0u;
    __syncthreads();
    XcdBarrier bar = xcd_barrier_post(F.ctl + CW_BAR, MISC + 8);
    const int lo = args.ph_lo, hi = args.ph_hi;
#define IN(k) (lo <= (k) && (k) < hi)
#define SEAM(k) do { if (IN(k) && IN((k) + 1)) xcd_barrier(bar); } while (0)
    float* out = args.out;
    LAS unsigned char* ring = F.lds;

    if (PHON(0) && IN(0)) {
        int tid_ = threadIdx.x; asm volatile("" : "+v"(tid_)); const int tid = tid_, lane = tid & 63; (void)tid; (void)lane;
        LAS float* scr = (LAS float*)(F.lds + F.wave * 16896);
        int it = F.gw;
#define TR_RUN(Wp, Kk, Nn, Dp, ROFF, MODE) do { const int cnt_ = ((Kk) >> 6) * ((Nn) >> 6); while (it < cnt_) { transpose_item((Wp), (Kk), (Nn), (Dp), (ROFF), (MODE), scr, it, lane); it += F.ngw; } it -= cnt_; } while (0)
#define TR_RUN8(Wp, Kk, Nn, Dp, ROFF, MODE) do { const int cnt_ = ((Kk) >> 7) * ((Nn) >> 5); while (it < cnt_) { transpose_item_f8((Wp), (Kk), (Nn), (Dp), (ROFF), (MODE), SC_W, scr8, it, lane); it += F.ngw; } it -= cnt_; } while (0)
        LAS float* scr8 = (LAS float*)(F.lds + F.wave * 16896);
        for (int l = 0; l < DEPTH; ++l) {
            TR_RUN(args.in[I_WIN] + (size_t)l * DM * DIN, DM, DIN, (bf16*)(F.ws + WS_WIN) + (size_t)l * DINP * DM, 0, 0);
            TR_RUN(args.in[I_WUQ] + (size_t)l * 512 * 768, 512, 768, (bf16*)(F.ws + WS_WUQ) + (size_t)l * 768 * 512, 0, 0);
            TR_RUN(args.in[I_WUKV] + (size_t)l * 256 * 1024, 256, 1024, (bf16*)(F.ws + WS_WUKV) + (size_t)l * 1024 * 256, 0, 0);
            TR_RUN(args.in[I_WOUT] + (size_t)l * DM * DM, DM, DM, (bf16*)(F.ws + WS_WOUT) + (size_t)l * DM * DM, 0, 0);
        }
        if constexpr (F8D) {
            TR_RUN8(args.in[I_WG], DM, DFF, (unsigned char*)(F.ws + WS_WGU), 0, 1);
            TR_RUN8(args.in[I_WU], DM, DFF, (unsigned char*)(F.ws + WS_WGU), 0, 2);
            TR_RUN8(args.in[I_WDN], DFF, DM, (unsigned char*)(F.ws + WS_WD), 0, 0);
        } else {
            TR_RUN(args.in[I_WG], DM, DFF, (bf16*)(F.ws + WS_WGU), 0, 1);
            TR_RUN(args.in[I_WU], DM, DFF, (bf16*)(F.ws + WS_WGU), 0, 2);
            TR_RUN(args.in[I_WDN], DFF, DM, (bf16*)(F.ws + WS_WD), 0, 0);
        }
        if constexpr (F8M) {
            for (int e = 0; e < NE; ++e) {
                TR_RUN8(args.in[I_WEG] + (size_t)e * DM * DFE, DM, DFE, (unsigned char*)(F.ws + WS_WEGU) + (size_t)e * 2 * DFE * DM, 0, 1);
                TR_RUN8(args.in[I_WEU] + (size_t)e * DM * DFE, DM, DFE, (unsigned char*)(F.ws + WS_WEGU) + (size_t)e * 2 * DFE * DM, 0, 2);
                TR_RUN8(args.in[I_WED] + (size_t)e * DFE * DM, DFE, DM, (unsigned char*)(F.ws + WS_WED) + (size_t)e * DM * DFE, 0, 0);
            }
        } else {
            for (int e = 0; e < NE; ++e) {
                TR_RUN(args.in[I_WEG] + (size_t)e * DM * DFE, DM, DFE, (bf16*)(F.ws + WS_WEGU) + (size_t)e * 2 * DFE * DM, 0, 1);
                TR_RUN(args.in[I_WEU] + (size_t)e * DM * DFE, DM, DFE, (bf16*)(F.ws + WS_WEGU) + (size_t)e * 2 * DFE * DM, 0, 2);
                TR_RUN(args.in[I_WED] + (size_t)e * DFE * DM, DFE, DM, (bf16*)(F.ws + WS_WED) + (size_t)e * DM * DFE, 0, 0);
            }
        }
#undef TR_RUN
#undef TR_RUN8
        for (int l = 0; l < DEPTH; ++l) { v4u* z = (v4u*)((bf16*)(F.ws + WS_WIN) + ((size_t)l * DINP + DIN) * DM); const v4u zz = {0u, 0u, 0u, 0u};
            for (int i = F.bid * NWAVES * 64 + tid; i < (DINP - DIN) * DM / 8; i += F.G * NWAVES * 64) z[i] = zz; }
        phase_rmsnorm<false>(F, args.in[I_X], args.in[I_MIXN], F.ws + WS_H, 1.f);
    }
    SEAM(0);

#pragma nounroll
    for (int l = 0; l < DEPTH; ++l) {
        const int P = 11 * l;
        if (PHON(1) && IN(P + 1)) {
            pg8::Gemm g{(const bf16*)(F.ws + WS_H), (const bf16*)(F.ws + WS_WIN) + (size_t)l * DINP * DM, NTOK, DINP, DM, 0, 0}; pg8::StaticOrder S; S.init(NTOK, DINP, F.G, F.bid);
            pg8::EpiBf16 E{(bf16*)(F.ws + WS_PROJ), DINP};
            pg8::gemm_phase<pg8::EpiBf16, pg8::StaticOrder, true, true>(ring, g, S, E);
        }
        SEAM(P + 1);
        if (PHON(2) && IN(P + 2)) phase_postproj(F, args, l);
        SEAM(P + 2);
        if (PHON(3) && IN(P + 3)) {
            { pg8::Gemm g{(const bf16*)(F.ws + WS_CQN), (const bf16*)(F.ws + WS_WUQ) + (size_t)l * 768 * 512, NTOK, 768, 512, 0, 0}; pg8::StaticOrder S; S.init(NTOK, 768, F.G, F.bid);
              pg8::EpiBf16 E{(bf16*)(F.ws + WS_QCR), 768}; pg8::gemm_phase<pg8::EpiBf16, pg8::StaticOrder, true, true>(ring, g, S, E); }
            { pg8::Gemm g{(const bf16*)(F.ws + WS_CKVN), (const bf16*)(F.ws + WS_WUKV) + (size_t)l * 1024 * 256, NTOK, 1024, 256, 0, 0}; pg8::StaticOrder S; S.init(NTOK, 1024, F.G, F.bid);
              pg8::EpiBf16 E{(bf16*)(F.ws + WS_KVR), 1024}; pg8::gemm_phase<pg8::EpiBf16, pg8::StaticOrder, true, true>(ring, g, S, E); }
        }
        SEAM(P + 3);
        if (PHON(4) && IN(P + 4)) phase_postmla(F, args, l);
        SEAM(P + 4);
        if (PHON(5) && IN(P + 5)) { phase_attention(F, args, l); __syncthreads(); }
        SEAM(P + 5);
        if (PHON(6) && IN(P + 6)) phase_groupnorm(F, args, l);
        SEAM(P + 6);
        if (PHON(7) && IN(P + 7)) {
            pg8::Gemm g{(const bf16*)(F.ws + WS_ON), (const bf16*)(F.ws + WS_WOUT) + (size_t)l * DM * DM, NTOK, DM, DM, 0, 0}; pg8::StaticOrder S; S.init(NTOK, DM, F.G, F.bid);
            pg8::EpiResF32 E{l == 0 ? args.in[I_X] : (const float*)out, out, DM};
            pg8::gemm_phase<pg8::EpiResF32, pg8::StaticOrder, true, true>(ring, g, S, E);
        }
        SEAM(P + 7);
        if (l == 0) {
            if (PHON(8) && IN(P + 8)) phase_rmsnorm<F8D>(F, out, args.in[I_FFNN] + (size_t)l * DM, F.ws + WS_H, F8D ? SC_H : 1.f);
            SEAM(P + 8);
            if (PHON(9) && IN(P + 9)) {
                pg8::Gemm g{F.ws + WS_H, F.ws + WS_WGU, NTOK, 2 * DFF, DM, E8_H, E8_W}; pg8::StaticOrder S; S.init(NTOK, 2 * DFF, F.G, F.bid);
                if constexpr (F8D) { pg8::EpiSwigluF8 E{F.ws + WS_ACT, DFF, SC_ACT}; pg8::gemm_phase<pg8::EpiSwigluF8, pg8::StaticOrder, true, true, true>(ring, g, S, E); }
                else { pg8::EpiSwiglu E{(bf16*)(F.ws + WS_ACT), DFF}; pg8::gemm_phase<pg8::EpiSwiglu, pg8::StaticOrder, true, true, false>(ring, g, S, E); }
            }
            SEAM(P + 9);
            if (PHON(10) && IN(P + 10)) {
                pg8::Gemm g{F.ws + WS_ACT, F.ws + WS_WD, NTOK, DM, DFF, E8_ACT, E8_W}; pg8::StaticOrder S; S.init(NTOK, DM, F.G, F.bid);
                pg8::EpiResF32 E{out, out, DM};
                pg8::gemm_phase<pg8::EpiResF32, pg8::StaticOrder, true, true, F8D>(ring, g, S, E);
            }
            SEAM(P + 10);
            if (PHON(8) && IN(P + 11)) phase_rmsnorm<false>(F, out, args.in[I_MIXN] + (size_t)(l + 1) * DM, F.ws + WS_H, 1.f);
            SEAM(P + 11);
        } else {
            if (PHON(11) && IN(P + 8)) phase_ffnnorm_route<F8M>(F, args, out, args.in[I_FFNN] + (size_t)l * DM, F.ws + WS_H, SC_H);
            SEAM(P + 8);
            if (PHON(12) && IN(P + 9)) phase_gather<F8M>(F);
            SEAM(P + 9);
            if (PHON(13) && IN(P + 10)) {
                int tb[9], cnt[8]; moe_tiles(F, tb, cnt);
                pg8::Gemm g{F.ws + WS_HG, F.ws + WS_WEGU, tb[8] * 256, 2 * DFE, DM, E8_H, E8_W}; pg8::GroupedOrder S; S.init(tb[8] * 256, 2 * DFE, F.G, F.bid);
#pragma unroll
                for (int k = 0; k < 7; ++k) S.tb[k] = tb[k + 1];
                S.nct = 2 * DFE / 256;
                if constexpr (F8M) { pg8::EpiSwigluF8 E{F.ws + WS_ACTM, DFE, SC_ACT}; pg8::gemm_phase<pg8::EpiSwigluF8, pg8::GroupedOrder, true, true, true>(ring, g, S, E); }
                else { pg8::EpiSwiglu E{(bf16*)(F.ws + WS_ACTM), DFE}; pg8::gemm_phase<pg8::EpiSwiglu, pg8::GroupedOrder, true, true, false>(ring, g, S, E); }
            }
            SEAM(P + 10);
            if (PHON(14) && IN(P + 11)) {
                int tb[9], cnt[8]; moe_tiles(F, tb, cnt);
                pg8::Gemm g{F.ws + WS_ACTM, F.ws + WS_WED, tb[8] * 256, DM, DFE, E8_ACT, E8_W}; pg8::GroupedOrder S; S.init(tb[8] * 256, DM, F.G, F.bid);
#pragma unroll
                for (int k = 0; k < 7; ++k) S.tb[k] = tb[k + 1];
                S.nct = DM / 256;
                pg8::EpiScaleBf16 E{(bf16*)(F.ws + WS_Y), DM, (const float*)(F.ws + WS_RGATE)};
                pg8::gemm_phase<pg8::EpiScaleBf16, pg8::GroupedOrder, true, true, F8M>(ring, g, S, E);
            }
            SEAM(P + 11);
            if (PHON(15) && IN(P + 12)) phase_combine(F, out);
        }
    }
#undef IN
#undef SEAM
}

extern "C" void kernel_launch(void* const* d_in, const int* in_sizes, int n_in, void* d_out, int out_size, void* d_ws, size_t ws_size, hipStream_t stream) {
    static int grid = 0;
    if (grid == 0) {
        if (n_in != 26 || in_sizes[0] != NTOK * DM || out_size != NTOK * DM || ws_size < WS_END) { fprintf(stderr, "kernel_launch: unexpected shapes (n_in %d, in0 %d, out %d, ws %zu < %zu)\n", n_in, n_in > 0 ? in_sizes[0] : -1, out_size, ws_size, (size_t)WS_END); grid = -1; return; }
        int dev = 0, cus = 0, per_cu = 0;
        if (hipGetDevice(&dev) != hipSuccess || hipDeviceGetAttribute(&cus, hipDeviceAttributeMultiprocessorCount, dev) != hipSuccess) { grid = -1; return; }
        if (hipFuncSetAttribute((const void*)mega_fwd, hipFuncAttributeMaxDynamicSharedMemorySize, LDS_BYTES) != hipSuccess) { fprintf(stderr, "kernel_launch: hipFuncSetAttribute failed\n"); grid = -1; return; }
        if (hipOccupancyMaxActiveBlocksPerMultiprocessor(&per_cu, (const void*)mega_fwd, NWAVES * 64, LDS_BYTES) != hipSuccess || per_cu < 1) fprintf(stderr, "kernel_launch: occupancy query reports %d\n", per_cu);
        (void)hipGetLastError();
        grid = cus;
    }
    if (grid < 0) return;
    if (hipMemsetAsync((char*)d_ws + WS_CTL, 0, CTL_ZERO_BYTES, stream) != hipSuccess) return;
    Args a{};
    for (int i = 0; i < 26; ++i) a.in[i] = (const float*)d_in[i];
    a.out = (float*)d_out; a.ws = (unsigned char*)d_ws;
#ifndef MK_SPLIT
    a.ph_lo = 0; a.ph_hi = NPHASE;
    hipLaunchKernelGGL(mega_fwd, dim3(grid), dim3(NWAVES * 64), LDS_BYTES, stream, a);
#else
    for (int p = 0; p < NPHASE; ++p) { a.ph_lo = p; a.ph_hi = p + 1; hipLaunchKernelGGL(mega_fwd, dim3(grid), dim3(NWAVES * 64), LDS_BYTES, stream, a); }
#endif
}
```

```cpp
#include <hip/hip_runtime.h>
#include <cstdio>
#include <cstdint>
namespace pg8 {
#define PG8_LAS __attribute__((address_space(3)))
typedef unsigned short bf16_t;
typedef short bf16x8 __attribute__((ext_vector_type(8)));
typedef float f32x4 __attribute__((ext_vector_type(4)));
typedef unsigned u32x4 __attribute__((ext_vector_type(4)));
constexpr int BM = 256, BK = 64, HALF = 128, HTB = HALF * BK * 2  , STAGE_BYTES = 8 * HTB, NXCD = 8, WGM = 8;

__host__ __device__ __forceinline__ int lds_byte(int r, int c) { const int st = (r >> 4) * 2 + (c >> 5), rr = r & 15, cc = c & 31, ob = rr * 64 + cc * 2; return st * 1024 + (ob ^ (((ob >> 9) & 1) << 5)); }
__host__ __device__ __forceinline__ void stage_rc(int b, int& R, int& C) { const int st = b / 1024, sb = b % 1024, swz = sb ^ (((sb >> 9) & 1) << 5); R = (st >> 1) * 16 + swz / 64; C = (st & 1) * 32 + (swz % 64) / 2; }
__host__ __device__ __forceinline__ int perm32(int rho) { const int n = rho >> 4, i = rho & 15; return 8 * (i >> 2) + 4 * n + (i & 3); }


struct Unit { int pm, pn, pc; };
struct Gemm { const void* A; const void* Bt; int M, N, K; int sa, sw; };
typedef int i32x4 __attribute__((ext_vector_type(4)));
typedef int i32x8 __attribute__((ext_vector_type(8)));

struct StaticOrder {
    int nM, nN, nwg, G, c;
    __device__ __forceinline__ void init(int M, int N, int G_, int c_) { nM = M / BM; nN = N / BM; nwg = nM * nN; G = G_; c = c_; }
    __device__ __forceinline__ bool next(int i, Unit& u) const {
        const long L = (long)i * G + c; if (L >= nwg) return false;
        int wgid = (int)L; { const int q = nwg / NXCD, r = nwg % NXCD, xcd = wgid % NXCD, off = wgid / NXCD; wgid = (xcd < r ? xcd * (q + 1) : r * (q + 1) + (xcd - r) * q) + off; }
        const int nig = WGM * nN, gid = wgid / nig, fm = gid * WGM, gsz = (nM - fm) < WGM ? (nM - fm) : WGM;
        u.pm = fm + ((wgid % nig) % gsz); u.pn = (wgid % nig) / gsz; u.pc = u.pn; return true;
    }
    __device__ __forceinline__ void a_ready(const Unit&) const {}
    __device__ __forceinline__ void done(const Unit&) const {}
};
struct GroupedOrder : StaticOrder {
    int tb[7]; int nct;
    __device__ __forceinline__ bool next(int i, Unit& u) const {
        if (!StaticOrder::next(i, u)) return false;
        int e = 0;
#pragma unroll
        for (int k = 0; k < 7; ++k) e += (u.pm >= tb[k]) ? 1 : 0;
        u.pc = u.pn; u.pn += e * nct; return true;
    }
};

__device__ __forceinline__ unsigned cvt_pk_bf16(float lo, float hi) { unsigned r; asm volatile("v_cvt_pk_bf16_f32 %0, %1, %2" : "=v"(r) : "v"(lo), "v"(hi)); return r; }

struct EpiBf16 {
    static constexpr bool PERM = true, AFTER_DRAIN = false;
    bf16_t* O; int ldc;
    __device__ __forceinline__ void operator()(const f32x4 (&acc)[2][2][4][2], const Unit& u, int wr, int wc, int fr, int fq) const {
        const int row0 = u.pm * BM + wr * 64 + fr, col0 = u.pc * BM + wc * 32 + 8 * fq;
#pragma unroll
        for (int ai = 0; ai < 2; ++ai)
#pragma unroll
            for (int m = 0; m < 4; ++m) { bf16_t* rowp = O + (size_t)(row0 + ai * HALF + m * 16) * ldc + col0;
#pragma unroll
                for (int bj = 0; bj < 2; ++bj) { const f32x4 v0 = acc[ai][bj][m][0], v1 = acc[ai][bj][m][1];
                    u32x4 w; w.x = cvt_pk_bf16(v0[0], v0[1]); w.y = cvt_pk_bf16(v0[2], v0[3]); w.z = cvt_pk_bf16(v1[0], v1[1]); w.w = cvt_pk_bf16(v1[2], v1[3]);
                    *(u32x4*)(rowp + bj * HALF) = w; } }
    }
};
struct EpiScaleBf16 {
    static constexpr bool PERM = true, AFTER_DRAIN = false;
    bf16_t* O; int ldc; const float* rs;
    __device__ __forceinline__ void operator()(const f32x4 (&acc)[2][2][4][2], const Unit& u, int wr, int wc, int fr, int fq) const {
        const int row0 = u.pm * BM + wr * 64 + fr, col0 = u.pc * BM + wc * 32 + 8 * fq;
#pragma unroll
        for (int ai = 0; ai < 2; ++ai)
#pragma unroll
            for (int m = 0; m < 4; ++m) { const int row = row0 + ai * HALF + m * 16; const float s = rs[row]; bf16_t* rowp = O + (size_t)row * ldc + col0;
#pragma unroll
                for (int bj = 0; bj < 2; ++bj) { const f32x4 v0 = acc[ai][bj][m][0] * s, v1 = acc[ai][bj][m][1] * s;
                    u32x4 w; w.x = cvt_pk_bf16(v0[0], v0[1]); w.y = cvt_pk_bf16(v0[2], v0[3]); w.z = cvt_pk_bf16(v1[0], v1[1]); w.w = cvt_pk_bf16(v1[2], v1[3]);
                    *(u32x4*)(rowp + bj * HALF) = w; } }
    }
};
struct EpiResF32 {
    static constexpr bool PERM = false, AFTER_DRAIN = false;
    const float* base; float* out; int ldc;
    __device__ __forceinline__ void operator()(const f32x4 (&acc)[2][2][4][2], const Unit& u, int wr, int wc, int fr, int fq) const {
        const int row0 = u.pm * BM + wr * 64 + fr, col0 = u.pc * BM + wc * 32 + 4 * fq;
#pragma unroll
        for (int ai = 0; ai < 2; ++ai)
#pragma unroll
            for (int m = 0; m < 4; ++m) { const size_t off = (size_t)(row0 + ai * HALF + m * 16) * ldc + col0;
                f32x4 b[2][2];
#pragma unroll
                for (int bj = 0; bj < 2; ++bj)
#pragma unroll
                    for (int n = 0; n < 2; ++n) b[bj][n] = *(const f32x4*)(base + off + bj * HALF + n * 16);
#pragma unroll
                for (int bj = 0; bj < 2; ++bj)
#pragma unroll
                    for (int n = 0; n < 2; ++n) *(f32x4*)(out + off + bj * HALF + n * 16) = b[bj][n] + acc[ai][bj][m][n];
                asm volatile("" ::: "memory"); }
    }
};
__device__ __forceinline__ float silu_mul(float g, float u) { return g * u * __builtin_amdgcn_rcpf(1.0f + __builtin_amdgcn_exp2f(-1.44269504089f * g)); }
struct EpiSwiglu {
    static constexpr bool PERM = true, AFTER_DRAIN = false;
    bf16_t* O; int ldc;
    __device__ __forceinline__ void operator()(const f32x4 (&acc)[2][2][4][2], const Unit& u, int wr, int wc, int fr, int fq) const {
        const int row0 = u.pm * BM + wr * 64 + fr, col0 = u.pc * HALF + wc * 32 + 8 * fq;
#pragma unroll
        for (int ai = 0; ai < 2; ++ai)
#pragma unroll
            for (int m = 0; m < 4; ++m) { bf16_t* rowp = O + (size_t)(row0 + ai * HALF + m * 16) * ldc + col0;
                const f32x4 g0 = acc[ai][0][m][0], g1 = acc[ai][0][m][1], u0 = acc[ai][1][m][0], u1 = acc[ai][1][m][1];
                u32x4 w; w.x = cvt_pk_bf16(silu_mul(g0[0], u0[0]), silu_mul(g0[1], u0[1])); w.y = cvt_pk_bf16(silu_mul(g0[2], u0[2]), silu_mul(g0[3], u0[3]));
                w.z = cvt_pk_bf16(silu_mul(g1[0], u1[0]), silu_mul(g1[1], u1[1])); w.w = cvt_pk_bf16(silu_mul(g1[2], u1[2]), silu_mul(g1[3], u1[3]));
                *(u32x4*)rowp = w; }
    }
};

__device__ __forceinline__ unsigned cvt_pk4_fp8(float a, float b, float c, float d) { unsigned w = 0u; w = __builtin_amdgcn_cvt_pk_fp8_f32(a, b, w, false); w = __builtin_amdgcn_cvt_pk_fp8_f32(c, d, w, true); return w; }
struct EpiSwigluF8 {
    static constexpr bool PERM = true, AFTER_DRAIN = false;
    unsigned char* O; int ldc; float osc;
    __device__ __forceinline__ void operator()(const f32x4 (&acc)[2][2][4][2], const Unit& u, int wr, int wc, int fr, int fq) const {
        const int row0 = u.pm * BM + wr * 64 + fr, col0 = u.pc * HALF + wc * 32 + 8 * fq;
#pragma unroll
        for (int ai = 0; ai < 2; ++ai)
#pragma unroll
            for (int m = 0; m < 4; ++m) { unsigned char* rowp = O + (size_t)(row0 + ai * HALF + m * 16) * ldc + col0;
                const f32x4 g0 = acc[ai][0][m][0], g1 = acc[ai][0][m][1], u0 = acc[ai][1][m][0] * osc, u1 = acc[ai][1][m][1] * osc;
                typedef unsigned u32x2 __attribute__((ext_vector_type(2)));
                u32x2 w; w.x = cvt_pk4_fp8(silu_mul(g0[0], u0[0]), silu_mul(g0[1], u0[1]), silu_mul(g0[2], u0[2]), silu_mul(g0[3], u0[3]));
                w.y = cvt_pk4_fp8(silu_mul(g1[0], u1[0]), silu_mul(g1[1], u1[1]), silu_mul(g1[2], u1[2]), silu_mul(g1[3], u1[3]));
                *(u32x2*)rowp = w; }
    }
};

template <class Epi, class Sched, bool ALIGN_EPI = false, bool SP2 = false, bool F8 = false>
__device__ __forceinline__ void gemm_phase(PG8_LAS unsigned char* lds, const Gemm g, const Sched& S, const Epi& E) {
    int tid_ = threadIdx.x; asm volatile("" : "+v"(tid_));
    const int tid = tid_, wid = __builtin_amdgcn_readfirstlane(tid >> 6), lane = tid & 63, wr = wid >> 2, wc = wid & 3, fr = lane & 15, fq = lane >> 4;
    const int K = g.K, nt = F8 ? K / (2 * BK) : K / BK, RB = F8 ? K : 2 * K;
    unsigned voffA[2], voffB[2];
#pragma unroll
    for (int i = 0; i < 2; ++i) { int R, C; stage_rc(tid * 16 + i * 8192, R, C); const int Rb = Epi::PERM ? ((R & ~31) + perm32(R & 31)) : R;
        voffA[i] = (unsigned)(R * RB + C * 2); voffB[i] = (unsigned)(Rb * RB + C * 2); }
    const size_t kstep = (size_t)(BK * 2);
    const size_t hstep = (size_t)HALF * RB;
    const size_t tstep = 2 * hstep;
    const unsigned ldsw = (unsigned)wid * 1024u;
    const int aoff = F8 ? lds_byte(wr * 64 + fr, fq * 16) : lds_byte(wr * 64 + fr, fq * 8), boff = F8 ? lds_byte(wc * 32 + fr, fq * 16) : lds_byte(wc * 32 + fr, fq * 8);
#define PG8_SA(b, h) (((b) * 2 + (h)) * HTB)
#define PG8_SB(b, h) ((4 + (b) * 2 + (h)) * HTB)
#define PG8_STAGE(bufoff, gbase, voff) do { _Pragma("unroll") for (int _i = 0; _i < 2; ++_i) \
        __builtin_amdgcn_global_load_lds((const unsigned*)((const char*)(gbase) + (voff)[_i]), (PG8_LAS unsigned*)(lds + (bufoff) + ldsw + _i * 8192), 16, 0, 0); } while (0)
#define PG8_LD16(p) (*(const PG8_LAS i32x4*)(p))
#define PG8_LDA(dst, b, h) do { _Pragma("unroll") for (int m = 0; m < 4; ++m) { if constexpr (F8) { dst##8[m] = __builtin_shufflevector(PG8_LD16(lds + PG8_SA(b, h) + aoff + m * 2048), PG8_LD16(lds + PG8_SA(b, h) + aoff + m * 2048 + 16), 0, 1, 2, 3, 4, 5, 6, 7); } \
        else { _Pragma("unroll") for (int k = 0; k < 2; ++k) dst[m][k] = *(const PG8_LAS bf16x8*)(lds + PG8_SA(b, h) + aoff + m * 2048 + k * 1024); } } } while (0)
#define PG8_LDB(dst, b, h) do { _Pragma("unroll") for (int n = 0; n < 2; ++n) { if constexpr (F8) { dst##8[n] = __builtin_shufflevector(PG8_LD16(lds + PG8_SB(b, h) + boff + n * 2048), PG8_LD16(lds + PG8_SB(b, h) + boff + n * 2048 + 16), 0, 1, 2, 3, 4, 5, 6, 7); } \
        else { _Pragma("unroll") for (int k = 0; k < 2; ++k) dst[n][k] = *(const PG8_LAS bf16x8*)(lds + PG8_SB(b, h) + boff + n * 2048 + k * 1024); } } } while (0)
#define PG8_MMA(ai, bj, At, Bt) do { __builtin_amdgcn_s_setprio(1); _Pragma("unroll") for (int m = 0; m < 4; ++m) _Pragma("unroll") for (int n = 0; n < 2; ++n) { \
        if constexpr (F8) asm volatile("v_mfma_scale_f32_16x16x128_f8f6f4 %0, %1, %2, %0, %3, %4 op_sel_hi:[0,0,0]" : "+v"(acc[ai][bj][m][n]) : "v"(Bt##8[n]), "v"(At##8[m]), "v"(f8sw), "v"(f8sa)); \
        else { _Pragma("unroll") for (int k = 0; k < 2; ++k) acc[ai][bj][m][n] = __builtin_amdgcn_mfma_f32_16x16x32_bf16(Bt[n][k], At[m][k], acc[ai][bj][m][n], 0, 0, 0); } } __builtin_amdgcn_s_setprio(0); } while (0)
#define PG8_WAIT_V(n) asm volatile("s_waitcnt vmcnt(" #n ")" ::: "memory")
#define PG8_WAIT_L(n) asm volatile("s_waitcnt lgkmcnt(" #n ")" ::: "memory")
#define PG8_BAR __builtin_amdgcn_s_barrier()
#define PG8_SCHED __builtin_amdgcn_sched_barrier(0)
    Unit cur, nxt; int ui = 0;
    if (!S.next(0, cur)) return;
    f32x4 acc[2][2][4][2];
#pragma unroll
    for (int a = 0; a < 2; ++a)
#pragma unroll
        for (int b = 0; b < 2; ++b)
#pragma unroll
            for (int m = 0; m < 4; ++m)
#pragma unroll
                for (int n = 0; n < 2; ++n) acc[a][b][m][n] = (f32x4){0.f, 0.f, 0.f, 0.f};
    const int f8sw = g.sw, f8sa = g.sa; (void)f8sw; (void)f8sa;
    bf16x8 At[4][2], B0[2][2], B1[2][2]; i32x8 At8[4], B08[2], B18[2];
    const char* cA = (const char*)g.A + (size_t)cur.pm * tstep; const char* cB = (const char*)g.Bt + (size_t)cur.pn * tstep;
    S.a_ready(cur);
    if constexpr (SP2) {
        PG8_STAGE(PG8_SB(0, 0), cB, voffB); PG8_STAGE(PG8_SB(0, 1), cB + hstep, voffB); PG8_STAGE(PG8_SA(0, 0), cA, voffA); PG8_STAGE(PG8_SA(0, 1), cA + hstep, voffA);
        if (wr == 1) PG8_BAR;
        PG8_WAIT_V(2); PG8_BAR;
        PG8_STAGE(PG8_SB(1, 0), cB + kstep, voffB); PG8_STAGE(PG8_SA(1, 0), cA + kstep, voffA); PG8_STAGE(PG8_SB(1, 1), cB + hstep + kstep, voffB);
        PG8_WAIT_V(6); PG8_BAR;
    } else {
        PG8_STAGE(PG8_SB(0, 0), cB, voffB); PG8_STAGE(PG8_SA(0, 0), cA, voffA); PG8_STAGE(PG8_SB(0, 1), cB + hstep, voffB); PG8_STAGE(PG8_SA(0, 1), cA + hstep, voffA);
        if (wr == 1) PG8_BAR;
        PG8_WAIT_V(4); PG8_BAR;
        PG8_STAGE(PG8_SB(1, 0), cB + kstep, voffB); PG8_STAGE(PG8_SA(1, 0), cA + kstep, voffA); PG8_STAGE(PG8_SB(1, 1), cB + hstep + kstep, voffB);
        PG8_WAIT_V(6); PG8_BAR;
    }
    for (;;) {
        const bool has_next = S.next(ui + 1, nxt);
        const char* nA = has_next ? (const char*)g.A + (size_t)nxt.pm * tstep : cA; const char* nB = has_next ? (const char*)g.Bt + (size_t)nxt.pn * tstep : cB;
        for (int t = 0; t < nt; t += 2) {
            const bool last = (t == nt - 2);
            const char* a1 = cA + (size_t)(t + 1) * kstep;
            const char* a2 = last ? nA : cA + (size_t)(t + 2) * kstep; const char* b2 = last ? nB : cB + (size_t)(t + 2) * kstep;
            const char* a3 = a2 + kstep; const char* b3 = b2 + kstep;
            if (last && has_next) S.a_ready(nxt);
            if constexpr (SP2) {
            PG8_LDB(B0, 0, 0); PG8_LDB(B1, 0, 1); PG8_SCHED; PG8_LDA(At, 0, 0); PG8_STAGE(PG8_SA(1, 1), a1 + hstep, voffA);
            PG8_WAIT_V(8); PG8_WAIT_L(0); PG8_BAR; PG8_MMA(0, 0, At, B0); PG8_MMA(0, 1, At, B1); PG8_BAR; PG8_SCHED;
            PG8_LDA(At, 0, 1); PG8_STAGE(PG8_SB(0, 0), b2, voffB); PG8_STAGE(PG8_SB(0, 1), b2 + hstep, voffB); PG8_STAGE(PG8_SA(0, 0), a2, voffA);
            PG8_WAIT_V(8); PG8_WAIT_L(0); PG8_BAR; PG8_MMA(1, 0, At, B0); PG8_MMA(1, 1, At, B1); PG8_BAR; PG8_SCHED;
            PG8_LDB(B0, 1, 0); PG8_LDB(B1, 1, 1); PG8_SCHED; PG8_LDA(At, 1, 0); PG8_STAGE(PG8_SA(0, 1), a2 + hstep, voffA);
            PG8_WAIT_V(8); PG8_WAIT_L(0); PG8_BAR; PG8_MMA(0, 0, At, B0); PG8_MMA(0, 1, At, B1); PG8_BAR; PG8_SCHED;
            PG8_LDA(At, 1, 1); PG8_STAGE(PG8_SB(1, 0), b3, voffB); PG8_STAGE(PG8_SB(1, 1), b3 + hstep, voffB); PG8_STAGE(PG8_SA(1, 0), a3, voffA);
            PG8_WAIT_V(8); PG8_WAIT_L(0); PG8_BAR; PG8_MMA(1, 0, At, B0); PG8_MMA(1, 1, At, B1); PG8_BAR; PG8_SCHED;
            } else {
            PG8_LDB(B0, 0, 0); PG8_SCHED; PG8_LDA(At, 0, 0); PG8_STAGE(PG8_SA(1, 1), a1 + hstep, voffA);
            PG8_WAIT_L(8); PG8_BAR; PG8_WAIT_L(0); PG8_MMA(0, 0, At, B0); PG8_BAR; PG8_SCHED;
            PG8_LDB(B1, 0, 1); PG8_STAGE(PG8_SB(0, 0), b2, voffB);
            PG8_BAR; PG8_WAIT_L(0); PG8_MMA(0, 1, At, B1); PG8_BAR;
            PG8_LDA(At, 0, 1); PG8_STAGE(PG8_SA(0, 0), a2, voffA);
            PG8_BAR; PG8_WAIT_L(0); PG8_MMA(1, 0, At, B0); PG8_BAR; PG8_SCHED;
            PG8_STAGE(PG8_SB(0, 1), b2 + hstep, voffB);
            PG8_WAIT_V(6); PG8_BAR; PG8_MMA(1, 1, At, B1); PG8_BAR;
            PG8_LDB(B0, 1, 0); PG8_SCHED; PG8_LDA(At, 1, 0); PG8_STAGE(PG8_SA(0, 1), a2 + hstep, voffA);
            PG8_WAIT_L(8); PG8_BAR; PG8_WAIT_L(0); PG8_MMA(0, 0, At, B0); PG8_BAR; PG8_SCHED;
            PG8_LDB(B1, 1, 1); PG8_STAGE(PG8_SB(1, 0), b3, voffB);
            PG8_BAR; PG8_WAIT_L(0); PG8_MMA(0, 1, At, B1); PG8_BAR;
            PG8_LDA(At, 1, 1); PG8_STAGE(PG8_SA(1, 0), a3, voffA);
            PG8_BAR; PG8_WAIT_L(0); PG8_MMA(1, 0, At, B0); PG8_BAR; PG8_SCHED;
            PG8_STAGE(PG8_SB(1, 1), b3 + hstep, voffB);
            PG8_WAIT_V(6); PG8_BAR; PG8_MMA(1, 1, At, B1); PG8_BAR;
            }
        }
        if constexpr (ALIGN_EPI) { if (wr == 0) PG8_BAR; }
        if constexpr (F8) {
            asm volatile("s_nop 15\n\ts_nop 15" : "+v"(acc[0][0][0][0]), "+v"(acc[0][0][0][1]), "+v"(acc[0][0][1][0]), "+v"(acc[0][0][1][1]), "+v"(acc[0][0][2][0]), "+v"(acc[0][0][2][1]), "+v"(acc[0][0][3][0]), "+v"(acc[0][0][3][1]) :: "memory");
            asm volatile("" : "+v"(acc[0][1][0][0]), "+v"(acc[0][1][0][1]), "+v"(acc[0][1][1][0]), "+v"(acc[0][1][1][1]), "+v"(acc[0][1][2][0]), "+v"(acc[0][1][2][1]), "+v"(acc[0][1][3][0]), "+v"(acc[0][1][3][1]) :: "memory");
            asm volatile("" : "+v"(acc[1][0][0][0]), "+v"(acc[1][0][0][1]), "+v"(acc[1][0][1][0]), "+v"(acc[1][0][1][1]), "+v"(acc[1][0][2][0]), "+v"(acc[1][0][2][1]), "+v"(acc[1][0][3][0]), "+v"(acc[1][0][3][1]) :: "memory");
            asm volatile("" : "+v"(acc[1][1][0][0]), "+v"(acc[1][1][0][1]), "+v"(acc[1][1][1][0]), "+v"(acc[1][1][1][1]), "+v"(acc[1][1][2][0]), "+v"(acc[1][1][2][1]), "+v"(acc[1][1][3][0]), "+v"(acc[1][1][3][1]) :: "memory");
        }
        if constexpr (!Epi::AFTER_DRAIN) { E(acc, cur, wr, wc, fr, fq); S.done(cur); }
        if (!has_next) break;
#pragma unroll
        for (int a = 0; a < 2; ++a)
#pragma unroll
            for (int b = 0; b < 2; ++b)
#pragma unroll
                for (int m = 0; m < 4; ++m)
#pragma unroll
                    for (int n = 0; n < 2; ++n) acc[a][b][m][n] = (f32x4){0.f, 0.f, 0.f, 0.f};
        cur = nxt; cA = nA; cB = nB; ++ui;
        if constexpr (ALIGN_EPI) { if (wr == 1) PG8_BAR; }
    }
    PG8_WAIT_V(0);
    if constexpr (!ALIGN_EPI) { if (wr == 0) PG8_BAR; }
    PG8_BAR;
    if constexpr (Epi::AFTER_DRAIN) { E.fused(acc, cur, wr, wc, fr, fq, lds, wid, lane); S.done(cur); }
#undef PG8_SA
#undef PG8_SB
#undef PG8_STAGE
#undef PG8_LDA
#undef PG8_LDB
#undef PG8_MMA
#undef PG8_LD16
#undef PG8_WAIT_V
#undef PG8_WAIT_L
#undef PG8_BAR
#undef PG8_SCHED
}
}

namespace att {
typedef unsigned short bf16;
using bf16x8 = __attribute__((ext_vector_type(8))) short;
using s16x4  = __attribute__((ext_vector_type(4))) short;
using f32x16 = __attribute__((ext_vector_type(16))) float;
using u32x4  = __attribute__((ext_vector_type(4))) unsigned;
constexpr int NW = 8, QBLK = 32, KVBLK = 64, DV = 128;
constexpr float THR = 8.f;
constexpr int SHM_V = KVBLK * DV * 2;
#define ATT_SBAR() __builtin_amdgcn_sched_barrier(0)
__device__ __forceinline__ int crow(int r, int hi) { return (r & 3) + 8 * (r >> 2) + 4 * hi; }
__device__ __forceinline__ unsigned cvtpk(float lo, float hi) { unsigned r; asm volatile("v_cvt_pk_bf16_f32 %0, %1, %2" : "=v"(r) : "v"(lo), "v"(hi)); return r; }
template <int DQ> struct Cst { static constexpr float SCALE = (DQ == 128) ? 0.088388347648318440f : 0.072168783648703220f; static constexpr int SHM_K = KVBLK * DQ * 2, ROWB = DQ * 2; };

template <int DQ>
__device__ __forceinline__ void partialSM(f32x16& p0, f32x16& p1, float& m_reg, float& mn, float& alpha) {
  constexpr float SCALE = Cst<DQ>::SCALE, C = SCALE * 1.4426950408889634f;
  float pmax = p0[0];
#pragma unroll
  for (int r = 1; r < 16; ++r) pmax = fmaxf(pmax, p0[r]);
#pragma unroll
  for (int r = 0; r < 16; ++r) pmax = fmaxf(pmax, p1[r]);
  { auto rr = __builtin_amdgcn_permlane32_swap(__float_as_uint(pmax), __float_as_uint(pmax), false, false);
    pmax = fmaxf(__uint_as_float(rr[0]), __uint_as_float(rr[1])); }
  if (__builtin_expect(__all(pmax - m_reg <= THR / SCALE), 1)) { mn = m_reg; alpha = 1.f; }
  else { mn = fmaxf(m_reg, pmax); alpha = __builtin_amdgcn_exp2f((m_reg - mn) * C); m_reg = mn; }
  const float mnC = -mn * C;
#pragma unroll
  for (int r = 0; r < 16; ++r) p0[r] = fmaf(p0[r], C, mnC);
#pragma unroll
  for (int r = 0; r < 16; ++r) p1[r] = fmaf(p1[r], C, mnC);
#pragma unroll
  for (int r = 0; r < 16; ++r) p0[r] = __builtin_amdgcn_exp2f(p0[r]);
}
__device__ __forceinline__ void finishSM(f32x16& p0, f32x16& p1, float alpha, float& l_reg, bf16x8& pa0, bf16x8& pa1, bf16x8& pa2, bf16x8& pa3) {
#pragma unroll
  for (int r = 0; r < 16; ++r) p1[r] = __builtin_amdgcn_exp2f(p1[r]);
  float ps = 0;
#pragma unroll
  for (int r = 0; r < 16; ++r) ps += p0[r];
#pragma unroll
  for (int r = 0; r < 16; ++r) ps += p1[r];
  { auto rr = __builtin_amdgcn_permlane32_swap(__float_as_uint(ps), __float_as_uint(ps), false, false);
    ps = __uint_as_float(rr[0]) + __uint_as_float(rr[1]); }
  l_reg = l_reg * alpha + ps;
#define ATT_PK4(P, BASE, OUT) do { unsigned a0 = cvtpk(P[BASE + 0], P[BASE + 1]), a1 = cvtpk(P[BASE + 2], P[BASE + 3]);   \
    unsigned b0 = cvtpk(P[BASE + 4], P[BASE + 5]), b1 = cvtpk(P[BASE + 6], P[BASE + 7]);                              \
    auto r0 = __builtin_amdgcn_permlane32_swap(a0, b0, false, false); auto r1 = __builtin_amdgcn_permlane32_swap(a1, b1, false, false); \
    u32x4 w = {r0[0], r1[0], r0[1], r1[1]}; OUT = *reinterpret_cast<bf16x8*>(&w); } while (0)
  ATT_PK4(p0, 0, pa0); ATT_PK4(p0, 8, pa1); ATT_PK4(p1, 0, pa2); ATT_PK4(p1, 8, pa3);
#undef ATT_PK4
}
template <int DQ, int NREG>
__device__ __forceinline__ void qkt(f32x16& p0, f32x16& p1, const char* Ks, const bf16x8* qr, const char* qpark, int r32, int hi) {
  constexpr int ROWB = Cst<DQ>::ROWB;
  p0 = f32x16{}; p1 = f32x16{};
#pragma unroll
  for (int d0 = 0; d0 < DQ / 16; ++d0) { const int cb = (d0 * 16 + hi * 8) * 2;
    bf16x8 b0 = *reinterpret_cast<const bf16x8*>(Ks + (r32 * ROWB + (cb ^ ((r32 & 7) << 4))));
    bf16x8 b1 = *reinterpret_cast<const bf16x8*>(Ks + ((32 + r32) * ROWB + (cb ^ ((r32 & 7) << 4))));
    bf16x8 q; if constexpr (true) { if (d0 < NREG) q = qr[d0 < NREG ? d0 : 0]; else q = *reinterpret_cast<const bf16x8*>(qpark + (d0 - NREG) * 1024); }
    p0 = __builtin_amdgcn_mfma_f32_32x32x16_bf16(b0, q, p0, 0, 0, 0);
    p1 = __builtin_amdgcn_mfma_f32_32x32x16_bf16(b1, q, p1, 0, 0, 0); }
}
__device__ __forceinline__ int v_st(int k, int c) { const int kk = (k & ~0xC) | ((k & 4) << 1) | ((k & 8) >> 1); return ((kk >> 3) * 4 + (c >> 5)) * 512 + ((kk & 7) * 32 + (c & 31)) * 2; }
__device__ __forceinline__ int v_rd_base(int lane) { return ((lane & 3) << 3) | (((lane >> 2) & 3) << 6) | (((lane >> 4) & 1) << 5) | (((lane >> 5) & 1) << 8); }
constexpr int v_rd_off(int d0, int ks, int half) { return d0 * 512 + ks * 4096 + half * 2048; }
template <int OFF> __device__ __forceinline__ s16x4 tr_read(int vb) {
  s16x4 r; asm volatile("ds_read_b64_tr_b16 %0, %1 offset:%2" : "=&v"(r) : "v"(vb), "i"(OFF) : "memory"); return r;
}
template <int D0> __device__ __forceinline__ void pv_one(f32x16& od, int vb, bf16x8 pa0, bf16x8 pa1, bf16x8 pa2, bf16x8 pa3) {
  const s16x4 l0 = tr_read<v_rd_off(D0, 0, 0)>(vb), h0 = tr_read<v_rd_off(D0, 0, 1)>(vb), l1 = tr_read<v_rd_off(D0, 1, 0)>(vb), h1 = tr_read<v_rd_off(D0, 1, 1)>(vb);
  const s16x4 l2 = tr_read<v_rd_off(D0, 2, 0)>(vb), h2 = tr_read<v_rd_off(D0, 2, 1)>(vb), l3 = tr_read<v_rd_off(D0, 3, 0)>(vb), h3 = tr_read<v_rd_off(D0, 3, 1)>(vb);
  asm volatile("s_waitcnt lgkmcnt(0)" ::: "memory"); ATT_SBAR();
#define ATT_PK(L, H) (bf16x8){L[0], L[1], L[2], L[3], H[0], H[1], H[2], H[3]}
  od = __builtin_amdgcn_mfma_f32_32x32x16_bf16(pa0, ATT_PK(l0, h0), od, 0, 0, 0);
  od = __builtin_amdgcn_mfma_f32_32x32x16_bf16(pa1, ATT_PK(l1, h1), od, 0, 0, 0);
  od = __builtin_amdgcn_mfma_f32_32x32x16_bf16(pa2, ATT_PK(l2, h2), od, 0, 0, 0);
  od = __builtin_amdgcn_mfma_f32_32x32x16_bf16(pa3, ATT_PK(l3, h3), od, 0, 0, 0);
#undef ATT_PK
}
__device__ __forceinline__ void pv_d0(f32x16* o, int vb, bf16x8 pa0, bf16x8 pa1, bf16x8 pa2, bf16x8 pa3) {
  pv_one<0>(o[0], vb, pa0, pa1, pa2, pa3); pv_one<1>(o[1], vb, pa0, pa1, pa2, pa3); pv_one<2>(o[2], vb, pa0, pa1, pa2, pa3); pv_one<3>(o[3], vb, pa0, pa1, pa2, pa3);
}
__device__ __forceinline__ void natten_mod(f32x16& p0, f32x16& p1, int kr, int rq, int qc, const float* biasT, int hi) {
  const int r0 = min(max(rq - 4, 0), 56), c0 = min(max(qc - 8, 0), 48);
  const float NEG = -__builtin_inff();
  if (kr < r0 || kr >= r0 + 8) {
#pragma unroll
    for (int r = 0; r < 16; ++r) { p0[r] = NEG; p1[r] = NEG; }
  } else {
    const float* bl = biasT + (kr - rq + 7) * 128 + (63 - qc + 4 * hi);
    const int t = 4 * hi - c0;
#pragma unroll
    for (int r = 0; r < 16; ++r) {
      const int kcc = (r & 3) + 8 * (r >> 2);
      const bool ok0 = (unsigned)(t + kcc) < 16u, ok1 = (unsigned)(t + kcc + 32) < 16u;
      const float b0 = bl[kcc], b1 = bl[kcc + 32];
      p0[r] = ok0 ? p0[r] + b0 : NEG; p1[r] = ok1 ? p1[r] + b1 : NEG;
      if ((r & 3) == 3) __builtin_amdgcn_sched_barrier(0);
    }
  }
}

template <int DQ, int LDQ, int LDK, int LDV, int LDO, int MODE, int SDEPTH, int NREG>
__device__ __forceinline__ void attn_body(const bf16* __restrict__ Qb, const bf16* __restrict__ Kh, const bf16* __restrict__ Vh, bf16* __restrict__ Ob, const int NT, char* lds,
                                          const int rq0, const int kr_lo, const float* biasT) {
  constexpr int SHM_K = Cst<DQ>::SHM_K, ROWB = Cst<DQ>::ROWB;
  int tid_ = threadIdx.x; asm volatile("" : "+v"(tid_));
  const int tid = tid_, wid = tid >> 6, lane = tid & 63, r32 = lane & 31, hi = lane >> 5;
  char* V_lds = lds; char* K_lds = lds + 2 * SHM_V;
  float* ws = (float*)(lds + 2 * SHM_V + 2 * SHM_K) + wid * 64; float* li_l = ws; float* al_l = ws + 32;
  float m_reg = -1e30f, l_reg = 0; f32x16 o[4] = {}; bf16x8 qr[NREG > 0 ? NREG : 1];
  const bf16* Qw = Qb + (long)(wid * QBLK + r32) * LDQ + hi * 8;
  char* qpark = lds + 2 * SHM_V + 2 * SHM_K + NW * 64 * 4 + wid * ((DQ / 16 - NREG) * 1024) + hi * 512 + r32 * 16;
#pragma unroll
  for (int d0 = 0; d0 < DQ / 16; ++d0) { const bf16x8 qv = *reinterpret_cast<const bf16x8*>(Qw + d0 * 16); if (d0 < NREG) qr[d0 < NREG ? d0 : 0] = qv; else *reinterpret_cast<bf16x8*>(qpark + (d0 - NREG) * 1024) = qv; }
  const int nrq = rq0 + (wid >> 1), nqc = (wid & 1) * 32 + r32;
  const int sr = tid >> 4, sc = (tid & 15) * 8, vst0 = v_st(sr, sc), vst1 = v_st(32 + sr, sc);
  const int kr3 = tid >> 3, kc3 = 128 + (tid & 7) * 8;
  const int vb0 = (int)(uintptr_t)V_lds + v_rd_base(lane);
  struct { bf16x8 vs0, vs1, ks0, ks1, ks2; } sr_[SDEPTH];
#define ATT_LD8(p) (*reinterpret_cast<const bf16x8*>(p))
#define ATT_SLOAD(i, k0) do { sr_[i].vs0 = ATT_LD8(&Vh[(long)((k0) + sr) * LDV + sc]); sr_[i].vs1 = ATT_LD8(&Vh[(long)((k0) + 32 + sr) * LDV + sc]); \
    sr_[i].ks0 = ATT_LD8(&Kh[(long)((k0) + sr) * LDK + sc]); sr_[i].ks1 = ATT_LD8(&Kh[(long)((k0) + 32 + sr) * LDK + sc]); \
    if constexpr (DQ == 192) sr_[i].ks2 = ATT_LD8(&Kh[(long)((k0) + kr3) * LDK + kc3]); } while (0)
#define ATT_SWRITE(b, i) do { *(bf16x8*)(V_lds + (b) * SHM_V + vst0) = sr_[i].vs0;          \
    *(bf16x8*)(V_lds + (b) * SHM_V + vst1) = sr_[i].vs1; const int kc = sc * 2;               \
    *(bf16x8*)(K_lds + (b) * SHM_K + sr * ROWB + (kc ^ ((sr & 7) << 4))) = sr_[i].ks0;                       \
    *(bf16x8*)(K_lds + (b) * SHM_K + (32 + sr) * ROWB + (kc ^ ((sr & 7) << 4))) = sr_[i].ks1; \
    if constexpr (DQ == 192) *(bf16x8*)(K_lds + (b) * SHM_K + kr3 * ROWB + ((kc3 * 2) ^ ((kr3 & 7) << 4))) = sr_[i].ks2; } while (0)
#define ATT_SWAIT() do { if constexpr (SDEPTH == 2) { if constexpr (DQ == 192) asm volatile("s_waitcnt vmcnt(5)" ::: "memory"); else asm volatile("s_waitcnt vmcnt(4)" ::: "memory"); } \
    else asm volatile("s_waitcnt vmcnt(0)" ::: "memory"); } while (0)
#define ATT_RESC(a) do { if (__any((a) < 1.f)) { if (hi == 0) al_l[r32] = (a); asm volatile("s_waitcnt lgkmcnt(0)" ::: "memory"); \
    _Pragma("unroll") for (int d = 0; d < 4; ++d) _Pragma("unroll") for (int r = 0; r < 16; ++r) o[d][r] *= al_l[crow(r, hi)]; } } while (0)
#define ATT_MOD(P0, P1, J) do { if constexpr (MODE == 1) natten_mod(P0, P1, kr_lo + (J), nrq, nqc, biasT, hi); } while (0)
  f32x16 pA0, pA1, pB0, pB1; float mnA, mnB, alA, alB; bf16x8 pa0, pa1, pa2, pa3;
  constexpr int SE = 0, SO = SDEPTH - 1;
  ATT_SLOAD(SE, 0); asm volatile("s_waitcnt vmcnt(0)" ::: "memory"); ATT_SWRITE(0, SE); __syncthreads();
  qkt<DQ, NREG>(pA0, pA1, K_lds, qr, qpark, r32, hi); ATT_MOD(pA0, pA1, 0); partialSM<DQ>(pA0, pA1, m_reg, mnA, alA);
  ATT_SLOAD(SO, KVBLK); if constexpr (SDEPTH == 2) { if (2 < NT) ATT_SLOAD(SE, 2 * KVBLK); }
  ATT_SWAIT(); ATT_SWRITE(1, SO); __syncthreads();
  for (int j = 1; j + 1 < NT; j += 2) {
    ATT_SBAR(); qkt<DQ, NREG>(pB0, pB1, K_lds + SHM_K, qr, qpark, r32, hi); ATT_MOD(pB0, pB1, j);
    finishSM(pA0, pA1, alA, l_reg, pa0, pa1, pa2, pa3); ATT_SBAR();
    ATT_SLOAD(SO, (j + SDEPTH) * KVBLK); ATT_SBAR();
    pv_d0(o, vb0, pa0, pa1, pa2, pa3); partialSM<DQ>(pB0, pB1, m_reg, mnB, alB);
    __syncthreads(); ATT_SWAIT(); ATT_SWRITE(0, SE);
    ATT_RESC(alB); __syncthreads();
    ATT_SBAR(); qkt<DQ, NREG>(pA0, pA1, K_lds, qr, qpark, r32, hi); ATT_MOD(pA0, pA1, j + 1);
    finishSM(pB0, pB1, alB, l_reg, pa0, pa1, pa2, pa3); ATT_SBAR();
    if (SDEPTH == 1 || j + 3 < NT) ATT_SLOAD(SE, (j + 1 + SDEPTH) * KVBLK); ATT_SBAR();
    pv_d0(o, vb0 + SHM_V, pa0, pa1, pa2, pa3); partialSM<DQ>(pA0, pA1, m_reg, mnA, alA);
    __syncthreads(); ATT_SWAIT(); ATT_SWRITE(1, SO);
    ATT_RESC(alA); __syncthreads();
  }
  ATT_SBAR(); qkt<DQ, NREG>(pB0, pB1, K_lds + SHM_K, qr, qpark, r32, hi); ATT_MOD(pB0, pB1, NT - 1);
  finishSM(pA0, pA1, alA, l_reg, pa0, pa1, pa2, pa3); ATT_SBAR();
  pv_d0(o, vb0, pa0, pa1, pa2, pa3); partialSM<DQ>(pB0, pB1, m_reg, mnB, alB);
  __syncthreads(); ATT_RESC(alB);
  finishSM(pB0, pB1, alB, l_reg, pa0, pa1, pa2, pa3); ATT_SBAR();
  pv_d0(o, vb0 + SHM_V, pa0, pa1, pa2, pa3);
  if (hi == 0) li_l[r32] = l_reg; asm volatile("s_waitcnt lgkmcnt(0)" ::: "memory");
  float rli[16];
#pragma unroll
  for (int r = 0; r < 16; ++r) rli[r] = __builtin_amdgcn_rcpf(li_l[crow(r, hi)]);
  bf16* Ow = Ob + (long)(wid * QBLK) * LDO;
#pragma unroll
  for (int r = 0; r < 16; ++r) { const int orow = crow(r, hi);
#pragma unroll
    for (int d0 = 0; d0 < 4; d0 += 1) { const unsigned w = cvtpk(o[d0][r] * rli[r], 0.f); Ow[(long)orow * LDO + d0 * 32 + r32] = (bf16)(w & 0xffffu); } }
#undef ATT_LD8
#undef ATT_SLOAD
#undef ATT_SWRITE
#undef ATT_SWAIT
#undef ATT_RESC
#undef ATT_MOD
}
}

#ifndef PH_MASK
#define PH_MASK 0xFFFFFFFFu
#endif
#define PHON(k) (((PH_MASK) >> (k)) & 1u)
#ifndef REP_MASK
#define REP_MASK 0u
#endif
#define REP(k) (((REP_MASK) >> (k)) & 1u)
constexpr int NWAVES = 8;
constexpr int DM = 2048, BATCH = 4, SEQ = 4096, NTOK = BATCH * SEQ, DEPTH = 2;
constexpr int DIN = 3904, DINP = 4096;
constexpr int DFF = 5632, NE = 8, DFE = 7168;
constexpr int PC_QA = 0, PC_KA = 512, PC_VA = 1024, PC_QB = 1536, PC_KB = 2560, PC_VB = 2816, PC_CQ = 3072, PC_CKV = 3584, PC_KPE = 3840;
constexpr float EPS = 1e-6f;
constexpr int MAXTILES = 136;
constexpr int MAXSLOTS = MAXTILES * 256;

constexpr size_t MiB = 1u << 20;
constexpr size_t WS_CTL = 0, CTL_ZERO_BYTES = 1 * MiB;
constexpr size_t WS_WIN = 1 * MiB;
constexpr size_t WS_WUQ = WS_WIN + 32 * MiB;
constexpr size_t WS_WUKV = WS_WUQ + 2 * MiB;
constexpr size_t WS_WOUT = WS_WUKV + 1 * MiB;
constexpr size_t WS_WGU = WS_WOUT + 16 * MiB;
constexpr size_t WS_WD = WS_WGU + 44 * MiB;
constexpr size_t WS_WEGU = WS_WD + 22 * MiB;
constexpr size_t WS_WED = WS_WEGU + 448 * MiB;
constexpr size_t WS_H = WS_WED + 224 * MiB;
constexpr size_t WS_ACT0 = WS_H + 64 * MiB;
constexpr size_t WS_PROJ = WS_ACT0;
constexpr size_t WS_QA = WS_PROJ + 128 * MiB;
constexpr size_t WS_KA = WS_QA + 16 * MiB;
constexpr size_t WS_QB = WS_KA + 16 * MiB;
constexpr size_t WS_KB = WS_QB + 32 * MiB;
constexpr size_t WS_CQN = WS_KB + 8 * MiB;
constexpr size_t WS_CKVN = WS_CQN + 16 * MiB;
constexpr size_t WS_KPE = WS_CKVN + 8 * MiB;
constexpr size_t WS_QCR = WS_KPE + 2 * MiB;
constexpr size_t WS_KVR = WS_QCR + 24 * MiB;
constexpr size_t WS_QC = WS_KVR + 32 * MiB;
constexpr size_t WS_KC = WS_QC + 24 * MiB;
constexpr size_t WS_O = WS_KC + 24 * MiB;
constexpr size_t WS_ON = WS_O + 64 * MiB;
constexpr size_t WS_ATT_END = WS_ON + 64 * MiB;
constexpr size_t WS_ACT = WS_ACT0;
constexpr size_t WS_HG = WS_ACT0;
constexpr size_t WS_ACTM = WS_HG + 136 * MiB;
constexpr size_t WS_Y = WS_ACTM + 476 * MiB;
constexpr size_t WS_RGATE = WS_Y + 136 * MiB;
constexpr size_t WS_TOKE = WS_RGATE + 1 * MiB;
constexpr size_t WS_TOKP = WS_TOKE + 1 * MiB;
constexpr size_t WS_TOKW = WS_TOKP + 1 * MiB;
constexpr size_t WS_END = WS_TOKW + 1 * MiB;
constexpr size_t WS_DUMMY = WS_END;
static_assert(WS_ATT_END <= WS_END, "map");
constexpr int CW_CNT = 64;
constexpr int CW_BAR = 4096;

constexpr int RING_BYTES = 131072;
constexpr int LDS_BYTES = 147456;
constexpr int MISC_OFF = LDS_BYTES - 256;

#define GAS __attribute__((address_space(1)))
#define LAS __attribute__((address_space(3)))
typedef unsigned short bf16;
typedef unsigned v4u __attribute__((ext_vector_type(4)));
typedef unsigned v2u __attribute__((ext_vector_type(2)));
typedef float f32x4 __attribute__((ext_vector_type(4)));
typedef float f32x2 __attribute__((ext_vector_type(2)));
__device__ __forceinline__ unsigned pk2(float lo, float hi) { unsigned r; asm volatile("v_cvt_pk_bf16_f32 %0, %1, %2" : "=v"(r) : "v"(lo), "v"(hi)); return r; }
__device__ __forceinline__ float bf_lo(unsigned w) { return __uint_as_float(w << 16); }
__device__ __forceinline__ float bf_hi(unsigned w) { return __uint_as_float(w & 0xffff0000u); }
__device__ __forceinline__ float wave_sum(float v) {
#pragma unroll
    for (int o = 1; o < 64; o <<= 1) v += __shfl_xor(v, o);
    return v;
}
__device__ __forceinline__ float rsq(float x) { return __builtin_amdgcn_rsqf(x); }
#define XB_TMO      128
#define XB_XCNT(j)  (256  + 64 * (j))
#define XB_XSUB(j)  (1280 + 64 * (j))
#define XB_XGEN(j)  (2304 + 64 * (j))
#define XB_TOP      3328
#define XB_TOPGEN   3392
#define XCD_BAR_WORDS 3456
#define XB_SPIN_CAP (1u << 18)

__device__ __forceinline__ unsigned xb_ld(unsigned* p)              { return __hip_atomic_load(p, __ATOMIC_RELAXED, __HIP_MEMORY_SCOPE_AGENT); }
__device__ __forceinline__ unsigned xb_add(unsigned* p, unsigned v) { return __hip_atomic_fetch_add(p, v, __ATOMIC_RELAXED, __HIP_MEMORY_SCOPE_AGENT); }
__device__ __forceinline__ unsigned xb_xcc_id() { return (unsigned)__builtin_amdgcn_s_getreg((3 << 11) | 20) & 0xFu; }
#define XB_SPIN(cond, bar) do { unsigned _sp = 0; while (cond) { __builtin_amdgcn_s_sleep(1); \
    if ((++_sp & 255u) == 0u) { if (xb_ld(&(bar)[XB_TMO])) break; if (_sp > XB_SPIN_CAP) { atomicAdd(&(bar)[XB_TMO], 1u); break; } } } } while (0)

struct XcdBarrier {
    unsigned* bar; unsigned x;
    volatile LAS unsigned* st;
};

__device__ __forceinline__ XcdBarrier xcd_barrier_post(unsigned* bar, volatile LAS unsigned* st) {
    XcdBarrier b; b.bar = bar; b.x = xb_xcc_id(); b.st = st;
    if (threadIdx.x == 0) (void)xb_add(&bar[XB_XCNT(b.x)], 1u);
    return b;
}
__device__ __forceinline__ void xcd_barrier_complete(unsigned* bar, unsigned x, unsigned& nloc, unsigned& nx) {
    const unsigned G = gridDim.x * gridDim.y * gridDim.z;
    unsigned sum, cnt, mine, sp = 0u;
    for (;;) {
        sum = 0u; cnt = 0u; mine = 0u;
#pragma unroll
        for (unsigned j = 0; j < 16; ++j) { const unsigned c = xb_ld(&bar[XB_XCNT(j)]); sum += c; cnt += (c > 0u) ? 1u : 0u; mine = (j == x) ? c : mine; }
        if (sum == G) break;
        __builtin_amdgcn_s_sleep(1);
        if ((++sp & 255u) == 0u) { if (xb_ld(&bar[XB_TMO])) break; if (sp > XB_SPIN_CAP) { atomicAdd(&bar[XB_TMO], 1u); break; } }
    }
    nloc = mine > 0u ? mine : 1u; nx = cnt > 0u ? cnt : 1u;
}

__device__ __forceinline__ void xcd_barrier(const XcdBarrier& b) {
    asm volatile("s_waitcnt vmcnt(0)" ::: "memory");
    __syncthreads();
    if (threadIdx.x == 0) {
        unsigned* bar = b.bar;
        __builtin_amdgcn_s_waitcnt(0);
        unsigned nloc = b.st[0], nx = b.st[1];
        if (nloc == 0u) { xcd_barrier_complete(bar, b.x, nloc, nx); b.st[0] = nloc; b.st[1] = nx; }
        const unsigned old = xb_add(&bar[XB_XSUB(b.x)], 1u);
        const unsigned gen = old / nloc;
        if (old + 1u == (gen + 1u) * nloc) {
            __builtin_amdgcn_fence(__ATOMIC_RELEASE, "agent");
            asm volatile("s_waitcnt vmcnt(0)" ::: "memory");
            const unsigned og = xb_add(&bar[XB_TOP], 1u);
            const unsigned tg = og / nx;
            if (og + 1u == (tg + 1u) * nx) xb_add(&bar[XB_TOPGEN], 1u);
            else XB_SPIN(xb_ld(&bar[XB_TOPGEN]) == tg, bar);
            __builtin_amdgcn_fence(__ATOMIC_ACQUIRE, "agent");
            xb_add(&bar[XB_XGEN(b.x)], 1u);
            asm volatile("s_waitcnt vmcnt(0)" ::: "memory");
        } else {
            XB_SPIN(xb_ld(&bar[XB_XGEN(b.x)]) == gen, bar);
            __builtin_amdgcn_fence(__ATOMIC_ACQUIRE, "agent");
            asm volatile("s_waitcnt vmcnt(0)" ::: "memory");
        }
    }
    __syncthreads();
}

struct Args { const float* in[26]; float* out; unsigned char* ws; int ph_lo, ph_hi; };
enum { I_X = 0, I_MIXN, I_WIN, I_RPB, I_QNA, I_KNA, I_QNB, I_KNB, I_CQN, I_CKVN, I_WUQ, I_WUKV, I_QNC, I_KNC, I_ONA, I_ONB, I_ONC, I_WOUT, I_FFNN, I_WG, I_WU, I_WDN, I_ROUTER, I_WEG, I_WEU, I_WED };
struct Frame {
    LAS unsigned char* lds; unsigned char* ws; unsigned* ctl;
    int wave, G, bid, gw, ngw;
};

__device__ __forceinline__ void transpose_item(const float* __restrict__ W, int K, int N, bf16* __restrict__ WT, int row_off, int mode, LAS float* scr, int item, int lane) {
    const int nblk = N >> 6, kb = item / nblk, nb = item - kb * nblk, k0 = kb << 6, n0 = nb << 6;
    const int lk = lane >> 4, ln = (lane & 15) << 2;
    f32x4 v[16];
#pragma unroll
    for (int i = 0; i < 16; ++i) v[i] = *(const f32x4*)(W + (size_t)(k0 + lk + 4 * i) * N + n0 + ln);
#pragma unroll
    for (int i = 0; i < 16; ++i) { LAS float* s = scr + (lk + 4 * i) * 65 + ln; s[0] = v[i][0]; s[1] = v[i][1]; s[2] = v[i][2]; s[3] = v[i][3]; }
    asm volatile("s_waitcnt lgkmcnt(0)" ::: "memory");
    const int drow0 = (mode == 0) ? (row_off + n0) : (row_off + (n0 >> 7) * 256 + (mode - 1) * 128 + (n0 & 127));
    const int c = lane & 7;
#pragma unroll
    for (int j = 0; j < 8; ++j) { const int n = 8 * j + (lane >> 3); const LAS float* s = scr + (8 * c) * 65 + n;
        v4u o; o.x = pk2(s[0 * 65], s[1 * 65]); o.y = pk2(s[2 * 65], s[3 * 65]); o.z = pk2(s[4 * 65], s[5 * 65]); o.w = pk2(s[6 * 65], s[7 * 65]);
        *(v4u*)(WT + (size_t)(drow0 + n) * K + k0 + 8 * c) = o; }
    asm volatile("s_waitcnt lgkmcnt(0)" ::: "memory");
}

__device__ __forceinline__ unsigned pk4_fp8(float a, float b, float c, float d) { unsigned w = 0u; w = __builtin_amdgcn_cvt_pk_fp8_f32(a, b, w, false); w = __builtin_amdgcn_cvt_pk_fp8_f32(c, d, w, true); return w; }
__device__ __forceinline__ void transpose_item_f8(const float* __restrict__ W, int K, int N, unsigned char* __restrict__ WT, int row_off, int mode, float wsc, LAS float* scr, int item, int lane) {
    const int nblk = N >> 5, kb = item / nblk, nb = item - kb * nblk, k0 = kb << 7, n0 = nb << 5;
    const int lk = lane >> 3, ln = (lane & 7) << 2;
    f32x4 v[16];
#pragma unroll
    for (int i = 0; i < 16; ++i) v[i] = *(const f32x4*)(W + (size_t)(k0 + lk + 8 * i) * N + n0 + ln);
#pragma unroll
    for (int i = 0; i < 16; ++i) { LAS float* s = scr + (lk + 8 * i) * 33 + ln; s[0] = v[i][0] * wsc; s[1] = v[i][1] * wsc; s[2] = v[i][2] * wsc; s[3] = v[i][3] * wsc; }
    asm volatile("s_waitcnt lgkmcnt(0)" ::: "memory");
    const int drow0 = (mode == 0) ? (row_off + n0) : (row_off + (n0 >> 7) * 256 + (mode - 1) * 128 + (n0 & 127));
    const int c = lane & 7;
#pragma unroll
    for (int j = 0; j < 4; ++j) { const int n = 8 * j + (lane >> 3); const LAS float* s = scr + (16 * c) * 33 + n;
        v4u o; o.x = pk4_fp8(s[0 * 33], s[1 * 33], s[2 * 33], s[3 * 33]); o.y = pk4_fp8(s[4 * 33], s[5 * 33], s[6 * 33], s[7 * 33]);
        o.z = pk4_fp8(s[8 * 33], s[9 * 33], s[10 * 33], s[11 * 33]); o.w = pk4_fp8(s[12 * 33], s[13 * 33], s[14 * 33], s[15 * 33]);
        *(v4u*)(WT + (size_t)(drow0 + n) * K + k0 + 16 * c) = o; }
    asm volatile("s_waitcnt lgkmcnt(0)" ::: "memory");
}

template <bool F8OUT>
__device__ __forceinline__ void phase_rmsnorm(const Frame& F, const float* __restrict__ src, const float* __restrict__ gain, void* __restrict__ dstv, float osc) {
    int tid_ = threadIdx.x; asm volatile("" : "+v"(tid_)); const int tid = tid_, lane = tid & 63; (void)tid; (void)lane;
    f32x4 g[8];
#pragma unroll
    for (int j = 0; j < 8; ++j) g[j] = ((const f32x4*)gain)[64 * j + lane] * osc;
    for (int m = F.gw; m < NTOK; m += F.ngw) {
        const f32x4* xr = (const f32x4*)(src + (size_t)m * DM) + lane; f32x4 v[8]; float s = 0.f;
#pragma unroll
        for (int j = 0; j < 8; ++j) { v[j] = xr[64 * j]; s += (v[j][0] * v[j][0] + v[j][1] * v[j][1]) + (v[j][2] * v[j][2] + v[j][3] * v[j][3]); }
        const float rstd = rsq(wave_sum(s) * (1.f / DM) + EPS);
        if constexpr (F8OUT) { unsigned* o4 = (unsigned*)((unsigned char*)dstv + (size_t)m * DM) + lane;
#pragma unroll
            for (int j = 0; j < 8; ++j) o4[64 * j] = pk4_fp8(v[j][0] * rstd * g[j][0], v[j][1] * rstd * g[j][1], v[j][2] * rstd * g[j][2], v[j][3] * rstd * g[j][3]);
        } else { v2u* o8 = (v2u*)((bf16*)dstv + (size_t)m * DM) + lane;
#pragma unroll
            for (int j = 0; j < 8; ++j) { v2u w; w.x = pk2(v[j][0] * rstd * g[j][0], v[j][1] * rstd * g[j][1]); w.y = pk2(v[j][2] * rstd * g[j][2], v[j][3] * rstd * g[j][3]); o8[64 * j] = w; } }
    }
}

__device__ __forceinline__ float rope_apply(float v, float c, float s, float sgn) { const float p = __shfl_xor(v, 16); return v * c + sgn * p * s; }
__device__ __forceinline__ void sincos_rev(float ang, float& s, float& c) { const float r = ang * 0.15915494309189535f; const float f = r - floorf(r); s = __builtin_amdgcn_sinf(f); c = __builtin_amdgcn_cosf(f); }

__device__ __forceinline__ void phase_postproj(const Frame& F, const Args& a, int l) {
    int tid_ = threadIdx.x; asm volatile("" : "+v"(tid_)); const int tid = tid_, lane = tid & 63; (void)tid; (void)lane;
    const bf16* PROJ = (const bf16*)(F.ws + WS_PROJ);
    bf16* QA = (bf16*)(F.ws + WS_QA); bf16* KA = (bf16*)(F.ws + WS_KA); bf16* QB = (bf16*)(F.ws + WS_QB); bf16* KB = (bf16*)(F.ws + WS_KB);
    bf16* CQN = (bf16*)(F.ws + WS_CQN); bf16* CKVN = (bf16*)(F.ws + WS_CKVN); bf16* KPE = (bf16*)(F.ws + WS_KPE);
    const f32x2 gqa = ((const f32x2*)(a.in[I_QNA] + l * 128))[lane], gka = ((const f32x2*)(a.in[I_KNA] + l * 128))[lane];
    const f32x2 gqb = ((const f32x2*)(a.in[I_QNB] + l * 128))[lane], gkb = ((const f32x2*)(a.in[I_KNB] + l * 128))[lane];
    const f32x4 gcq0 = ((const f32x4*)(a.in[I_CQN] + l * 512))[2 * lane], gcq1 = ((const f32x4*)(a.in[I_CQN] + l * 512))[2 * lane + 1];
    const f32x4 gckv = ((const f32x4*)(a.in[I_CKVN] + l * 256))[lane];
    const float gkpe = a.in[I_KNC][l * 192 + 128 + lane];
    constexpr float LOG2T = 13.287712379549449f;
    const int q = lane & 15;
    const float f128a = __builtin_amdgcn_exp2f(-(float)(2 * q) * (LOG2T / 32.f)), f128b = __builtin_amdgcn_exp2f(-(float)(2 * q + 1) * (LOG2T / 32.f));
    const float f64 = __builtin_amdgcn_exp2f(-(float)q * (LOG2T / 16.f));
    const float sgn = (lane & 16) ? 1.f : -1.f;
    for (int t = F.gw; t < NTOK; t += F.ngw) {
        const int pos = t & (SEQ - 1); const float p = (float)((lane & 32) ? (pos & 63) : (pos >> 6));
        float s0, c0, s1, c1, s2, c2; sincos_rev(p * f128a, s0, c0); sincos_rev(p * f128b, s1, c1); sincos_rev(p * f64, s2, c2);
        const bf16* pr = PROJ + (size_t)t * DINP;
        unsigned hv[18];
#pragma unroll
        for (int i = 0; i < 8; ++i) hv[i] = ((const unsigned*)(pr + i * 128))[lane];
#pragma unroll
        for (int i = 8; i < 18; ++i) hv[i] = ((const unsigned*)(pr + PC_QB + (i - 8) * 128))[lane];
        const v4u cqv = ((const v4u*)(pr + PC_CQ))[lane]; const v2u ckvv = ((const v2u*)(pr + PC_CKV))[lane]; const unsigned kpev = (unsigned)pr[PC_KPE + lane];
#pragma unroll
        for (int i = 0; i < 18; ++i) {
            float v0 = bf_lo(hv[i]), v1 = bf_hi(hv[i]);
            const float rstd = rsq(wave_sum(v0 * v0 + v1 * v1) * (1.f / 128.f) + EPS);
            const f32x2 g = (i < 4) ? gqa : (i < 8) ? gka : (i < 16) ? gqb : gkb;
            v0 = v0 * rstd * g[0]; v1 = v1 * rstd * g[1];
            if (i >= 8) { v0 = rope_apply(v0, c0, s0, sgn); v1 = rope_apply(v1, c1, s1, sgn); }
            bf16* dst = (i < 4) ? (QA + (size_t)t * 512 + i * 128) : (i < 8) ? (KA + (size_t)t * 512 + (i - 4) * 128) : (i < 16) ? (QB + (size_t)t * 1024 + (i - 8) * 128) : (KB + (size_t)t * 256 + (i - 16) * 128);
            ((unsigned*)dst)[lane] = pk2(v0, v1);
        }
        {
            float x[8] = {bf_lo(cqv.x), bf_hi(cqv.x), bf_lo(cqv.y), bf_hi(cqv.y), bf_lo(cqv.z), bf_hi(cqv.z), bf_lo(cqv.w), bf_hi(cqv.w)}; float s = 0.f;
#pragma unroll
            for (int i = 0; i < 8; ++i) s += x[i] * x[i];
            const float rstd = rsq(wave_sum(s) * (1.f / 512.f) + EPS);
            v4u w; w.x = pk2(x[0] * rstd * gcq0[0], x[1] * rstd * gcq0[1]); w.y = pk2(x[2] * rstd * gcq0[2], x[3] * rstd * gcq0[3]);
            w.z = pk2(x[4] * rstd * gcq1[0], x[5] * rstd * gcq1[1]); w.w = pk2(x[6] * rstd * gcq1[2], x[7] * rstd * gcq1[3]);
            ((v4u*)(CQN + (size_t)t * 512))[lane] = w;
        }
        {
            const float x0 = bf_lo(ckvv.x), x1 = bf_hi(ckvv.x), x2 = bf_lo(ckvv.y), x3 = bf_hi(ckvv.y);
            const float rstd = rsq(wave_sum((x0 * x0 + x1 * x1) + (x2 * x2 + x3 * x3)) * (1.f / 256.f) + EPS);
            v2u w; w.x = pk2(x0 * rstd * gckv[0], x1 * rstd * gckv[1]); w.y = pk2(x2 * rstd * gckv[2], x3 * rstd * gckv[3]);
            ((v2u*)(CKVN + (size_t)t * 256))[lane] = w;
        }
        {
            float x = bf_lo(kpev);
            const float rstd = rsq(wave_sum(x * x) * (1.f / 64.f) + EPS);
            x = rope_apply(x * rstd * gkpe, c2, s2, sgn);
            KPE[(size_t)t * 64 + lane] = (bf16)(pk2(x, 0.f) & 0xffffu);
        }
    }
}

__device__ __forceinline__ void phase_postmla(const Frame& F, const Args& a, int l) {
    int tid_ = threadIdx.x; asm volatile("" : "+v"(tid_)); const int tid = tid_, lane = tid & 63; (void)tid; (void)lane;
    const bf16* QCR = (const bf16*)(F.ws + WS_QCR); const bf16* KVR = (const bf16*)(F.ws + WS_KVR); const bf16* KPE = (const bf16*)(F.ws + WS_KPE);
    bf16* QC = (bf16*)(F.ws + WS_QC); bf16* KC = (bf16*)(F.ws + WS_KC);
    const f32x2 gqn = ((const f32x2*)(a.in[I_QNC] + l * 192))[lane], gkn = ((const f32x2*)(a.in[I_KNC] + l * 192))[lane];
    const float gqpe = a.in[I_QNC][l * 192 + 128 + lane];
    constexpr float LOG2T = 13.287712379549449f;
    const float f64 = __builtin_amdgcn_exp2f(-(float)(lane & 15) * (LOG2T / 16.f));
    const float sgn = (lane & 16) ? 1.f : -1.f;
    for (int t = F.gw; t < NTOK; t += F.ngw) {
        const int pos = t & (SEQ - 1); const float p = (float)((lane & 32) ? (pos & 63) : (pos >> 6));
        float s2, c2; sincos_rev(p * f64, s2, c2);
        const bf16* qr = QCR + (size_t)t * 768; const bf16* kr = KVR + (size_t)t * 1024;
        unsigned qn[4], kn[4]; unsigned qp[4];
#pragma unroll
        for (int h = 0; h < 4; ++h) { qn[h] = ((const unsigned*)(qr + h * 192))[lane]; qp[h] = (unsigned)qr[h * 192 + 128 + lane]; kn[h] = ((const unsigned*)(kr + h * 256))[lane]; }
        const bf16 kpe = KPE[(size_t)t * 64 + lane];
#pragma unroll
        for (int h = 0; h < 4; ++h) {
            { float v0 = bf_lo(qn[h]), v1 = bf_hi(qn[h]); const float rstd = rsq(wave_sum(v0 * v0 + v1 * v1) * (1.f / 128.f) + EPS);
              ((unsigned*)(QC + (size_t)t * 768 + h * 192))[lane] = pk2(v0 * rstd * gqn[0], v1 * rstd * gqn[1]); }
            { float x = bf_lo(qp[h]); const float rstd = rsq(wave_sum(x * x) * (1.f / 64.f) + EPS); x = rope_apply(x * rstd * gqpe, c2, s2, sgn);
              QC[(size_t)t * 768 + h * 192 + 128 + lane] = (bf16)(pk2(x, 0.f) & 0xffffu); }
            { float v0 = bf_lo(kn[h]), v1 = bf_hi(kn[h]); const float rstd = rsq(wave_sum(v0 * v0 + v1 * v1) * (1.f / 128.f) + EPS);
              ((unsigned*)(KC + (size_t)t * 768 + h * 192))[lane] = pk2(v0 * rstd * gkn[0], v1 * rstd * gkn[1]); }
            KC[(size_t)t * 768 + h * 192 + 128 + lane] = kpe;
        }
    }
}

__device__ __forceinline__ void phase_groupnorm(const Frame& F, const Args& a, int l) {
    int tid_ = threadIdx.x; asm volatile("" : "+v"(tid_)); const int tid = tid_, lane = tid & 63; (void)tid; (void)lane;
    const bf16* O = (const bf16*)(F.ws + WS_O); bf16* ON = (bf16*)(F.ws + WS_ON);
    f32x4 g[4][2];
    { const f32x4* ga = (const f32x4*)(a.in[I_ONA] + l * 512); const f32x4* gb = (const f32x4*)(a.in[I_ONB] + l * 1024); const f32x4* gc = (const f32x4*)(a.in[I_ONC] + l * 512);
      g[0][0] = ga[2 * lane]; g[0][1] = ga[2 * lane + 1]; g[1][0] = gb[2 * lane]; g[1][1] = gb[2 * lane + 1]; g[2][0] = gb[128 + 2 * lane]; g[2][1] = gb[128 + 2 * lane + 1]; g[3][0] = gc[2 * lane]; g[3][1] = gc[2 * lane + 1]; }
    for (int t = F.gw; t < NTOK; t += F.ngw) {
        const v4u* orow = (const v4u*)(O + (size_t)t * DM) + lane; float x[4][8]; float ss[4];
#pragma unroll
        for (int j = 0; j < 4; ++j) { const v4u w = orow[64 * j]; x[j][0] = bf_lo(w.x); x[j][1] = bf_hi(w.x); x[j][2] = bf_lo(w.y); x[j][3] = bf_hi(w.y); x[j][4] = bf_lo(w.z); x[j][5] = bf_hi(w.z); x[j][6] = bf_lo(w.w); x[j][7] = bf_hi(w.w);
            float s = 0.f;
#pragma unroll
            for (int i = 0; i < 8; ++i) s += x[j][i] * x[j][i];
            ss[j] = s; }
        const float ra = rsq(wave_sum(ss[0]) * (1.f / 512.f) + EPS), rb = rsq(wave_sum(ss[1] + ss[2]) * (1.f / 1024.f) + EPS), rc = rsq(wave_sum(ss[3]) * (1.f / 512.f) + EPS);
        v4u* nrow = (v4u*)(ON + (size_t)t * DM) + lane;
#pragma unroll
        for (int j = 0; j < 4; ++j) { const float r = (j == 0) ? ra : (j == 3) ? rc : rb; v4u w;
            w.x = pk2(x[j][0] * r * g[j][0][0], x[j][1] * r * g[j][0][1]); w.y = pk2(x[j][2] * r * g[j][0][2], x[j][3] * r * g[j][0][3]);
            w.z = pk2(x[j][4] * r * g[j][1][0], x[j][5] * r * g[j][1][1]); w.w = pk2(x[j][6] * r * g[j][1][2], x[j][7] * r * g[j][1][3]); nrow[64 * j] = w; }
    }
}

constexpr int ROUTER_LDS = 0;
constexpr int MOE_LDS_CNT = 65536;
constexpr int MOE_LDS_REC = 65536 + 64;
template <bool F8OUT>
__device__ __forceinline__ void phase_ffnnorm_route(const Frame& F, const Args& a, const float* __restrict__ src, const float* __restrict__ gain, void* __restrict__ dstv, float osc) {
    int tid_ = threadIdx.x; asm volatile("" : "+v"(tid_)); const int tid = tid_, lane = tid & 63; (void)tid; (void)lane;
    LAS float* rt = (LAS float*)(F.lds + ROUTER_LDS); LAS unsigned* lcnt = (LAS unsigned*)(F.lds + MOE_LDS_CNT); LAS int* rec = (LAS int*)(F.lds + MOE_LDS_REC);
    const float* router = a.in[I_ROUTER];
    for (int i = tid; i < DM * NE / 4; i += NWAVES * 64) ((LAS f32x4*)rt)[i] = ((const f32x4*)router)[i];
    if (tid < 16) lcnt[tid] = 0u;
    __syncthreads();
    const int t0 = (int)(((long)F.bid * NTOK) / F.G), t1 = (int)(((long)(F.bid + 1) * NTOK) / F.G);
    f32x4 g[8];
#pragma unroll
    for (int j = 0; j < 8; ++j) g[j] = ((const f32x4*)gain)[64 * j + lane];
    for (int m = t0 + F.wave; m < t1; m += NWAVES) {
        const f32x4* xr = (const f32x4*)(src + (size_t)m * DM) + lane; f32x4 v[8]; float s = 0.f;
#pragma unroll
        for (int j = 0; j < 8; ++j) { v[j] = xr[64 * j]; s += (v[j][0] * v[j][0] + v[j][1] * v[j][1]) + (v[j][2] * v[j][2] + v[j][3] * v[j][3]); }
        const float rstd = rsq(wave_sum(s) * (1.f / DM) + EPS);
        v2u* o8 = (v2u*)((bf16*)dstv + (size_t)m * DM) + lane; unsigned* o4 = (unsigned*)((unsigned char*)dstv + (size_t)m * DM) + lane;
        float lg[8] = {0.f, 0.f, 0.f, 0.f, 0.f, 0.f, 0.f, 0.f};
#pragma unroll
        for (int j = 0; j < 8; ++j) {
            f32x4 h; h[0] = v[j][0] * rstd * g[j][0]; h[1] = v[j][1] * rstd * g[j][1]; h[2] = v[j][2] * rstd * g[j][2]; h[3] = v[j][3] * rstd * g[j][3];
            if constexpr (F8OUT) o4[64 * j] = pk4_fp8(h[0] * osc, h[1] * osc, h[2] * osc, h[3] * osc); else { v2u w; w.x = pk2(h[0], h[1]); w.y = pk2(h[2], h[3]); o8[64 * j] = w; }
            const int k0 = 256 * j + 4 * lane;
#pragma unroll
            for (int i = 0; i < 4; ++i) { const f32x4 r0 = ((const LAS f32x4*)(rt + (k0 + i) * 8))[0], r1 = ((const LAS f32x4*)(rt + (k0 + i) * 8))[1];
                lg[0] += h[i] * r0[0]; lg[1] += h[i] * r0[1]; lg[2] += h[i] * r0[2]; lg[3] += h[i] * r0[3]; lg[4] += h[i] * r1[0]; lg[5] += h[i] * r1[1]; lg[6] += h[i] * r1[2]; lg[7] += h[i] * r1[3]; }
        }
#pragma unroll
        for (int e = 0; e < 8; ++e) lg[e] = wave_sum(lg[e]);
        int e0 = 0; float v0 = lg[0];
#pragma unroll
        for (int e = 1; e < 8; ++e) if (lg[e] > v0) { v0 = lg[e]; e0 = e; }
        int e1 = -1; float v1 = -3.0e38f;
#pragma unroll
        for (int e = 0; e < 8; ++e) if (e != e0 && lg[e] > v1) { v1 = lg[e]; e1 = e; }
        const float ex = __expf(v1 - v0), w0 = 1.f / (1.f + ex), w1 = ex * w0;
        if (lane == 0) { const int li = m - t0; const unsigned p0 = atomicAdd((unsigned*)&lcnt[e0], 1u), p1 = atomicAdd((unsigned*)&lcnt[e1], 1u);
            rec[li * 6 + 0] = e0; rec[li * 6 + 1] = e1; rec[li * 6 + 2] = (int)p0; rec[li * 6 + 3] = (int)p1; ((LAS float*)rec)[li * 6 + 4] = w0; ((LAS float*)rec)[li * 6 + 5] = w1; }
    }
    __syncthreads();
    if (tid < 8) lcnt[8 + tid] = __hip_atomic_fetch_add(F.ctl + CW_CNT + tid, lcnt[tid], __ATOMIC_RELAXED, __HIP_MEMORY_SCOPE_AGENT);
    __syncthreads();
    int* toke = (int*)(F.ws + WS_TOKE); int* tokp = (int*)(F.ws + WS_TOKP); float* tokw = (float*)(F.ws + WS_TOKW);
    for (int i = tid; i < (t1 - t0) * 2; i += NWAVES * 64) { const int li = i >> 1, k = i & 1, e = rec[li * 6 + k];
        toke[(size_t)(t0 + li) * 2 + k] = e; tokp[(size_t)(t0 + li) * 2 + k] = rec[li * 6 + 2 + k] + (int)lcnt[8 + e]; tokw[(size_t)(t0 + li) * 2 + k] = ((LAS float*)rec)[li * 6 + 4 + k]; }
    __syncthreads();
}
__device__ __forceinline__ void moe_tiles(const Frame& F, int (&tb)[9], int (&cnt)[8]) {
    int acc = 0;
#pragma unroll
    for (int e = 0; e < 8; ++e) { cnt[e] = (int)__hip_atomic_load(F.ctl + CW_CNT + e, __ATOMIC_RELAXED, __HIP_MEMORY_SCOPE_AGENT); tb[e] = acc; acc += (cnt[e] + 255) >> 8; }
    tb[8] = acc;
}
template <bool F8ROWS>
__device__ __forceinline__ void phase_gather(const Frame& F) {
    int tid_ = threadIdx.x; asm volatile("" : "+v"(tid_)); const int tid = tid_, lane = tid & 63; (void)tid; (void)lane;
    int tb[9], cnt[8]; moe_tiles(F, tb, cnt);
    constexpr int RBYTES = F8ROWS ? DM : 2 * DM, NCH = RBYTES / 1024;
    const unsigned char* H = (const unsigned char*)(F.ws + WS_H); unsigned char* HG = (unsigned char*)(F.ws + WS_HG); float* rg = (float*)(F.ws + WS_RGATE);
    const int* toke = (const int*)(F.ws + WS_TOKE); int* tokp = (int*)(F.ws + WS_TOKP); const float* tokw = (const float*)(F.ws + WS_TOKW);
    for (int t = F.gw; t < NTOK; t += F.ngw) {
        const v4u* hr = (const v4u*)(H + (size_t)t * RBYTES) + lane; v4u v[NCH];
#pragma unroll
        for (int j = 0; j < NCH; ++j) v[j] = hr[64 * j];
#pragma unroll
        for (int k = 0; k < 2; ++k) { const int e = toke[(size_t)t * 2 + k], p = tokp[(size_t)t * 2 + k]; int base = 0;
#pragma unroll
            for (int q = 0; q < 8; ++q) base = (q == e) ? tb[q] : base;
            const int slot = base * 256 + p; v4u* dr = (v4u*)(HG + (size_t)slot * RBYTES) + lane;
#pragma unroll
            for (int j = 0; j < NCH; ++j) dr[64 * j] = v[j];
            if (lane == 0) { rg[slot] = tokw[(size_t)t * 2 + k]; tokp[(size_t)t * 2 + k] = slot; } }
    }
#pragma unroll
    for (int e = 0; e < 8; ++e) { const int r0 = tb[e] * 256 + cnt[e], r1 = tb[e + 1] * 256;
        for (int r = r0 + F.gw; r < r1; r += F.ngw) { v4u* dr = (v4u*)(HG + (size_t)r * RBYTES) + lane; const v4u z = {0u, 0u, 0u, 0u};
#pragma unroll
            for (int j = 0; j < NCH; ++j) dr[64 * j] = z;
            if (lane == 0) rg[r] = 0.f; } }
}
__device__ __forceinline__ void phase_combine(const Frame& F, float* __restrict__ out) {
    int tid_ = threadIdx.x; asm volatile("" : "+v"(tid_)); const int tid = tid_, lane = tid & 63; (void)tid; (void)lane;
    const bf16* Y = (const bf16*)(F.ws + WS_Y); const int* tokp = (const int*)(F.ws + WS_TOKP);
    for (int t = F.gw; t < NTOK; t += F.ngw) {
        const int s0 = tokp[(size_t)t * 2], s1 = tokp[(size_t)t * 2 + 1];
        const v4u* y0 = (const v4u*)(Y + (size_t)s0 * DM) + lane; const v4u* y1 = (const v4u*)(Y + (size_t)s1 * DM) + lane;
        f32x4* xr = (f32x4*)(out + (size_t)t * DM) + 2 * lane;
#pragma unroll
        for (int j = 0; j < 4; ++j) { const v4u p = y0[64 * j], q = y1[64 * j]; f32x4 xa = xr[128 * j], xb = xr[128 * j + 1];
            xa[0] += bf_lo(p.x) + bf_lo(q.x); xa[1] += bf_hi(p.x) + bf_hi(q.x); xa[2] += bf_lo(p.y) + bf_lo(q.y); xa[3] += bf_hi(p.y) + bf_hi(q.y);
            xb[0] += bf_lo(p.z) + bf_lo(q.z); xb[1] += bf_hi(p.z) + bf_hi(q.z); xb[2] += bf_lo(p.w) + bf_lo(q.w); xb[3] += bf_hi(p.w) + bf_hi(q.w);
            xr[128 * j] = xa; xr[128 * j + 1] = xb; }
    }
}

__device__ __forceinline__ void phase_attention(const Frame& F, const Args& a, int l) {
    int tid_ = threadIdx.x; asm volatile("" : "+v"(tid_)); const int tid = tid_, lane = tid & 63; (void)tid; (void)lane;
    const bf16* PROJ = (const bf16*)(F.ws + WS_PROJ);
    const bf16* QA = (const bf16*)(F.ws + WS_QA); const bf16* KA = (const bf16*)(F.ws + WS_KA); const bf16* QB = (const bf16*)(F.ws + WS_QB); const bf16* KB = (const bf16*)(F.ws + WS_KB);
    const bf16* KVR = (const bf16*)(F.ws + WS_KVR); const bf16* QC = (const bf16*)(F.ws + WS_QC); const bf16* KC = (const bf16*)(F.ws + WS_KC);
    bf16* O = (bf16*)(F.ws + WS_O);
    char* L = (char*)F.lds;
    if (PHON(16)) for (int rep = 0; rep < (REP(16) ? 2 : 1); ++rep) for (int Lu = F.bid; Lu < 256; Lu += F.G) {
        const int id = (Lu & 7) * 32 + (Lu >> 3), b = id >> 6, h = (id >> 4) & 3, qb = id & 15; const size_t tq = (size_t)b * SEQ + qb * 256, tk = (size_t)b * SEQ;
        att::attn_body<192, 768, 768, 1024, 2048, 0, 1, 8>(QC + tq * 768 + h * 192, KC + tk * 768 + h * 192, KVR + tk * 1024 + h * 256 + 128, O + tq * DM + 1536 + h * 128, SEQ / 64, L, 0, 0, nullptr);
    }
    if (PHON(17)) for (int rep = 0; rep < (REP(17) ? 2 : 1); ++rep) for (int Lu = F.bid; Lu < 512; Lu += F.G) {
        const int id = (Lu & 7) * 64 + (Lu >> 3), b = id >> 7, kvh = (id >> 6) & 1, g = (id >> 4) & 3, qb = id & 15, h = kvh * 4 + g; const size_t tq = (size_t)b * SEQ + qb * 256, tk = (size_t)b * SEQ;
        att::attn_body<128, 1024, 256, 4096, 2048, 0, 2, 8>(QB + tq * 1024 + h * 128, KB + tk * 256 + kvh * 128, PROJ + tk * DINP + PC_VB + kvh * 128, O + tq * DM + 512 + h * 128, SEQ / 64, L, 0, 0, nullptr);
    }
    float* biasT = (float*)(L + 136 * 1024);
    if (PHON(18)) for (int rep = 0; rep < (REP(18) ? 2 : 1); ++rep) for (int Lu = F.bid; Lu < 256; Lu += F.G) {
        const int id = (Lu & 7) * 32 + (Lu >> 3), b = id >> 6, h = (id >> 4) & 3, rb = id & 15; const size_t tq = (size_t)b * SEQ + rb * 256;
        int lo = min(max(rb * 4 - 4, 0), 56), hi = min(max(rb * 4 + 3 - 4, 0), 56) + 8;
        if ((hi - lo) & 1) { if (hi < 64) ++hi; else --lo; }
        __syncthreads();
        const float* rpb = a.in[I_RPB] + ((size_t)l * 4 + h) * 465;
        for (int i = tid; i < 15 * 128; i += NWAVES * 64) { const int bi = i >> 7, bj = (i & 127) - 48; biasT[i] = (bj >= 0 && bj < 31) ? rpb[bi * 31 + bj] * 11.313708498984761f : 0.f; }
        __syncthreads();
        const size_t tk = (size_t)b * SEQ + lo * 64;
        att::attn_body<128, 512, 512, 4096, 2048, 1, 1, 4>(QA + tq * 512 + h * 128, KA + tk * 512 + h * 128, PROJ + tk * DINP + PC_VA + h * 128, O + tq * DM + h * 128, hi - lo, L, rb * 4, lo, biasT);
    }
}

#ifndef FFN_F8
#define FFN_F8 3
#endif
constexpr bool F8D = (FFN_F8 & 1) != 0, F8M = (FFN_F8 & 2) != 0;
constexpr float SC_H = 4.f, SC_ACT = 8.f, SC_W = 256.f;
constexpr int E8_H = 0x7D7D7D7D, E8_ACT = 0x7C7C7C7C, E8_W = 0x77777777;
constexpr int NPHASE = 24;
__global__ void __launch_bounds__(NWAVES * 64, 2) mega_fwd(Args args) {
    extern __shared__ __attribute__((aligned(16))) unsigned char lds_raw[];
    Frame F;
    F.lds = (LAS unsigned char*)lds_raw; F.ws = args.ws; F.ctl = (unsigned*)(args.ws + WS_CTL);
    F.wave = __builtin_amdgcn_readfirstlane((int)threadIdx.x >> 6);
    F.G = gridDim.x; F.bid = blockIdx.x; F.gw = F.bid * NWAVES + F.wave; F.ngw = F.G * NWAVES;
    volatile LAS unsigned* MISC = (volatile LAS unsigned*)(F.lds + MISC_OFF);
    if (threadIdx.x < 64) MISC[threadIdx.x] = 0u;
    __syncthreads();
    XcdBarrier bar = xcd_barrier_post(F.ctl + CW_BAR, MISC + 8);
    const int lo = args.ph_lo, hi = args.ph_hi;
#define IN(k) (lo <= (k) && (k) < hi)
#define SEAM(k) do { if (IN(k) && IN((k) + 1)) xcd_barrier(bar); } while (0)
    float* out = args.out;
    LAS unsigned char* ring = F.lds;

    if (PHON(0) && IN(0)) {
            if (REP(0)) {
        int tid_ = threadIdx.x; asm volatile("" : "+v"(tid_)); const int tid = tid_, lane = tid & 63; (void)tid; (void)lane;
        LAS float* scr = (LAS float*)(F.lds + F.wave * 16896);
        int it = F.gw;
#define TR_RUN(Wp, Kk, Nn, Dp, ROFF, MODE) do { const int cnt_ = ((Kk) >> 6) * ((Nn) >> 6); while (it < cnt_) { transpose_item((Wp), (Kk), (Nn), (Dp), (ROFF), (MODE), scr, it, lane); it += F.ngw; } it -= cnt_; } while (0)
#define TR_RUN8(Wp, Kk, Nn, Dp, ROFF, MODE) do { const int cnt_ = ((Kk) >> 7) * ((Nn) >> 5); while (it < cnt_) { transpose_item_f8((Wp), (Kk), (Nn), (Dp), (ROFF), (MODE), SC_W, scr8, it, lane); it += F.ngw; } it -= cnt_; } while (0)
        LAS float* scr8 = (LAS float*)(F.lds + F.wave * 16896);
        for (int l = 0; l < DEPTH; ++l) {
            TR_RUN(args.in[I_WIN] + (size_t)l * DM * DIN, DM, DIN, (bf16*)(F.ws + WS_WIN) + (size_t)l * DINP * DM, 0, 0);
            TR_RUN(args.in[I_WUQ] + (size_t)l * 512 * 768, 512, 768, (bf16*)(F.ws + WS_WUQ) + (size_t)l * 768 * 512, 0, 0);
            TR_RUN(args.in[I_WUKV] + (size_t)l * 256 * 1024, 256, 1024, (bf16*)(F.ws + WS_WUKV) + (size_t)l * 1024 * 256, 0, 0);
            TR_RUN(args.in[I_WOUT] + (size_t)l * DM * DM, DM, DM, (bf16*)(F.ws + WS_WOUT) + (size_t)l * DM * DM, 0, 0);
        }
        if constexpr (F8D) {
            TR_RUN8(args.in[I_WG], DM, DFF, (unsigned char*)(F.ws + WS_WGU), 0, 1);
            TR_RUN8(args.in[I_WU], DM, DFF, (unsigned char*)(F.ws + WS_WGU), 0, 2);
            TR_RUN8(args.in[I_WDN], DFF, DM, (unsigned char*)(F.ws + WS_WD), 0, 0);
        } else {
            TR_RUN(args.in[I_WG], DM, DFF, (bf16*)(F.ws + WS_WGU), 0, 1);
            TR_RUN(args.in[I_WU], DM, DFF, (bf16*)(F.ws + WS_WGU), 0, 2);
            TR_RUN(args.in[I_WDN], DFF, DM, (bf16*)(F.ws + WS_WD), 0, 0);
        }
        if constexpr (F8M) {
            for (int e = 0; e < NE; ++e) {
                TR_RUN8(args.in[I_WEG] + (size_t)e * DM * DFE, DM, DFE, (unsigned char*)(F.ws + WS_WEGU) + (size_t)e * 2 * DFE * DM, 0, 1);
                TR_RUN8(args.in[I_WEU] + (size_t)e * DM * DFE, DM, DFE, (unsigned char*)(F.ws + WS_WEGU) + (size_t)e * 2 * DFE * DM, 0, 2);
                TR_RUN8(args.in[I_WED] + (size_t)e * DFE * DM, DFE, DM, (unsigned char*)(F.ws + WS_WED) + (size_t)e * DM * DFE, 0, 0);
            }
        } else {
            for (int e = 0; e < NE; ++e) {
                TR_RUN(args.in[I_WEG] + (size_t)e * DM * DFE, DM, DFE, (bf16*)(F.ws + WS_WEGU) + (size_t)e * 2 * DFE * DM, 0, 1);
                TR_RUN(args.in[I_WEU] + (size_t)e * DM * DFE, DM, DFE, (bf16*)(F.ws + WS_WEGU) + (size_t)e * 2 * DFE * DM, 0, 2);
                TR_RUN(args.in[I_WED] + (size_t)e * DFE * DM, DFE, DM, (bf16*)(F.ws + WS_WED) + (size_t)e * DM * DFE, 0, 0);
            }
        }
#undef TR_RUN
#undef TR_RUN8
        for (int l = 0; l < DEPTH; ++l) { v4u* z = (v4u*)((bf16*)(F.ws + WS_WIN) + ((size_t)l * DINP + DIN) * DM); const v4u zz = {0u, 0u, 0u, 0u};
            for (int i = F.bid * NWAVES * 64 + tid; i < (DINP - DIN) * DM / 8; i += F.G * NWAVES * 64) z[i] = zz; }
        phase_rmsnorm<false>(F, args.in[I_X], args.in[I_MIXN], F.ws + WS_H, 1.f);
     xcd_barrier(bar); }
        int tid_ = threadIdx.x; asm volatile("" : "+v"(tid_)); const int tid = tid_, lane = tid & 63; (void)tid; (void)lane;
        LAS float* scr = (LAS float*)(F.lds + F.wave * 16896);
        int it = F.gw;
#define TR_RUN(Wp, Kk, Nn, Dp, ROFF, MODE) do { const int cnt_ = ((Kk) >> 6) * ((Nn) >> 6); while (it < cnt_) { transpose_item((Wp), (Kk), (Nn), (Dp), (ROFF), (MODE), scr, it, lane); it += F.ngw; } it -= cnt_; } while (0)
#define TR_RUN8(Wp, Kk, Nn, Dp, ROFF, MODE) do { const int cnt_ = ((Kk) >> 7) * ((Nn) >> 5); while (it < cnt_) { transpose_item_f8((Wp), (Kk), (Nn), (Dp), (ROFF), (MODE), SC_W, scr8, it, lane); it += F.ngw; } it -= cnt_; } while (0)
        LAS float* scr8 = (LAS float*)(F.lds + F.wave * 16896);
        for (int l = 0; l < DEPTH; ++l) {
            TR_RUN(args.in[I_WIN] + (size_t)l * DM * DIN, DM, DIN, (bf16*)(F.ws + WS_WIN) + (size_t)l * DINP * DM, 0, 0);
            TR_RUN(args.in[I_WUQ] + (size_t)l * 512 * 768, 512, 768, (bf16*)(F.ws + WS_WUQ) + (size_t)l * 768 * 512, 0, 0);
            TR_RUN(args.in[I_WUKV] + (size_t)l * 256 * 1024, 256, 1024, (bf16*)(F.ws + WS_WUKV) + (size_t)l * 1024 * 256, 0, 0);
            TR_RUN(args.in[I_WOUT] + (size_t)l * DM * DM, DM, DM, (bf16*)(F.ws + WS_WOUT) + (size_t)l * DM * DM, 0, 0);
        }
        if constexpr (F8D) {
            TR_RUN8(args.in[I_WG], DM, DFF, (unsigned char*)(F.ws + WS_WGU), 0, 1);
            TR_RUN8(args.in[I_WU], DM, DFF, (unsigned char*)(F.ws + WS_WGU), 0, 2);
            TR_RUN8(args.in[I_WDN], DFF, DM, (unsigned char*)(F.ws + WS_WD), 0, 0);
        } else {
            TR_RUN(args.in[I_WG], DM, DFF, (bf16*)(F.ws + WS_WGU), 0, 1);
            TR_RUN(args.in[I_WU], DM, DFF, (bf16*)(F.ws + WS_WGU), 0, 2);
            TR_RUN(args.in[I_WDN], DFF, DM, (bf16*)(F.ws + WS_WD), 0, 0);
        }
        if constexpr (F8M) {
            for (int e = 0; e < NE; ++e) {
                TR_RUN8(args.in[I_WEG] + (size_t)e * DM * DFE, DM, DFE, (unsigned char*)(F.ws + WS_WEGU) + (size_t)e * 2 * DFE * DM, 0, 1);
                TR_RUN8(args.in[I_WEU] + (size_t)e * DM * DFE, DM, DFE, (unsigned char*)(F.ws + WS_WEGU) + (size_t)e * 2 * DFE * DM, 0, 2);
                TR_RUN8(args.in[I_WED] + (size_t)e * DFE * DM, DFE, DM, (unsigned char*)(F.ws + WS_WED) + (size_t)e * DM * DFE, 0, 0);
            }
        } else {
            for (int e = 0; e < NE; ++e) {
                TR_RUN(args.in[I_WEG] + (size_t)e * DM * DFE, DM, DFE, (bf16*)(F.ws + WS_WEGU) + (size_t)e * 2 * DFE * DM, 0, 1);
                TR_RUN(args.in[I_WEU] + (size_t)e * DM * DFE, DM, DFE, (bf16*)(F.ws + WS_WEGU) + (size_t)e * 2 * DFE * DM, 0, 2);
                TR_RUN(args.in[I_WED] + (size_t)e * DFE * DM, DFE, DM, (bf16*)(F.ws + WS_WED) + (size_t)e * DM * DFE, 0, 0);
            }
        }
#undef TR_RUN
#undef TR_RUN8
        for (int l = 0; l < DEPTH; ++l) { v4u* z = (v4u*)((bf16*)(F.ws + WS_WIN) + ((size_t)l * DINP + DIN) * DM); const v4u zz = {0u, 0u, 0u, 0u};
            for (int i = F.bid * NWAVES * 64 + tid; i < (DINP - DIN) * DM / 8; i += F.G * NWAVES * 64) z[i] = zz; }
        phase_rmsnorm<false>(F, args.in[I_X], args.in[I_MIXN], F.ws + WS_H, 1.f);
    }
    SEAM(0);

#pragma nounroll
    for (int l = 0; l < DEPTH; ++l) {
        const int P = 11 * l;
        if (PHON(1) && IN(P + 1)) {
            if (REP(1)) {
            pg8::Gemm g{(const bf16*)(F.ws + WS_H), (const bf16*)(F.ws + WS_WIN) + (size_t)l * DINP * DM, NTOK, DINP, DM, 0, 0}; pg8::StaticOrder S; S.init(NTOK, DINP, F.G, F.bid);
            pg8::EpiBf16 E{(bf16*)(F.ws + WS_PROJ), DINP};
            pg8::gemm_phase<pg8::EpiBf16, pg8::StaticOrder, true, true>(ring, g, S, E);
         xcd_barrier(bar); }
            pg8::Gemm g{(const bf16*)(F.ws + WS_H), (const bf16*)(F.ws + WS_WIN) + (size_t)l * DINP * DM, NTOK, DINP, DM, 0, 0}; pg8::StaticOrder S; S.init(NTOK, DINP, F.G, F.bid);
            pg8::EpiBf16 E{(bf16*)(F.ws + WS_PROJ), DINP};
            pg8::gemm_phase<pg8::EpiBf16, pg8::StaticOrder, true, true>(ring, g, S, E);
        }
        SEAM(P + 1);
        if (PHON(2) && IN(P + 2)) { if (REP(2)) { phase_postproj(F, args, l); xcd_barrier(bar); } phase_postproj(F, args, l); }
        SEAM(P + 2);
        if (PHON(3) && IN(P + 3)) {
            if (REP(3)) {
            { pg8::Gemm g{(const bf16*)(F.ws + WS_CQN), (const bf16*)(F.ws + WS_WUQ) + (size_t)l * 768 * 512, NTOK, 768, 512, 0, 0}; pg8::StaticOrder S; S.init(NTOK, 768, F.G, F.bid);
              pg8::EpiBf16 E{(bf16*)(F.ws + WS_QCR), 768}; pg8::gemm_phase<pg8::EpiBf16, pg8::StaticOrder, true, true>(ring, g, S, E); }
            { pg8::Gemm g{(const bf16*)(F.ws + WS_CKVN), (const bf16*)(F.ws + WS_WUKV) + (size_t)l * 1024 * 256, NTOK, 1024, 256, 0, 0}; pg8::StaticOrder S; S.init(NTOK, 1024, F.G, F.bid);
              pg8::EpiBf16 E{(bf16*)(F.ws + WS_KVR), 1024}; pg8::gemm_phase<pg8::EpiBf16, pg8::StaticOrder, true, true>(ring, g, S, E); }
         xcd_barrier(bar); }
            { pg8::Gemm g{(const bf16*)(F.ws + WS_CQN), (const bf16*)(F.ws + WS_WUQ) + (size_t)l * 768 * 512, NTOK, 768, 512, 0, 0}; pg8::StaticOrder S; S.init(NTOK, 768, F.G, F.bid);
              pg8::EpiBf16 E{(bf16*)(F.ws + WS_QCR), 768}; pg8::gemm_phase<pg8::EpiBf16, pg8::StaticOrder, true, true>(ring, g, S, E); }
            { pg8::Gemm g{(const bf16*)(F.ws + WS_CKVN), (const bf16*)(F.ws + WS_WUKV) + (size_t)l * 1024 * 256, NTOK, 1024, 256, 0, 0}; pg8::StaticOrder S; S.init(NTOK, 1024, F.G, F.bid);
              pg8::EpiBf16 E{(bf16*)(F.ws + WS_KVR), 1024}; pg8::gemm_phase<pg8::EpiBf16, pg8::StaticOrder, true, true>(ring, g, S, E); }
        }
        SEAM(P + 3);
        if (PHON(4) && IN(P + 4)) { if (REP(4)) { phase_postmla(F, args, l); xcd_barrier(bar); } phase_postmla(F, args, l); }
        SEAM(P + 4);
        if (PHON(5) && IN(P + 5)) { if (REP(5)) { { phase_attention(F, args, l); __syncthreads(); } xcd_barrier(bar); } { phase_attention(F, args, l); __syncthreads(); } }
        SEAM(P + 5);
        if (PHON(6) && IN(P + 6)) { if (REP(6)) { phase_groupnorm(F, args, l); xcd_barrier(bar); } phase_groupnorm(F, args, l); }
        SEAM(P + 6);
        if (PHON(7) && IN(P + 7)) {
            if (REP(7)) {
            pg8::Gemm g{(const bf16*)(F.ws + WS_ON), (const bf16*)(F.ws + WS_WOUT) + (size_t)l * DM * DM, NTOK, DM, DM, 0, 0}; pg8::StaticOrder S; S.init(NTOK, DM, F.G, F.bid);
            pg8::EpiResF32 E{l == 0 ? args.in[I_X] : (const float*)out, (float*)(F.ws + WS_DUMMY), DM};
            pg8::gemm_phase<pg8::EpiResF32, pg8::StaticOrder, true, true>(ring, g, S, E);
         xcd_barrier(bar); }
            pg8::Gemm g{(const bf16*)(F.ws + WS_ON), (const bf16*)(F.ws + WS_WOUT) + (size_t)l * DM * DM, NTOK, DM, DM, 0, 0}; pg8::StaticOrder S; S.init(NTOK, DM, F.G, F.bid);
            pg8::EpiResF32 E{l == 0 ? args.in[I_X] : (const float*)out, out, DM};
            pg8::gemm_phase<pg8::EpiResF32, pg8::StaticOrder, true, true>(ring, g, S, E);
        }
        SEAM(P + 7);
        if (l == 0) {
            if (PHON(8) && IN(P + 8)) { if (REP(8)) { phase_rmsnorm<F8D>(F, out, args.in[I_FFNN] + (size_t)l * DM, F.ws + WS_H, F8D ? SC_H : 1.f); xcd_barrier(bar); } phase_rmsnorm<F8D>(F, out, args.in[I_FFNN] + (size_t)l * DM, F.ws + WS_H, F8D ? SC_H : 1.f); }
            SEAM(P + 8);
            if (PHON(9) && IN(P + 9)) {
            if (REP(9)) {
                pg8::Gemm g{F.ws + WS_H, F.ws + WS_WGU, NTOK, 2 * DFF, DM, E8_H, E8_W}; pg8::StaticOrder S; S.init(NTOK, 2 * DFF, F.G, F.bid);
                if constexpr (F8D) { pg8::EpiSwigluF8 E{F.ws + WS_ACT, DFF, SC_ACT}; pg8::gemm_phase<pg8::EpiSwigluF8, pg8::StaticOrder, true, true, true>(ring, g, S, E); }
                else { pg8::EpiSwiglu E{(bf16*)(F.ws + WS_ACT), DFF}; pg8::gemm_phase<pg8::EpiSwiglu, pg8::StaticOrder, true, true, false>(ring, g, S, E); }
             xcd_barrier(bar); }
                pg8::Gemm g{F.ws + WS_H, F.ws + WS_WGU, NTOK, 2 * DFF, DM, E8_H, E8_W}; pg8::StaticOrder S; S.init(NTOK, 2 * DFF, F.G, F.bid);
                if constexpr (F8D) { pg8::EpiSwigluF8 E{F.ws + WS_ACT, DFF, SC_ACT}; pg8::gemm_phase<pg8::EpiSwigluF8, pg8::StaticOrder, true, true, true>(ring, g, S, E); }
                else { pg8::EpiSwiglu E{(bf16*)(F.ws + WS_ACT), DFF}; pg8::gemm_phase<pg8::EpiSwiglu, pg8::StaticOrder, true, true, false>(ring, g, S, E); }
            }
            SEAM(P + 9);
            if (PHON(10) && IN(P + 10)) {
            if (REP(10)) {
                pg8::Gemm g{F.ws + WS_ACT, F.ws + WS_WD, NTOK, DM, DFF, E8_ACT, E8_W}; pg8::StaticOrder S; S.init(NTOK, DM, F.G, F.bid);
                pg8::EpiResF32 E{out, (float*)(F.ws + WS_DUMMY), DM};
                pg8::gemm_phase<pg8::EpiResF32, pg8::StaticOrder, true, true, F8D>(ring, g, S, E);
             xcd_barrier(bar); }
                pg8::Gemm g{F.ws + WS_ACT, F.ws + WS_WD, NTOK, DM, DFF, E8_ACT, E8_W}; pg8::StaticOrder S; S.init(NTOK, DM, F.G, F.bid);
                pg8::EpiResF32 E{out, out, DM};
                pg8::gemm_phase<pg8::EpiResF32, pg8::StaticOrder, true, true, F8D>(ring, g, S, E);
            }
            SEAM(P + 10);
            if (PHON(8) && IN(P + 11)) phase_rmsnorm<false>(F, out, args.in[I_MIXN] + (size_t)(l + 1) * DM, F.ws + WS_H, 1.f);
            SEAM(P + 11);
        } else {
            if (PHON(11) && IN(P + 8)) phase_ffnnorm_route<F8M>(F, args, out, args.in[I_FFNN] + (size_t)l * DM, F.ws + WS_H, SC_H);
            SEAM(P + 8);
            if (PHON(12) && IN(P + 9)) { if (REP(12)) { phase_gather<F8M>(F); xcd_barrier(bar); } phase_gather<F8M>(F); }
            SEAM(P + 9);
            if (PHON(13) && IN(P + 10)) {
            if (REP(13)) {
                int tb[9], cnt[8]; moe_tiles(F, tb, cnt);
                pg8::Gemm g{F.ws + WS_HG, F.ws + WS_WEGU, tb[8] * 256, 2 * DFE, DM, E8_H, E8_W}; pg8::GroupedOrder S; S.init(tb[8] * 256, 2 * DFE, F.G, F.bid);
#pragma unroll
                for (int k = 0; k < 7; ++k) S.tb[k] = tb[k + 1];
                S.nct = 2 * DFE / 256;
                if constexpr (F8M) { pg8::EpiSwigluF8 E{F.ws + WS_ACTM, DFE, SC_ACT}; pg8::gemm_phase<pg8::EpiSwigluF8, pg8::GroupedOrder, true, true, true>(ring, g, S, E); }
                else { pg8::EpiSwiglu E{(bf16*)(F.ws + WS_ACTM), DFE}; pg8::gemm_phase<pg8::EpiSwiglu, pg8::GroupedOrder, true, true, false>(ring, g, S, E); }
             xcd_barrier(bar); }
                int tb[9], cnt[8]; moe_tiles(F, tb, cnt);
                pg8::Gemm g{F.ws + WS_HG, F.ws + WS_WEGU, tb[8] * 256, 2 * DFE, DM, E8_H, E8_W}; pg8::GroupedOrder S; S.init(tb[8] * 256, 2 * DFE, F.G, F.bid);
#pragma unroll
                for (int k = 0; k < 7; ++k) S.tb[k] = tb[k + 1];
                S.nct = 2 * DFE / 256;
                if constexpr (F8M) { pg8::EpiSwigluF8 E{F.ws + WS_ACTM, DFE, SC_ACT}; pg8::gemm_phase<pg8::EpiSwigluF8, pg8::GroupedOrder, true, true, true>(ring, g, S, E); }
                else { pg8::EpiSwiglu E{(bf16*)(F.ws + WS_ACTM), DFE}; pg8::gemm_phase<pg8::EpiSwiglu, pg8::GroupedOrder, true, true, false>(ring, g, S, E); }
            }
            SEAM(P + 10);
            if (PHON(14) && IN(P + 11)) {
            if (REP(14)) {
                int tb[9], cnt[8]; moe_tiles(F, tb, cnt);
                pg8::Gemm g{F.ws + WS_ACTM, F.ws + WS_WED, tb[8] * 256, DM, DFE, E8_ACT, E8_W}; pg8::GroupedOrder S; S.init(tb[8] * 256, DM, F.G, F.bid);
#pragma unroll
                for (int k = 0; k < 7; ++k) S.tb[k] = tb[k + 1];
                S.nct = DM / 256;
                pg8::EpiScaleBf16 E{(bf16*)(F.ws + WS_Y), DM, (const float*)(F.ws + WS_RGATE)};
                pg8::gemm_phase<pg8::EpiScaleBf16, pg8::GroupedOrder, true, true, F8M>(ring, g, S, E);
             xcd_barrier(bar); }
                int tb[9], cnt[8]; moe_tiles(F, tb, cnt);
                pg8::Gemm g{F.ws + WS_ACTM, F.ws + WS_WED, tb[8] * 256, DM, DFE, E8_ACT, E8_W}; pg8::GroupedOrder S; S.init(tb[8] * 256, DM, F.G, F.bid);
#pragma unroll
                for (int k = 0; k < 7; ++k) S.tb[k] = tb[k + 1];
                S.nct = DM / 256;
                pg8::EpiScaleBf16 E{(bf16*)(F.ws + WS_Y), DM, (const float*)(F.ws + WS_RGATE)};
                pg8::gemm_phase<pg8::EpiScaleBf16, pg8::GroupedOrder, true, true, F8M>(ring, g, S, E);
            }
            SEAM(P + 11);
            if (PHON(15) && IN(P + 12)) phase_combine(F, out);
        }
    }
#undef IN
#undef SEAM
}

extern "C" void kernel_launch(void* const* d_in, const int* in_sizes, int n_in, void* d_out, int out_size, void* d_ws, size_t ws_size, hipStream_t stream) {
    static int grid = 0;
    if (grid == 0) {
        if (n_in != 26 || in_sizes[0] != NTOK * DM || out_size != NTOK * DM || ws_size < WS_END) { fprintf(stderr, "kernel_launch: unexpected shapes (n_in %d, in0 %d, out %d, ws %zu < %zu)\n", n_in, n_in > 0 ? in_sizes[0] : -1, out_size, ws_size, (size_t)WS_END); grid = -1; return; }
        int dev = 0, cus = 0, per_cu = 0;
        if (hipGetDevice(&dev) != hipSuccess || hipDeviceGetAttribute(&cus, hipDeviceAttributeMultiprocessorCount, dev) != hipSuccess) { grid = -1; return; }
        if (hipFuncSetAttribute((const void*)mega_fwd, hipFuncAttributeMaxDynamicSharedMemorySize, LDS_BYTES) != hipSuccess) { fprintf(stderr, "kernel_launch: hipFuncSetAttribute failed\n"); grid = -1; return; }
        if (hipOccupancyMaxActiveBlocksPerMultiprocessor(&per_cu, (const void*)mega_fwd, NWAVES * 64, LDS_BYTES) != hipSuccess || per_cu < 1) fprintf(stderr, "kernel_launch: occupancy query reports %d\n", per_cu);
        (void)hipGetLastError();
        grid = cus;
    }
    if (grid < 0) return;
    if (hipMemsetAsync((char*)d_ws + WS_CTL, 0, CTL_ZERO_BYTES, stream) != hipSuccess) return;
    Args a{};
    for (int i = 0; i < 26; ++i) a.in[i] = (const float*)d_in[i];
    a.out = (float*)d_out; a.ws = (unsigned char*)d_ws;
#ifndef MK_SPLIT
    a.ph_lo = 0; a.ph_hi = NPHASE;
    hipLaunchKernelGGL(mega_fwd, dim3(grid), dim3(NWAVES * 64), LDS_BYTES, stream, a);
#else
    for (int p = 0; p < NPHASE; ++p) { a.ph_lo = p; a.ph_hi = p + 1; hipLaunchKernelGGL(mega_fwd, dim3(grid), dim3(NWAVES * 64), LDS_BYTES, stream, a); }
#endif
}
```

```cpp
#include <hip/hip_runtime.h>
#include <cstdio>
#include <cstdint>
namespace pg8 {
#define PG8_LAS __attribute__((address_space(3)))
typedef unsigned short bf16_t;
typedef short bf16x8 __attribute__((ext_vector_type(8)));
typedef float f32x4 __attribute__((ext_vector_type(4)));
typedef unsigned u32x4 __attribute__((ext_vector_type(4)));
constexpr int BM = 256, BK = 64, HALF = 128, HTB = HALF * BK * 2  , STAGE_BYTES = 8 * HTB, NXCD = 8, WGM = 8;

__host__ __device__ __forceinline__ int lds_byte(int r, int c) { const int st = (r >> 4) * 2 + (c >> 5), rr = r & 15, cc = c & 31, ob = rr * 64 + cc * 2; return st * 1024 + (ob ^ (((ob >> 9) & 1) << 5)); }
__host__ __device__ __forceinline__ void stage_rc(int b, int& R, int& C) { const int st = b / 1024, sb = b % 1024, swz = sb ^ (((sb >> 9) & 1) << 5); R = (st >> 1) * 16 + swz / 64; C = (st & 1) * 32 + (swz % 64) / 2; }
__host__ __device__ __forceinline__ int perm32(int rho) { const int n = rho >> 4, i = rho & 15; return 8 * (i >> 2) + 4 * n + (i & 3); }


struct Unit { int pm, pn, pc; };
struct Gemm { const void* A; const void* Bt; int M, N, K; };
typedef int i32x4 __attribute__((ext_vector_type(4)));
typedef int i32x8 __attribute__((ext_vector_type(8)));

struct StaticOrder {
    int nM, nN, nwg, G, c;
    __device__ __forceinline__ void init(int M, int N, int G_, int c_) { nM = M / BM; nN = N / BM; nwg = nM * nN; G = G_; c = c_; }
    __device__ __forceinline__ bool next(int i, Unit& u) const {
        const long L = (long)i * G + c; if (L >= nwg) return false;
        int wgid = (int)L; { const int q = nwg / NXCD, r = nwg % NXCD, xcd = wgid % NXCD, off = wgid / NXCD; wgid = (xcd < r ? xcd * (q + 1) : r * (q + 1) + (xcd - r) * q) + off; }
        const int nig = WGM * nN, gid = wgid / nig, fm = gid * WGM, gsz = (nM - fm) < WGM ? (nM - fm) : WGM;
        u.pm = fm + ((wgid % nig) % gsz); u.pn = (wgid % nig) / gsz; u.pc = u.pn; return true;
    }
    __device__ __forceinline__ void a_ready(const Unit&) const {}
    __device__ __forceinline__ void done(const Unit&) const {}
};
struct GroupedOrder : StaticOrder {
    int tb[7]; int nct;
    __device__ __forceinline__ bool next(int i, Unit& u) const {
        if (!StaticOrder::next(i, u)) return false;
        int e = 0;
#pragma unroll
        for (int k = 0; k < 7; ++k) e += (u.pm >= tb[k]) ? 1 : 0;
        u.pc = u.pn; u.pn += e * nct; return true;
    }
};

__device__ __forceinline__ unsigned cvt_pk_bf16(float lo, float hi) { unsigned r; asm volatile("v_cvt_pk_bf16_f32 %0, %1, %2" : "=v"(r) : "v"(lo), "v"(hi)); return r; }

struct EpiBf16 {
    static constexpr bool PERM = true, AFTER_DRAIN = false;
    bf16_t* O; int ldc;
    __device__ __forceinline__ void operator()(const f32x4 (&acc)[2][2][4][2], const Unit& u, int wr, int wc, int fr, int fq) const {
        const int row0 = u.pm * BM + wr * 64 + fr, col0 = u.pc * BM + wc * 32 + 8 * fq;
#pragma unroll
        for (int ai = 0; ai < 2; ++ai)
#pragma unroll
            for (int m = 0; m < 4; ++m) { bf16_t* rowp = O + (size_t)(row0 + ai * HALF + m * 16) * ldc + col0;
#pragma unroll
                for (int bj = 0; bj < 2; ++bj) { const f32x4 v0 = acc[ai][bj][m][0], v1 = acc[ai][bj][m][1];
                    u32x4 w; w.x = cvt_pk_bf16(v0[0], v0[1]); w.y = cvt_pk_bf16(v0[2], v0[3]); w.z = cvt_pk_bf16(v1[0], v1[1]); w.w = cvt_pk_bf16(v1[2], v1[3]);
                    *(u32x4*)(rowp + bj * HALF) = w; } }
    }
};
struct EpiScaleBf16 {
    static constexpr bool PERM = true, AFTER_DRAIN = false;
    bf16_t* O; int ldc; const float* rs; float isc;
    __device__ __forceinline__ void operator()(const f32x4 (&acc)[2][2][4][2], const Unit& u, int wr, int wc, int fr, int fq) const {
        const int row0 = u.pm * BM + wr * 64 + fr, col0 = u.pc * BM + wc * 32 + 8 * fq;
#pragma unroll
        for (int ai = 0; ai < 2; ++ai)
#pragma unroll
            for (int m = 0; m < 4; ++m) { const int row = row0 + ai * HALF + m * 16; const float s = rs[row] * isc; bf16_t* rowp = O + (size_t)row * ldc + col0;
#pragma unroll
                for (int bj = 0; bj < 2; ++bj) { const f32x4 v0 = acc[ai][bj][m][0] * s, v1 = acc[ai][bj][m][1] * s;
                    u32x4 w; w.x = cvt_pk_bf16(v0[0], v0[1]); w.y = cvt_pk_bf16(v0[2], v0[3]); w.z = cvt_pk_bf16(v1[0], v1[1]); w.w = cvt_pk_bf16(v1[2], v1[3]);
                    *(u32x4*)(rowp + bj * HALF) = w; } }
    }
};
struct EpiResF32 {
    static constexpr bool PERM = false, AFTER_DRAIN = false;
    const float* base; float* out; int ldc; float isc;
    __device__ __forceinline__ void operator()(const f32x4 (&acc)[2][2][4][2], const Unit& u, int wr, int wc, int fr, int fq) const {
        const int row0 = u.pm * BM + wr * 64 + fr, col0 = u.pc * BM + wc * 32 + 4 * fq;
#pragma unroll
        for (int ai = 0; ai < 2; ++ai)
#pragma unroll
            for (int m = 0; m < 4; ++m) { const size_t off = (size_t)(row0 + ai * HALF + m * 16) * ldc + col0;
                f32x4 b[2][2];
#pragma unroll
                for (int bj = 0; bj < 2; ++bj)
#pragma unroll
                    for (int n = 0; n < 2; ++n) b[bj][n] = *(const f32x4*)(base + off + bj * HALF + n * 16);
#pragma unroll
                for (int bj = 0; bj < 2; ++bj)
#pragma unroll
                    for (int n = 0; n < 2; ++n) *(f32x4*)(out + off + bj * HALF + n * 16) = b[bj][n] + acc[ai][bj][m][n] * isc;
                asm volatile("" ::: "memory"); }
    }
};
__device__ __forceinline__ float silu_mul(float g, float u) { return g * u * __builtin_amdgcn_rcpf(1.0f + __builtin_amdgcn_exp2f(-1.44269504089f * g)); }
struct EpiSwiglu {
    static constexpr bool PERM = true, AFTER_DRAIN = false;
    bf16_t* O; int ldc;
    __device__ __forceinline__ void operator()(const f32x4 (&acc)[2][2][4][2], const Unit& u, int wr, int wc, int fr, int fq) const {
        const int row0 = u.pm * BM + wr * 64 + fr, col0 = u.pc * HALF + wc * 32 + 8 * fq;
#pragma unroll
        for (int ai = 0; ai < 2; ++ai)
#pragma unroll
            for (int m = 0; m < 4; ++m) { bf16_t* rowp = O + (size_t)(row0 + ai * HALF + m * 16) * ldc + col0;
                const f32x4 g0 = acc[ai][0][m][0], g1 = acc[ai][0][m][1], u0 = acc[ai][1][m][0], u1 = acc[ai][1][m][1];
                u32x4 w; w.x = cvt_pk_bf16(silu_mul(g0[0], u0[0]), silu_mul(g0[1], u0[1])); w.y = cvt_pk_bf16(silu_mul(g0[2], u0[2]), silu_mul(g0[3], u0[3]));
                w.z = cvt_pk_bf16(silu_mul(g1[0], u1[0]), silu_mul(g1[1], u1[1])); w.w = cvt_pk_bf16(silu_mul(g1[2], u1[2]), silu_mul(g1[3], u1[3]));
                *(u32x4*)rowp = w; }
    }
};

__device__ __forceinline__ unsigned cvt_pk4_fp8(float a, float b, float c, float d) { unsigned w = 0u; w = __builtin_amdgcn_cvt_pk_fp8_f32(a, b, w, false); w = __builtin_amdgcn_cvt_pk_fp8_f32(c, d, w, true); return w; }
struct EpiSwigluF8 {
    static constexpr bool PERM = true, AFTER_DRAIN = false;
    unsigned char* O; int ldc; float osc, isc;
    __device__ __forceinline__ void operator()(const f32x4 (&acc)[2][2][4][2], const Unit& u, int wr, int wc, int fr, int fq) const {
        const int row0 = u.pm * BM + wr * 64 + fr, col0 = u.pc * HALF + wc * 32 + 8 * fq;
        const float k1 = osc * isc * isc, k2 = -1.44269504089f * isc;
#define SWF8(G, U) ((G) * (U) * k1 * __builtin_amdgcn_rcpf(1.0f + __builtin_amdgcn_exp2f((G) * k2)))
#pragma unroll
        for (int ai = 0; ai < 2; ++ai)
#pragma unroll
            for (int m = 0; m < 4; ++m) { unsigned char* rowp = O + (size_t)(row0 + ai * HALF + m * 16) * ldc + col0;
                const f32x4 g0 = acc[ai][0][m][0], g1 = acc[ai][0][m][1], u0 = acc[ai][1][m][0], u1 = acc[ai][1][m][1];
                typedef unsigned u32x2 __attribute__((ext_vector_type(2)));
                u32x2 w; w.x = cvt_pk4_fp8(SWF8(g0[0], u0[0]), SWF8(g0[1], u0[1]), SWF8(g0[2], u0[2]), SWF8(g0[3], u0[3]));
                w.y = cvt_pk4_fp8(SWF8(g1[0], u1[0]), SWF8(g1[1], u1[1]), SWF8(g1[2], u1[2]), SWF8(g1[3], u1[3]));
                *(u32x2*)rowp = w; }
#undef SWF8
    }
};

template <class Epi, class Sched, bool ALIGN_EPI = false, bool SP2 = false, bool F8 = false>
__device__ __forceinline__ void gemm_phase(PG8_LAS unsigned char* lds, const Gemm g, const Sched& S, const Epi& E) {
    int tid_ = threadIdx.x; asm volatile("" : "+v"(tid_));
    const int tid = tid_, wid = __builtin_amdgcn_readfirstlane(tid >> 6), lane = tid & 63, wr = wid >> 2, wc = wid & 3, fr = lane & 15, fq = lane >> 4;
    const int K = g.K, nt = F8 ? K / (2 * BK) : K / BK, RB = F8 ? K : 2 * K;
    unsigned voffA[2], voffB[2];
#pragma unroll
    for (int i = 0; i < 2; ++i) { int R, C; stage_rc(tid * 16 + i * 8192, R, C); const int Rb = Epi::PERM ? ((R & ~31) + perm32(R & 31)) : R;
        voffA[i] = (unsigned)(R * RB + C * 2); voffB[i] = (unsigned)(Rb * RB + C * 2); }
    const size_t kstep = (size_t)(BK * 2);
    const size_t hstep = (size_t)HALF * RB;
    const size_t tstep = 2 * hstep;
    const unsigned ldsw = (unsigned)wid * 1024u;
    const int aoff = F8 ? lds_byte(wr * 64 + fr, fq * 16) : lds_byte(wr * 64 + fr, fq * 8), boff = F8 ? lds_byte(wc * 32 + fr, fq * 16) : lds_byte(wc * 32 + fr, fq * 8);
#define PG8_SA(b, h) (((b) * 2 + (h)) * HTB)
#define PG8_SB(b, h) ((4 + (b) * 2 + (h)) * HTB)
#define PG8_STAGE(bufoff, gbase, voff) do { _Pragma("unroll") for (int _i = 0; _i < 2; ++_i) \
        __builtin_amdgcn_global_load_lds((const unsigned*)((const char*)(gbase) + (voff)[_i]), (PG8_LAS unsigned*)(lds + (bufoff) + ldsw + _i * 8192), 16, 0, 0); } while (0)
#define PG8_LD16(p) (*(const PG8_LAS i32x4*)(p))
#define PG8_LDA(dst, b, h) do { _Pragma("unroll") for (int m = 0; m < 4; ++m) { if constexpr (F8) { dst##8[m] = __builtin_shufflevector(PG8_LD16(lds + PG8_SA(b, h) + aoff + m * 2048), PG8_LD16(lds + PG8_SA(b, h) + aoff + m * 2048 + 16), 0, 1, 2, 3, 4, 5, 6, 7); } \
        else { _Pragma("unroll") for (int k = 0; k < 2; ++k) dst[m][k] = *(const PG8_LAS bf16x8*)(lds + PG8_SA(b, h) + aoff + m * 2048 + k * 1024); } } } while (0)
#define PG8_LDB(dst, b, h) do { _Pragma("unroll") for (int n = 0; n < 2; ++n) { if constexpr (F8) { dst##8[n] = __builtin_shufflevector(PG8_LD16(lds + PG8_SB(b, h) + boff + n * 2048), PG8_LD16(lds + PG8_SB(b, h) + boff + n * 2048 + 16), 0, 1, 2, 3, 4, 5, 6, 7); } \
        else { _Pragma("unroll") for (int k = 0; k < 2; ++k) dst[n][k] = *(const PG8_LAS bf16x8*)(lds + PG8_SB(b, h) + boff + n * 2048 + k * 1024); } } } while (0)
#define PG8_MMA(ai, bj, At, Bt) do { __builtin_amdgcn_s_setprio(1); _Pragma("unroll") for (int m = 0; m < 4; ++m) _Pragma("unroll") for (int n = 0; n < 2; ++n) { \
        if constexpr (F8) asm volatile("v_mfma_f32_16x16x128_f8f6f4 %0, %1, %2, %0" : "+v"(acc[ai][bj][m][n]) : "v"(Bt##8[n]), "v"(At##8[m])); \
        else { _Pragma("unroll") for (int k = 0; k < 2; ++k) acc[ai][bj][m][n] = __builtin_amdgcn_mfma_f32_16x16x32_bf16(Bt[n][k], At[m][k], acc[ai][bj][m][n], 0, 0, 0); } } __builtin_amdgcn_s_setprio(0); } while (0)
#define PG8_WAIT_V(n) asm volatile("s_waitcnt vmcnt(" #n ")" ::: "memory")
#define PG8_WAIT_L(n) asm volatile("s_waitcnt lgkmcnt(" #n ")" ::: "memory")
#define PG8_BAR __builtin_amdgcn_s_barrier()
#define PG8_SCHED __builtin_amdgcn_sched_barrier(0)
    Unit cur, nxt; int ui = 0;
    if (!S.next(0, cur)) return;
    f32x4 acc[2][2][4][2];
#pragma unroll
    for (int a = 0; a < 2; ++a)
#pragma unroll
        for (int b = 0; b < 2; ++b)
#pragma unroll
            for (int m = 0; m < 4; ++m)
#pragma unroll
                for (int n = 0; n < 2; ++n) acc[a][b][m][n] = (f32x4){0.f, 0.f, 0.f, 0.f};
    bf16x8 At[4][2], B0[2][2], B1[2][2]; i32x8 At8[4], B08[2], B18[2];
    const char* cA = (const char*)g.A + (size_t)cur.pm * tstep; const char* cB = (const char*)g.Bt + (size_t)cur.pn * tstep;
    S.a_ready(cur);
    if constexpr (SP2) {
        PG8_STAGE(PG8_SB(0, 0), cB, voffB); PG8_STAGE(PG8_SB(0, 1), cB + hstep, voffB); PG8_STAGE(PG8_SA(0, 0), cA, voffA); PG8_STAGE(PG8_SA(0, 1), cA + hstep, voffA);
        if (wr == 1) PG8_BAR;
        PG8_WAIT_V(2); PG8_BAR;
        PG8_STAGE(PG8_SB(1, 0), cB + kstep, voffB); PG8_STAGE(PG8_SA(1, 0), cA + kstep, voffA); PG8_STAGE(PG8_SB(1, 1), cB + hstep + kstep, voffB);
        PG8_WAIT_V(6); PG8_BAR;
    } else {
        PG8_STAGE(PG8_SB(0, 0), cB, voffB); PG8_STAGE(PG8_SA(0, 0), cA, voffA); PG8_STAGE(PG8_SB(0, 1), cB + hstep, voffB); PG8_STAGE(PG8_SA(0, 1), cA + hstep, voffA);
        if (wr == 1) PG8_BAR;
        PG8_WAIT_V(4); PG8_BAR;
        PG8_STAGE(PG8_SB(1, 0), cB + kstep, voffB); PG8_STAGE(PG8_SA(1, 0), cA + kstep, voffA); PG8_STAGE(PG8_SB(1, 1), cB + hstep + kstep, voffB);
        PG8_WAIT_V(6); PG8_BAR;
    }
    for (;;) {
        const bool has_next = S.next(ui + 1, nxt);
        const char* nA = has_next ? (const char*)g.A + (size_t)nxt.pm * tstep : cA; const char* nB = has_next ? (const char*)g.Bt + (size_t)nxt.pn * tstep : cB;
        for (int t = 0; t < nt; t += 2) {
            const bool last = (t == nt - 2);
            const char* a1 = cA + (size_t)(t + 1) * kstep;
            const char* a2 = last ? nA : cA + (size_t)(t + 2) * kstep; const char* b2 = last ? nB : cB + (size_t)(t + 2) * kstep;
            const char* a3 = a2 + kstep; const char* b3 = b2 + kstep;
            if (last && has_next) S.a_ready(nxt);
            if constexpr (SP2) {
            PG8_LDB(B0, 0, 0); PG8_LDB(B1, 0, 1); PG8_SCHED; PG8_LDA(At, 0, 0); PG8_STAGE(PG8_SA(1, 1), a1 + hstep, voffA);
            PG8_WAIT_V(8); PG8_WAIT_L(0); PG8_BAR; PG8_MMA(0, 0, At, B0); PG8_MMA(0, 1, At, B1); PG8_BAR; PG8_SCHED;
            PG8_LDA(At, 0, 1); PG8_STAGE(PG8_SB(0, 0), b2, voffB); PG8_STAGE(PG8_SB(0, 1), b2 + hstep, voffB); PG8_STAGE(PG8_SA(0, 0), a2, voffA);
            PG8_WAIT_V(8); PG8_WAIT_L(0); PG8_BAR; PG8_MMA(1, 0, At, B0); PG8_MMA(1, 1, At, B1); PG8_BAR; PG8_SCHED;
            PG8_LDB(B0, 1, 0); PG8_LDB(B1, 1, 1); PG8_SCHED; PG8_LDA(At, 1, 0); PG8_STAGE(PG8_SA(0, 1), a2 + hstep, voffA);
            PG8_WAIT_V(8); PG8_WAIT_L(0); PG8_BAR; PG8_MMA(0, 0, At, B0); PG8_MMA(0, 1, At, B1); PG8_BAR; PG8_SCHED;
            PG8_LDA(At, 1, 1); PG8_STAGE(PG8_SB(1, 0), b3, voffB); PG8_STAGE(PG8_SB(1, 1), b3 + hstep, voffB); PG8_STAGE(PG8_SA(1, 0), a3, voffA);
            PG8_WAIT_V(8); PG8_WAIT_L(0); PG8_BAR; PG8_MMA(1, 0, At, B0); PG8_MMA(1, 1, At, B1); PG8_BAR; PG8_SCHED;
            } else {
            PG8_LDB(B0, 0, 0); PG8_SCHED; PG8_LDA(At, 0, 0); PG8_STAGE(PG8_SA(1, 1), a1 + hstep, voffA);
            PG8_WAIT_L(8); PG8_BAR; PG8_WAIT_L(0); PG8_MMA(0, 0, At, B0); PG8_BAR; PG8_SCHED;
            PG8_LDB(B1, 0, 1); PG8_STAGE(PG8_SB(0, 0), b2, voffB);
            PG8_BAR; PG8_WAIT_L(0); PG8_MMA(0, 1, At, B1); PG8_BAR;
            PG8_LDA(At, 0, 1); PG8_STAGE(PG8_SA(0, 0), a2, voffA);
            PG8_BAR; PG8_WAIT_L(0); PG8_MMA(1, 0, At, B0); PG8_BAR; PG8_SCHED;
            PG8_STAGE(PG8_SB(0, 1), b2 + hstep, voffB);
            PG8_WAIT_V(6); PG8_BAR; PG8_MMA(1, 1, At, B1); PG8_BAR;
            PG8_LDB(B0, 1, 0); PG8_SCHED; PG8_LDA(At, 1, 0); PG8_STAGE(PG8_SA(0, 1), a2 + hstep, voffA);
            PG8_WAIT_L(8); PG8_BAR; PG8_WAIT_L(0); PG8_MMA(0, 0, At, B0); PG8_BAR; PG8_SCHED;
            PG8_LDB(B1, 1, 1); PG8_STAGE(PG8_SB(1, 0), b3, voffB);
            PG8_BAR; PG8_WAIT_L(0); PG8_MMA(0, 1, At, B1); PG8_BAR;
            PG8_LDA(At, 1, 1); PG8_STAGE(PG8_SA(1, 0), a3, voffA);
            PG8_BAR; PG8_WAIT_L(0); PG8_MMA(1, 0, At, B0); PG8_BAR; PG8_SCHED;
            PG8_STAGE(PG8_SB(1, 1), b3 + hstep, voffB);
            PG8_WAIT_V(6); PG8_BAR; PG8_MMA(1, 1, At, B1); PG8_BAR;
            }
        }
        if constexpr (ALIGN_EPI) { if (wr == 0) PG8_BAR; }
        if constexpr (F8) {
            asm volatile("s_nop 15\n\ts_nop 15" : "+v"(acc[0][0][0][0]), "+v"(acc[0][0][0][1]), "+v"(acc[0][0][1][0]), "+v"(acc[0][0][1][1]), "+v"(acc[0][0][2][0]), "+v"(acc[0][0][2][1]), "+v"(acc[0][0][3][0]), "+v"(acc[0][0][3][1]) :: "memory");
            asm volatile("" : "+v"(acc[0][1][0][0]), "+v"(acc[0][1][0][1]), "+v"(acc[0][1][1][0]), "+v"(acc[0][1][1][1]), "+v"(acc[0][1][2][0]), "+v"(acc[0][1][2][1]), "+v"(acc[0][1][3][0]), "+v"(acc[0][1][3][1]) :: "memory");
            asm volatile("" : "+v"(acc[1][0][0][0]), "+v"(acc[1][0][0][1]), "+v"(acc[1][0][1][0]), "+v"(acc[1][0][1][1]), "+v"(acc[1][0][2][0]), "+v"(acc[1][0][2][1]), "+v"(acc[1][0][3][0]), "+v"(acc[1][0][3][1]) :: "memory");
            asm volatile("" : "+v"(acc[1][1][0][0]), "+v"(acc[1][1][0][1]), "+v"(acc[1][1][1][0]), "+v"(acc[1][1][1][1]), "+v"(acc[1][1][2][0]), "+v"(acc[1][1][2][1]), "+v"(acc[1][1][3][0]), "+v"(acc[1][1][3][1]) :: "memory");
        }
        if constexpr (!Epi::AFTER_DRAIN) { E(acc, cur, wr, wc, fr, fq); S.done(cur); }
        if (!has_next) break;
#pragma unroll
        for (int a = 0; a < 2; ++a)
#pragma unroll
            for (int b = 0; b < 2; ++b)
#pragma unroll
                for (int m = 0; m < 4; ++m)
#pragma unroll
                    for (int n = 0; n < 2; ++n) acc[a][b][m][n] = (f32x4){0.f, 0.f, 0.f, 0.f};
        cur = nxt; cA = nA; cB = nB; ++ui;
        if constexpr (ALIGN_EPI) { if (wr == 1) PG8_BAR; }
    }
    PG8_WAIT_V(0);
    if constexpr (!ALIGN_EPI) { if (wr == 0) PG8_BAR; }
    PG8_BAR;
    if constexpr (Epi::AFTER_DRAIN) { E.fused(acc, cur, wr, wc, fr, fq, lds, wid, lane); S.done(cur); }
#undef PG8_SA
#undef PG8_SB
#undef PG8_STAGE
#undef PG8_LDA
#undef PG8_LDB
#undef PG8_MMA
#undef PG8_LD16
#undef PG8_WAIT_V
#undef PG8_WAIT_L
#undef PG8_BAR
#undef PG8_SCHED
}
}

namespace att {
typedef unsigned short bf16;
using bf16x8 = __attribute__((ext_vector_type(8))) short;
using s16x4  = __attribute__((ext_vector_type(4))) short;
using f32x16 = __attribute__((ext_vector_type(16))) float;
using u32x4  = __attribute__((ext_vector_type(4))) unsigned;
constexpr int NW = 8, QBLK = 32, KVBLK = 64, DV = 128;
constexpr float THR = 8.f;
constexpr int SHM_V = KVBLK * DV * 2;
#define ATT_SBAR() __builtin_amdgcn_sched_barrier(0)
__device__ __forceinline__ int crow(int r, int hi) { return (r & 3) + 8 * (r >> 2) + 4 * hi; }
__device__ __forceinline__ unsigned cvtpk(float lo, float hi) { unsigned r; asm volatile("v_cvt_pk_bf16_f32 %0, %1, %2" : "=v"(r) : "v"(lo), "v"(hi)); return r; }
template <int DQ> struct Cst { static constexpr float SCALE = (DQ == 128) ? 0.088388347648318440f : 0.072168783648703220f; static constexpr int SHM_K = KVBLK * DQ * 2, ROWB = DQ * 2; };

template <int DQ>
__device__ __forceinline__ void partialSM(f32x16& p0, f32x16& p1, float& m_reg, float& mn, float& alpha) {
  constexpr float SCALE = Cst<DQ>::SCALE, C = SCALE * 1.4426950408889634f;
  float pmax = p0[0];
#pragma unroll
  for (int r = 1; r < 16; ++r) pmax = fmaxf(pmax, p0[r]);
#pragma unroll
  for (int r = 0; r < 16; ++r) pmax = fmaxf(pmax, p1[r]);
  { auto rr = __builtin_amdgcn_permlane32_swap(__float_as_uint(pmax), __float_as_uint(pmax), false, false);
    pmax = fmaxf(__uint_as_float(rr[0]), __uint_as_float(rr[1])); }
  if (__builtin_expect(__all(pmax - m_reg <= THR / SCALE), 1)) { mn = m_reg; alpha = 1.f; }
  else { mn = fmaxf(m_reg, pmax); alpha = __builtin_amdgcn_exp2f((m_reg - mn) * C); m_reg = mn; }
  const float mnC = -mn * C;
#pragma unroll
  for (int r = 0; r < 16; ++r) p0[r] = fmaf(p0[r], C, mnC);
#pragma unroll
  for (int r = 0; r < 16; ++r) p1[r] = fmaf(p1[r], C, mnC);
#pragma unroll
  for (int r = 0; r < 16; ++r) p0[r] = __builtin_amdgcn_exp2f(p0[r]);
}
__device__ __forceinline__ void finishSM(f32x16& p0, f32x16& p1, float alpha, float& l_reg, bf16x8& pa0, bf16x8& pa1, bf16x8& pa2, bf16x8& pa3) {
#pragma unroll
  for (int r = 0; r < 16; ++r) p1[r] = __builtin_amdgcn_exp2f(p1[r]);
  float ps = 0;
#pragma unroll
  for (int r = 0; r < 16; ++r) ps += p0[r];
#pragma unroll
  for (int r = 0; r < 16; ++r) ps += p1[r];
  { auto rr = __builtin_amdgcn_permlane32_swap(__float_as_uint(ps), __float_as_uint(ps), false, false);
    ps = __uint_as_float(rr[0]) + __uint_as_float(rr[1]); }
  l_reg = l_reg * alpha + ps;
#define ATT_PK4(P, BASE, OUT) do { unsigned a0 = cvtpk(P[BASE + 0], P[BASE + 1]), a1 = cvtpk(P[BASE + 2], P[BASE + 3]);   \
    unsigned b0 = cvtpk(P[BASE + 4], P[BASE + 5]), b1 = cvtpk(P[BASE + 6], P[BASE + 7]);                              \
    auto r0 = __builtin_amdgcn_permlane32_swap(a0, b0, false, false); auto r1 = __builtin_amdgcn_permlane32_swap(a1, b1, false, false); \
    u32x4 w = {r0[0], r1[0], r0[1], r1[1]}; OUT = *reinterpret_cast<bf16x8*>(&w); } while (0)
  ATT_PK4(p0, 0, pa0); ATT_PK4(p0, 8, pa1); ATT_PK4(p1, 0, pa2); ATT_PK4(p1, 8, pa3);
#undef ATT_PK4
}
template <int DQ, int NREG>
__device__ __forceinline__ void qkt(f32x16& p0, f32x16& p1, const char* Ks, const bf16x8* qr, const char* qpark, int r32, int hi) {
  constexpr int ROWB = Cst<DQ>::ROWB;
  p0 = f32x16{}; p1 = f32x16{};
#pragma unroll
  for (int d0 = 0; d0 < DQ / 16; ++d0) { const int cb = (d0 * 16 + hi * 8) * 2;
    bf16x8 b0 = *reinterpret_cast<const bf16x8*>(Ks + (r32 * ROWB + (cb ^ ((r32 & 7) << 4))));
    bf16x8 b1 = *reinterpret_cast<const bf16x8*>(Ks + ((32 + r32) * ROWB + (cb ^ ((r32 & 7) << 4))));
    bf16x8 q; if constexpr (true) { if (d0 < NREG) q = qr[d0 < NREG ? d0 : 0]; else q = *reinterpret_cast<const bf16x8*>(qpark + (d0 - NREG) * 1024); }
    p0 = __builtin_amdgcn_mfma_f32_32x32x16_bf16(b0, q, p0, 0, 0, 0);
    p1 = __builtin_amdgcn_mfma_f32_32x32x16_bf16(b1, q, p1, 0, 0, 0); }
}
__device__ __forceinline__ int v_st(int k, int c) { const int kk = (k & ~0xC) | ((k & 4) << 1) | ((k & 8) >> 1); return ((kk >> 3) * 4 + (c >> 5)) * 512 + ((kk & 7) * 32 + (c & 31)) * 2; }
__device__ __forceinline__ int v_rd_base(int lane) { return ((lane & 3) << 3) | (((lane >> 2) & 3) << 6) | (((lane >> 4) & 1) << 5) | (((lane >> 5) & 1) << 8); }
constexpr int v_rd_off(int d0, int ks, int half) { return d0 * 512 + ks * 4096 + half * 2048; }
template <int OFF> __device__ __forceinline__ s16x4 tr_read(int vb) {
  s16x4 r; asm volatile("ds_read_b64_tr_b16 %0, %1 offset:%2" : "=&v"(r) : "v"(vb), "i"(OFF) : "memory"); return r;
}
template <int D0> __device__ __forceinline__ void pv_one(f32x16& od, int vb, bf16x8 pa0, bf16x8 pa1, bf16x8 pa2, bf16x8 pa3) {
  const s16x4 l0 = tr_read<v_rd_off(D0, 0, 0)>(vb), h0 = tr_read<v_rd_off(D0, 0, 1)>(vb), l1 = tr_read<v_rd_off(D0, 1, 0)>(vb), h1 = tr_read<v_rd_off(D0, 1, 1)>(vb);
  const s16x4 l2 = tr_read<v_rd_off(D0, 2, 0)>(vb), h2 = tr_read<v_rd_off(D0, 2, 1)>(vb), l3 = tr_read<v_rd_off(D0, 3, 0)>(vb), h3 = tr_read<v_rd_off(D0, 3, 1)>(vb);
  asm volatile("s_waitcnt lgkmcnt(0)" ::: "memory"); ATT_SBAR();
#define ATT_PK(L, H) (bf16x8){L[0], L[1], L[2], L[3], H[0], H[1], H[2], H[3]}
  od = __builtin_amdgcn_mfma_f32_32x32x16_bf16(pa0, ATT_PK(l0, h0), od, 0, 0, 0);
  od = __builtin_amdgcn_mfma_f32_32x32x16_bf16(pa1, ATT_PK(l1, h1), od, 0, 0, 0);
  od = __builtin_amdgcn_mfma_f32_32x32x16_bf16(pa2, ATT_PK(l2, h2), od, 0, 0, 0);
  od = __builtin_amdgcn_mfma_f32_32x32x16_bf16(pa3, ATT_PK(l3, h3), od, 0, 0, 0);
#undef ATT_PK
}
__device__ __forceinline__ void pv_d0(f32x16* o, int vb, bf16x8 pa0, bf16x8 pa1, bf16x8 pa2, bf16x8 pa3) {
  pv_one<0>(o[0], vb, pa0, pa1, pa2, pa3); pv_one<1>(o[1], vb, pa0, pa1, pa2, pa3); pv_one<2>(o[2], vb, pa0, pa1, pa2, pa3); pv_one<3>(o[3], vb, pa0, pa1, pa2, pa3);
}
__device__ __forceinline__ void natten_mod(f32x16& p0, f32x16& p1, int kr, int rq, int qc, const float* biasT, int hi) {
  const int r0 = min(max(rq - 4, 0), 56), c0 = min(max(qc - 8, 0), 48);
  const float NEG = -__builtin_inff();
  if (kr < r0 || kr >= r0 + 8) {
#pragma unroll
    for (int r = 0; r < 16; ++r) { p0[r] = NEG; p1[r] = NEG; }
  } else {
    const float* bl = biasT + (kr - rq + 7) * 128 + (63 - qc + 4 * hi);
    const int t = 4 * hi - c0;
#pragma unroll
    for (int r = 0; r < 16; ++r) {
      const int kcc = (r & 3) + 8 * (r >> 2);
      const bool ok0 = (unsigned)(t + kcc) < 16u, ok1 = (unsigned)(t + kcc + 32) < 16u;
      const float b0 = bl[kcc], b1 = bl[kcc + 32];
      p0[r] = ok0 ? p0[r] + b0 : NEG; p1[r] = ok1 ? p1[r] + b1 : NEG;
      if ((r & 3) == 3) __builtin_amdgcn_sched_barrier(0);
    }
  }
}

template <int DQ, int LDQ, int LDK, int LDV, int LDO, int MODE, int SDEPTH, int NREG>
__device__ __forceinline__ void attn_body(const bf16* __restrict__ Qb, const bf16* __restrict__ Kh, const bf16* __restrict__ Vh, bf16* __restrict__ Ob, const int NT, char* lds,
                                          const int rq0, const int kr_lo, const float* biasT) {
  constexpr int SHM_K = Cst<DQ>::SHM_K, ROWB = Cst<DQ>::ROWB;
  int tid_ = threadIdx.x; asm volatile("" : "+v"(tid_));
  const int tid = tid_, wid = tid >> 6, lane = tid & 63, r32 = lane & 31, hi = lane >> 5;
  char* V_lds = lds; char* K_lds = lds + 2 * SHM_V;
  float* ws = (float*)(lds + 2 * SHM_V + 2 * SHM_K) + wid * 64; float* li_l = ws; float* al_l = ws + 32;
  float m_reg = -1e30f, l_reg = 0; f32x16 o[4] = {}; bf16x8 qr[NREG > 0 ? NREG : 1];
  const bf16* Qw = Qb + (long)(wid * QBLK + r32) * LDQ + hi * 8;
  char* qpark = lds + 2 * SHM_V + 2 * SHM_K + NW * 64 * 4 + wid * ((DQ / 16 - NREG) * 1024) + hi * 512 + r32 * 16;
#pragma unroll
  for (int d0 = 0; d0 < DQ / 16; ++d0) { const bf16x8 qv = *reinterpret_cast<const bf16x8*>(Qw + d0 * 16); if (d0 < NREG) qr[d0 < NREG ? d0 : 0] = qv; else *reinterpret_cast<bf16x8*>(qpark + (d0 - NREG) * 1024) = qv; }
  const int nrq = rq0 + (wid >> 1), nqc = (wid & 1) * 32 + r32;
  const int sr = tid >> 4, sc = (tid & 15) * 8, vst0 = v_st(sr, sc), vst1 = v_st(32 + sr, sc);
  const int kr3 = tid >> 3, kc3 = 128 + (tid & 7) * 8;
  const int vb0 = (int)(uintptr_t)V_lds + v_rd_base(lane);
  struct { bf16x8 vs0, vs1, ks0, ks1, ks2; } sr_[SDEPTH];
#define ATT_LD8(p) (*reinterpret_cast<const bf16x8*>(p))
#define ATT_SLOAD(i, k0) do { sr_[i].vs0 = ATT_LD8(&Vh[(long)((k0) + sr) * LDV + sc]); sr_[i].vs1 = ATT_LD8(&Vh[(long)((k0) + 32 + sr) * LDV + sc]); \
    sr_[i].ks0 = ATT_LD8(&Kh[(long)((k0) + sr) * LDK + sc]); sr_[i].ks1 = ATT_LD8(&Kh[(long)((k0) + 32 + sr) * LDK + sc]); \
    if constexpr (DQ == 192) sr_[i].ks2 = ATT_LD8(&Kh[(long)((k0) + kr3) * LDK + kc3]); } while (0)
#define ATT_SWRITE(b, i) do { *(bf16x8*)(V_lds + (b) * SHM_V + vst0) = sr_[i].vs0;          \
    *(bf16x8*)(V_lds + (b) * SHM_V + vst1) = sr_[i].vs1; const int kc = sc * 2;               \
    *(bf16x8*)(K_lds + (b) * SHM_K + sr * ROWB + (kc ^ ((sr & 7) << 4))) = sr_[i].ks0;                       \
    *(bf16x8*)(K_lds + (b) * SHM_K + (32 + sr) * ROWB + (kc ^ ((sr & 7) << 4))) = sr_[i].ks1; \
    if constexpr (DQ == 192) *(bf16x8*)(K_lds + (b) * SHM_K + kr3 * ROWB + ((kc3 * 2) ^ ((kr3 & 7) << 4))) = sr_[i].ks2; } while (0)
#define ATT_SWAIT() do { if constexpr (SDEPTH == 2) { if constexpr (DQ == 192) asm volatile("s_waitcnt vmcnt(5)" ::: "memory"); else asm volatile("s_waitcnt vmcnt(4)" ::: "memory"); } \
    else asm volatile("s_waitcnt vmcnt(0)" ::: "memory"); } while (0)
#define ATT_RESC(a) do { if (__any((a) < 1.f)) { if (hi == 0) al_l[r32] = (a); asm volatile("s_waitcnt lgkmcnt(0)" ::: "memory"); \
    _Pragma("unroll") for (int d = 0; d < 4; ++d) _Pragma("unroll") for (int r = 0; r < 16; ++r) o[d][r] *= al_l[crow(r, hi)]; } } while (0)
#define ATT_MOD(P0, P1, J) do { if constexpr (MODE == 1) natten_mod(P0, P1, kr_lo + (J), nrq, nqc, biasT, hi); } while (0)
  f32x16 pA0, pA1, pB0, pB1; float mnA, mnB, alA, alB; bf16x8 pa0, pa1, pa2, pa3;
  constexpr int SE = 0, SO = SDEPTH - 1;
  ATT_SLOAD(SE, 0); asm volatile("s_waitcnt vmcnt(0)" ::: "memory"); ATT_SWRITE(0, SE); __syncthreads();
  qkt<DQ, NREG>(pA0, pA1, K_lds, qr, qpark, r32, hi); ATT_MOD(pA0, pA1, 0); partialSM<DQ>(pA0, pA1, m_reg, mnA, alA);
  ATT_SLOAD(SO, KVBLK); if constexpr (SDEPTH == 2) { if (2 < NT) ATT_SLOAD(SE, 2 * KVBLK); }
  ATT_SWAIT(); ATT_SWRITE(1, SO); __syncthreads();
  for (int j = 1; j + 1 < NT; j += 2) {
    ATT_SBAR(); qkt<DQ, NREG>(pB0, pB1, K_lds + SHM_K, qr, qpark, r32, hi); ATT_MOD(pB0, pB1, j);
    finishSM(pA0, pA1, alA, l_reg, pa0, pa1, pa2, pa3); ATT_SBAR();
    ATT_SLOAD(SO, (j + SDEPTH) * KVBLK); ATT_SBAR();
    pv_d0(o, vb0, pa0, pa1, pa2, pa3); partialSM<DQ>(pB0, pB1, m_reg, mnB, alB);
    __syncthreads(); ATT_SWAIT(); ATT_SWRITE(0, SE);
    ATT_RESC(alB); __syncthreads();
    ATT_SBAR(); qkt<DQ, NREG>(pA0, pA1, K_lds, qr, qpark, r32, hi); ATT_MOD(pA0, pA1, j + 1);
    finishSM(pB0, pB1, alB, l_reg, pa0, pa1, pa2, pa3); ATT_SBAR();
    if (SDEPTH == 1 || j + 3 < NT) ATT_SLOAD(SE, (j + 1 + SDEPTH) * KVBLK); ATT_SBAR();
    pv_d0(o, vb0 + SHM_V, pa0, pa1, pa2, pa3); partialSM<DQ>(pA0, pA1, m_reg, mnA, alA);
    __syncthreads(); ATT_SWAIT(); ATT_SWRITE(1, SO);
    ATT_RESC(alA); __syncthreads();
  }
  ATT_SBAR(); qkt<DQ, NREG>(pB0, pB1, K_lds + SHM_K, qr, qpark, r32, hi); ATT_MOD(pB0, pB1, NT - 1);
  finishSM(pA0, pA1, alA, l_reg, pa0, pa1, pa2, pa3); ATT_SBAR();
  pv_d0(o, vb0, pa0, pa1, pa2, pa3); partialSM<DQ>(pB0, pB1, m_reg, mnB, alB);
  __syncthreads(); ATT_RESC(alB);
  finishSM(pB0, pB1, alB, l_reg, pa0, pa1, pa2, pa3); ATT_SBAR();
  pv_d0(o, vb0 + SHM_V, pa0, pa1, pa2, pa3);
  if (hi == 0) li_l[r32] = l_reg; asm volatile("s_waitcnt lgkmcnt(0)" ::: "memory");
  float rli[16];
#pragma unroll
  for (int r = 0; r < 16; ++r) rli[r] = __builtin_amdgcn_rcpf(li_l[crow(r, hi)]);
  bf16* Ow = Ob + (long)(wid * QBLK) * LDO;
#pragma unroll
  for (int r = 0; r < 16; ++r) { const int orow = crow(r, hi);
#pragma unroll
    for (int d0 = 0; d0 < 4; d0 += 1) { const unsigned w = cvtpk(o[d0][r] * rli[r], 0.f); Ow[(long)orow * LDO + d0 * 32 + r32] = (bf16)(w & 0xffffu); } }
#undef ATT_LD8
#undef ATT_SLOAD
#undef ATT_SWRITE
#undef ATT_SWAIT
#undef ATT_RESC
#undef ATT_MOD
}
}

#ifndef PH_MASK
#define PH_MASK 0xFFFFFFFFu
#endif
#define PHON(k) (((PH_MASK) >> (k)) & 1u)
#ifndef REP_MASK
#define REP_MASK 0u
#endif
#define REP(k) (((REP_MASK) >> (k)) & 1u)
#ifndef FFN_F8
#define FFN_F8 3
#endif
#ifndef MOE_CVT_IN_ATTN
#define MOE_CVT_IN_ATTN 1
#endif
constexpr bool F8D = (FFN_F8 & 1) != 0, F8M = (FFN_F8 & 2) != 0;
constexpr float SC_H = 4.f, SC_ACT = 8.f, SC_W = 256.f;
constexpr int NWAVES = 8;
constexpr int DM = 2048, BATCH = 4, SEQ = 4096, NTOK = BATCH * SEQ, DEPTH = 2;
constexpr int DIN = 3904, DINP = 4096;
constexpr int DFF = 5632, NE = 8, DFE = 7168;
constexpr int PC_QA = 0, PC_KA = 512, PC_VA = 1024, PC_QB = 1536, PC_KB = 2560, PC_VB = 2816, PC_CQ = 3072, PC_CKV = 3584, PC_KPE = 3840;
constexpr float EPS = 1e-6f;
constexpr int MAXTILES = 136;
constexpr int MAXSLOTS = MAXTILES * 256;

constexpr size_t MiB = 1u << 20;
constexpr size_t WS_CTL = 0, CTL_ZERO_BYTES = 1 * MiB;
constexpr size_t WS_WIN = 1 * MiB;
constexpr size_t WS_WUQ = WS_WIN + 32 * MiB;
constexpr size_t WS_WUKV = WS_WUQ + 2 * MiB;
constexpr size_t WS_WOUT = WS_WUKV + 1 * MiB;
constexpr size_t WS_WGU = WS_WOUT + 16 * MiB;
constexpr size_t WS_WD = WS_WGU + 44 * MiB;
constexpr size_t WS_WEGU = WS_WD + 22 * MiB;
constexpr size_t WS_WED = WS_WEGU + 448 * MiB;
constexpr size_t WS_H = WS_WED + 224 * MiB;
constexpr size_t WS_ACT0 = WS_H + 64 * MiB;
constexpr size_t WS_PROJ = WS_ACT0;
constexpr size_t WS_QA = WS_PROJ + 128 * MiB;
constexpr size_t WS_KA = WS_QA + 16 * MiB;
constexpr size_t WS_QB = WS_KA + 16 * MiB;
constexpr size_t WS_KB = WS_QB + 32 * MiB;
constexpr size_t WS_CQN = WS_KB + 8 * MiB;
constexpr size_t WS_CKVN = WS_CQN + 16 * MiB;
constexpr size_t WS_KPE = WS_CKVN + 8 * MiB;
constexpr size_t WS_QCR = WS_KPE + 2 * MiB;
constexpr size_t WS_KVR = WS_QCR + 24 * MiB;
constexpr size_t WS_QC = WS_KVR + 32 * MiB;
constexpr size_t WS_KC = WS_QC + 24 * MiB;
constexpr size_t WS_O = WS_KC + 24 * MiB;
constexpr size_t WS_ON = WS_O + 64 * MiB;
constexpr size_t WS_ATT_END = WS_ON + 64 * MiB;
constexpr size_t WS_ACT = WS_ACT0;
constexpr size_t WS_HG = WS_ACT0;
constexpr size_t WS_ACTM = WS_HG + 136 * MiB;
constexpr size_t WS_Y = WS_ACTM + 476 * MiB;
constexpr size_t WS_RGATE = WS_Y + 136 * MiB;
constexpr size_t WS_TOKE = WS_RGATE + 1 * MiB;
constexpr size_t WS_TOKP = WS_TOKE + 1 * MiB;
constexpr size_t WS_TOKW = WS_TOKP + 1 * MiB;
constexpr size_t WS_END = WS_TOKW + 1 * MiB;
constexpr size_t WS_DUMMY = WS_END;
static_assert(WS_ATT_END <= WS_END, "map");
constexpr int CW_CNT = 64;
constexpr int CW_BAR = 4096;

constexpr int RING_BYTES = 131072;
constexpr int LDS_BYTES = 163840;
constexpr int MISC_OFF = LDS_BYTES - 256;

#define GAS __attribute__((address_space(1)))
#define LAS __attribute__((address_space(3)))
typedef unsigned short bf16;
typedef unsigned v4u __attribute__((ext_vector_type(4)));
typedef unsigned v2u __attribute__((ext_vector_type(2)));
typedef float f32x4 __attribute__((ext_vector_type(4)));
typedef float f32x2 __attribute__((ext_vector_type(2)));
__device__ __forceinline__ unsigned pk2(float lo, float hi) { unsigned r; asm volatile("v_cvt_pk_bf16_f32 %0, %1, %2" : "=v"(r) : "v"(lo), "v"(hi)); return r; }
__device__ __forceinline__ float bf_lo(unsigned w) { return __uint_as_float(w << 16); }
__device__ __forceinline__ float bf_hi(unsigned w) { return __uint_as_float(w & 0xffff0000u); }
__device__ __forceinline__ float wave_sum(float v) {
#pragma unroll
    for (int o = 1; o < 64; o <<= 1) v += __shfl_xor(v, o);
    return v;
}
__device__ __forceinline__ float rsq(float x) { return __builtin_amdgcn_rsqf(x); }
#define XB_TMO      128
#define XB_XCNT(j)  (256  + 64 * (j))
#define XB_XSUB(j)  (1280 + 64 * (j))
#define XB_XGEN(j)  (2304 + 64 * (j))
#define XB_TOP      3328
#define XB_TOPGEN   3392
#define XCD_BAR_WORDS 3456
#define XB_SPIN_CAP (1u << 18)

__device__ __forceinline__ unsigned xb_ld(unsigned* p)              { return __hip_atomic_load(p, __ATOMIC_RELAXED, __HIP_MEMORY_SCOPE_AGENT); }
__device__ __forceinline__ unsigned xb_add(unsigned* p, unsigned v) { return __hip_atomic_fetch_add(p, v, __ATOMIC_RELAXED, __HIP_MEMORY_SCOPE_AGENT); }
__device__ __forceinline__ unsigned xb_xcc_id() { return (unsigned)__builtin_amdgcn_s_getreg((3 << 11) | 20) & 0xFu; }
#define XB_SPIN(cond, bar) do { unsigned _sp = 0; while (cond) { __builtin_amdgcn_s_sleep(1); \
    if ((++_sp & 255u) == 0u) { if (xb_ld(&(bar)[XB_TMO])) break; if (_sp > XB_SPIN_CAP) { atomicAdd(&(bar)[XB_TMO], 1u); break; } } } } while (0)

struct XcdBarrier {
    unsigned* bar; unsigned x;
    volatile LAS unsigned* st;
};

__device__ __forceinline__ XcdBarrier xcd_barrier_post(unsigned* bar, volatile LAS unsigned* st) {
    XcdBarrier b; b.bar = bar; b.x = xb_xcc_id(); b.st = st;
    if (threadIdx.x == 0) (void)xb_add(&bar[XB_XCNT(b.x)], 1u);
    return b;
}
__device__ __forceinline__ void xcd_barrier_complete(unsigned* bar, unsigned x, unsigned& nloc, unsigned& nx) {
    const unsigned G = gridDim.x * gridDim.y * gridDim.z;
    unsigned sum, cnt, mine, sp = 0u;
    for (;;) {
        sum = 0u; cnt = 0u; mine = 0u;
#pragma unroll
        for (unsigned j = 0; j < 16; ++j) { const unsigned c = xb_ld(&bar[XB_XCNT(j)]); sum += c; cnt += (c > 0u) ? 1u : 0u; mine = (j == x) ? c : mine; }
        if (sum == G) break;
        __builtin_amdgcn_s_sleep(1);
        if ((++sp & 255u) == 0u) { if (xb_ld(&bar[XB_TMO])) break; if (sp > XB_SPIN_CAP) { atomicAdd(&bar[XB_TMO], 1u); break; } }
    }
    nloc = mine > 0u ? mine : 1u; nx = cnt > 0u ? cnt : 1u;
}

__device__ __forceinline__ void xcd_barrier(const XcdBarrier& b) {
    asm volatile("s_waitcnt vmcnt(0)" ::: "memory");
    __syncthreads();
    if (threadIdx.x == 0) {
        unsigned* bar = b.bar;
        __builtin_amdgcn_s_waitcnt(0);
        unsigned nloc = b.st[0], nx = b.st[1];
        if (nloc == 0u) { xcd_barrier_complete(bar, b.x, nloc, nx); b.st[0] = nloc; b.st[1] = nx; }
        const unsigned old = xb_add(&bar[XB_XSUB(b.x)], 1u);
        const unsigned gen = old / nloc;
        if (old + 1u == (gen + 1u) * nloc) {
            __builtin_amdgcn_fence(__ATOMIC_RELEASE, "agent");
            asm volatile("s_waitcnt vmcnt(0)" ::: "memory");
            const unsigned og = xb_add(&bar[XB_TOP], 1u);
            const unsigned tg = og / nx;
            if (og + 1u == (tg + 1u) * nx) xb_add(&bar[XB_TOPGEN], 1u);
            else XB_SPIN(xb_ld(&bar[XB_TOPGEN]) == tg, bar);
            __builtin_amdgcn_fence(__ATOMIC_ACQUIRE, "agent");
            xb_add(&bar[XB_XGEN(b.x)], 1u);
            asm volatile("s_waitcnt vmcnt(0)" ::: "memory");
        } else {
            XB_SPIN(xb_ld(&bar[XB_XGEN(b.x)]) == gen, bar);
            __builtin_amdgcn_fence(__ATOMIC_ACQUIRE, "agent");
            asm volatile("s_waitcnt vmcnt(0)" ::: "memory");
        }
    }
    __syncthreads();
}

struct Args { const float* in[26]; float* out; unsigned char* ws; int ph_lo, ph_hi; };
enum { I_X = 0, I_MIXN, I_WIN, I_RPB, I_QNA, I_KNA, I_QNB, I_KNB, I_CQN, I_CKVN, I_WUQ, I_WUKV, I_QNC, I_KNC, I_ONA, I_ONB, I_ONC, I_WOUT, I_FFNN, I_WG, I_WU, I_WDN, I_ROUTER, I_WEG, I_WEU, I_WED };
struct Frame {
    LAS unsigned char* lds; unsigned char* ws; unsigned* ctl;
    int wave, G, bid, gw, ngw;
};

__device__ __forceinline__ void transpose_item(const float* __restrict__ W, int K, int N, bf16* __restrict__ WT, int row_off, int mode, LAS float* scr, int item, int lane) {
    (void)scr;
    const int nblk = N >> 5, kb = item / nblk, nb = item - kb * nblk, k0 = kb << 6, n0 = nb << 5; const int c = lane >> 3, q = lane & 7;
    const float* p = W + (size_t)(k0 + 8 * c) * N + n0 + 4 * q;
    f32x4 v[8];
#pragma unroll
    for (int i = 0; i < 8; ++i) v[i] = *(const f32x4*)(p + (size_t)i * N);
    const int drow0 = (mode == 0) ? (row_off + n0) : (row_off + (n0 >> 7) * 256 + (mode - 1) * 128 + (n0 & 127));
    bf16* d = WT + (size_t)(drow0 + 4 * q) * K + k0 + 8 * c;
#pragma unroll
    for (int j = 0; j < 4; ++j) { v4u o; o.x = pk2(v[0][j], v[1][j]); o.y = pk2(v[2][j], v[3][j]); o.z = pk2(v[4][j], v[5][j]); o.w = pk2(v[6][j], v[7][j]); *(v4u*)(d + (size_t)j * K) = o; }
}

__device__ __forceinline__ unsigned pk4_fp8(float a, float b, float c, float d) { unsigned w = 0u; w = __builtin_amdgcn_cvt_pk_fp8_f32(a, b, w, false); w = __builtin_amdgcn_cvt_pk_fp8_f32(c, d, w, true); return w; }
__device__ __forceinline__ void transpose_item_f8(const float* __restrict__ W, int K, int N, unsigned char* __restrict__ WT, int row_off, int mode, float wsc, LAS float* scr, int item, int lane) {
    (void)scr;
    const int nblk = N >> 5, kb = item / nblk, nb = item - kb * nblk, k0 = kb << 7, n0 = nb << 5; const int c = lane >> 3, q = lane & 7;
    const float* p = W + (size_t)(k0 + 16 * c) * N + n0 + 4 * q;
    f32x4 v[16];
#pragma unroll
    for (int i = 0; i < 16; ++i) v[i] = *(const f32x4*)(p + (size_t)i * N);
    const int drow0 = (mode == 0) ? (row_off + n0) : (row_off + (n0 >> 7) * 256 + (mode - 1) * 128 + (n0 & 127));
    unsigned char* d = WT + (size_t)(drow0 + 4 * q) * K + k0 + 16 * c;
#pragma unroll
    for (int j = 0; j < 4; ++j) {
        v4u o; o.x = pk4_fp8(v[0][j] * wsc, v[1][j] * wsc, v[2][j] * wsc, v[3][j] * wsc); o.y = pk4_fp8(v[4][j] * wsc, v[5][j] * wsc, v[6][j] * wsc, v[7][j] * wsc);
        o.z = pk4_fp8(v[8][j] * wsc, v[9][j] * wsc, v[10][j] * wsc, v[11][j] * wsc); o.w = pk4_fp8(v[12][j] * wsc, v[13][j] * wsc, v[14][j] * wsc, v[15][j] * wsc);
        *(v4u*)(d + (size_t)j * K) = o; }
}

template <bool F8OUT>
__device__ __forceinline__ void phase_rmsnorm(const Frame& F, const float* __restrict__ src, const float* __restrict__ gain, void* __restrict__ dstv, float osc) {
    int tid_ = threadIdx.x; asm volatile("" : "+v"(tid_)); const int tid = tid_, lane = tid & 63; (void)tid; (void)lane;
    f32x4 g[8];
#pragma unroll
    for (int j = 0; j < 8; ++j) g[j] = ((const f32x4*)gain)[64 * j + lane] * osc;
    for (int m = F.gw; m < NTOK; m += F.ngw) {
        const f32x4* xr = (const f32x4*)(src + (size_t)m * DM) + lane; f32x4 v[8]; float s = 0.f;
#pragma unroll
        for (int j = 0; j < 8; ++j) { v[j] = xr[64 * j]; s += (v[j][0] * v[j][0] + v[j][1] * v[j][1]) + (v[j][2] * v[j][2] + v[j][3] * v[j][3]); }
        const float rstd = rsq(wave_sum(s) * (1.f / DM) + EPS);
        if constexpr (F8OUT) { unsigned* o4 = (unsigned*)((unsigned char*)dstv + (size_t)m * DM) + lane;
#pragma unroll
            for (int j = 0; j < 8; ++j) o4[64 * j] = pk4_fp8(v[j][0] * rstd * g[j][0], v[j][1] * rstd * g[j][1], v[j][2] * rstd * g[j][2], v[j][3] * rstd * g[j][3]);
        } else { v2u* o8 = (v2u*)((bf16*)dstv + (size_t)m * DM) + lane;
#pragma unroll
            for (int j = 0; j < 8; ++j) { v2u w; w.x = pk2(v[j][0] * rstd * g[j][0], v[j][1] * rstd * g[j][1]); w.y = pk2(v[j][2] * rstd * g[j][2], v[j][3] * rstd * g[j][3]); o8[64 * j] = w; } }
    }
}

__device__ __forceinline__ float rope_apply(float v, float c, float s, float sgn) { const float p = __shfl_xor(v, 16); return v * c + sgn * p * s; }
__device__ __forceinline__ void sincos_rev(float ang, float& s, float& c) { const float r = ang * 0.15915494309189535f; const float f = r - floorf(r); s = __builtin_amdgcn_sinf(f); c = __builtin_amdgcn_cosf(f); }

__device__ __forceinline__ void phase_postproj(const Frame& F, const Args& a, int l) {
    int tid_ = threadIdx.x; asm volatile("" : "+v"(tid_)); const int tid = tid_, lane = tid & 63; (void)tid; (void)lane;
    const bf16* PROJ = (const bf16*)(F.ws + WS_PROJ);
    bf16* QA = (bf16*)(F.ws + WS_QA); bf16* KA = (bf16*)(F.ws + WS_KA); bf16* QB = (bf16*)(F.ws + WS_QB); bf16* KB = (bf16*)(F.ws + WS_KB);
    bf16* CQN = (bf16*)(F.ws + WS_CQN); bf16* CKVN = (bf16*)(F.ws + WS_CKVN); bf16* KPE = (bf16*)(F.ws + WS_KPE);
    const f32x2 gqa = ((const f32x2*)(a.in[I_QNA] + l * 128))[lane], gka = ((const f32x2*)(a.in[I_KNA] + l * 128))[lane];
    const f32x2 gqb = ((const f32x2*)(a.in[I_QNB] + l * 128))[lane], gkb = ((const f32x2*)(a.in[I_KNB] + l * 128))[lane];
    const f32x4 gcq0 = ((const f32x4*)(a.in[I_CQN] + l * 512))[2 * lane], gcq1 = ((const f32x4*)(a.in[I_CQN] + l * 512))[2 * lane + 1];
    const f32x4 gckv = ((const f32x4*)(a.in[I_CKVN] + l * 256))[lane];
    const float gkpe = a.in[I_KNC][l * 192 + 128 + lane];
    constexpr float LOG2T = 13.287712379549449f;
    const int q = lane & 15;
    const float f128a = __builtin_amdgcn_exp2f(-(float)(2 * q) * (LOG2T / 32.f)), f128b = __builtin_amdgcn_exp2f(-(float)(2 * q + 1) * (LOG2T / 32.f));
    const float f64 = __builtin_amdgcn_exp2f(-(float)q * (LOG2T / 16.f));
    const float sgn = (lane & 16) ? 1.f : -1.f;
    for (int t = F.gw; t < NTOK; t += F.ngw) {
        const int pos = t & (SEQ - 1); const float p = (float)((lane & 32) ? (pos & 63) : (pos >> 6));
        float s0, c0, s1, c1, s2, c2; sincos_rev(p * f128a, s0, c0); sincos_rev(p * f128b, s1, c1); sincos_rev(p * f64, s2, c2);
        const bf16* pr = PROJ + (size_t)t * DINP;
        unsigned hv[18];
#pragma unroll
        for (int i = 0; i < 8; ++i) hv[i] = ((const unsigned*)(pr + i * 128))[lane];
#pragma unroll
        for (int i = 8; i < 18; ++i) hv[i] = ((const unsigned*)(pr + PC_QB + (i - 8) * 128))[lane];
        const v4u cqv = ((const v4u*)(pr + PC_CQ))[lane]; const v2u ckvv = ((const v2u*)(pr + PC_CKV))[lane]; const unsigned kpev = (unsigned)pr[PC_KPE + lane];
#pragma unroll
        for (int i = 0; i < 18; ++i) {
            float v0 = bf_lo(hv[i]), v1 = bf_hi(hv[i]);
            const float rstd = rsq(wave_sum(v0 * v0 + v1 * v1) * (1.f / 128.f) + EPS);
            const f32x2 g = (i < 4) ? gqa : (i < 8) ? gka : (i < 16) ? gqb : gkb;
            v0 = v0 * rstd * g[0]; v1 = v1 * rstd * g[1];
            if (i >= 8) { v0 = rope_apply(v0, c0, s0, sgn); v1 = rope_apply(v1, c1, s1, sgn); }
            bf16* dst = (i < 4) ? (QA + (size_t)t * 512 + i * 128) : (i < 8) ? (KA + (size_t)t * 512 + (i - 4) * 128) : (i < 16) ? (QB + (size_t)t * 1024 + (i - 8) * 128) : (KB + (size_t)t * 256 + (i - 16) * 128);
            ((unsigned*)dst)[lane] = pk2(v0, v1);
        }
        {
            float x[8] = {bf_lo(cqv.x), bf_hi(cqv.x), bf_lo(cqv.y), bf_hi(cqv.y), bf_lo(cqv.z), bf_hi(cqv.z), bf_lo(cqv.w), bf_hi(cqv.w)}; float s = 0.f;
#pragma unroll
            for (int i = 0; i < 8; ++i) s += x[i] * x[i];
            const float rstd = rsq(wave_sum(s) * (1.f / 512.f) + EPS);
            v4u w; w.x = pk2(x[0] * rstd * gcq0[0], x[1] * rstd * gcq0[1]); w.y = pk2(x[2] * rstd * gcq0[2], x[3] * rstd * gcq0[3]);
            w.z = pk2(x[4] * rstd * gcq1[0], x[5] * rstd * gcq1[1]); w.w = pk2(x[6] * rstd * gcq1[2], x[7] * rstd * gcq1[3]);
            ((v4u*)(CQN + (size_t)t * 512))[lane] = w;
        }
        {
            const float x0 = bf_lo(ckvv.x), x1 = bf_hi(ckvv.x), x2 = bf_lo(ckvv.y), x3 = bf_hi(ckvv.y);
            const float rstd = rsq(wave_sum((x0 * x0 + x1 * x1) + (x2 * x2 + x3 * x3)) * (1.f / 256.f) + EPS);
            v2u w; w.x = pk2(x0 * rstd * gckv[0], x1 * rstd * gckv[1]); w.y = pk2(x2 * rstd * gckv[2], x3 * rstd * gckv[3]);
            ((v2u*)(CKVN + (size_t)t * 256))[lane] = w;
        }
        {
            float x = bf_lo(kpev);
            const float rstd = rsq(wave_sum(x * x) * (1.f / 64.f) + EPS);
            x = rope_apply(x * rstd * gkpe, c2, s2, sgn);
            KPE[(size_t)t * 64 + lane] = (bf16)(pk2(x, 0.f) & 0xffffu);
        }
    }
}

__device__ __forceinline__ void phase_postmla(const Frame& F, const Args& a, int l) {
    int tid_ = threadIdx.x; asm volatile("" : "+v"(tid_)); const int tid = tid_, lane = tid & 63; (void)tid; (void)lane;
    const bf16* QCR = (const bf16*)(F.ws + WS_QCR); const bf16* KVR = (const bf16*)(F.ws + WS_KVR); const bf16* KPE = (const bf16*)(F.ws + WS_KPE);
    bf16* QC = (bf16*)(F.ws + WS_QC); bf16* KC = (bf16*)(F.ws + WS_KC);
    const f32x2 gqn = ((const f32x2*)(a.in[I_QNC] + l * 192))[lane], gkn = ((const f32x2*)(a.in[I_KNC] + l * 192))[lane];
    const float gqpe = a.in[I_QNC][l * 192 + 128 + lane];
    constexpr float LOG2T = 13.287712379549449f;
    const float f64 = __builtin_amdgcn_exp2f(-(float)(lane & 15) * (LOG2T / 16.f));
    const float sgn = (lane & 16) ? 1.f : -1.f;
    for (int t = F.gw; t < NTOK; t += F.ngw) {
        const int pos = t & (SEQ - 1); const float p = (float)((lane & 32) ? (pos & 63) : (pos >> 6));
        float s2, c2; sincos_rev(p * f64, s2, c2);
        const bf16* qr = QCR + (size_t)t * 768; const bf16* kr = KVR + (size_t)t * 1024;
        unsigned qn[4], kn[4]; unsigned qp[4];
#pragma unroll
        for (int h = 0; h < 4; ++h) { qn[h] = ((const unsigned*)(qr + h * 192))[lane]; qp[h] = (unsigned)qr[h * 192 + 128 + lane]; kn[h] = ((const unsigned*)(kr + h * 256))[lane]; }
        const bf16 kpe = KPE[(size_t)t * 64 + lane];
#pragma unroll
        for (int h = 0; h < 4; ++h) {
            { float v0 = bf_lo(qn[h]), v1 = bf_hi(qn[h]); const float rstd = rsq(wave_sum(v0 * v0 + v1 * v1) * (1.f / 128.f) + EPS);
              ((unsigned*)(QC + (size_t)t * 768 + h * 192))[lane] = pk2(v0 * rstd * gqn[0], v1 * rstd * gqn[1]); }
            { float x = bf_lo(qp[h]); const float rstd = rsq(wave_sum(x * x) * (1.f / 64.f) + EPS); x = rope_apply(x * rstd * gqpe, c2, s2, sgn);
              QC[(size_t)t * 768 + h * 192 + 128 + lane] = (bf16)(pk2(x, 0.f) & 0xffffu); }
            { float v0 = bf_lo(kn[h]), v1 = bf_hi(kn[h]); const float rstd = rsq(wave_sum(v0 * v0 + v1 * v1) * (1.f / 128.f) + EPS);
              ((unsigned*)(KC + (size_t)t * 768 + h * 192))[lane] = pk2(v0 * rstd * gkn[0], v1 * rstd * gkn[1]); }
            KC[(size_t)t * 768 + h * 192 + 128 + lane] = kpe;
        }
    }
}

__device__ __forceinline__ void phase_groupnorm(const Frame& F, const Args& a, int l) {
    int tid_ = threadIdx.x; asm volatile("" : "+v"(tid_)); const int tid = tid_, lane = tid & 63; (void)tid; (void)lane;
    const bf16* O = (const bf16*)(F.ws + WS_O); bf16* ON = (bf16*)(F.ws + WS_ON);
    f32x4 g[4][2];
    { const f32x4* ga = (const f32x4*)(a.in[I_ONA] + l * 512); const f32x4* gb = (const f32x4*)(a.in[I_ONB] + l * 1024); const f32x4* gc = (const f32x4*)(a.in[I_ONC] + l * 512);
      g[0][0] = ga[2 * lane]; g[0][1] = ga[2 * lane + 1]; g[1][0] = gb[2 * lane]; g[1][1] = gb[2 * lane + 1]; g[2][0] = gb[128 + 2 * lane]; g[2][1] = gb[128 + 2 * lane + 1]; g[3][0] = gc[2 * lane]; g[3][1] = gc[2 * lane + 1]; }
    for (int t = F.gw; t < NTOK; t += F.ngw) {
        const v4u* orow = (const v4u*)(O + (size_t)t * DM) + lane; float x[4][8]; float ss[4];
#pragma unroll
        for (int j = 0; j < 4; ++j) { const v4u w = orow[64 * j]; x[j][0] = bf_lo(w.x); x[j][1] = bf_hi(w.x); x[j][2] = bf_lo(w.y); x[j][3] = bf_hi(w.y); x[j][4] = bf_lo(w.z); x[j][5] = bf_hi(w.z); x[j][6] = bf_lo(w.w); x[j][7] = bf_hi(w.w);
            float s = 0.f;
#pragma unroll
            for (int i = 0; i < 8; ++i) s += x[j][i] * x[j][i];
            ss[j] = s; }
        const float ra = rsq(wave_sum(ss[0]) * (1.f / 512.f) + EPS), rb = rsq(wave_sum(ss[1] + ss[2]) * (1.f / 1024.f) + EPS), rc = rsq(wave_sum(ss[3]) * (1.f / 512.f) + EPS);
        v4u* nrow = (v4u*)(ON + (size_t)t * DM) + lane;
#pragma unroll
        for (int j = 0; j < 4; ++j) { const float r = (j == 0) ? ra : (j == 3) ? rc : rb; v4u w;
            w.x = pk2(x[j][0] * r * g[j][0][0], x[j][1] * r * g[j][0][1]); w.y = pk2(x[j][2] * r * g[j][0][2], x[j][3] * r * g[j][0][3]);
            w.z = pk2(x[j][4] * r * g[j][1][0], x[j][5] * r * g[j][1][1]); w.w = pk2(x[j][6] * r * g[j][1][2], x[j][7] * r * g[j][1][3]); nrow[64 * j] = w; }
    }
}

constexpr int ROUTER_LDS = 0;
constexpr int MOE_LDS_CNT = 65536;
constexpr int MOE_LDS_REC = 65536 + 64;
template <bool F8OUT>
__device__ __forceinline__ void phase_ffnnorm_route(const Frame& F, const Args& a, const float* __restrict__ src, const float* __restrict__ gain, void* __restrict__ dstv, float osc) {
    int tid_ = threadIdx.x; asm volatile("" : "+v"(tid_)); const int tid = tid_, lane = tid & 63; (void)tid; (void)lane;
    LAS float* rt = (LAS float*)(F.lds + ROUTER_LDS); LAS unsigned* lcnt = (LAS unsigned*)(F.lds + MOE_LDS_CNT); LAS int* rec = (LAS int*)(F.lds + MOE_LDS_REC);
    const float* router = a.in[I_ROUTER];
    for (int i = tid; i < DM * NE / 4; i += NWAVES * 64) ((LAS f32x4*)rt)[i] = ((const f32x4*)router)[i];
    if (tid < 16) lcnt[tid] = 0u;
    __syncthreads();
    const int t0 = (int)(((long)F.bid * NTOK) / F.G), t1 = (int)(((long)(F.bid + 1) * NTOK) / F.G);
    f32x4 g[8];
#pragma unroll
    for (int j = 0; j < 8; ++j) g[j] = ((const f32x4*)gain)[64 * j + lane];
    for (int m = t0 + F.wave; m < t1; m += NWAVES) {
        const f32x4* xr = (const f32x4*)(src + (size_t)m * DM) + lane; f32x4 v[8]; float s = 0.f;
#pragma unroll
        for (int j = 0; j < 8; ++j) { v[j] = xr[64 * j]; s += (v[j][0] * v[j][0] + v[j][1] * v[j][1]) + (v[j][2] * v[j][2] + v[j][3] * v[j][3]); }
        const float rstd = rsq(wave_sum(s) * (1.f / DM) + EPS);
        v2u* o8 = (v2u*)((bf16*)dstv + (size_t)m * DM) + lane; unsigned* o4 = (unsigned*)((unsigned char*)dstv + (size_t)m * DM) + lane;
        float lg[8] = {0.f, 0.f, 0.f, 0.f, 0.f, 0.f, 0.f, 0.f};
#pragma unroll
        for (int j = 0; j < 8; ++j) {
            f32x4 h; h[0] = v[j][0] * rstd * g[j][0]; h[1] = v[j][1] * rstd * g[j][1]; h[2] = v[j][2] * rstd * g[j][2]; h[3] = v[j][3] * rstd * g[j][3];
            if constexpr (F8OUT) o4[64 * j] = pk4_fp8(h[0] * osc, h[1] * osc, h[2] * osc, h[3] * osc); else { v2u w; w.x = pk2(h[0], h[1]); w.y = pk2(h[2], h[3]); o8[64 * j] = w; }
            const int k0 = 256 * j + 4 * lane;
#pragma unroll
            for (int i = 0; i < 4; ++i) { const f32x4 r0 = ((const LAS f32x4*)(rt + (k0 + i) * 8))[0], r1 = ((const LAS f32x4*)(rt + (k0 + i) * 8))[1];
                lg[0] += h[i] * r0[0]; lg[1] += h[i] * r0[1]; lg[2] += h[i] * r0[2]; lg[3] += h[i] * r0[3]; lg[4] += h[i] * r1[0]; lg[5] += h[i] * r1[1]; lg[6] += h[i] * r1[2]; lg[7] += h[i] * r1[3]; }
        }
#pragma unroll
        for (int e = 0; e < 8; ++e) lg[e] = wave_sum(lg[e]);
        int e0 = 0; float v0 = lg[0];
#pragma unroll
        for (int e = 1; e < 8; ++e) if (lg[e] > v0) { v0 = lg[e]; e0 = e; }
        int e1 = -1; float v1 = -3.0e38f;
#pragma unroll
        for (int e = 0; e < 8; ++e) if (e != e0 && lg[e] > v1) { v1 = lg[e]; e1 = e; }
        const float ex = __expf(v1 - v0), w0 = 1.f / (1.f + ex), w1 = ex * w0;
        if (lane == 0) { const int li = m - t0; const unsigned p0 = atomicAdd((unsigned*)&lcnt[e0], 1u), p1 = atomicAdd((unsigned*)&lcnt[e1], 1u);
            rec[li * 6 + 0] = e0; rec[li * 6 + 1] = e1; rec[li * 6 + 2] = (int)p0; rec[li * 6 + 3] = (int)p1; ((LAS float*)rec)[li * 6 + 4] = w0; ((LAS float*)rec)[li * 6 + 5] = w1; }
    }
    __syncthreads();
    if (tid < 8) lcnt[8 + tid] = __hip_atomic_fetch_add(F.ctl + CW_CNT + tid, lcnt[tid], __ATOMIC_RELAXED, __HIP_MEMORY_SCOPE_AGENT);
    __syncthreads();
    int* toke = (int*)(F.ws + WS_TOKE); int* tokp = (int*)(F.ws + WS_TOKP); float* tokw = (float*)(F.ws + WS_TOKW);
    for (int i = tid; i < (t1 - t0) * 2; i += NWAVES * 64) { const int li = i >> 1, k = i & 1, e = rec[li * 6 + k];
        toke[(size_t)(t0 + li) * 2 + k] = e; tokp[(size_t)(t0 + li) * 2 + k] = rec[li * 6 + 2 + k] + (int)lcnt[8 + e]; tokw[(size_t)(t0 + li) * 2 + k] = ((LAS float*)rec)[li * 6 + 4 + k]; }
    __syncthreads();
}
__device__ __forceinline__ void moe_tiles(const Frame& F, int (&tb)[9], int (&cnt)[8]) {
    int acc = 0;
#pragma unroll
    for (int e = 0; e < 8; ++e) { cnt[e] = (int)__hip_atomic_load(F.ctl + CW_CNT + e, __ATOMIC_RELAXED, __HIP_MEMORY_SCOPE_AGENT); tb[e] = acc; acc += (cnt[e] + 255) >> 8; }
    tb[8] = acc;
}
template <bool F8ROWS>
__device__ __forceinline__ void phase_gather(const Frame& F) {
    int tid_ = threadIdx.x; asm volatile("" : "+v"(tid_)); const int tid = tid_, lane = tid & 63; (void)tid; (void)lane;
    int tb[9], cnt[8]; moe_tiles(F, tb, cnt);
    constexpr int RBYTES = F8ROWS ? DM : 2 * DM, NCH = RBYTES / 1024;
    const unsigned char* H = (const unsigned char*)(F.ws + WS_H); unsigned char* HG = (unsigned char*)(F.ws + WS_HG); float* rg = (float*)(F.ws + WS_RGATE);
    const int* toke = (const int*)(F.ws + WS_TOKE); int* tokp = (int*)(F.ws + WS_TOKP); const float* tokw = (const float*)(F.ws + WS_TOKW);
    for (int t = F.gw; t < NTOK; t += F.ngw) {
        const v4u* hr = (const v4u*)(H + (size_t)t * RBYTES) + lane; v4u v[NCH];
#pragma unroll
        for (int j = 0; j < NCH; ++j) v[j] = hr[64 * j];
#pragma unroll
        for (int k = 0; k < 2; ++k) { const int e = toke[(size_t)t * 2 + k], p = tokp[(size_t)t * 2 + k]; int base = 0;
#pragma unroll
            for (int q = 0; q < 8; ++q) base = (q == e) ? tb[q] : base;
            const int slot = base * 256 + p; v4u* dr = (v4u*)(HG + (size_t)slot * RBYTES) + lane;
#pragma unroll
            for (int j = 0; j < NCH; ++j) dr[64 * j] = v[j];
            if (lane == 0) { rg[slot] = tokw[(size_t)t * 2 + k]; tokp[(size_t)t * 2 + k] = slot; } }
    }
#pragma unroll
    for (int e = 0; e < 8; ++e) { const int r0 = tb[e] * 256 + cnt[e], r1 = tb[e + 1] * 256;
        for (int r = r0 + F.gw; r < r1; r += F.ngw) { v4u* dr = (v4u*)(HG + (size_t)r * RBYTES) + lane; const v4u z = {0u, 0u, 0u, 0u};
#pragma unroll
            for (int j = 0; j < NCH; ++j) dr[64 * j] = z;
            if (lane == 0) rg[r] = 0.f; } }
}
__device__ __forceinline__ void phase_combine(const Frame& F, float* __restrict__ out) {
    int tid_ = threadIdx.x; asm volatile("" : "+v"(tid_)); const int tid = tid_, lane = tid & 63; (void)tid; (void)lane;
    const bf16* Y = (const bf16*)(F.ws + WS_Y); const int* tokp = (const int*)(F.ws + WS_TOKP);
    for (int t = F.gw; t < NTOK; t += F.ngw) {
        const int s0 = tokp[(size_t)t * 2], s1 = tokp[(size_t)t * 2 + 1];
        const v4u* y0 = (const v4u*)(Y + (size_t)s0 * DM) + lane; const v4u* y1 = (const v4u*)(Y + (size_t)s1 * DM) + lane;
        f32x4* xr = (f32x4*)(out + (size_t)t * DM) + 2 * lane;
#pragma unroll
        for (int j = 0; j < 4; ++j) { const v4u p = y0[64 * j], q = y1[64 * j]; f32x4 xa = xr[128 * j], xb = xr[128 * j + 1];
            xa[0] += bf_lo(p.x) + bf_lo(q.x); xa[1] += bf_hi(p.x) + bf_hi(q.x); xa[2] += bf_lo(p.y) + bf_lo(q.y); xa[3] += bf_hi(p.y) + bf_hi(q.y);
            xb[0] += bf_lo(p.z) + bf_lo(q.z); xb[1] += bf_hi(p.z) + bf_hi(q.z); xb[2] += bf_lo(p.w) + bf_lo(q.w); xb[3] += bf_hi(p.w) + bf_hi(q.w);
            xr[128 * j] = xa; xr[128 * j + 1] = xb; }
    }
}

__device__ __forceinline__ void convert_experts(const Frame& F, const Args& args, int e_lo, int e_hi, int w, int nw);
__device__ __forceinline__ void phase_attention(const Frame& F, const Args& a, int l) {
    int tid_ = threadIdx.x; asm volatile("" : "+v"(tid_)); const int tid = tid_, lane = tid & 63; (void)tid; (void)lane;
    const bf16* PROJ = (const bf16*)(F.ws + WS_PROJ);
    const bf16* QA = (const bf16*)(F.ws + WS_QA); const bf16* KA = (const bf16*)(F.ws + WS_KA); const bf16* QB = (const bf16*)(F.ws + WS_QB); const bf16* KB = (const bf16*)(F.ws + WS_KB);
    const bf16* KVR = (const bf16*)(F.ws + WS_KVR); const bf16* QC = (const bf16*)(F.ws + WS_QC); const bf16* KC = (const bf16*)(F.ws + WS_KC);
    bf16* O = (bf16*)(F.ws + WS_O);
    char* L = (char*)F.lds;
    const int cslot = MOE_CVT_IN_ATTN ? ((F.bid >> 3) & 3) : -1; bool cvt_done = !MOE_CVT_IN_ATTN;
#define ATT_CVT() do { __syncthreads(); convert_experts(F, a, 4 * l, 4 * l + 4, F.gw, F.ngw); __syncthreads(); cvt_done = true; } while (0)
    if (cslot == 0) ATT_CVT();
    if (PHON(16)) for (int Lu = F.bid; Lu < 256; Lu += F.G) {
        const int id = (Lu & 7) * 32 + (Lu >> 3), b = id >> 6, h = (id >> 4) & 3, qb = id & 15; const size_t tq = (size_t)b * SEQ + qb * 256, tk = (size_t)b * SEQ;
        att::attn_body<192, 768, 768, 1024, 2048, 0, 1, 8>(QC + tq * 768 + h * 192, KC + tk * 768 + h * 192, KVR + tk * 1024 + h * 256 + 128, O + tq * DM + 1536 + h * 128, SEQ / 64, L, 0, 0, nullptr);
    }
    if (cslot == 1) ATT_CVT();
    if (PHON(17)) for (int Lu = F.bid; Lu < 512; Lu += F.G) {
        if (cslot == 2 && !cvt_done && Lu != F.bid) ATT_CVT();
        const int id = (Lu & 7) * 64 + (Lu >> 3), b = id >> 7, kvh = (id >> 6) & 1, g = (id >> 4) & 3, qb = id & 15, h = kvh * 4 + g; const size_t tq = (size_t)b * SEQ + qb * 256, tk = (size_t)b * SEQ;
        att::attn_body<128, 1024, 256, 4096, 2048, 0, 2, 8>(QB + tq * 1024 + h * 128, KB + tk * 256 + kvh * 128, PROJ + tk * DINP + PC_VB + kvh * 128, O + tq * DM + 512 + h * 128, SEQ / 64, L, 0, 0, nullptr);
    }
    float* biasT = (float*)(L + 136 * 1024);
    if (!cvt_done && cslot == 3) ATT_CVT();
    if (PHON(18)) for (int Lu = F.bid; Lu < 256; Lu += F.G) {
        const int id = (Lu & 7) * 32 + (Lu >> 3), b = id >> 6, h = (id >> 4) & 3, rb = id & 15; const size_t tq = (size_t)b * SEQ + rb * 256;
        int lo = min(max(rb * 4 - 4, 0), 56), hi = min(max(rb * 4 + 3 - 4, 0), 56) + 8;
        if ((hi - lo) & 1) { if (hi < 64) ++hi; else --lo; }
        __syncthreads();
        const float* rpb = a.in[I_RPB] + ((size_t)l * 4 + h) * 465;
        for (int i = tid; i < 15 * 128; i += NWAVES * 64) { const int bi = i >> 7, bj = (i & 127) - 48; biasT[i] = (bj >= 0 && bj < 31) ? rpb[bi * 31 + bj] * 11.313708498984761f : 0.f; }
        __syncthreads();
        const size_t tk = (size_t)b * SEQ + lo * 64;
        att::attn_body<128, 512, 512, 4096, 2048, 1, 1, 4>(QA + tq * 512 + h * 128, KA + tk * 512 + h * 128, PROJ + tk * DINP + PC_VA + h * 128, O + tq * DM + h * 128, hi - lo, L, rb * 4, lo, biasT);
    }
    if (!cvt_done) ATT_CVT();
#undef ATT_CVT
}

constexpr int NPHASE = 24;

__device__ __forceinline__ void tr8_decode(const Args& args, unsigned char* ws, int e_lo, int gi, const float*& W, unsigned char*& WT, int& K, int& N, int& mode, int& item) {
    const int m = gi / 3584; item = gi - m * 3584; const int e = e_lo + m / 3, kind = m - (m / 3) * 3;
    if (kind == 2) { W = args.in[I_WED] + (size_t)e * DFE * DM; WT = ws + WS_WED + (size_t)e * DM * DFE; K = DFE; N = DM; mode = 0; }
    else { W = (kind == 0 ? args.in[I_WEG] : args.in[I_WEU]) + (size_t)e * DM * DFE; WT = ws + WS_WEGU + (size_t)e * 2 * DFE * DM; K = DM; N = DFE; mode = 1 + kind; }
}
__device__ __forceinline__ void tr8_load(const float* __restrict__ W, int N, int item, int lane, f32x4 (&v)[16]) {
    const int nblk = N >> 5, kb = item / nblk, nb = item - kb * nblk, k0 = kb << 7, n0 = nb << 5; const int c = lane >> 3, q = lane & 7;
    const float* p = W + (size_t)(k0 + 16 * c) * N + n0 + 4 * q;
#pragma unroll
    for (int i = 0; i < 16; ++i) v[i] = __builtin_nontemporal_load((const f32x4*)(p + (size_t)i * N));
}
__device__ __forceinline__ void tr8_store(unsigned char* __restrict__ WT, int K, int N, int mode, int item, int lane, float wsc, LAS float* scr, const f32x4 (&v)[16]) {
    (void)scr;
    const int nblk = N >> 5, kb = item / nblk, nb = item - kb * nblk, k0 = kb << 7, n0 = nb << 5; const int c = lane >> 3, q = lane & 7;
    const int drow0 = (mode == 0) ? n0 : ((n0 >> 7) * 256 + (mode - 1) * 128 + (n0 & 127));
    unsigned char* p = WT + (size_t)(drow0 + 4 * q) * K + k0 + 16 * c;
#pragma unroll
    for (int j = 0; j < 4; ++j) {
        v4u o; o.x = pk4_fp8(v[0][j] * wsc, v[1][j] * wsc, v[2][j] * wsc, v[3][j] * wsc); o.y = pk4_fp8(v[4][j] * wsc, v[5][j] * wsc, v[6][j] * wsc, v[7][j] * wsc);
        o.z = pk4_fp8(v[8][j] * wsc, v[9][j] * wsc, v[10][j] * wsc, v[11][j] * wsc); o.w = pk4_fp8(v[12][j] * wsc, v[13][j] * wsc, v[14][j] * wsc, v[15][j] * wsc);
        *(v4u*)(p + (size_t)j * K) = o; }
}
__device__ __forceinline__ void convert_experts(const Frame& F, const Args& args, int e_lo, int e_hi, int w, int nw) {
    int tid_ = threadIdx.x; asm volatile("" : "+v"(tid_)); const int lane = tid_ & 63;
    LAS float* scr = (LAS float*)(F.lds + F.wave * 18432);
    if constexpr (F8M) {
        const int total = (e_hi - e_lo) * 3 * 3584;
        f32x4 va[16], vb[16], vc[16]; const float* W; unsigned char* WT; int K, N, mode, item;
#define TR8_LD(buf, gx) do { if ((gx) < total) { tr8_decode(args, F.ws, e_lo, (gx), W, WT, K, N, mode, item); tr8_load(W, N, item, lane, buf); } } while (0)
#define TR8_ST(buf, gx) do { tr8_decode(args, F.ws, e_lo, (gx), W, WT, K, N, mode, item); tr8_store(WT, K, N, mode, item, lane, SC_W, scr, buf); } while (0)
        int gi = w;
        TR8_LD(va, gi); TR8_LD(vb, gi + nw);
        while (gi < total) {
            TR8_LD(vc, gi + 2 * nw); TR8_ST(va, gi); gi += nw; if (gi >= total) break;
            TR8_LD(va, gi + 2 * nw); TR8_ST(vb, gi); gi += nw; if (gi >= total) break;
            TR8_LD(vb, gi + 2 * nw); TR8_ST(vc, gi); gi += nw;
        }
#undef TR8_LD
#undef TR8_ST
    } else {
        int it = w;
#define TR_RUNB(Wp, Kk, Nn, Dp, ROFF, MODE) do { const int cnt_ = ((Kk) >> 6) * ((Nn) >> 5); while (it < cnt_) { transpose_item((Wp), (Kk), (Nn), (Dp), (ROFF), (MODE), scr, it, lane); it += nw; } it -= cnt_; } while (0)
        for (int e = e_lo; e < e_hi; ++e) {
            TR_RUNB(args.in[I_WEG] + (size_t)e * DM * DFE, DM, DFE, (bf16*)(F.ws + WS_WEGU) + (size_t)e * 2 * DFE * DM, 0, 1);
            TR_RUNB(args.in[I_WEU] + (size_t)e * DM * DFE, DM, DFE, (bf16*)(F.ws + WS_WEGU) + (size_t)e * 2 * DFE * DM, 0, 2);
            TR_RUNB(args.in[I_WED] + (size_t)e * DFE * DM, DFE, DM, (bf16*)(F.ws + WS_WED) + (size_t)e * DM * DFE, 0, 0);
        }
#undef TR_RUNB
    }
}
__device__ __forceinline__ void phase_prologue(const Frame& F, const Args& args) {
    int tid_ = threadIdx.x; asm volatile("" : "+v"(tid_)); const int tid = tid_, lane = tid & 63;
    LAS float* scr = (LAS float*)(F.lds + F.wave * 16896);
    int it = F.gw; const int nw = F.ngw;
#define TR_RUN(Wp, Kk, Nn, Dp, ROFF, MODE) do { const int cnt_ = ((Kk) >> 6) * ((Nn) >> 5); while (it < cnt_) { transpose_item((Wp), (Kk), (Nn), (Dp), (ROFF), (MODE), scr, it, lane); it += nw; } it -= cnt_; } while (0)
#define TR_RUN8(Wp, Kk, Nn, Dp, ROFF, MODE) do { const int cnt_ = ((Kk) >> 7) * ((Nn) >> 5); while (it < cnt_) { transpose_item_f8((Wp), (Kk), (Nn), (Dp), (ROFF), (MODE), SC_W, scr, it, lane); it += nw; } it -= cnt_; } while (0)
    for (int l = 0; l < DEPTH; ++l) {
        TR_RUN(args.in[I_WIN] + (size_t)l * DM * DIN, DM, DIN, (bf16*)(F.ws + WS_WIN) + (size_t)l * DINP * DM, 0, 0);
        TR_RUN(args.in[I_WUQ] + (size_t)l * 512 * 768, 512, 768, (bf16*)(F.ws + WS_WUQ) + (size_t)l * 768 * 512, 0, 0);
        TR_RUN(args.in[I_WUKV] + (size_t)l * 256 * 1024, 256, 1024, (bf16*)(F.ws + WS_WUKV) + (size_t)l * 1024 * 256, 0, 0);
        TR_RUN(args.in[I_WOUT] + (size_t)l * DM * DM, DM, DM, (bf16*)(F.ws + WS_WOUT) + (size_t)l * DM * DM, 0, 0);
    }
    if constexpr (F8D) {
        TR_RUN8(args.in[I_WG], DM, DFF, (unsigned char*)(F.ws + WS_WGU), 0, 1);
        TR_RUN8(args.in[I_WU], DM, DFF, (unsigned char*)(F.ws + WS_WGU), 0, 2);
        TR_RUN8(args.in[I_WDN], DFF, DM, (unsigned char*)(F.ws + WS_WD), 0, 0);
    } else {
        TR_RUN(args.in[I_WG], DM, DFF, (bf16*)(F.ws + WS_WGU), 0, 1);
        TR_RUN(args.in[I_WU], DM, DFF, (bf16*)(F.ws + WS_WGU), 0, 2);
        TR_RUN(args.in[I_WDN], DFF, DM, (bf16*)(F.ws + WS_WD), 0, 0);
    }
#undef TR_RUN
#undef TR_RUN8
    for (int l = 0; l < DEPTH; ++l) { v4u* z = (v4u*)((bf16*)(F.ws + WS_WIN) + ((size_t)l * DINP + DIN) * DM); const v4u zz = {0u, 0u, 0u, 0u};
        for (int i = F.bid * NWAVES * 64 + tid; i < (DINP - DIN) * DM / 8; i += F.G * NWAVES * 64) z[i] = zz; }
    if (!MOE_CVT_IN_ATTN) convert_experts(F, args, 0, NE, F.gw, F.ngw);
    phase_rmsnorm<false>(F, args.in[I_X], args.in[I_MIXN], F.ws + WS_H, 1.f);
}

__global__ void __launch_bounds__(NWAVES * 64, 2) mega_fwd(Args args) {
    extern __shared__ __attribute__((aligned(16))) unsigned char lds_raw[];
    Frame F;
    F.lds = (LAS unsigned char*)lds_raw; F.ws = args.ws; F.ctl = (unsigned*)(args.ws + WS_CTL);
    F.wave = __builtin_amdgcn_readfirstlane((int)threadIdx.x >> 6);
    F.G = gridDim.x; F.bid = blockIdx.x; F.gw = F.bid * NWAVES + F.wave; F.ngw = F.G * NWAVES;
    volatile LAS unsigned* MISC = (volatile LAS unsigned*)(F.lds + MISC_OFF);
    if (threadIdx.x < 64) MISC[threadIdx.x] = 0u;
    __syncthreads();
    XcdBarrier bar = xcd_barrier_post(F.ctl + CW_BAR, MISC + 8);
    const int lo = args.ph_lo, hi = args.ph_hi;
#define IN(k) (lo <= (k) && (k) < hi)
#define SEAM(k) do { if (IN(k) && IN((k) + 1)) xcd_barrier(bar); } while (0)
    float* out = args.out;
    LAS unsigned char* ring = F.lds;

    if (PHON(0) && IN(0)) phase_prologue(F, args);
    SEAM(0);

#pragma nounroll
    for (int l = 0; l < DEPTH; ++l) {
        const int P = 11 * l;
        if (PHON(1) && IN(P + 1)) {
            pg8::Gemm g{F.ws + WS_H, (const bf16*)(F.ws + WS_WIN) + (size_t)l * DINP * DM, NTOK, DINP, DM}; pg8::StaticOrder S; S.init(NTOK, DINP, F.G, F.bid);
            pg8::EpiBf16 E{(bf16*)(F.ws + WS_PROJ), DINP};
            pg8::gemm_phase<pg8::EpiBf16, pg8::StaticOrder, true, true>(ring, g, S, E);
        }
        SEAM(P + 1);
        if (PHON(2) && IN(P + 2)) phase_postproj(F, args, l);
        SEAM(P + 2);
        if (PHON(3) && IN(P + 3)) {
            { pg8::Gemm g{F.ws + WS_CQN, (const bf16*)(F.ws + WS_WUQ) + (size_t)l * 768 * 512, NTOK, 768, 512}; pg8::StaticOrder S; S.init(NTOK, 768, F.G, F.bid);
              pg8::EpiBf16 E{(bf16*)(F.ws + WS_QCR), 768}; pg8::gemm_phase<pg8::EpiBf16, pg8::StaticOrder, true, true>(ring, g, S, E); }
            { pg8::Gemm g{F.ws + WS_CKVN, (const bf16*)(F.ws + WS_WUKV) + (size_t)l * 1024 * 256, NTOK, 1024, 256}; pg8::StaticOrder S; S.init(NTOK, 1024, F.G, F.bid);
              pg8::EpiBf16 E{(bf16*)(F.ws + WS_KVR), 1024}; pg8::gemm_phase<pg8::EpiBf16, pg8::StaticOrder, true, true>(ring, g, S, E); }
        }
        SEAM(P + 3);
        if (PHON(4) && IN(P + 4)) phase_postmla(F, args, l);
        SEAM(P + 4);
        if (PHON(5) && IN(P + 5)) { phase_attention(F, args, l); __syncthreads(); }
        SEAM(P + 5);
        if (PHON(6) && IN(P + 6)) phase_groupnorm(F, args, l);
        SEAM(P + 6);
        if (PHON(7) && IN(P + 7)) {
            pg8::Gemm g{F.ws + WS_ON, (const bf16*)(F.ws + WS_WOUT) + (size_t)l * DM * DM, NTOK, DM, DM}; pg8::StaticOrder S; S.init(NTOK, DM, F.G, F.bid);
            pg8::EpiResF32 E{l == 0 ? args.in[I_X] : (const float*)out, out, DM, 1.f};
            pg8::gemm_phase<pg8::EpiResF32, pg8::StaticOrder, true, true>(ring, g, S, E);
        }
        SEAM(P + 7);
        if (l == 0) {
            if (PHON(8) && IN(P + 8)) phase_rmsnorm<F8D>(F, out, args.in[I_FFNN] + (size_t)l * DM, F.ws + WS_H, F8D ? SC_H : 1.f);
            SEAM(P + 8);
            if (PHON(9) && IN(P + 9)) {
                pg8::Gemm g{F.ws + WS_H, F.ws + WS_WGU, NTOK, 2 * DFF, DM}; pg8::StaticOrder S; S.init(NTOK, 2 * DFF, F.G, F.bid);
                if constexpr (F8D) { pg8::EpiSwigluF8 E{F.ws + WS_ACT, DFF, SC_ACT, 1.f / (SC_H * SC_W)}; pg8::gemm_phase<pg8::EpiSwigluF8, pg8::StaticOrder, true, true, true>(ring, g, S, E); }
                else { pg8::EpiSwiglu E{(bf16*)(F.ws + WS_ACT), DFF}; pg8::gemm_phase<pg8::EpiSwiglu, pg8::StaticOrder, true, true, false>(ring, g, S, E); }
            }
            SEAM(P + 9);
            if (PHON(10) && IN(P + 10)) {
                pg8::Gemm g{F.ws + WS_ACT, F.ws + WS_WD, NTOK, DM, DFF}; pg8::StaticOrder S; S.init(NTOK, DM, F.G, F.bid);
                pg8::EpiResF32 E{out, out, DM, F8D ? 1.f / (SC_ACT * SC_W) : 1.f};
                pg8::gemm_phase<pg8::EpiResF32, pg8::StaticOrder, true, true, F8D>(ring, g, S, E);
            }
            SEAM(P + 10);
            if (PHON(8) && IN(P + 11)) phase_rmsnorm<false>(F, out, args.in[I_MIXN] + (size_t)(l + 1) * DM, F.ws + WS_H, 1.f);
            SEAM(P + 11);
        } else {
            if (PHON(11) && IN(P + 8)) phase_ffnnorm_route<F8M>(F, args, out, args.in[I_FFNN] + (size_t)l * DM, F.ws + WS_H, SC_H);
            SEAM(P + 8);
            if (PHON(12) && IN(P + 9)) phase_gather<F8M>(F);
            SEAM(P + 9);
            if (PHON(13) && IN(P + 10)) {
                int tb[9], cnt[8]; moe_tiles(F, tb, cnt);
                pg8::Gemm g{F.ws + WS_HG, F.ws + WS_WEGU, tb[8] * 256, 2 * DFE, DM}; pg8::GroupedOrder S; S.init(tb[8] * 256, 2 * DFE, F.G, F.bid);
#pragma unroll
                for (int k = 0; k < 7; ++k) S.tb[k] = tb[k + 1];
                S.nct = 2 * DFE / 256;
                if constexpr (F8M) { pg8::EpiSwigluF8 E{F.ws + WS_ACTM, DFE, SC_ACT, 1.f / (SC_H * SC_W)}; pg8::gemm_phase<pg8::EpiSwigluF8, pg8::GroupedOrder, true, true, true>(ring, g, S, E); }
                else { pg8::EpiSwiglu E{(bf16*)(F.ws + WS_ACTM), DFE}; pg8::gemm_phase<pg8::EpiSwiglu, pg8::GroupedOrder, true, true, false>(ring, g, S, E); }
            }
            SEAM(P + 10);
            if (PHON(14) && IN(P + 11)) {
                int tb[9], cnt[8]; moe_tiles(F, tb, cnt);
                pg8::Gemm g{F.ws + WS_ACTM, F.ws + WS_WED, tb[8] * 256, DM, DFE}; pg8::GroupedOrder S; S.init(tb[8] * 256, DM, F.G, F.bid);
#pragma unroll
                for (int k = 0; k < 7; ++k) S.tb[k] = tb[k + 1];
                S.nct = DM / 256;
                pg8::EpiScaleBf16 E{(bf16*)(F.ws + WS_Y), DM, (const float*)(F.ws + WS_RGATE), F8M ? 1.f / (SC_ACT * SC_W) : 1.f};
                pg8::gemm_phase<pg8::EpiScaleBf16, pg8::GroupedOrder, true, true, F8M>(ring, g, S, E);
            }
            SEAM(P + 11);
            if (PHON(15) && IN(P + 12)) phase_combine(F, out);
        }
    }
#undef IN
#undef SEAM
}

extern "C" void kernel_launch(void* const* d_in, const int* in_sizes, int n_in, void* d_out, int out_size, void* d_ws, size_t ws_size, hipStream_t stream) {
    static int grid = 0;
    if (grid == 0) {
        if (n_in != 26 || in_sizes[0] != NTOK * DM || out_size != NTOK * DM || ws_size < WS_END) { fprintf(stderr, "kernel_launch: unexpected shapes (n_in %d, in0 %d, out %d, ws %zu < %zu)\n", n_in, n_in > 0 ? in_sizes[0] : -1, out_size, ws_size, (size_t)WS_END); grid = -1; return; }
        int dev = 0, cus = 0, per_cu = 0;
        if (hipGetDevice(&dev) != hipSuccess || hipDeviceGetAttribute(&cus, hipDeviceAttributeMultiprocessorCount, dev) != hipSuccess) { grid = -1; return; }
        if (hipFuncSetAttribute((const void*)mega_fwd, hipFuncAttributeMaxDynamicSharedMemorySize, LDS_BYTES) != hipSuccess) { fprintf(stderr, "kernel_launch: hipFuncSetAttribute failed\n"); grid = -1; return; }
        if (hipOccupancyMaxActiveBlocksPerMultiprocessor(&per_cu, (const void*)mega_fwd, NWAVES * 64, LDS_BYTES) != hipSuccess || per_cu < 1) fprintf(stderr, "kernel_launch: occupancy query reports %d\n", per_cu);
        (void)hipGetLastError();
        grid = cus;
    }
    if (grid < 0) return;
    if (hipMemsetAsync((char*)d_ws + WS_CTL, 0, CTL_ZERO_BYTES, stream) != hipSuccess) return;
    Args a{};
    for (int i = 0; i < 26; ++i) a.in[i] = (const float*)d_in[i];
    a.out = (float*)d_out; a.ws = (unsigned char*)d_ws;
#ifndef MK_SPLIT
    a.ph_lo = 0; a.ph_hi = NPHASE;
    hipLaunchKernelGGL(mega_fwd, dim3(grid), dim3(NWAVES * 64), LDS_BYTES, stream, a);
#else
    for (int p = 0; p < NPHASE; ++p) { a.ph_lo = p; a.ph_hi = p + 1; hipLaunchKernelGGL(mega_fwd, dim3(grid), dim3(NWAVES * 64), LDS_BYTES, stream, a); }
#endif
}
```

```cpp
#include <hip/hip_runtime.h>
#include <cstdio>
#include <cstdint>
namespace pg8 {
#define PG8_LAS __attribute__((address_space(3)))
typedef unsigned short bf16_t;
typedef short bf16x8 __attribute__((ext_vector_type(8)));
typedef float f32x4 __attribute__((ext_vector_type(4)));
typedef unsigned u32x4 __attribute__((ext_vector_type(4)));
constexpr int BM = 256, BK = 64, HALF = 128, HTB = HALF * BK * 2  , STAGE_BYTES = 8 * HTB, NXCD = 8, WGM = 8;

__host__ __device__ __forceinline__ int lds_byte(int r, int c) { const int st = (r >> 4) * 2 + (c >> 5), rr = r & 15, cc = c & 31, ob = rr * 64 + cc * 2; return st * 1024 + (ob ^ (((ob >> 9) & 1) << 5)); }
__host__ __device__ __forceinline__ void stage_rc(int b, int& R, int& C) { const int st = b / 1024, sb = b % 1024, swz = sb ^ (((sb >> 9) & 1) << 5); R = (st >> 1) * 16 + swz / 64; C = (st & 1) * 32 + (swz % 64) / 2; }
__host__ __device__ __forceinline__ int perm32(int rho) { const int n = rho >> 4, i = rho & 15; return 8 * (i >> 2) + 4 * n + (i & 3); }


struct Unit { int pm, pn, pc; };
struct Gemm { const void* A; const void* Bt; int M, N, K; };
typedef int i32x4 __attribute__((ext_vector_type(4)));
typedef int i32x8 __attribute__((ext_vector_type(8)));

struct StaticOrder {
    int nM, nN, nwg, G, c;
    __device__ __forceinline__ void init(int M, int N, int G_, int c_) { nM = M / BM; nN = N / BM; nwg = nM * nN; G = G_; c = c_; }
    __device__ __forceinline__ bool next(int i, Unit& u) const {
        const long L = (long)i * G + c; if (L >= nwg) return false;
        int wgid = (int)L; { const int q = nwg / NXCD, r = nwg % NXCD, xcd = wgid % NXCD, off = wgid / NXCD; wgid = (xcd < r ? xcd * (q + 1) : r * (q + 1) + (xcd - r) * q) + off; }
        const int nig = WGM * nN, gid = wgid / nig, fm = gid * WGM, gsz = (nM - fm) < WGM ? (nM - fm) : WGM;
        u.pm = fm + ((wgid % nig) % gsz); u.pn = (wgid % nig) / gsz; u.pc = u.pn; return true;
    }
    __device__ __forceinline__ void a_ready(const Unit&) const {}
    __device__ __forceinline__ void done(const Unit&) const {}
};
struct GroupedOrder : StaticOrder {
    int tb[7]; int nct;
    __device__ __forceinline__ bool next(int i, Unit& u) const {
        if (!StaticOrder::next(i, u)) return false;
        int e = 0;
#pragma unroll
        for (int k = 0; k < 7; ++k) e += (u.pm >= tb[k]) ? 1 : 0;
        u.pc = u.pn; u.pn += e * nct; return true;
    }
};

__device__ __forceinline__ unsigned cvt_pk_bf16(float lo, float hi) { unsigned r; asm volatile("v_cvt_pk_bf16_f32 %0, %1, %2" : "=v"(r) : "v"(lo), "v"(hi)); return r; }

struct EpiBf16 {
    static constexpr bool PERM = true, AFTER_DRAIN = false;
    bf16_t* O; int ldc;
    __device__ __forceinline__ void operator()(const f32x4 (&acc)[2][2][4][2], const Unit& u, int wr, int wc, int fr, int fq) const {
        const int row0 = u.pm * BM + wr * 64 + fr, col0 = u.pc * BM + wc * 32 + 8 * fq;
#pragma unroll
        for (int ai = 0; ai < 2; ++ai)
#pragma unroll
            for (int m = 0; m < 4; ++m) { bf16_t* rowp = O + (size_t)(row0 + ai * HALF + m * 16) * ldc + col0;
#pragma unroll
                for (int bj = 0; bj < 2; ++bj) { const f32x4 v0 = acc[ai][bj][m][0], v1 = acc[ai][bj][m][1];
                    u32x4 w; w.x = cvt_pk_bf16(v0[0], v0[1]); w.y = cvt_pk_bf16(v0[2], v0[3]); w.z = cvt_pk_bf16(v1[0], v1[1]); w.w = cvt_pk_bf16(v1[2], v1[3]);
                    *(u32x4*)(rowp + bj * HALF) = w; } }
    }
};
struct EpiScaleBf16 {
    static constexpr bool PERM = true, AFTER_DRAIN = false;
    bf16_t* O; int ldc; const float* rs; float isc;
    __device__ __forceinline__ void operator()(const f32x4 (&acc)[2][2][4][2], const Unit& u, int wr, int wc, int fr, int fq) const {
        const int row0 = u.pm * BM + wr * 64 + fr, col0 = u.pc * BM + wc * 32 + 8 * fq;
#pragma unroll
        for (int ai = 0; ai < 2; ++ai)
#pragma unroll
            for (int m = 0; m < 4; ++m) { const int row = row0 + ai * HALF + m * 16; const float s = rs[row] * isc; bf16_t* rowp = O + (size_t)row * ldc + col0;
#pragma unroll
                for (int bj = 0; bj < 2; ++bj) { const f32x4 v0 = acc[ai][bj][m][0] * s, v1 = acc[ai][bj][m][1] * s;
                    u32x4 w; w.x = cvt_pk_bf16(v0[0], v0[1]); w.y = cvt_pk_bf16(v0[2], v0[3]); w.z = cvt_pk_bf16(v1[0], v1[1]); w.w = cvt_pk_bf16(v1[2], v1[3]);
                    *(u32x4*)(rowp + bj * HALF) = w; } }
    }
};
struct EpiResF32 {
    static constexpr bool PERM = false, AFTER_DRAIN = false;
    const float* base; float* out; int ldc; float isc;
    __device__ __forceinline__ void operator()(const f32x4 (&acc)[2][2][4][2], const Unit& u, int wr, int wc, int fr, int fq) const {
        const int row0 = u.pm * BM + wr * 64 + fr, col0 = u.pc * BM + wc * 32 + 4 * fq;
#pragma unroll
        for (int ai = 0; ai < 2; ++ai)
#pragma unroll
            for (int m = 0; m < 4; ++m) { const size_t off = (size_t)(row0 + ai * HALF + m * 16) * ldc + col0;
                f32x4 b[2][2];
#pragma unroll
                for (int bj = 0; bj < 2; ++bj)
#pragma unroll
                    for (int n = 0; n < 2; ++n) b[bj][n] = *(const f32x4*)(base + off + bj * HALF + n * 16);
#pragma unroll
                for (int bj = 0; bj < 2; ++bj)
#pragma unroll
                    for (int n = 0; n < 2; ++n) *(f32x4*)(out + off + bj * HALF + n * 16) = b[bj][n] + acc[ai][bj][m][n] * isc;
                asm volatile("" ::: "memory"); }
    }
};
template <bool BASEB> struct EpiResBf16 {
    static constexpr bool PERM = true, AFTER_DRAIN = false;
    const void* base; bf16_t* out; int ldc; float isc;
    __device__ __forceinline__ void operator()(const f32x4 (&acc)[2][2][4][2], const Unit& u, int wr, int wc, int fr, int fq) const {
        const int row0 = u.pm * BM + wr * 64 + fr, col0 = u.pc * BM + wc * 32 + 8 * fq;
#pragma unroll
        for (int ai = 0; ai < 2; ++ai)
#pragma unroll
            for (int m = 0; m < 4; ++m) { const size_t off = (size_t)(row0 + ai * HALF + m * 16) * ldc + col0;
#pragma unroll
                for (int bj = 0; bj < 2; ++bj) { f32x4 b0, b1;
                    if constexpr (BASEB) { const u32x4 w = *(const u32x4*)((const bf16_t*)base + off + bj * HALF);
                        b0 = (f32x4){__uint_as_float(w.x << 16), __uint_as_float(w.x & 0xffff0000u), __uint_as_float(w.y << 16), __uint_as_float(w.y & 0xffff0000u)};
                        b1 = (f32x4){__uint_as_float(w.z << 16), __uint_as_float(w.z & 0xffff0000u), __uint_as_float(w.w << 16), __uint_as_float(w.w & 0xffff0000u)}; }
                    else { b0 = *(const f32x4*)((const float*)base + off + bj * HALF); b1 = *(const f32x4*)((const float*)base + off + bj * HALF + 4); }
                    const f32x4 v0 = b0 + acc[ai][bj][m][0] * isc, v1 = b1 + acc[ai][bj][m][1] * isc;
                    u32x4 o; o.x = cvt_pk_bf16(v0[0], v0[1]); o.y = cvt_pk_bf16(v0[2], v0[3]); o.z = cvt_pk_bf16(v1[0], v1[1]); o.w = cvt_pk_bf16(v1[2], v1[3]);
                    *(u32x4*)(out + off + bj * HALF) = o; }
                asm volatile("" ::: "memory"); }
    }
};
__device__ __forceinline__ float silu_mul(float g, float u) { return g * u * __builtin_amdgcn_rcpf(1.0f + __builtin_amdgcn_exp2f(-1.44269504089f * g)); }
struct EpiSwiglu {
    static constexpr bool PERM = true, AFTER_DRAIN = false;
    bf16_t* O; int ldc; float isc;
    __device__ __forceinline__ void operator()(const f32x4 (&acc)[2][2][4][2], const Unit& u, int wr, int wc, int fr, int fq) const {
        const int row0 = u.pm * BM + wr * 64 + fr, col0 = u.pc * HALF + wc * 32 + 8 * fq;
#pragma unroll
        for (int ai = 0; ai < 2; ++ai)
#pragma unroll
            for (int m = 0; m < 4; ++m) { bf16_t* rowp = O + (size_t)(row0 + ai * HALF + m * 16) * ldc + col0;
                const f32x4 g0 = acc[ai][0][m][0] * isc, g1 = acc[ai][0][m][1] * isc, u0 = acc[ai][1][m][0] * isc, u1 = acc[ai][1][m][1] * isc;
                u32x4 w; w.x = cvt_pk_bf16(silu_mul(g0[0], u0[0]), silu_mul(g0[1], u0[1])); w.y = cvt_pk_bf16(silu_mul(g0[2], u0[2]), silu_mul(g0[3], u0[3]));
                w.z = cvt_pk_bf16(silu_mul(g1[0], u1[0]), silu_mul(g1[1], u1[1])); w.w = cvt_pk_bf16(silu_mul(g1[2], u1[2]), silu_mul(g1[3], u1[3]));
                *(u32x4*)rowp = w; }
    }
};

__device__ __forceinline__ unsigned cvt_pk4_fp8(float a, float b, float c, float d) { unsigned w = 0u; w = __builtin_amdgcn_cvt_pk_fp8_f32(a, b, w, false); w = __builtin_amdgcn_cvt_pk_fp8_f32(c, d, w, true); return w; }
struct EpiSwigluF8 {
    static constexpr bool PERM = true, AFTER_DRAIN = false;
    unsigned char* O; int ldc; float osc, isc;
    __device__ __forceinline__ void operator()(const f32x4 (&acc)[2][2][4][2], const Unit& u, int wr, int wc, int fr, int fq) const {
        const int row0 = u.pm * BM + wr * 64 + fr, col0 = u.pc * HALF + wc * 32 + 8 * fq;
        const float k1 = osc * isc * isc, k2 = -1.44269504089f * isc;
#define SWF8(G, U) ((G) * (U) * k1 * __builtin_amdgcn_rcpf(1.0f + __builtin_amdgcn_exp2f((G) * k2)))
#pragma unroll
        for (int ai = 0; ai < 2; ++ai)
#pragma unroll
            for (int m = 0; m < 4; ++m) { unsigned char* rowp = O + (size_t)(row0 + ai * HALF + m * 16) * ldc + col0;
                const f32x4 g0 = acc[ai][0][m][0], g1 = acc[ai][0][m][1], u0 = acc[ai][1][m][0], u1 = acc[ai][1][m][1];
                typedef unsigned u32x2 __attribute__((ext_vector_type(2)));
                u32x2 w; w.x = cvt_pk4_fp8(SWF8(g0[0], u0[0]), SWF8(g0[1], u0[1]), SWF8(g0[2], u0[2]), SWF8(g0[3], u0[3]));
                w.y = cvt_pk4_fp8(SWF8(g1[0], u1[0]), SWF8(g1[1], u1[1]), SWF8(g1[2], u1[2]), SWF8(g1[3], u1[3]));
                *(u32x2*)rowp = w; }
#undef SWF8
    }
};

template <class Epi, class Sched, bool ALIGN_EPI = false, bool SP2 = false, bool F8 = false>
__device__ __forceinline__ void gemm_phase(PG8_LAS unsigned char* lds, const Gemm g, const Sched& S, const Epi& E) {
    int tid_ = threadIdx.x; asm volatile("" : "+v"(tid_));
    const int tid = tid_, wid = __builtin_amdgcn_readfirstlane(tid >> 6), lane = tid & 63, wr = wid >> 2, wc = wid & 3, fr = lane & 15, fq = lane >> 4;
    const int K = g.K, nt = F8 ? K / (2 * BK) : K / BK, RB = F8 ? K : 2 * K;
    unsigned voffA[2], voffB[2];
#pragma unroll
    for (int i = 0; i < 2; ++i) { int R, C; stage_rc(tid * 16 + i * 8192, R, C); const int Rb = Epi::PERM ? ((R & ~31) + perm32(R & 31)) : R;
        voffA[i] = (unsigned)(R * RB + C * 2); voffB[i] = (unsigned)(Rb * RB + C * 2); }
    const size_t kstep = (size_t)(BK * 2);
    const size_t hstep = (size_t)HALF * RB;
    const size_t tstep = 2 * hstep;
    const unsigned ldsw = (unsigned)wid * 1024u;
    const int aoff = F8 ? lds_byte(wr * 64 + fr, fq * 16) : lds_byte(wr * 64 + fr, fq * 8), boff = F8 ? lds_byte(wc * 32 + fr, fq * 16) : lds_byte(wc * 32 + fr, fq * 8);
#define PG8_SA(b, h) (((b) * 2 + (h)) * HTB)
#define PG8_SB(b, h) ((4 + (b) * 2 + (h)) * HTB)
#define PG8_STAGE(bufoff, gbase, voff) do { _Pragma("unroll") for (int _i = 0; _i < 2; ++_i) \
        __builtin_amdgcn_global_load_lds((const unsigned*)((const char*)(gbase) + (voff)[_i]), (PG8_LAS unsigned*)(lds + (bufoff) + ldsw + _i * 8192), 16, 0, 0); } while (0)
#define PG8_LD16(p) (*(const PG8_LAS i32x4*)(p))
#define PG8_LDA(dst, b, h) do { _Pragma("unroll") for (int m = 0; m < 4; ++m) { if constexpr (F8) { dst##8[m] = __builtin_shufflevector(PG8_LD16(lds + PG8_SA(b, h) + aoff + m * 2048), PG8_LD16(lds + PG8_SA(b, h) + aoff + m * 2048 + 16), 0, 1, 2, 3, 4, 5, 6, 7); } \
        else { _Pragma("unroll") for (int k = 0; k < 2; ++k) dst[m][k] = *(const PG8_LAS bf16x8*)(lds + PG8_SA(b, h) + aoff + m * 2048 + k * 1024); } } } while (0)
#define PG8_LDB(dst, b, h) do { _Pragma("unroll") for (int n = 0; n < 2; ++n) { if constexpr (F8) { dst##8[n] = __builtin_shufflevector(PG8_LD16(lds + PG8_SB(b, h) + boff + n * 2048), PG8_LD16(lds + PG8_SB(b, h) + boff + n * 2048 + 16), 0, 1, 2, 3, 4, 5, 6, 7); } \
        else { _Pragma("unroll") for (int k = 0; k < 2; ++k) dst[n][k] = *(const PG8_LAS bf16x8*)(lds + PG8_SB(b, h) + boff + n * 2048 + k * 1024); } } } while (0)
#define PG8_MMA(ai, bj, At, Bt) do { __builtin_amdgcn_s_setprio(1); _Pragma("unroll") for (int m = 0; m < 4; ++m) _Pragma("unroll") for (int n = 0; n < 2; ++n) { \
        if constexpr (F8) asm volatile("v_mfma_f32_16x16x128_f8f6f4 %0, %1, %2, %0" : "+v"(acc[ai][bj][m][n]) : "v"(Bt##8[n]), "v"(At##8[m])); \
        else { _Pragma("unroll") for (int k = 0; k < 2; ++k) acc[ai][bj][m][n] = __builtin_amdgcn_mfma_f32_16x16x32_bf16(Bt[n][k], At[m][k], acc[ai][bj][m][n], 0, 0, 0); } } __builtin_amdgcn_s_setprio(0); } while (0)
#define PG8_WAIT_V(n) asm volatile("s_waitcnt vmcnt(" #n ")" ::: "memory")
#define PG8_WAIT_L(n) asm volatile("s_waitcnt lgkmcnt(" #n ")" ::: "memory")
#define PG8_BAR __builtin_amdgcn_s_barrier()
#define PG8_SCHED __builtin_amdgcn_sched_barrier(0)
    Unit cur, nxt; int ui = 0;
    if (!S.next(0, cur)) return;
    f32x4 acc[2][2][4][2];
#pragma unroll
    for (int a = 0; a < 2; ++a)
#pragma unroll
        for (int b = 0; b < 2; ++b)
#pragma unroll
            for (int m = 0; m < 4; ++m)
#pragma unroll
                for (int n = 0; n < 2; ++n) acc[a][b][m][n] = (f32x4){0.f, 0.f, 0.f, 0.f};
    bf16x8 At[4][2], B0[2][2], B1[2][2]; i32x8 At8[4], B08[2], B18[2];
    const char* cA = (const char*)g.A + (size_t)cur.pm * tstep; const char* cB = (const char*)g.Bt + (size_t)cur.pn * tstep;
    S.a_ready(cur);
    if constexpr (SP2) {
        PG8_STAGE(PG8_SB(0, 0), cB, voffB); PG8_STAGE(PG8_SB(0, 1), cB + hstep, voffB); PG8_STAGE(PG8_SA(0, 0), cA, voffA); PG8_STAGE(PG8_SA(0, 1), cA + hstep, voffA);
        if (wr == 1) PG8_BAR;
        PG8_WAIT_V(2); PG8_BAR;
        PG8_STAGE(PG8_SB(1, 0), cB + kstep, voffB); PG8_STAGE(PG8_SA(1, 0), cA + kstep, voffA); PG8_STAGE(PG8_SB(1, 1), cB + hstep + kstep, voffB);
        PG8_WAIT_V(6); PG8_BAR;
    } else {
        PG8_STAGE(PG8_SB(0, 0), cB, voffB); PG8_STAGE(PG8_SA(0, 0), cA, voffA); PG8_STAGE(PG8_SB(0, 1), cB + hstep, voffB); PG8_STAGE(PG8_SA(0, 1), cA + hstep, voffA);
        if (wr == 1) PG8_BAR;
        PG8_WAIT_V(4); PG8_BAR;
        PG8_STAGE(PG8_SB(1, 0), cB + kstep, voffB); PG8_STAGE(PG8_SA(1, 0), cA + kstep, voffA); PG8_STAGE(PG8_SB(1, 1), cB + hstep + kstep, voffB);
        PG8_WAIT_V(6); PG8_BAR;
    }
    for (;;) {
        const bool has_next = S.next(ui + 1, nxt);
        const char* nA = has_next ? (const char*)g.A + (size_t)nxt.pm * tstep : cA; const char* nB = has_next ? (const char*)g.Bt + (size_t)nxt.pn * tstep : cB;
        for (int t = 0; t < nt; t += 2) {
            const bool last = (t == nt - 2);
            const char* a1 = cA + (size_t)(t + 1) * kstep;
            const char* a2 = last ? nA : cA + (size_t)(t + 2) * kstep; const char* b2 = last ? nB : cB + (size_t)(t + 2) * kstep;
            const char* a3 = a2 + kstep; const char* b3 = b2 + kstep;
            if (last && has_next) S.a_ready(nxt);
            if constexpr (SP2) {
            PG8_LDB(B0, 0, 0); PG8_LDB(B1, 0, 1); PG8_SCHED; PG8_LDA(At, 0, 0); PG8_STAGE(PG8_SA(1, 1), a1 + hstep, voffA);
            PG8_WAIT_V(8); PG8_WAIT_L(0); PG8_BAR; PG8_MMA(0, 0, At, B0); PG8_MMA(0, 1, At, B1); PG8_BAR; PG8_SCHED;
            PG8_LDA(At, 0, 1); PG8_STAGE(PG8_SB(0, 0), b2, voffB); PG8_STAGE(PG8_SB(0, 1), b2 + hstep, voffB); PG8_STAGE(PG8_SA(0, 0), a2, voffA);
            PG8_WAIT_V(8); PG8_WAIT_L(0); PG8_BAR; PG8_MMA(1, 0, At, B0); PG8_MMA(1, 1, At, B1); PG8_BAR; PG8_SCHED;
            PG8_LDB(B0, 1, 0); PG8_LDB(B1, 1, 1); PG8_SCHED; PG8_LDA(At, 1, 0); PG8_STAGE(PG8_SA(0, 1), a2 + hstep, voffA);
            PG8_WAIT_V(8); PG8_WAIT_L(0); PG8_BAR; PG8_MMA(0, 0, At, B0); PG8_MMA(0, 1, At, B1); PG8_BAR; PG8_SCHED;
            PG8_LDA(At, 1, 1); PG8_STAGE(PG8_SB(1, 0), b3, voffB); PG8_STAGE(PG8_SB(1, 1), b3 + hstep, voffB); PG8_STAGE(PG8_SA(1, 0), a3, voffA);
            PG8_WAIT_V(8); PG8_WAIT_L(0); PG8_BAR; PG8_MMA(1, 0, At, B0); PG8_MMA(1, 1, At, B1); PG8_BAR; PG8_SCHED;
            } else {
            PG8_LDB(B0, 0, 0); PG8_SCHED; PG8_LDA(At, 0, 0); PG8_STAGE(PG8_SA(1, 1), a1 + hstep, voffA);
            PG8_WAIT_L(8); PG8_BAR; PG8_WAIT_L(0); PG8_MMA(0, 0, At, B0); PG8_BAR; PG8_SCHED;
            PG8_LDB(B1, 0, 1); PG8_STAGE(PG8_SB(0, 0), b2, voffB);
            PG8_BAR; PG8_WAIT_L(0); PG8_MMA(0, 1, At, B1); PG8_BAR;
            PG8_LDA(At, 0, 1); PG8_STAGE(PG8_SA(0, 0), a2, voffA);
            PG8_BAR; PG8_WAIT_L(0); PG8_MMA(1, 0, At, B0); PG8_BAR; PG8_SCHED;
            PG8_STAGE(PG8_SB(0, 1), b2 + hstep, voffB);
            PG8_WAIT_V(6); PG8_BAR; PG8_MMA(1, 1, At, B1); PG8_BAR;
            PG8_LDB(B0, 1, 0); PG8_SCHED; PG8_LDA(At, 1, 0); PG8_STAGE(PG8_SA(0, 1), a2 + hstep, voffA);
            PG8_WAIT_L(8); PG8_BAR; PG8_WAIT_L(0); PG8_MMA(0, 0, At, B0); PG8_BAR; PG8_SCHED;
            PG8_LDB(B1, 1, 1); PG8_STAGE(PG8_SB(1, 0), b3, voffB);
            PG8_BAR; PG8_WAIT_L(0); PG8_MMA(0, 1, At, B1); PG8_BAR;
            PG8_LDA(At, 1, 1); PG8_STAGE(PG8_SA(1, 0), a3, voffA);
            PG8_BAR; PG8_WAIT_L(0); PG8_MMA(1, 0, At, B0); PG8_BAR; PG8_SCHED;
            PG8_STAGE(PG8_SB(1, 1), b3 + hstep, voffB);
            PG8_WAIT_V(6); PG8_BAR; PG8_MMA(1, 1, At, B1); PG8_BAR;
            }
        }
        if constexpr (ALIGN_EPI) { if (wr == 0) PG8_BAR; }
        if constexpr (F8) {
            asm volatile("s_nop 15\n\ts_nop 15" : "+v"(acc[0][0][0][0]), "+v"(acc[0][0][0][1]), "+v"(acc[0][0][1][0]), "+v"(acc[0][0][1][1]), "+v"(acc[0][0][2][0]), "+v"(acc[0][0][2][1]), "+v"(acc[0][0][3][0]), "+v"(acc[0][0][3][1]) :: "memory");
            asm volatile("" : "+v"(acc[0][1][0][0]), "+v"(acc[0][1][0][1]), "+v"(acc[0][1][1][0]), "+v"(acc[0][1][1][1]), "+v"(acc[0][1][2][0]), "+v"(acc[0][1][2][1]), "+v"(acc[0][1][3][0]), "+v"(acc[0][1][3][1]) :: "memory");
            asm volatile("" : "+v"(acc[1][0][0][0]), "+v"(acc[1][0][0][1]), "+v"(acc[1][0][1][0]), "+v"(acc[1][0][1][1]), "+v"(acc[1][0][2][0]), "+v"(acc[1][0][2][1]), "+v"(acc[1][0][3][0]), "+v"(acc[1][0][3][1]) :: "memory");
            asm volatile("" : "+v"(acc[1][1][0][0]), "+v"(acc[1][1][0][1]), "+v"(acc[1][1][1][0]), "+v"(acc[1][1][1][1]), "+v"(acc[1][1][2][0]), "+v"(acc[1][1][2][1]), "+v"(acc[1][1][3][0]), "+v"(acc[1][1][3][1]) :: "memory");
        }
        if constexpr (!Epi::AFTER_DRAIN) { E(acc, cur, wr, wc, fr, fq); S.done(cur); }
        if (!has_next) break;
#pragma unroll
        for (int a = 0; a < 2; ++a)
#pragma unroll
            for (int b = 0; b < 2; ++b)
#pragma unroll
                for (int m = 0; m < 4; ++m)
#pragma unroll
                    for (int n = 0; n < 2; ++n) acc[a][b][m][n] = (f32x4){0.f, 0.f, 0.f, 0.f};
        cur = nxt; cA = nA; cB = nB; ++ui;
        if constexpr (ALIGN_EPI) { if (wr == 1) PG8_BAR; }
    }
    PG8_WAIT_V(0);
    if constexpr (!ALIGN_EPI) { if (wr == 0) PG8_BAR; }
    PG8_BAR;
    if constexpr (Epi::AFTER_DRAIN) { E.fused(acc, cur, wr, wc, fr, fq, lds, wid, lane); S.done(cur); }
#undef PG8_SA
#undef PG8_SB
#undef PG8_STAGE
#undef PG8_LDA
#undef PG8_LDB
#undef PG8_MMA
#undef PG8_LD16
#undef PG8_WAIT_V
#undef PG8_WAIT_L
#undef PG8_BAR
#undef PG8_SCHED
}
}

namespace att {
typedef unsigned short bf16;
using bf16x8 = __attribute__((ext_vector_type(8))) short;
using s16x4  = __attribute__((ext_vector_type(4))) short;
using f32x16 = __attribute__((ext_vector_type(16))) float;
using u32x4  = __attribute__((ext_vector_type(4))) unsigned;
constexpr int NW = 8, QBLK = 32, KVBLK = 64, DV = 128;
constexpr float THR = 8.f;
constexpr int SHM_V = KVBLK * DV * 2;
#define ATT_SBAR() __builtin_amdgcn_sched_barrier(0)
__device__ __forceinline__ int crow(int r, int hi) { return (r & 3) + 8 * (r >> 2) + 4 * hi; }
__device__ __forceinline__ unsigned cvtpk(float lo, float hi) { unsigned r; asm volatile("v_cvt_pk_bf16_f32 %0, %1, %2" : "=v"(r) : "v"(lo), "v"(hi)); return r; }
template <int DQ> struct Cst { static constexpr float SCALE = (DQ == 128) ? 0.088388347648318440f : 0.072168783648703220f; static constexpr int SHM_K = KVBLK * DQ * 2, ROWB = DQ * 2; };

template <int DQ>
__device__ __forceinline__ void partialSM(f32x16& p0, f32x16& p1, float& m_reg, float& mn, float& alpha) {
  constexpr float SCALE = Cst<DQ>::SCALE, C = SCALE * 1.4426950408889634f;
  float pmax = p0[0];
#pragma unroll
  for (int r = 1; r < 16; ++r) pmax = fmaxf(pmax, p0[r]);
#pragma unroll
  for (int r = 0; r < 16; ++r) pmax = fmaxf(pmax, p1[r]);
  { auto rr = __builtin_amdgcn_permlane32_swap(__float_as_uint(pmax), __float_as_uint(pmax), false, false);
    pmax = fmaxf(__uint_as_float(rr[0]), __uint_as_float(rr[1])); }
  if (__builtin_expect(__all(pmax - m_reg <= THR / SCALE), 1)) { mn = m_reg; alpha = 1.f; }
  else { mn = fmaxf(m_reg, pmax); alpha = __builtin_amdgcn_exp2f((m_reg - mn) * C); m_reg = mn; }
  const float mnC = -mn * C;
#pragma unroll
  for (int r = 0; r < 16; ++r) p0[r] = fmaf(p0[r], C, mnC);
#pragma unroll
  for (int r = 0; r < 16; ++r) p1[r] = fmaf(p1[r], C, mnC);
#pragma unroll
  for (int r = 0; r < 16; ++r) p0[r] = __builtin_amdgcn_exp2f(p0[r]);
}
__device__ __forceinline__ void finishSM(f32x16& p0, f32x16& p1, float alpha, float& l_reg, bf16x8& pa0, bf16x8& pa1, bf16x8& pa2, bf16x8& pa3) {
#pragma unroll
  for (int r = 0; r < 16; ++r) p1[r] = __builtin_amdgcn_exp2f(p1[r]);
  float ps = 0;
#pragma unroll
  for (int r = 0; r < 16; ++r) ps += p0[r];
#pragma unroll
  for (int r = 0; r < 16; ++r) ps += p1[r];
  { auto rr = __builtin_amdgcn_permlane32_swap(__float_as_uint(ps), __float_as_uint(ps), false, false);
    ps = __uint_as_float(rr[0]) + __uint_as_float(rr[1]); }
  l_reg = l_reg * alpha + ps;
#define ATT_PK4(P, BASE, OUT) do { unsigned a0 = cvtpk(P[BASE + 0], P[BASE + 1]), a1 = cvtpk(P[BASE + 2], P[BASE + 3]);   \
    unsigned b0 = cvtpk(P[BASE + 4], P[BASE + 5]), b1 = cvtpk(P[BASE + 6], P[BASE + 7]);                              \
    auto r0 = __builtin_amdgcn_permlane32_swap(a0, b0, false, false); auto r1 = __builtin_amdgcn_permlane32_swap(a1, b1, false, false); \
    u32x4 w = {r0[0], r1[0], r0[1], r1[1]}; OUT = *reinterpret_cast<bf16x8*>(&w); } while (0)
  ATT_PK4(p0, 0, pa0); ATT_PK4(p0, 8, pa1); ATT_PK4(p1, 0, pa2); ATT_PK4(p1, 8, pa3);
#undef ATT_PK4
}
template <int DQ, int NREG>
__device__ __forceinline__ void qkt(f32x16& p0, f32x16& p1, const char* Ks, const bf16x8* qr, const char* qpark, int r32, int hi) {
  constexpr int ROWB = Cst<DQ>::ROWB;
  p0 = f32x16{}; p1 = f32x16{};
#pragma unroll
  for (int d0 = 0; d0 < DQ / 16; ++d0) { const int cb = (d0 * 16 + hi * 8) * 2;
    bf16x8 b0 = *reinterpret_cast<const bf16x8*>(Ks + (r32 * ROWB + (cb ^ ((r32 & 7) << 4))));
    bf16x8 b1 = *reinterpret_cast<const bf16x8*>(Ks + ((32 + r32) * ROWB + (cb ^ ((r32 & 7) << 4))));
    bf16x8 q; if constexpr (true) { if (d0 < NREG) q = qr[d0 < NREG ? d0 : 0]; else q = *reinterpret_cast<const bf16x8*>(qpark + (d0 - NREG) * 1024); }
    p0 = __builtin_amdgcn_mfma_f32_32x32x16_bf16(b0, q, p0, 0, 0, 0);
    p1 = __builtin_amdgcn_mfma_f32_32x32x16_bf16(b1, q, p1, 0, 0, 0); }
}
__device__ __forceinline__ int v_st(int k, int c) { const int kk = (k & ~0xC) | ((k & 4) << 1) | ((k & 8) >> 1); return ((kk >> 3) * 4 + (c >> 5)) * 512 + ((kk & 7) * 32 + (c & 31)) * 2; }
__device__ __forceinline__ int v_rd_base(int lane) { return ((lane & 3) << 3) | (((lane >> 2) & 3) << 6) | (((lane >> 4) & 1) << 5) | (((lane >> 5) & 1) << 8); }
constexpr int v_rd_off(int d0, int ks, int half) { return d0 * 512 + ks * 4096 + half * 2048; }
template <int OFF> __device__ __forceinline__ s16x4 tr_read(int vb) {
  s16x4 r; asm volatile("ds_read_b64_tr_b16 %0, %1 offset:%2" : "=&v"(r) : "v"(vb), "i"(OFF) : "memory"); return r;
}
template <int D0> __device__ __forceinline__ void pv_one(f32x16& od, int vb, bf16x8 pa0, bf16x8 pa1, bf16x8 pa2, bf16x8 pa3) {
  const s16x4 l0 = tr_read<v_rd_off(D0, 0, 0)>(vb), h0 = tr_read<v_rd_off(D0, 0, 1)>(vb), l1 = tr_read<v_rd_off(D0, 1, 0)>(vb), h1 = tr_read<v_rd_off(D0, 1, 1)>(vb);
  const s16x4 l2 = tr_read<v_rd_off(D0, 2, 0)>(vb), h2 = tr_read<v_rd_off(D0, 2, 1)>(vb), l3 = tr_read<v_rd_off(D0, 3, 0)>(vb), h3 = tr_read<v_rd_off(D0, 3, 1)>(vb);
  asm volatile("s_waitcnt lgkmcnt(0)" ::: "memory"); ATT_SBAR();
#define ATT_PK(L, H) (bf16x8){L[0], L[1], L[2], L[3], H[0], H[1], H[2], H[3]}
  od = __builtin_amdgcn_mfma_f32_32x32x16_bf16(pa0, ATT_PK(l0, h0), od, 0, 0, 0);
  od = __builtin_amdgcn_mfma_f32_32x32x16_bf16(pa1, ATT_PK(l1, h1), od, 0, 0, 0);
  od = __builtin_amdgcn_mfma_f32_32x32x16_bf16(pa2, ATT_PK(l2, h2), od, 0, 0, 0);
  od = __builtin_amdgcn_mfma_f32_32x32x16_bf16(pa3, ATT_PK(l3, h3), od, 0, 0, 0);
#undef ATT_PK
}
__device__ __forceinline__ void pv_d0(f32x16* o, int vb, bf16x8 pa0, bf16x8 pa1, bf16x8 pa2, bf16x8 pa3) {
  pv_one<0>(o[0], vb, pa0, pa1, pa2, pa3); pv_one<1>(o[1], vb, pa0, pa1, pa2, pa3); pv_one<2>(o[2], vb, pa0, pa1, pa2, pa3); pv_one<3>(o[3], vb, pa0, pa1, pa2, pa3);
}
__device__ __forceinline__ void natten_mod(f32x16& p0, f32x16& p1, int kr, int rq, int qc, const float* biasT, int hi) {
  const int r0 = min(max(rq - 4, 0), 56), c0 = min(max(qc - 8, 0), 48);
  const float NEG = -__builtin_inff();
  if (kr < r0 || kr >= r0 + 8) {
#pragma unroll
    for (int r = 0; r < 16; ++r) { p0[r] = NEG; p1[r] = NEG; }
  } else {
    const float* bl = biasT + (kr - rq + 7) * 128 + (63 - qc + 4 * hi);
    const int t = 4 * hi - c0;
#pragma unroll
    for (int r = 0; r < 16; ++r) {
      const int kcc = (r & 3) + 8 * (r >> 2);
      const bool ok0 = (unsigned)(t + kcc) < 16u, ok1 = (unsigned)(t + kcc + 32) < 16u;
      const float b0 = bl[kcc], b1 = bl[kcc + 32];
      p0[r] = ok0 ? p0[r] + b0 : NEG; p1[r] = ok1 ? p1[r] + b1 : NEG;
      if ((r & 3) == 3) __builtin_amdgcn_sched_barrier(0);
    }
  }
}

template <int DQ, int LDQ, int LDK, int LDV, int LDO, int MODE, int SDEPTH, int NREG>
__device__ __forceinline__ void attn_body(const bf16* __restrict__ Qb, const bf16* __restrict__ Kh, const bf16* __restrict__ Vh, bf16* __restrict__ Ob, const int NT, char* lds,
                                          const int rq0, const int kr_lo, const float* biasT) {
  constexpr int SHM_K = Cst<DQ>::SHM_K, ROWB = Cst<DQ>::ROWB;
  int tid_ = threadIdx.x; asm volatile("" : "+v"(tid_));
  const int tid = tid_, wid = tid >> 6, lane = tid & 63, r32 = lane & 31, hi = lane >> 5;
  char* V_lds = lds; char* K_lds = lds + 2 * SHM_V;
  float* ws = (float*)(lds + 2 * SHM_V + 2 * SHM_K) + wid * 64; float* li_l = ws; float* al_l = ws + 32;
  float m_reg = -1e30f, l_reg = 0; f32x16 o[4] = {}; bf16x8 qr[NREG > 0 ? NREG : 1];
  const bf16* Qw = Qb + (long)(wid * QBLK + r32) * LDQ + hi * 8;
  char* qpark = lds + 2 * SHM_V + 2 * SHM_K + NW * 64 * 4 + wid * ((DQ / 16 - NREG) * 1024) + hi * 512 + r32 * 16;
#pragma unroll
  for (int d0 = 0; d0 < DQ / 16; ++d0) { const bf16x8 qv = *reinterpret_cast<const bf16x8*>(Qw + d0 * 16); if (d0 < NREG) qr[d0 < NREG ? d0 : 0] = qv; else *reinterpret_cast<bf16x8*>(qpark + (d0 - NREG) * 1024) = qv; }
  const int nrq = rq0 + (wid >> 1), nqc = (wid & 1) * 32 + r32;
  const int sr = tid >> 4, sc = (tid & 15) * 8, vst0 = v_st(sr, sc), vst1 = v_st(32 + sr, sc);
  const int kr3 = tid >> 3, kc3 = 128 + (tid & 7) * 8;
  const int vb0 = (int)(uintptr_t)V_lds + v_rd_base(lane);
  struct { bf16x8 vs0, vs1, ks0, ks1, ks2; } sr_[SDEPTH];
#define ATT_LD8(p) (*reinterpret_cast<const bf16x8*>(p))
#define ATT_SLOAD(i, k0) do { sr_[i].vs0 = ATT_LD8(&Vh[(long)((k0) + sr) * LDV + sc]); sr_[i].vs1 = ATT_LD8(&Vh[(long)((k0) + 32 + sr) * LDV + sc]); \
    sr_[i].ks0 = ATT_LD8(&Kh[(long)((k0) + sr) * LDK + sc]); sr_[i].ks1 = ATT_LD8(&Kh[(long)((k0) + 32 + sr) * LDK + sc]); \
    if constexpr (DQ == 192) sr_[i].ks2 = ATT_LD8(&Kh[(long)((k0) + kr3) * LDK + kc3]); } while (0)
#define ATT_SWRITE(b, i) do { *(bf16x8*)(V_lds + (b) * SHM_V + vst0) = sr_[i].vs0;          \
    *(bf16x8*)(V_lds + (b) * SHM_V + vst1) = sr_[i].vs1; const int kc = sc * 2;               \
    *(bf16x8*)(K_lds + (b) * SHM_K + sr * ROWB + (kc ^ ((sr & 7) << 4))) = sr_[i].ks0;                       \
    *(bf16x8*)(K_lds + (b) * SHM_K + (32 + sr) * ROWB + (kc ^ ((sr & 7) << 4))) = sr_[i].ks1; \
    if constexpr (DQ == 192) *(bf16x8*)(K_lds + (b) * SHM_K + kr3 * ROWB + ((kc3 * 2) ^ ((kr3 & 7) << 4))) = sr_[i].ks2; } while (0)
#define ATT_SWAIT() do { if constexpr (SDEPTH == 2) { if constexpr (DQ == 192) asm volatile("s_waitcnt vmcnt(5)" ::: "memory"); else asm volatile("s_waitcnt vmcnt(4)" ::: "memory"); } \
    else asm volatile("s_waitcnt vmcnt(0)" ::: "memory"); } while (0)
#define ATT_RESC(a) do { if (__any((a) < 1.f)) { if (hi == 0) al_l[r32] = (a); asm volatile("s_waitcnt lgkmcnt(0)" ::: "memory"); \
    _Pragma("unroll") for (int d = 0; d < 4; ++d) _Pragma("unroll") for (int r = 0; r < 16; ++r) o[d][r] *= al_l[crow(r, hi)]; } } while (0)
#define ATT_MOD(P0, P1, J) do { if constexpr (MODE == 1) natten_mod(P0, P1, kr_lo + (J), nrq, nqc, biasT, hi); } while (0)
  f32x16 pA0, pA1, pB0, pB1; float mnA, mnB, alA, alB; bf16x8 pa0, pa1, pa2, pa3;
  constexpr int SE = 0, SO = SDEPTH - 1;
  ATT_SLOAD(SE, 0); asm volatile("s_waitcnt vmcnt(0)" ::: "memory"); ATT_SWRITE(0, SE); __syncthreads();
  qkt<DQ, NREG>(pA0, pA1, K_lds, qr, qpark, r32, hi); ATT_MOD(pA0, pA1, 0); partialSM<DQ>(pA0, pA1, m_reg, mnA, alA);
  ATT_SLOAD(SO, KVBLK); if constexpr (SDEPTH == 2) { if (2 < NT) ATT_SLOAD(SE, 2 * KVBLK); }
  ATT_SWAIT(); ATT_SWRITE(1, SO); __syncthreads();
  for (int j = 1; j + 1 < NT; j += 2) {
    ATT_SBAR(); qkt<DQ, NREG>(pB0, pB1, K_lds + SHM_K, qr, qpark, r32, hi); ATT_MOD(pB0, pB1, j);
    finishSM(pA0, pA1, alA, l_reg, pa0, pa1, pa2, pa3); ATT_SBAR();
    ATT_SLOAD(SO, (j + SDEPTH) * KVBLK); ATT_SBAR();
    pv_d0(o, vb0, pa0, pa1, pa2, pa3); partialSM<DQ>(pB0, pB1, m_reg, mnB, alB);
    __syncthreads(); ATT_SWAIT(); ATT_SWRITE(0, SE);
    ATT_RESC(alB); __syncthreads();
    ATT_SBAR(); qkt<DQ, NREG>(pA0, pA1, K_lds, qr, qpark, r32, hi); ATT_MOD(pA0, pA1, j + 1);
    finishSM(pB0, pB1, alB, l_reg, pa0, pa1, pa2, pa3); ATT_SBAR();
    if (SDEPTH == 1 || j + 3 < NT) ATT_SLOAD(SE, (j + 1 + SDEPTH) * KVBLK); ATT_SBAR();
    pv_d0(o, vb0 + SHM_V, pa0, pa1, pa2, pa3); partialSM<DQ>(pA0, pA1, m_reg, mnA, alA);
    __syncthreads(); ATT_SWAIT(); ATT_SWRITE(1, SO);
    ATT_RESC(alA); __syncthreads();
  }
  ATT_SBAR(); qkt<DQ, NREG>(pB0, pB1, K_lds + SHM_K, qr, qpark, r32, hi); ATT_MOD(pB0, pB1, NT - 1);
  finishSM(pA0, pA1, alA, l_reg, pa0, pa1, pa2, pa3); ATT_SBAR();
  pv_d0(o, vb0, pa0, pa1, pa2, pa3); partialSM<DQ>(pB0, pB1, m_reg, mnB, alB);
  __syncthreads(); ATT_RESC(alB);
  finishSM(pB0, pB1, alB, l_reg, pa0, pa1, pa2, pa3); ATT_SBAR();
  pv_d0(o, vb0 + SHM_V, pa0, pa1, pa2, pa3);
  if (hi == 0) li_l[r32] = l_reg; asm volatile("s_waitcnt lgkmcnt(0)" ::: "memory");
  float rli[16];
#pragma unroll
  for (int r = 0; r < 16; ++r) rli[r] = __builtin_amdgcn_rcpf(li_l[crow(r, hi)]);
  bf16* Ow = Ob + (long)(wid * QBLK) * LDO;
#pragma unroll
  for (int r = 0; r < 16; ++r) { const int orow = crow(r, hi);
#pragma unroll
    for (int d0 = 0; d0 < 4; d0 += 1) { const unsigned w = cvtpk(o[d0][r] * rli[r], 0.f); Ow[(long)orow * LDO + d0 * 32 + r32] = (bf16)(w & 0xffffu); } }
#undef ATT_LD8
#undef ATT_SLOAD
#undef ATT_SWRITE
#undef ATT_SWAIT
#undef ATT_RESC
#undef ATT_MOD
}
}

#ifndef PH_MASK
#define PH_MASK 0xFFFFFFFFu
#endif
#define PHON(k) (((PH_MASK) >> (k)) & 1u)
#ifndef REP_MASK
#define REP_MASK 0u
#endif
#define REP(k) (((REP_MASK) >> (k)) & 1u)
#ifndef FFN_F8
#define FFN_F8 7
#endif
#ifndef MOE_CVT_IN_ATTN
#define MOE_CVT_IN_ATTN 1
#endif
constexpr bool F8DG = (FFN_F8 & 1) != 0, F8DD = (FFN_F8 & 4) != 0, F8M = (FFN_F8 & 2) != 0;
constexpr float SC_H = 4.f, SC_ACT = 8.f, SC_W = 256.f;
constexpr int NWAVES = 8;
constexpr int DM = 2048, BATCH = 4, SEQ = 4096, NTOK = BATCH * SEQ, DEPTH = 2;
constexpr int DIN = 3904, DINP = 4096;
constexpr int DFF = 5632, NE = 8, DFE = 7168;
constexpr int PC_QA = 0, PC_KA = 512, PC_VA = 1024, PC_QB = 1536, PC_KB = 2560, PC_VB = 2816, PC_CQ = 3072, PC_CKV = 3584, PC_KPE = 3840;
constexpr float EPS = 1e-6f;
constexpr int MAXTILES = 136;
constexpr int MAXSLOTS = MAXTILES * 256;

constexpr size_t MiB = 1u << 20;
constexpr size_t WS_CTL = 0, CTL_ZERO_BYTES = 1 * MiB;
constexpr size_t WS_WIN = 1 * MiB;
constexpr size_t WS_WUQ = WS_WIN + 32 * MiB;
constexpr size_t WS_WUKV = WS_WUQ + 2 * MiB;
constexpr size_t WS_WOUT = WS_WUKV + 1 * MiB;
constexpr size_t WS_WGU = WS_WOUT + 16 * MiB;
constexpr size_t WS_WD = WS_WGU + 44 * MiB;
constexpr size_t WS_WEGU = WS_WD + 22 * MiB;
constexpr size_t WS_WED = WS_WEGU + 448 * MiB;
constexpr size_t WS_H = WS_WED + 224 * MiB;
constexpr size_t WS_ACT0 = WS_H + 64 * MiB;
constexpr size_t WS_PROJ = WS_ACT0;
constexpr size_t WS_QA = WS_PROJ + 128 * MiB;
constexpr size_t WS_KA = WS_QA + 16 * MiB;
constexpr size_t WS_QB = WS_KA + 16 * MiB;
constexpr size_t WS_KB = WS_QB + 32 * MiB;
constexpr size_t WS_CQN = WS_KB + 8 * MiB;
constexpr size_t WS_CKVN = WS_CQN + 16 * MiB;
constexpr size_t WS_KPE = WS_CKVN + 8 * MiB;
constexpr size_t WS_QCR = WS_KPE + 2 * MiB;
constexpr size_t WS_KVR = WS_QCR + 24 * MiB;
constexpr size_t WS_QC = WS_KVR + 32 * MiB;
constexpr size_t WS_KC = WS_QC + 24 * MiB;
constexpr size_t WS_O = WS_KC + 24 * MiB;
constexpr size_t WS_ON = WS_O + 64 * MiB;
constexpr size_t WS_ATT_END = WS_ON + 64 * MiB;
constexpr size_t WS_ACT = WS_ACT0;
constexpr size_t WS_HG = WS_ACT0;
constexpr size_t WS_ACTM = WS_HG + 136 * MiB;
constexpr size_t WS_Y = WS_ACTM + 476 * MiB;
constexpr size_t WS_RGATE = WS_Y + 136 * MiB;
constexpr size_t WS_TOKE = WS_RGATE + 1 * MiB;
constexpr size_t WS_TOKP = WS_TOKE + 1 * MiB;
constexpr size_t WS_TOKW = WS_TOKP + 1 * MiB;
constexpr size_t WS_END = WS_TOKW + 1 * MiB;
constexpr size_t WS_XB = WS_END;
constexpr size_t WS_END2 = WS_XB + 64 * MiB;
constexpr size_t WS_DUMMY = WS_END2;
static_assert(WS_ATT_END <= WS_END, "map");
constexpr int CW_CNT = 64;
constexpr int CW_BAR = 4096;

constexpr int RING_BYTES = 131072;
constexpr int LDS_BYTES = 163840;
constexpr int MISC_OFF = LDS_BYTES - 256;

#define GAS __attribute__((address_space(1)))
#define LAS __attribute__((address_space(3)))
typedef unsigned short bf16;
typedef unsigned v4u __attribute__((ext_vector_type(4)));
typedef unsigned v2u __attribute__((ext_vector_type(2)));
typedef float f32x4 __attribute__((ext_vector_type(4)));
typedef float f32x2 __attribute__((ext_vector_type(2)));
__device__ __forceinline__ unsigned pk2(float lo, float hi) { unsigned r; asm volatile("v_cvt_pk_bf16_f32 %0, %1, %2" : "=v"(r) : "v"(lo), "v"(hi)); return r; }
__device__ __forceinline__ float bf_lo(unsigned w) { return __uint_as_float(w << 16); }
__device__ __forceinline__ float bf_hi(unsigned w) { return __uint_as_float(w & 0xffff0000u); }
__device__ __forceinline__ float wave_sum(float v) {
#pragma unroll
    for (int o = 1; o < 64; o <<= 1) v += __shfl_xor(v, o);
    return v;
}
__device__ __forceinline__ float rsq(float x) { return __builtin_amdgcn_rsqf(x); }
#define XB_TMO      128
#define XB_XCNT(j)  (256  + 64 * (j))
#define XB_XSUB(j)  (1280 + 64 * (j))
#define XB_XGEN(j)  (2304 + 64 * (j))
#define XB_TOP      3328
#define XB_TOPGEN   3392
#define XCD_BAR_WORDS 3456
#define XB_SPIN_CAP (1u << 18)

__device__ __forceinline__ unsigned xb_ld(unsigned* p)              { return __hip_atomic_load(p, __ATOMIC_RELAXED, __HIP_MEMORY_SCOPE_AGENT); }
__device__ __forceinline__ unsigned xb_add(unsigned* p, unsigned v) { return __hip_atomic_fetch_add(p, v, __ATOMIC_RELAXED, __HIP_MEMORY_SCOPE_AGENT); }
__device__ __forceinline__ unsigned xb_xcc_id() { return (unsigned)__builtin_amdgcn_s_getreg((3 << 11) | 20) & 0xFu; }
#define XB_SPIN(cond, bar) do { unsigned _sp = 0; while (cond) { __builtin_amdgcn_s_sleep(1); \
    if ((++_sp & 255u) == 0u) { if (xb_ld(&(bar)[XB_TMO])) break; if (_sp > XB_SPIN_CAP) { atomicAdd(&(bar)[XB_TMO], 1u); break; } } } } while (0)

struct XcdBarrier {
    unsigned* bar; unsigned x;
    volatile LAS unsigned* st;
};

__device__ __forceinline__ XcdBarrier xcd_barrier_post(unsigned* bar, volatile LAS unsigned* st) {
    XcdBarrier b; b.bar = bar; b.x = xb_xcc_id(); b.st = st;
    if (threadIdx.x == 0) (void)xb_add(&bar[XB_XCNT(b.x)], 1u);
    return b;
}
__device__ __forceinline__ void xcd_barrier_complete(unsigned* bar, unsigned x, unsigned& nloc, unsigned& nx) {
    const unsigned G = gridDim.x * gridDim.y * gridDim.z;
    unsigned sum, cnt, mine, sp = 0u;
    for (;;) {
        sum = 0u; cnt = 0u; mine = 0u;
#pragma unroll
        for (unsigned j = 0; j < 16; ++j) { const unsigned c = xb_ld(&bar[XB_XCNT(j)]); sum += c; cnt += (c > 0u) ? 1u : 0u; mine = (j == x) ? c : mine; }
        if (sum == G) break;
        __builtin_amdgcn_s_sleep(1);
        if ((++sp & 255u) == 0u) { if (xb_ld(&bar[XB_TMO])) break; if (sp > XB_SPIN_CAP) { atomicAdd(&bar[XB_TMO], 1u); break; } }
    }
    nloc = mine > 0u ? mine : 1u; nx = cnt > 0u ? cnt : 1u;
}

__device__ __forceinline__ void xcd_barrier(const XcdBarrier& b) {
    asm volatile("s_waitcnt vmcnt(0)" ::: "memory");
    __syncthreads();
    if (threadIdx.x == 0) {
        unsigned* bar = b.bar;
        __builtin_amdgcn_s_waitcnt(0);
        unsigned nloc = b.st[0], nx = b.st[1];
        if (nloc == 0u) { xcd_barrier_complete(bar, b.x, nloc, nx); b.st[0] = nloc; b.st[1] = nx; }
        const unsigned old = xb_add(&bar[XB_XSUB(b.x)], 1u);
        const unsigned gen = old / nloc;
        if (old + 1u == (gen + 1u) * nloc) {
            __builtin_amdgcn_fence(__ATOMIC_RELEASE, "agent");
            asm volatile("s_waitcnt vmcnt(0)" ::: "memory");
            const unsigned og = xb_add(&bar[XB_TOP], 1u);
            const unsigned tg = og / nx;
            if (og + 1u == (tg + 1u) * nx) xb_add(&bar[XB_TOPGEN], 1u);
            else XB_SPIN(xb_ld(&bar[XB_TOPGEN]) == tg, bar);
            __builtin_amdgcn_fence(__ATOMIC_ACQUIRE, "agent");
            xb_add(&bar[XB_XGEN(b.x)], 1u);
            asm volatile("s_waitcnt vmcnt(0)" ::: "memory");
        } else {
            XB_SPIN(xb_ld(&bar[XB_XGEN(b.x)]) == gen, bar);
            __builtin_amdgcn_fence(__ATOMIC_ACQUIRE, "agent");
            asm volatile("s_waitcnt vmcnt(0)" ::: "memory");
        }
    }
    __syncthreads();
}

struct Args { const float* in[26]; float* out; unsigned char* ws; int ph_lo, ph_hi; };
enum { I_X = 0, I_MIXN, I_WIN, I_RPB, I_QNA, I_KNA, I_QNB, I_KNB, I_CQN, I_CKVN, I_WUQ, I_WUKV, I_QNC, I_KNC, I_ONA, I_ONB, I_ONC, I_WOUT, I_FFNN, I_WG, I_WU, I_WDN, I_ROUTER, I_WEG, I_WEU, I_WED };
struct Frame {
    LAS unsigned char* lds; unsigned char* ws; unsigned* ctl;
    int wave, G, bid, gw, ngw;
};

__device__ __forceinline__ void transpose_item(const float* __restrict__ W, int K, int N, bf16* __restrict__ WT, int row_off, int mode, LAS float* scr, int item, int lane) {
    (void)scr;
    const int nblk = N >> 5, kb = item / nblk, nb = item - kb * nblk, k0 = kb << 6, n0 = nb << 5; const int c = lane >> 3, q = lane & 7;
    const float* p = W + (size_t)(k0 + 8 * c) * N + n0 + 4 * q;
    f32x4 v[8];
#pragma unroll
    for (int i = 0; i < 8; ++i) v[i] = *(const f32x4*)(p + (size_t)i * N);
    const int drow0 = (mode == 0) ? (row_off + n0) : (row_off + (n0 >> 7) * 256 + (mode - 1) * 128 + (n0 & 127));
    bf16* d = WT + (size_t)(drow0 + 4 * q) * K + k0 + 8 * c;
#pragma unroll
    for (int j = 0; j < 4; ++j) { v4u o; o.x = pk2(v[0][j], v[1][j]); o.y = pk2(v[2][j], v[3][j]); o.z = pk2(v[4][j], v[5][j]); o.w = pk2(v[6][j], v[7][j]); *(v4u*)(d + (size_t)j * K) = o; }
}

__device__ __forceinline__ unsigned pk4_fp8(float a, float b, float c, float d) { unsigned w = 0u; w = __builtin_amdgcn_cvt_pk_fp8_f32(a, b, w, false); w = __builtin_amdgcn_cvt_pk_fp8_f32(c, d, w, true); return w; }
__device__ __forceinline__ void transpose_item_f8(const float* __restrict__ W, int K, int N, unsigned char* __restrict__ WT, int row_off, int mode, float wsc, LAS float* scr, int item, int lane) {
    (void)scr;
    const int nblk = N >> 5, kb = item / nblk, nb = item - kb * nblk, k0 = kb << 7, n0 = nb << 5; const int c = lane >> 3, q = lane & 7;
    const float* p = W + (size_t)(k0 + 16 * c) * N + n0 + 4 * q;
    f32x4 v[16];
#pragma unroll
    for (int i = 0; i < 16; ++i) v[i] = *(const f32x4*)(p + (size_t)i * N);
    const int drow0 = (mode == 0) ? (row_off + n0) : (row_off + (n0 >> 7) * 256 + (mode - 1) * 128 + (n0 & 127));
    unsigned char* d = WT + (size_t)(drow0 + 4 * q) * K + k0 + 16 * c;
#pragma unroll
    for (int j = 0; j < 4; ++j) {
        v4u o; o.x = pk4_fp8(v[0][j] * wsc, v[1][j] * wsc, v[2][j] * wsc, v[3][j] * wsc); o.y = pk4_fp8(v[4][j] * wsc, v[5][j] * wsc, v[6][j] * wsc, v[7][j] * wsc);
        o.z = pk4_fp8(v[8][j] * wsc, v[9][j] * wsc, v[10][j] * wsc, v[11][j] * wsc); o.w = pk4_fp8(v[12][j] * wsc, v[13][j] * wsc, v[14][j] * wsc, v[15][j] * wsc);
        *(v4u*)(d + (size_t)j * K) = o; }
}

template <bool SRCB>
__device__ __forceinline__ void load_row32(const void* __restrict__ row, int lane, float (&v)[4][8]) {
    if constexpr (SRCB) { const v4u* p = (const v4u*)row + lane;
#pragma unroll
        for (int j = 0; j < 4; ++j) { const v4u w = p[64 * j]; v[j][0] = bf_lo(w.x); v[j][1] = bf_hi(w.x); v[j][2] = bf_lo(w.y); v[j][3] = bf_hi(w.y); v[j][4] = bf_lo(w.z); v[j][5] = bf_hi(w.z); v[j][6] = bf_lo(w.w); v[j][7] = bf_hi(w.w); }
    } else { const f32x4* p = (const f32x4*)row + 2 * lane;
#pragma unroll
        for (int j = 0; j < 4; ++j) { const f32x4 a = p[128 * j], b = p[128 * j + 1]; v[j][0] = a[0]; v[j][1] = a[1]; v[j][2] = a[2]; v[j][3] = a[3]; v[j][4] = b[0]; v[j][5] = b[1]; v[j][6] = b[2]; v[j][7] = b[3]; }
    }
}
__device__ __forceinline__ void load_gain32(const float* __restrict__ gain, int lane, float osc, float (&g)[4][8]) {
    const f32x4* p = (const f32x4*)gain + 2 * lane;
#pragma unroll
    for (int j = 0; j < 4; ++j) { const f32x4 a = p[128 * j], b = p[128 * j + 1]; g[j][0] = a[0] * osc; g[j][1] = a[1] * osc; g[j][2] = a[2] * osc; g[j][3] = a[3] * osc; g[j][4] = b[0] * osc; g[j][5] = b[1] * osc; g[j][6] = b[2] * osc; g[j][7] = b[3] * osc; }
}
template <bool F8OUT, bool SRCB>
__device__ __forceinline__ void phase_rmsnorm(const Frame& F, const void* __restrict__ src, const float* __restrict__ gain, void* __restrict__ dstv, float osc) {
    int tid_ = threadIdx.x; asm volatile("" : "+v"(tid_)); const int tid = tid_, lane = tid & 63; (void)tid; (void)lane;
    float g[4][8]; load_gain32(gain, lane, osc, g);
    for (int m = F.gw; m < NTOK; m += F.ngw) {
        float v[4][8]; load_row32<SRCB>((const unsigned char*)src + (size_t)m * DM * (SRCB ? 2 : 4), lane, v); float s = 0.f;
#pragma unroll
        for (int j = 0; j < 4; ++j)
#pragma unroll
            for (int i = 0; i < 8; ++i) s += v[j][i] * v[j][i];
        const float rstd = rsq(wave_sum(s) * (1.f / DM) + EPS);
        if constexpr (F8OUT) { v2u* o8 = (v2u*)((unsigned char*)dstv + (size_t)m * DM) + lane;
#pragma unroll
            for (int j = 0; j < 4; ++j) { v2u w; w.x = pk4_fp8(v[j][0] * rstd * g[j][0], v[j][1] * rstd * g[j][1], v[j][2] * rstd * g[j][2], v[j][3] * rstd * g[j][3]);
                w.y = pk4_fp8(v[j][4] * rstd * g[j][4], v[j][5] * rstd * g[j][5], v[j][6] * rstd * g[j][6], v[j][7] * rstd * g[j][7]); o8[64 * j] = w; }
        } else { v4u* o16 = (v4u*)((bf16*)dstv + (size_t)m * DM) + lane;
#pragma unroll
            for (int j = 0; j < 4; ++j) { v4u w; w.x = pk2(v[j][0] * rstd * g[j][0], v[j][1] * rstd * g[j][1]); w.y = pk2(v[j][2] * rstd * g[j][2], v[j][3] * rstd * g[j][3]);
                w.z = pk2(v[j][4] * rstd * g[j][4], v[j][5] * rstd * g[j][5]); w.w = pk2(v[j][6] * rstd * g[j][6], v[j][7] * rstd * g[j][7]); o16[64 * j] = w; } }
    }
}

__device__ __forceinline__ float rope_apply(float v, float c, float s, float sgn) { const float p = __shfl_xor(v, 16); return v * c + sgn * p * s; }
__device__ __forceinline__ void sincos_rev(float ang, float& s, float& c) { const float r = ang * 0.15915494309189535f; const float f = r - floorf(r); s = __builtin_amdgcn_sinf(f); c = __builtin_amdgcn_cosf(f); }

__device__ __forceinline__ void phase_postproj(const Frame& F, const Args& a, int l) {
    int tid_ = threadIdx.x; asm volatile("" : "+v"(tid_)); const int tid = tid_, lane = tid & 63; (void)tid; (void)lane;
    const bf16* PROJ = (const bf16*)(F.ws + WS_PROJ);
    bf16* QA = (bf16*)(F.ws + WS_QA); bf16* KA = (bf16*)(F.ws + WS_KA); bf16* QB = (bf16*)(F.ws + WS_QB); bf16* KB = (bf16*)(F.ws + WS_KB);
    bf16* CQN = (bf16*)(F.ws + WS_CQN); bf16* CKVN = (bf16*)(F.ws + WS_CKVN); bf16* KPE = (bf16*)(F.ws + WS_KPE);
    const f32x2 gqa = ((const f32x2*)(a.in[I_QNA] + l * 128))[lane], gka = ((const f32x2*)(a.in[I_KNA] + l * 128))[lane];
    const f32x2 gqb = ((const f32x2*)(a.in[I_QNB] + l * 128))[lane], gkb = ((const f32x2*)(a.in[I_KNB] + l * 128))[lane];
    const f32x4 gcq0 = ((const f32x4*)(a.in[I_CQN] + l * 512))[2 * lane], gcq1 = ((const f32x4*)(a.in[I_CQN] + l * 512))[2 * lane + 1];
    const f32x4 gckv = ((const f32x4*)(a.in[I_CKVN] + l * 256))[lane];
    const float gkpe = a.in[I_KNC][l * 192 + 128 + lane];
    constexpr float LOG2T = 13.287712379549449f;
    const int q = lane & 15;
    const float f128a = __builtin_amdgcn_exp2f(-(float)(2 * q) * (LOG2T / 32.f)), f128b = __builtin_amdgcn_exp2f(-(float)(2 * q + 1) * (LOG2T / 32.f));
    const float f64 = __builtin_amdgcn_exp2f(-(float)q * (LOG2T / 16.f));
    const float sgn = (lane & 16) ? 1.f : -1.f;
    for (int t = F.gw; t < NTOK; t += F.ngw) {
        const int pos = t & (SEQ - 1); const float p = (float)((lane & 32) ? (pos & 63) : (pos >> 6));
        float s0, c0, s1, c1, s2, c2; sincos_rev(p * f128a, s0, c0); sincos_rev(p * f128b, s1, c1); sincos_rev(p * f64, s2, c2);
        const bf16* pr = PROJ + (size_t)t * DINP;
        unsigned hv[18];
#pragma unroll
        for (int i = 0; i < 8; ++i) hv[i] = ((const unsigned*)(pr + i * 128))[lane];
#pragma unroll
        for (int i = 8; i < 18; ++i) hv[i] = ((const unsigned*)(pr + PC_QB + (i - 8) * 128))[lane];
        const v4u cqv = ((const v4u*)(pr + PC_CQ))[lane]; const v2u ckvv = ((const v2u*)(pr + PC_CKV))[lane]; const unsigned kpev = (unsigned)pr[PC_KPE + lane];
#pragma unroll
        for (int i = 0; i < 18; ++i) {
            float v0 = bf_lo(hv[i]), v1 = bf_hi(hv[i]);
            const float rstd = rsq(wave_sum(v0 * v0 + v1 * v1) * (1.f / 128.f) + EPS);
            const f32x2 g = (i < 4) ? gqa : (i < 8) ? gka : (i < 16) ? gqb : gkb;
            v0 = v0 * rstd * g[0]; v1 = v1 * rstd * g[1];
            if (i >= 8) { v0 = rope_apply(v0, c0, s0, sgn); v1 = rope_apply(v1, c1, s1, sgn); }
            bf16* dst = (i < 4) ? (QA + (size_t)t * 512 + i * 128) : (i < 8) ? (KA + (size_t)t * 512 + (i - 4) * 128) : (i < 16) ? (QB + (size_t)t * 1024 + (i - 8) * 128) : (KB + (size_t)t * 256 + (i - 16) * 128);
            ((unsigned*)dst)[lane] = pk2(v0, v1);
        }
        {
            float x[8] = {bf_lo(cqv.x), bf_hi(cqv.x), bf_lo(cqv.y), bf_hi(cqv.y), bf_lo(cqv.z), bf_hi(cqv.z), bf_lo(cqv.w), bf_hi(cqv.w)}; float s = 0.f;
#pragma unroll
            for (int i = 0; i < 8; ++i) s += x[i] * x[i];
            const float rstd = rsq(wave_sum(s) * (1.f / 512.f) + EPS);
            v4u w; w.x = pk2(x[0] * rstd * gcq0[0], x[1] * rstd * gcq0[1]); w.y = pk2(x[2] * rstd * gcq0[2], x[3] * rstd * gcq0[3]);
            w.z = pk2(x[4] * rstd * gcq1[0], x[5] * rstd * gcq1[1]); w.w = pk2(x[6] * rstd * gcq1[2], x[7] * rstd * gcq1[3]);
            ((v4u*)(CQN + (size_t)t * 512))[lane] = w;
        }
        {
            const float x0 = bf_lo(ckvv.x), x1 = bf_hi(ckvv.x), x2 = bf_lo(ckvv.y), x3 = bf_hi(ckvv.y);
            const float rstd = rsq(wave_sum((x0 * x0 + x1 * x1) + (x2 * x2 + x3 * x3)) * (1.f / 256.f) + EPS);
            v2u w; w.x = pk2(x0 * rstd * gckv[0], x1 * rstd * gckv[1]); w.y = pk2(x2 * rstd * gckv[2], x3 * rstd * gckv[3]);
            ((v2u*)(CKVN + (size_t)t * 256))[lane] = w;
        }
        {
            float x = bf_lo(kpev);
            const float rstd = rsq(wave_sum(x * x) * (1.f / 64.f) + EPS);
            x = rope_apply(x * rstd * gkpe, c2, s2, sgn);
            KPE[(size_t)t * 64 + lane] = (bf16)(pk2(x, 0.f) & 0xffffu);
        }
    }
}

__device__ __forceinline__ void phase_postmla(const Frame& F, const Args& a, int l) {
    int tid_ = threadIdx.x; asm volatile("" : "+v"(tid_)); const int tid = tid_, lane = tid & 63; (void)tid; (void)lane;
    const bf16* QCR = (const bf16*)(F.ws + WS_QCR); const bf16* KVR = (const bf16*)(F.ws + WS_KVR); const bf16* KPE = (const bf16*)(F.ws + WS_KPE);
    bf16* QC = (bf16*)(F.ws + WS_QC); bf16* KC = (bf16*)(F.ws + WS_KC);
    const f32x2 gqn = ((const f32x2*)(a.in[I_QNC] + l * 192))[lane], gkn = ((const f32x2*)(a.in[I_KNC] + l * 192))[lane];
    const float gqpe = a.in[I_QNC][l * 192 + 128 + lane];
    constexpr float LOG2T = 13.287712379549449f;
    const float f64 = __builtin_amdgcn_exp2f(-(float)(lane & 15) * (LOG2T / 16.f));
    const float sgn = (lane & 16) ? 1.f : -1.f;
    for (int t = F.gw; t < NTOK; t += F.ngw) {
        const int pos = t & (SEQ - 1); const float p = (float)((lane & 32) ? (pos & 63) : (pos >> 6));
        float s2, c2; sincos_rev(p * f64, s2, c2);
        const bf16* qr = QCR + (size_t)t * 768; const bf16* kr = KVR + (size_t)t * 1024;
        unsigned qn[4], kn[4]; unsigned qp[4];
#pragma unroll
        for (int h = 0; h < 4; ++h) { qn[h] = ((const unsigned*)(qr + h * 192))[lane]; qp[h] = (unsigned)qr[h * 192 + 128 + lane]; kn[h] = ((const unsigned*)(kr + h * 256))[lane]; }
        const bf16 kpe = KPE[(size_t)t * 64 + lane];
#pragma unroll
        for (int h = 0; h < 4; ++h) {
            { float v0 = bf_lo(qn[h]), v1 = bf_hi(qn[h]); const float rstd = rsq(wave_sum(v0 * v0 + v1 * v1) * (1.f / 128.f) + EPS);
              ((unsigned*)(QC + (size_t)t * 768 + h * 192))[lane] = pk2(v0 * rstd * gqn[0], v1 * rstd * gqn[1]); }
            { float x = bf_lo(qp[h]); const float rstd = rsq(wave_sum(x * x) * (1.f / 64.f) + EPS); x = rope_apply(x * rstd * gqpe, c2, s2, sgn);
              QC[(size_t)t * 768 + h * 192 + 128 + lane] = (bf16)(pk2(x, 0.f) & 0xffffu); }
            { float v0 = bf_lo(kn[h]), v1 = bf_hi(kn[h]); const float rstd = rsq(wave_sum(v0 * v0 + v1 * v1) * (1.f / 128.f) + EPS);
              ((unsigned*)(KC + (size_t)t * 768 + h * 192))[lane] = pk2(v0 * rstd * gkn[0], v1 * rstd * gkn[1]); }
            KC[(size_t)t * 768 + h * 192 + 128 + lane] = kpe;
        }
    }
}

__device__ __forceinline__ void phase_groupnorm(const Frame& F, const Args& a, int l) {
    int tid_ = threadIdx.x; asm volatile("" : "+v"(tid_)); const int tid = tid_, lane = tid & 63; (void)tid; (void)lane;
    const bf16* O = (const bf16*)(F.ws + WS_O); bf16* ON = (bf16*)(F.ws + WS_ON);
    f32x4 g[4][2];
    { const f32x4* ga = (const f32x4*)(a.in[I_ONA] + l * 512); const f32x4* gb = (const f32x4*)(a.in[I_ONB] + l * 1024); const f32x4* gc = (const f32x4*)(a.in[I_ONC] + l * 512);
      g[0][0] = ga[2 * lane]; g[0][1] = ga[2 * lane + 1]; g[1][0] = gb[2 * lane]; g[1][1] = gb[2 * lane + 1]; g[2][0] = gb[128 + 2 * lane]; g[2][1] = gb[128 + 2 * lane + 1]; g[3][0] = gc[2 * lane]; g[3][1] = gc[2 * lane + 1]; }
    for (int t = F.gw; t < NTOK; t += F.ngw) {
        const v4u* orow = (const v4u*)(O + (size_t)t * DM) + lane; float x[4][8]; float ss[4];
#pragma unroll
        for (int j = 0; j < 4; ++j) { const v4u w = orow[64 * j]; x[j][0] = bf_lo(w.x); x[j][1] = bf_hi(w.x); x[j][2] = bf_lo(w.y); x[j][3] = bf_hi(w.y); x[j][4] = bf_lo(w.z); x[j][5] = bf_hi(w.z); x[j][6] = bf_lo(w.w); x[j][7] = bf_hi(w.w);
            float s = 0.f;
#pragma unroll
            for (int i = 0; i < 8; ++i) s += x[j][i] * x[j][i];
            ss[j] = s; }
        const float ra = rsq(wave_sum(ss[0]) * (1.f / 512.f) + EPS), rb = rsq(wave_sum(ss[1] + ss[2]) * (1.f / 1024.f) + EPS), rc = rsq(wave_sum(ss[3]) * (1.f / 512.f) + EPS);
        v4u* nrow = (v4u*)(ON + (size_t)t * DM) + lane;
#pragma unroll
        for (int j = 0; j < 4; ++j) { const float r = (j == 0) ? ra : (j == 3) ? rc : rb; v4u w;
            w.x = pk2(x[j][0] * r * g[j][0][0], x[j][1] * r * g[j][0][1]); w.y = pk2(x[j][2] * r * g[j][0][2], x[j][3] * r * g[j][0][3]);
            w.z = pk2(x[j][4] * r * g[j][1][0], x[j][5] * r * g[j][1][1]); w.w = pk2(x[j][6] * r * g[j][1][2], x[j][7] * r * g[j][1][3]); nrow[64 * j] = w; }
    }
}

constexpr int ROUTER_LDS = 0;
constexpr int MOE_LDS_CNT = 65536;
constexpr int MOE_LDS_REC = 65536 + 64;
template <bool F8OUT, bool SRCB>
__device__ __forceinline__ void phase_ffnnorm_route(const Frame& F, const Args& a, const void* __restrict__ src, const float* __restrict__ gain, void* __restrict__ dstv, float osc) {
    int tid_ = threadIdx.x; asm volatile("" : "+v"(tid_)); const int tid = tid_, lane = tid & 63; (void)tid; (void)lane;
    LAS float* rt = (LAS float*)(F.lds + ROUTER_LDS); LAS unsigned* lcnt = (LAS unsigned*)(F.lds + MOE_LDS_CNT); LAS int* rec = (LAS int*)(F.lds + MOE_LDS_REC);
    const float* router = a.in[I_ROUTER];
    for (int i = tid; i < DM * NE / 4; i += NWAVES * 64) ((LAS f32x4*)rt)[i] = ((const f32x4*)router)[i];
    if (tid < 16) lcnt[tid] = 0u;
    __syncthreads();
    const int t0 = (int)(((long)F.bid * NTOK) / F.G), t1 = (int)(((long)(F.bid + 1) * NTOK) / F.G);
    float g[4][8]; load_gain32(gain, lane, 1.f, g);
    for (int m = t0 + F.wave; m < t1; m += NWAVES) {
        float v[4][8]; load_row32<SRCB>((const unsigned char*)src + (size_t)m * DM * (SRCB ? 2 : 4), lane, v); float s = 0.f;
#pragma unroll
        for (int j = 0; j < 4; ++j)
#pragma unroll
            for (int i = 0; i < 8; ++i) s += v[j][i] * v[j][i];
        const float rstd = rsq(wave_sum(s) * (1.f / DM) + EPS);
        v4u* o16 = (v4u*)((bf16*)dstv + (size_t)m * DM) + lane; v2u* o8 = (v2u*)((unsigned char*)dstv + (size_t)m * DM) + lane;
        float lg[8] = {0.f, 0.f, 0.f, 0.f, 0.f, 0.f, 0.f, 0.f};
#pragma unroll
        for (int j = 0; j < 4; ++j) {
            float h[8];
#pragma unroll
            for (int i = 0; i < 8; ++i) h[i] = v[j][i] * rstd * g[j][i];
            if constexpr (F8OUT) { v2u w; w.x = pk4_fp8(h[0] * osc, h[1] * osc, h[2] * osc, h[3] * osc); w.y = pk4_fp8(h[4] * osc, h[5] * osc, h[6] * osc, h[7] * osc); o8[64 * j] = w; }
            else { v4u w; w.x = pk2(h[0], h[1]); w.y = pk2(h[2], h[3]); w.z = pk2(h[4], h[5]); w.w = pk2(h[6], h[7]); o16[64 * j] = w; }
            const int k0 = 512 * j + 8 * lane;
#pragma unroll
            for (int i = 0; i < 8; ++i) { const f32x4 r0 = ((const LAS f32x4*)(rt + (k0 + i) * 8))[0], r1 = ((const LAS f32x4*)(rt + (k0 + i) * 8))[1];
                lg[0] += h[i] * r0[0]; lg[1] += h[i] * r0[1]; lg[2] += h[i] * r0[2]; lg[3] += h[i] * r0[3]; lg[4] += h[i] * r1[0]; lg[5] += h[i] * r1[1]; lg[6] += h[i] * r1[2]; lg[7] += h[i] * r1[3]; }
        }
#pragma unroll
        for (int e = 0; e < 8; ++e) lg[e] = wave_sum(lg[e]);
        int e0 = 0; float v0 = lg[0];
#pragma unroll
        for (int e = 1; e < 8; ++e) if (lg[e] > v0) { v0 = lg[e]; e0 = e; }
        int e1 = -1; float v1 = -3.0e38f;
#pragma unroll
        for (int e = 0; e < 8; ++e) if (e != e0 && lg[e] > v1) { v1 = lg[e]; e1 = e; }
        const float ex = __expf(v1 - v0), w0 = 1.f / (1.f + ex), w1 = ex * w0;
        if (lane == 0) { const int li = m - t0; const unsigned p0 = atomicAdd((unsigned*)&lcnt[e0], 1u), p1 = atomicAdd((unsigned*)&lcnt[e1], 1u);
            rec[li * 6 + 0] = e0; rec[li * 6 + 1] = e1; rec[li * 6 + 2] = (int)p0; rec[li * 6 + 3] = (int)p1; ((LAS float*)rec)[li * 6 + 4] = w0; ((LAS float*)rec)[li * 6 + 5] = w1; }
    }
    __syncthreads();
    if (tid < 8) lcnt[8 + tid] = __hip_atomic_fetch_add(F.ctl + CW_CNT + tid, lcnt[tid], __ATOMIC_RELAXED, __HIP_MEMORY_SCOPE_AGENT);
    __syncthreads();
    int* toke = (int*)(F.ws + WS_TOKE); int* tokp = (int*)(F.ws + WS_TOKP); float* tokw = (float*)(F.ws + WS_TOKW);
    for (int i = tid; i < (t1 - t0) * 2; i += NWAVES * 64) { const int li = i >> 1, k = i & 1, e = rec[li * 6 + k];
        toke[(size_t)(t0 + li) * 2 + k] = e; tokp[(size_t)(t0 + li) * 2 + k] = rec[li * 6 + 2 + k] + (int)lcnt[8 + e]; tokw[(size_t)(t0 + li) * 2 + k] = ((LAS float*)rec)[li * 6 + 4 + k]; }
    __syncthreads();
}
__device__ __forceinline__ void moe_tiles(const Frame& F, int (&tb)[9], int (&cnt)[8]) {
    int acc = 0;
#pragma unroll
    for (int e = 0; e < 8; ++e) { cnt[e] = (int)__hip_atomic_load(F.ctl + CW_CNT + e, __ATOMIC_RELAXED, __HIP_MEMORY_SCOPE_AGENT); tb[e] = acc; acc += (cnt[e] + 255) >> 8; }
    tb[8] = acc;
}
template <bool F8ROWS>
__device__ __forceinline__ void phase_gather(const Frame& F) {
    int tid_ = threadIdx.x; asm volatile("" : "+v"(tid_)); const int tid = tid_, lane = tid & 63; (void)tid; (void)lane;
    int tb[9], cnt[8]; moe_tiles(F, tb, cnt);
    constexpr int RBYTES = F8ROWS ? DM : 2 * DM, NCH = RBYTES / 1024;
    const unsigned char* H = (const unsigned char*)(F.ws + WS_H); unsigned char* HG = (unsigned char*)(F.ws + WS_HG); float* rg = (float*)(F.ws + WS_RGATE);
    const int* toke = (const int*)(F.ws + WS_TOKE); int* tokp = (int*)(F.ws + WS_TOKP); const float* tokw = (const float*)(F.ws + WS_TOKW);
    for (int t = F.gw; t < NTOK; t += F.ngw) {
        const v4u* hr = (const v4u*)(H + (size_t)t * RBYTES) + lane; v4u v[NCH];
#pragma unroll
        for (int j = 0; j < NCH; ++j) v[j] = hr[64 * j];
#pragma unroll
        for (int k = 0; k < 2; ++k) { const int e = toke[(size_t)t * 2 + k], p = tokp[(size_t)t * 2 + k]; int base = 0;
#pragma unroll
            for (int q = 0; q < 8; ++q) base = (q == e) ? tb[q] : base;
            const int slot = base * 256 + p; v4u* dr = (v4u*)(HG + (size_t)slot * RBYTES) + lane;
#pragma unroll
            for (int j = 0; j < NCH; ++j) dr[64 * j] = v[j];
            if (lane == 0) { rg[slot] = tokw[(size_t)t * 2 + k]; tokp[(size_t)t * 2 + k] = slot; } }
    }
#pragma unroll
    for (int e = 0; e < 8; ++e) { const int r0 = tb[e] * 256 + cnt[e], r1 = tb[e + 1] * 256;
        for (int r = r0 + F.gw; r < r1; r += F.ngw) { v4u* dr = (v4u*)(HG + (size_t)r * RBYTES) + lane; const v4u z = {0u, 0u, 0u, 0u};
#pragma unroll
            for (int j = 0; j < NCH; ++j) dr[64 * j] = z;
            if (lane == 0) rg[r] = 0.f; } }
}
template <bool XBF>
__device__ __forceinline__ void phase_combine(const Frame& F, const void* __restrict__ xsrc, float* __restrict__ out) {
    int tid_ = threadIdx.x; asm volatile("" : "+v"(tid_)); const int tid = tid_, lane = tid & 63; (void)tid; (void)lane;
    const bf16* Y = (const bf16*)(F.ws + WS_Y); const int* tokp = (const int*)(F.ws + WS_TOKP);
    for (int t = F.gw; t < NTOK; t += F.ngw) {
        const int s0 = tokp[(size_t)t * 2], s1 = tokp[(size_t)t * 2 + 1];
        const v4u* y0 = (const v4u*)(Y + (size_t)s0 * DM) + lane; const v4u* y1 = (const v4u*)(Y + (size_t)s1 * DM) + lane;
        float x[4][8]; load_row32<XBF>((const unsigned char*)xsrc + (size_t)t * DM * (XBF ? 2 : 4), lane, x);
        f32x4* xr = (f32x4*)(out + (size_t)t * DM) + 2 * lane;
#pragma unroll
        for (int j = 0; j < 4; ++j) { const v4u p = y0[64 * j], q = y1[64 * j]; f32x4 xa, xb;
            xa[0] = x[j][0] + bf_lo(p.x) + bf_lo(q.x); xa[1] = x[j][1] + bf_hi(p.x) + bf_hi(q.x); xa[2] = x[j][2] + bf_lo(p.y) + bf_lo(q.y); xa[3] = x[j][3] + bf_hi(p.y) + bf_hi(q.y);
            xb[0] = x[j][4] + bf_lo(p.z) + bf_lo(q.z); xb[1] = x[j][5] + bf_hi(p.z) + bf_hi(q.z); xb[2] = x[j][6] + bf_lo(p.w) + bf_lo(q.w); xb[3] = x[j][7] + bf_hi(p.w) + bf_hi(q.w);
            xr[128 * j] = xa; xr[128 * j + 1] = xb; }
    }
}

__device__ __forceinline__ void convert_experts(const Frame& F, const Args& args, int e_lo, int e_hi, int w, int nw);
__device__ __forceinline__ void phase_attention(const Frame& F, const Args& a, int l) {
    int tid_ = threadIdx.x; asm volatile("" : "+v"(tid_)); const int tid = tid_, lane = tid & 63; (void)tid; (void)lane;
    const bf16* PROJ = (const bf16*)(F.ws + WS_PROJ);
    const bf16* QA = (const bf16*)(F.ws + WS_QA); const bf16* KA = (const bf16*)(F.ws + WS_KA); const bf16* QB = (const bf16*)(F.ws + WS_QB); const bf16* KB = (const bf16*)(F.ws + WS_KB);
    const bf16* KVR = (const bf16*)(F.ws + WS_KVR); const bf16* QC = (const bf16*)(F.ws + WS_QC); const bf16* KC = (const bf16*)(F.ws + WS_KC);
    bf16* O = (bf16*)(F.ws + WS_O);
    char* L = (char*)F.lds;
    const int cslot = MOE_CVT_IN_ATTN ? ((F.bid >> 3) & 3) : -1; bool cvt_done = !MOE_CVT_IN_ATTN;
#define ATT_CVT() do { __syncthreads(); convert_experts(F, a, 4 * l, 4 * l + 4, F.gw, F.ngw); __syncthreads(); cvt_done = true; } while (0)
    if (cslot == 0) ATT_CVT();
    if (PHON(16)) for (int Lu = F.bid; Lu < 256; Lu += F.G) {
        const int id = (Lu & 7) * 32 + (Lu >> 3), b = id >> 6, h = (id >> 4) & 3, qb = id & 15; const size_t tq = (size_t)b * SEQ + qb * 256, tk = (size_t)b * SEQ;
        att::attn_body<192, 768, 768, 1024, 2048, 0, 1, 8>(QC + tq * 768 + h * 192, KC + tk * 768 + h * 192, KVR + tk * 1024 + h * 256 + 128, O + tq * DM + 1536 + h * 128, SEQ / 64, L, 0, 0, nullptr);
    }
    if (cslot == 1) ATT_CVT();
    if (PHON(17)) for (int Lu = F.bid; Lu < 512; Lu += F.G) {
        if (cslot == 2 && !cvt_done && Lu != F.bid) ATT_CVT();
        const int id = (Lu & 7) * 64 + (Lu >> 3), b = id >> 7, kvh = (id >> 6) & 1, g = (id >> 4) & 3, qb = id & 15, h = kvh * 4 + g; const size_t tq = (size_t)b * SEQ + qb * 256, tk = (size_t)b * SEQ;
        att::attn_body<128, 1024, 256, 4096, 2048, 0, 2, 8>(QB + tq * 1024 + h * 128, KB + tk * 256 + kvh * 128, PROJ + tk * DINP + PC_VB + kvh * 128, O + tq * DM + 512 + h * 128, SEQ / 64, L, 0, 0, nullptr);
    }
    float* biasT = (float*)(L + 136 * 1024);
    if (!cvt_done && cslot == 3) ATT_CVT();
    if (PHON(18)) for (int Lu = F.bid; Lu < 256; Lu += F.G) {
        const int id = (Lu & 7) * 32 + (Lu >> 3), b = id >> 6, h = (id >> 4) & 3, rb = id & 15; const size_t tq = (size_t)b * SEQ + rb * 256;
        int lo = min(max(rb * 4 - 4, 0), 56), hi = min(max(rb * 4 + 3 - 4, 0), 56) + 8;
        if ((hi - lo) & 1) { if (hi < 64) ++hi; else --lo; }
        __syncthreads();
        const float* rpb = a.in[I_RPB] + ((size_t)l * 4 + h) * 465;
        for (int i = tid; i < 15 * 128; i += NWAVES * 64) { const int bi = i >> 7, bj = (i & 127) - 48; biasT[i] = (bj >= 0 && bj < 31) ? rpb[bi * 31 + bj] * 11.313708498984761f : 0.f; }
        __syncthreads();
        const size_t tk = (size_t)b * SEQ + lo * 64;
        att::attn_body<128, 512, 512, 4096, 2048, 1, 1, 4>(QA + tq * 512 + h * 128, KA + tk * 512 + h * 128, PROJ + tk * DINP + PC_VA + h * 128, O + tq * DM + h * 128, hi - lo, L, rb * 4, lo, biasT);
    }
    if (!cvt_done) ATT_CVT();
#undef ATT_CVT
}

constexpr int NPHASE = 24;

__device__ __forceinline__ void tr8_decode(const Args& args, unsigned char* ws, int e_lo, int gi, const float*& W, unsigned char*& WT, int& K, int& N, int& mode, int& item) {
    const int m = gi / 3584; item = gi - m * 3584; const int e = e_lo + m / 3, kind = m - (m / 3) * 3;
    if (kind == 2) { W = args.in[I_WED] + (size_t)e * DFE * DM; WT = ws + WS_WED + (size_t)e * DM * DFE; K = DFE; N = DM; mode = 0; }
    else { W = (kind == 0 ? args.in[I_WEG] : args.in[I_WEU]) + (size_t)e * DM * DFE; WT = ws + WS_WEGU + (size_t)e * 2 * DFE * DM; K = DM; N = DFE; mode = 1 + kind; }
}
__device__ __forceinline__ void tr8_load(const float* __restrict__ W, int N, int item, int lane, f32x4 (&v)[16]) {
    const int nblk = N >> 5, kb = item / nblk, nb = item - kb * nblk, k0 = kb << 7, n0 = nb << 5; const int c = lane >> 3, q = lane & 7;
    const float* p = W + (size_t)(k0 + 16 * c) * N + n0 + 4 * q;
#pragma unroll
    for (int i = 0; i < 16; ++i) v[i] = __builtin_nontemporal_load((const f32x4*)(p + (size_t)i * N));
}
__device__ __forceinline__ void tr8_store(unsigned char* __restrict__ WT, int K, int N, int mode, int item, int lane, float wsc, LAS float* scr, const f32x4 (&v)[16]) {
    (void)scr;
    const int nblk = N >> 5, kb = item / nblk, nb = item - kb * nblk, k0 = kb << 7, n0 = nb << 5; const int c = lane >> 3, q = lane & 7;
    const int drow0 = (mode == 0) ? n0 : ((n0 >> 7) * 256 + (mode - 1) * 128 + (n0 & 127));
    unsigned char* p = WT + (size_t)(drow0 + 4 * q) * K + k0 + 16 * c;
#pragma unroll
    for (int j = 0; j < 4; ++j) {
        v4u o; o.x = pk4_fp8(v[0][j] * wsc, v[1][j] * wsc, v[2][j] * wsc, v[3][j] * wsc); o.y = pk4_fp8(v[4][j] * wsc, v[5][j] * wsc, v[6][j] * wsc, v[7][j] * wsc);
        o.z = pk4_fp8(v[8][j] * wsc, v[9][j] * wsc, v[10][j] * wsc, v[11][j] * wsc); o.w = pk4_fp8(v[12][j] * wsc, v[13][j] * wsc, v[14][j] * wsc, v[15][j] * wsc);
        *(v4u*)(p + (size_t)j * K) = o; }
}
__device__ __forceinline__ void convert_experts(const Frame& F, const Args& args, int e_lo, int e_hi, int w, int nw) {
    int tid_ = threadIdx.x; asm volatile("" : "+v"(tid_)); const int lane = tid_ & 63;
    LAS float* scr = (LAS float*)(F.lds + F.wave * 18432);
    if constexpr (F8M) {
        const int total = (e_hi - e_lo) * 3 * 3584;
        f32x4 va[16], vb[16], vc[16]; const float* W; unsigned char* WT; int K, N, mode, item;
#define TR8_LD(buf, gx) do { if ((gx) < total) { tr8_decode(args, F.ws, e_lo, (gx), W, WT, K, N, mode, item); tr8_load(W, N, item, lane, buf); } } while (0)
#define TR8_ST(buf, gx) do { tr8_decode(args, F.ws, e_lo, (gx), W, WT, K, N, mode, item); tr8_store(WT, K, N, mode, item, lane, SC_W, scr, buf); } while (0)
        int gi = w;
        TR8_LD(va, gi); TR8_LD(vb, gi + nw);
        while (gi < total) {
            TR8_LD(vc, gi + 2 * nw); TR8_ST(va, gi); gi += nw; if (gi >= total) break;
            TR8_LD(va, gi + 2 * nw); TR8_ST(vb, gi); gi += nw; if (gi >= total) break;
            TR8_LD(vb, gi + 2 * nw); TR8_ST(vc, gi); gi += nw;
        }
#undef TR8_LD
#undef TR8_ST
    } else {
        int it = w;
#define TR_RUNB(Wp, Kk, Nn, Dp, ROFF, MODE) do { const int cnt_ = ((Kk) >> 6) * ((Nn) >> 5); while (it < cnt_) { transpose_item((Wp), (Kk), (Nn), (Dp), (ROFF), (MODE), scr, it, lane); it += nw; } it -= cnt_; } while (0)
        for (int e = e_lo; e < e_hi; ++e) {
            TR_RUNB(args.in[I_WEG] + (size_t)e * DM * DFE, DM, DFE, (bf16*)(F.ws + WS_WEGU) + (size_t)e * 2 * DFE * DM, 0, 1);
            TR_RUNB(args.in[I_WEU] + (size_t)e * DM * DFE, DM, DFE, (bf16*)(F.ws + WS_WEGU) + (size_t)e * 2 * DFE * DM, 0, 2);
            TR_RUNB(args.in[I_WED] + (size_t)e * DFE * DM, DFE, DM, (bf16*)(F.ws + WS_WED) + (size_t)e * DM * DFE, 0, 0);
        }
#undef TR_RUNB
    }
}
__device__ __forceinline__ void phase_prologue(const Frame& F, const Args& args) {
    int tid_ = threadIdx.x; asm volatile("" : "+v"(tid_)); const int tid = tid_, lane = tid & 63;
    LAS float* scr = (LAS float*)(F.lds + F.wave * 16896);
    int it = F.gw; const int nw = F.ngw;
#define TR_RUN(Wp, Kk, Nn, Dp, ROFF, MODE) do { const int cnt_ = ((Kk) >> 6) * ((Nn) >> 5); while (it < cnt_) { transpose_item((Wp), (Kk), (Nn), (Dp), (ROFF), (MODE), scr, it, lane); it += nw; } it -= cnt_; } while (0)
#define TR_RUN8(Wp, Kk, Nn, Dp, ROFF, MODE) do { const int cnt_ = ((Kk) >> 7) * ((Nn) >> 5); while (it < cnt_) { transpose_item_f8((Wp), (Kk), (Nn), (Dp), (ROFF), (MODE), SC_W, scr, it, lane); it += nw; } it -= cnt_; } while (0)
    for (int l = 0; l < DEPTH; ++l) {
        TR_RUN(args.in[I_WIN] + (size_t)l * DM * DIN, DM, DIN, (bf16*)(F.ws + WS_WIN) + (size_t)l * DINP * DM, 0, 0);
        TR_RUN(args.in[I_WUQ] + (size_t)l * 512 * 768, 512, 768, (bf16*)(F.ws + WS_WUQ) + (size_t)l * 768 * 512, 0, 0);
        TR_RUN(args.in[I_WUKV] + (size_t)l * 256 * 1024, 256, 1024, (bf16*)(F.ws + WS_WUKV) + (size_t)l * 1024 * 256, 0, 0);
        TR_RUN(args.in[I_WOUT] + (size_t)l * DM * DM, DM, DM, (bf16*)(F.ws + WS_WOUT) + (size_t)l * DM * DM, 0, 0);
    }
    if constexpr (F8DG) {
        TR_RUN8(args.in[I_WG], DM, DFF, (unsigned char*)(F.ws + WS_WGU), 0, 1);
        TR_RUN8(args.in[I_WU], DM, DFF, (unsigned char*)(F.ws + WS_WGU), 0, 2);
    } else {
        TR_RUN(args.in[I_WG], DM, DFF, (bf16*)(F.ws + WS_WGU), 0, 1);
        TR_RUN(args.in[I_WU], DM, DFF, (bf16*)(F.ws + WS_WGU), 0, 2);
    }
    if constexpr (F8DD) TR_RUN8(args.in[I_WDN], DFF, DM, (unsigned char*)(F.ws + WS_WD), 0, 0);
    else TR_RUN(args.in[I_WDN], DFF, DM, (bf16*)(F.ws + WS_WD), 0, 0);
#undef TR_RUN
#undef TR_RUN8
    for (int l = 0; l < DEPTH; ++l) { v4u* z = (v4u*)((bf16*)(F.ws + WS_WIN) + ((size_t)l * DINP + DIN) * DM); const v4u zz = {0u, 0u, 0u, 0u};
        for (int i = F.bid * NWAVES * 64 + tid; i < (DINP - DIN) * DM / 8; i += F.G * NWAVES * 64) z[i] = zz; }
    if (!MOE_CVT_IN_ATTN) convert_experts(F, args, 0, NE, F.gw, F.ngw);
    phase_rmsnorm<false, false>(F, args.in[I_X], args.in[I_MIXN], F.ws + WS_H, 1.f);
}

__global__ void __launch_bounds__(NWAVES * 64, 2) mega_fwd(Args args) {
    extern __shared__ __attribute__((aligned(16))) unsigned char lds_raw[];
    Frame F;
    F.lds = (LAS unsigned char*)lds_raw; F.ws = args.ws; F.ctl = (unsigned*)(args.ws + WS_CTL);
    F.wave = __builtin_amdgcn_readfirstlane((int)threadIdx.x >> 6);
    F.G = gridDim.x; F.bid = blockIdx.x; F.gw = F.bid * NWAVES + F.wave; F.ngw = F.G * NWAVES;
    volatile LAS unsigned* MISC = (volatile LAS unsigned*)(F.lds + MISC_OFF);
    if (threadIdx.x < 64) MISC[threadIdx.x] = 0u;
    __syncthreads();
    XcdBarrier bar = xcd_barrier_post(F.ctl + CW_BAR, MISC + 8);
    const int lo = args.ph_lo, hi = args.ph_hi;
#define IN(k) (lo <= (k) && (k) < hi)
#define SEAM(k) do { if (IN(k) && IN((k) + 1)) xcd_barrier(bar); } while (0)
    float* out = args.out;
    bf16* XB = (bf16*)(F.ws + WS_XB);
    LAS unsigned char* ring = F.lds;

    if (PHON(0) && IN(0)) phase_prologue(F, args);
    SEAM(0);

#pragma nounroll
    for (int l = 0; l < DEPTH; ++l) {
        const int P = 11 * l;
        if (PHON(1) && IN(P + 1)) {
            pg8::Gemm g{F.ws + WS_H, (const bf16*)(F.ws + WS_WIN) + (size_t)l * DINP * DM, NTOK, DINP, DM}; pg8::StaticOrder S; S.init(NTOK, DINP, F.G, F.bid);
            pg8::EpiBf16 E{(bf16*)(F.ws + WS_PROJ), DINP};
            pg8::gemm_phase<pg8::EpiBf16, pg8::StaticOrder, true, true>(ring, g, S, E);
        }
        SEAM(P + 1);
        if (PHON(2) && IN(P + 2)) phase_postproj(F, args, l);
        SEAM(P + 2);
        if (PHON(3) && IN(P + 3)) {
            { pg8::Gemm g{F.ws + WS_CQN, (const bf16*)(F.ws + WS_WUQ) + (size_t)l * 768 * 512, NTOK, 768, 512}; pg8::StaticOrder S; S.init(NTOK, 768, F.G, F.bid);
              pg8::EpiBf16 E{(bf16*)(F.ws + WS_QCR), 768}; pg8::gemm_phase<pg8::EpiBf16, pg8::StaticOrder, true, true>(ring, g, S, E); }
            { pg8::Gemm g{F.ws + WS_CKVN, (const bf16*)(F.ws + WS_WUKV) + (size_t)l * 1024 * 256, NTOK, 1024, 256}; pg8::StaticOrder S; S.init(NTOK, 1024, F.G, F.bid);
              pg8::EpiBf16 E{(bf16*)(F.ws + WS_KVR), 1024}; pg8::gemm_phase<pg8::EpiBf16, pg8::StaticOrder, true, true>(ring, g, S, E); }
        }
        SEAM(P + 3);
        if (PHON(4) && IN(P + 4)) phase_postmla(F, args, l);
        SEAM(P + 4);
        if (PHON(5) && IN(P + 5)) { phase_attention(F, args, l); __syncthreads(); }
        SEAM(P + 5);
        if (PHON(6) && IN(P + 6)) phase_groupnorm(F, args, l);
        SEAM(P + 6);
        if (PHON(7) && IN(P + 7)) {
            pg8::Gemm g{F.ws + WS_ON, (const bf16*)(F.ws + WS_WOUT) + (size_t)l * DM * DM, NTOK, DM, DM}; pg8::StaticOrder S; S.init(NTOK, DM, F.G, F.bid);
            if (l == 0) { pg8::EpiResBf16<false> E{args.in[I_X], XB, DM, 1.f}; pg8::gemm_phase<pg8::EpiResBf16<false>, pg8::StaticOrder, true, true>(ring, g, S, E); }
            else { pg8::EpiResBf16<true> E{XB, XB, DM, 1.f}; pg8::gemm_phase<pg8::EpiResBf16<true>, pg8::StaticOrder, true, true>(ring, g, S, E); }
        }
        SEAM(P + 7);
        if (l == 0) {
            if (PHON(8) && IN(P + 8)) phase_rmsnorm<F8DG, true>(F, XB, args.in[I_FFNN] + (size_t)l * DM, F.ws + WS_H, F8DG ? SC_H : 1.f);
            SEAM(P + 8);
            if (PHON(9) && IN(P + 9)) {
                pg8::Gemm g{F.ws + WS_H, F.ws + WS_WGU, NTOK, 2 * DFF, DM}; pg8::StaticOrder S; S.init(NTOK, 2 * DFF, F.G, F.bid);
                constexpr float isc = F8DG ? 1.f / (SC_H * SC_W) : 1.f;
                if constexpr (F8DD) { pg8::EpiSwigluF8 E{F.ws + WS_ACT, DFF, SC_ACT, isc}; pg8::gemm_phase<pg8::EpiSwigluF8, pg8::StaticOrder, true, true, F8DG>(ring, g, S, E); }
                else { pg8::EpiSwiglu E{(bf16*)(F.ws + WS_ACT), DFF, isc}; pg8::gemm_phase<pg8::EpiSwiglu, pg8::StaticOrder, true, true, F8DG>(ring, g, S, E); }
            }
            SEAM(P + 9);
            if (PHON(10) && IN(P + 10)) {
                pg8::Gemm g{F.ws + WS_ACT, F.ws + WS_WD, NTOK, DM, DFF}; pg8::StaticOrder S; S.init(NTOK, DM, F.G, F.bid);
                pg8::EpiResBf16<true> E{XB, XB, DM, F8DD ? 1.f / (SC_ACT * SC_W) : 1.f};
                pg8::gemm_phase<pg8::EpiResBf16<true>, pg8::StaticOrder, true, true, F8DD>(ring, g, S, E);
            }
            SEAM(P + 10);
            if (PHON(8) && IN(P + 11)) phase_rmsnorm<false, true>(F, XB, args.in[I_MIXN] + (size_t)(l + 1) * DM, F.ws + WS_H, 1.f);
            SEAM(P + 11);
        } else {
            if (PHON(11) && IN(P + 8)) phase_ffnnorm_route<F8M, true>(F, args, XB, args.in[I_FFNN] + (size_t)l * DM, F.ws + WS_H, SC_H);
            SEAM(P + 8);
            if (PHON(12) && IN(P + 9)) phase_gather<F8M>(F);
            SEAM(P + 9);
            if (PHON(13) && IN(P + 10)) {
                int tb[9], cnt[8]; moe_tiles(F, tb, cnt);
                pg8::Gemm g{F.ws + WS_HG, F.ws + WS_WEGU, tb[8] * 256, 2 * DFE, DM}; pg8::GroupedOrder S; S.init(tb[8] * 256, 2 * DFE, F.G, F.bid);
#pragma unroll
                for (int k = 0; k < 7; ++k) S.tb[k] = tb[k + 1];
                S.nct = 2 * DFE / 256;
                if constexpr (F8M) { pg8::EpiSwigluF8 E{F.ws + WS_ACTM, DFE, SC_ACT, 1.f / (SC_H * SC_W)}; pg8::gemm_phase<pg8::EpiSwigluF8, pg8::GroupedOrder, true, true, true>(ring, g, S, E); }
                else { pg8::EpiSwiglu E{(bf16*)(F.ws + WS_ACTM), DFE, 1.f}; pg8::gemm_phase<pg8::EpiSwiglu, pg8::GroupedOrder, true, true, false>(ring, g, S, E); }
            }
            SEAM(P + 10);
            if (PHON(14) && IN(P + 11)) {
                int tb[9], cnt[8]; moe_tiles(F, tb, cnt);
                pg8::Gemm g{F.ws + WS_ACTM, F.ws + WS_WED, tb[8] * 256, DM, DFE}; pg8::GroupedOrder S; S.init(tb[8] * 256, DM, F.G, F.bid);
#pragma unroll
                for (int k = 0; k < 7; ++k) S.tb[k] = tb[k + 1];
                S.nct = DM / 256;
                pg8::EpiScaleBf16 E{(bf16*)(F.ws + WS_Y), DM, (const float*)(F.ws + WS_RGATE), F8M ? 1.f / (SC_ACT * SC_W) : 1.f};
                pg8::gemm_phase<pg8::EpiScaleBf16, pg8::GroupedOrder, true, true, F8M>(ring, g, S, E);
            }
            SEAM(P + 11);
            if (PHON(15) && IN(P + 12)) phase_combine<true>(F, XB, out);
        }
    }
#undef IN
#undef SEAM
}

extern "C" void kernel_launch(void* const* d_in, const int* in_sizes, int n_in, void* d_out, int out_size, void* d_ws, size_t ws_size, hipStream_t stream) {
    static int grid = 0;
    if (grid == 0) {
        if (n_in != 26 || in_sizes[0] != NTOK * DM || out_size != NTOK * DM || ws_size < WS_END2) { fprintf(stderr, "kernel_launch: unexpected shapes (n_in %d, in0 %d, out %d, ws %zu < %zu)\n", n_in, n_in > 0 ? in_sizes[0] : -1, out_size, ws_size, (size_t)WS_END2); grid = -1; return; }
        int dev = 0, cus = 0, per_cu = 0;
        if (hipGetDevice(&dev) != hipSuccess || hipDeviceGetAttribute(&cus, hipDeviceAttributeMultiprocessorCount, dev) != hipSuccess) { grid = -1; return; }
        if (hipFuncSetAttribute((const void*)mega_fwd, hipFuncAttributeMaxDynamicSharedMemorySize, LDS_BYTES) != hipSuccess) { fprintf(stderr, "kernel_launch: hipFuncSetAttribute failed\n"); grid = -1; return; }
        if (hipOccupancyMaxActiveBlocksPerMultiprocessor(&per_cu, (const void*)mega_fwd, NWAVES * 64, LDS_BYTES) != hipSuccess || per_cu < 1) fprintf(stderr, "kernel_launch: occupancy query reports %d\n", per_cu);
        (void)hipGetLastError();
        grid = cus;
    }
    if (grid < 0) return;
    if (hipMemsetAsync((char*)d_ws + WS_CTL, 0, CTL_ZERO_BYTES, stream) != hipSuccess) return;
    Args a{};
    for (int i = 0; i < 26; ++i) a.in[i] = (const float*)d_in[i];
    a.out = (float*)d_out; a.ws = (unsigned char*)d_ws;
#ifndef MK_SPLIT
    a.ph_lo = 0; a.ph_hi = NPHASE;
    hipLaunchKernelGGL(mega_fwd, dim3(grid), dim3(NWAVES * 64), LDS_BYTES, stream, a);
#else
    for (int p = 0; p < NPHASE; ++p) { a.ph_lo = p; a.ph_hi = p + 1; hipLaunchKernelGGL(mega_fwd, dim3(grid), dim3(NWAVES * 64), LDS_BYTES, stream, a); }
#endif
}
```

```cpp
#include <hip/hip_runtime.h>
#include <cstdio>
#include <cstdint>
namespace pg8 {
#define PG8_LAS __attribute__((address_space(3)))
typedef unsigned short bf16_t;
typedef short bf16x8 __attribute__((ext_vector_type(8)));
typedef float f32x4 __attribute__((ext_vector_type(4)));
typedef unsigned u32x4 __attribute__((ext_vector_type(4)));
constexpr int BM = 256, BK = 64, HALF = 128, HTB = HALF * BK * 2  , STAGE_BYTES = 8 * HTB, NXCD = 8, WGM = 8;

__host__ __device__ __forceinline__ int lds_byte(int r, int c) { const int st = (r >> 4) * 2 + (c >> 5), rr = r & 15, cc = c & 31, ob = rr * 64 + cc * 2; return st * 1024 + (ob ^ (((ob >> 9) & 1) << 5)); }
__host__ __device__ __forceinline__ void stage_rc(int b, int& R, int& C) { const int st = b / 1024, sb = b % 1024, swz = sb ^ (((sb >> 9) & 1) << 5); R = (st >> 1) * 16 + swz / 64; C = (st & 1) * 32 + (swz % 64) / 2; }
__host__ __device__ __forceinline__ int perm32(int rho) { const int n = rho >> 4, i = rho & 15; return 8 * (i >> 2) + 4 * n + (i & 3); }


struct Unit { int pm, pn, pc, ko; };
struct Gemm { const void* A; const void* Bt; int M, N, K, kt; };
typedef int i32x4 __attribute__((ext_vector_type(4)));
typedef int i32x8 __attribute__((ext_vector_type(8)));

struct StaticOrder {
    int nM, nN, nwg, G, c;
    __device__ __forceinline__ void init(int M, int N, int G_, int c_) { nM = M / BM; nN = N / BM; nwg = nM * nN; G = G_; c = c_; }
    __device__ __forceinline__ bool next(int i, Unit& u) const {
        const long L = (long)i * G + c; if (L >= nwg) return false;
        int wgid = (int)L; { const int q = nwg / NXCD, r = nwg % NXCD, xcd = wgid % NXCD, off = wgid / NXCD; wgid = (xcd < r ? xcd * (q + 1) : r * (q + 1) + (xcd - r) * q) + off; }
        const int nig = WGM * nN, gid = wgid / nig, fm = gid * WGM, gsz = (nM - fm) < WGM ? (nM - fm) : WGM;
        u.pm = fm + ((wgid % nig) % gsz); u.pn = (wgid % nig) / gsz; u.pc = u.pn; u.ko = 0; return true;
    }
    __device__ __forceinline__ void a_ready(const Unit&) const {}
    __device__ __forceinline__ void done(const Unit&) const {}
};
struct GroupedOrder : StaticOrder {
    int tb[7]; int nct; int lim;
    __device__ __forceinline__ void expert(Unit& u) const { int e = 0;
#pragma unroll
        for (int k = 0; k < 7; ++k) e += (u.pm >= tb[k]) ? 1 : 0;
        u.pc = u.pn; u.pn += e * nct; }
    __device__ __forceinline__ bool next(int i, Unit& u) const {
        if (lim > 0 && (long)i * G + c >= lim) return false;
        if (!StaticOrder::next(i, u)) return false;
        expert(u); return true;
    }
};
struct GroupedTail : GroupedOrder {
    int nsp, kslice;
    __device__ __forceinline__ bool next(int i, Unit& u) const {
        if (i > 0) return false;
        const int ent = lim + c / nsp; if (ent >= nwg) return false;
        StaticOrder s = *this; s.c = ent % G; if (!s.next(ent / G, u)) return false;
        expert(u); u.ko = (c % nsp) * kslice; u.pc = c; return true;
    }
};

__device__ __forceinline__ unsigned cvt_pk_bf16(float lo, float hi) { unsigned r; asm volatile("v_cvt_pk_bf16_f32 %0, %1, %2" : "=v"(r) : "v"(lo), "v"(hi)); return r; }

struct EpiBf16 {
    static constexpr bool PERM = true, AFTER_DRAIN = false;
    bf16_t* O; int ldc;
    __device__ __forceinline__ void operator()(const f32x4 (&acc)[2][2][4][2], const Unit& u, int wr, int wc, int fr, int fq) const {
        const int row0 = u.pm * BM + wr * 64 + fr, col0 = u.pc * BM + wc * 32 + 8 * fq;
#pragma unroll
        for (int ai = 0; ai < 2; ++ai)
#pragma unroll
            for (int m = 0; m < 4; ++m) { bf16_t* rowp = O + (size_t)(row0 + ai * HALF + m * 16) * ldc + col0;
#pragma unroll
                for (int bj = 0; bj < 2; ++bj) { const f32x4 v0 = acc[ai][bj][m][0], v1 = acc[ai][bj][m][1];
                    u32x4 w; w.x = cvt_pk_bf16(v0[0], v0[1]); w.y = cvt_pk_bf16(v0[2], v0[3]); w.z = cvt_pk_bf16(v1[0], v1[1]); w.w = cvt_pk_bf16(v1[2], v1[3]);
                    *(u32x4*)(rowp + bj * HALF) = w; } }
    }
};
struct EpiPartF32 {
    static constexpr bool PERM = true, AFTER_DRAIN = false;
    float* P;
    __device__ __forceinline__ void operator()(const f32x4 (&acc)[2][2][4][2], const Unit& u, int wr, int wc, int fr, int fq) const {
        float* t = P + (size_t)u.pc * 65536 + (size_t)(wr * 64 + fr) * 256 + wc * 32 + 8 * fq;
#pragma unroll
        for (int ai = 0; ai < 2; ++ai)
#pragma unroll
            for (int m = 0; m < 4; ++m)
#pragma unroll
                for (int bj = 0; bj < 2; ++bj) { float* q = t + (size_t)(ai * HALF + m * 16) * 256 + bj * HALF; *(f32x4*)q = acc[ai][bj][m][0]; *(f32x4*)(q + 4) = acc[ai][bj][m][1]; }
    }
};
struct EpiScaleBf16 {
    static constexpr bool PERM = true, AFTER_DRAIN = false;
    bf16_t* O; int ldc; const float* rs; float isc;
    __device__ __forceinline__ void operator()(const f32x4 (&acc)[2][2][4][2], const Unit& u, int wr, int wc, int fr, int fq) const {
        const int row0 = u.pm * BM + wr * 64 + fr, col0 = u.pc * BM + wc * 32 + 8 * fq;
#pragma unroll
        for (int ai = 0; ai < 2; ++ai)
#pragma unroll
            for (int m = 0; m < 4; ++m) { const int row = row0 + ai * HALF + m * 16; const float s = rs[row] * isc; bf16_t* rowp = O + (size_t)row * ldc + col0;
#pragma unroll
                for (int bj = 0; bj < 2; ++bj) { const f32x4 v0 = acc[ai][bj][m][0] * s, v1 = acc[ai][bj][m][1] * s;
                    u32x4 w; w.x = cvt_pk_bf16(v0[0], v0[1]); w.y = cvt_pk_bf16(v0[2], v0[3]); w.z = cvt_pk_bf16(v1[0], v1[1]); w.w = cvt_pk_bf16(v1[2], v1[3]);
                    *(u32x4*)(rowp + bj * HALF) = w; } }
    }
};
struct EpiResF32 {
    static constexpr bool PERM = false, AFTER_DRAIN = false;
    const float* base; float* out; int ldc; float isc;
    __device__ __forceinline__ void operator()(const f32x4 (&acc)[2][2][4][2], const Unit& u, int wr, int wc, int fr, int fq) const {
        const int row0 = u.pm * BM + wr * 64 + fr, col0 = u.pc * BM + wc * 32 + 4 * fq;
#pragma unroll
        for (int ai = 0; ai < 2; ++ai)
#pragma unroll
            for (int m = 0; m < 4; ++m) { const size_t off = (size_t)(row0 + ai * HALF + m * 16) * ldc + col0;
                f32x4 b[2][2];
#pragma unroll
                for (int bj = 0; bj < 2; ++bj)
#pragma unroll
                    for (int n = 0; n < 2; ++n) b[bj][n] = *(const f32x4*)(base + off + bj * HALF + n * 16);
#pragma unroll
                for (int bj = 0; bj < 2; ++bj)
#pragma unroll
                    for (int n = 0; n < 2; ++n) *(f32x4*)(out + off + bj * HALF + n * 16) = b[bj][n] + acc[ai][bj][m][n] * isc;
                asm volatile("" ::: "memory"); }
    }
};
template <bool BASEB> struct EpiResBf16 {
    static constexpr bool PERM = true, AFTER_DRAIN = false;
    const void* base; bf16_t* out; int ldc; float isc;
    __device__ __forceinline__ void operator()(const f32x4 (&acc)[2][2][4][2], const Unit& u, int wr, int wc, int fr, int fq) const {
        const int row0 = u.pm * BM + wr * 64 + fr, col0 = u.pc * BM + wc * 32 + 8 * fq;
#pragma unroll
        for (int ai = 0; ai < 2; ++ai)
#pragma unroll
            for (int m = 0; m < 4; ++m) { const size_t off = (size_t)(row0 + ai * HALF + m * 16) * ldc + col0;
#pragma unroll
                for (int bj = 0; bj < 2; ++bj) { f32x4 b0, b1;
                    if constexpr (BASEB) { const u32x4 w = *(const u32x4*)((const bf16_t*)base + off + bj * HALF);
                        b0 = (f32x4){__uint_as_float(w.x << 16), __uint_as_float(w.x & 0xffff0000u), __uint_as_float(w.y << 16), __uint_as_float(w.y & 0xffff0000u)};
                        b1 = (f32x4){__uint_as_float(w.z << 16), __uint_as_float(w.z & 0xffff0000u), __uint_as_float(w.w << 16), __uint_as_float(w.w & 0xffff0000u)}; }
                    else { b0 = *(const f32x4*)((const float*)base + off + bj * HALF); b1 = *(const f32x4*)((const float*)base + off + bj * HALF + 4); }
                    const f32x4 v0 = b0 + acc[ai][bj][m][0] * isc, v1 = b1 + acc[ai][bj][m][1] * isc;
                    u32x4 o; o.x = cvt_pk_bf16(v0[0], v0[1]); o.y = cvt_pk_bf16(v0[2], v0[3]); o.z = cvt_pk_bf16(v1[0], v1[1]); o.w = cvt_pk_bf16(v1[2], v1[3]);
                    *(u32x4*)(out + off + bj * HALF) = o; }
                asm volatile("" ::: "memory"); }
    }
};
__device__ __forceinline__ float silu_mul(float g, float u) { return g * u * __builtin_amdgcn_rcpf(1.0f + __builtin_amdgcn_exp2f(-1.44269504089f * g)); }
struct EpiSwiglu {
    static constexpr bool PERM = true, AFTER_DRAIN = false;
    bf16_t* O; int ldc; float isc;
    __device__ __forceinline__ void operator()(const f32x4 (&acc)[2][2][4][2], const Unit& u, int wr, int wc, int fr, int fq) const {
        const int row0 = u.pm * BM + wr * 64 + fr, col0 = u.pc * HALF + wc * 32 + 8 * fq;
#pragma unroll
        for (int ai = 0; ai < 2; ++ai)
#pragma unroll
            for (int m = 0; m < 4; ++m) { bf16_t* rowp = O + (size_t)(row0 + ai * HALF + m * 16) * ldc + col0;
                const f32x4 g0 = acc[ai][0][m][0] * isc, g1 = acc[ai][0][m][1] * isc, u0 = acc[ai][1][m][0] * isc, u1 = acc[ai][1][m][1] * isc;
                u32x4 w; w.x = cvt_pk_bf16(silu_mul(g0[0], u0[0]), silu_mul(g0[1], u0[1])); w.y = cvt_pk_bf16(silu_mul(g0[2], u0[2]), silu_mul(g0[3], u0[3]));
                w.z = cvt_pk_bf16(silu_mul(g1[0], u1[0]), silu_mul(g1[1], u1[1])); w.w = cvt_pk_bf16(silu_mul(g1[2], u1[2]), silu_mul(g1[3], u1[3]));
                *(u32x4*)rowp = w; }
    }
};

__device__ __forceinline__ unsigned cvt_pk4_fp8(float a, float b, float c, float d) { unsigned w = 0u; w = __builtin_amdgcn_cvt_pk_fp8_f32(a, b, w, false); w = __builtin_amdgcn_cvt_pk_fp8_f32(c, d, w, true); return w; }
struct EpiSwigluF8 {
    static constexpr bool PERM = true, AFTER_DRAIN = false;
    unsigned char* O; int ldc; float osc, isc;
    __device__ __forceinline__ void operator()(const f32x4 (&acc)[2][2][4][2], const Unit& u, int wr, int wc, int fr, int fq) const {
        const int row0 = u.pm * BM + wr * 64 + fr, col0 = u.pc * HALF + wc * 32 + 8 * fq;
        const float k1 = osc * isc * isc, k2 = -1.44269504089f * isc;
#define SWF8(G, U) ((G) * (U) * k1 * __builtin_amdgcn_rcpf(1.0f + __builtin_amdgcn_exp2f((G) * k2)))
#pragma unroll
        for (int ai = 0; ai < 2; ++ai)
#pragma unroll
            for (int m = 0; m < 4; ++m) { unsigned char* rowp = O + (size_t)(row0 + ai * HALF + m * 16) * ldc + col0;
                const f32x4 g0 = acc[ai][0][m][0], g1 = acc[ai][0][m][1], u0 = acc[ai][1][m][0], u1 = acc[ai][1][m][1];
                typedef unsigned u32x2 __attribute__((ext_vector_type(2)));
                u32x2 w; w.x = cvt_pk4_fp8(SWF8(g0[0], u0[0]), SWF8(g0[1], u0[1]), SWF8(g0[2], u0[2]), SWF8(g0[3], u0[3]));
                w.y = cvt_pk4_fp8(SWF8(g1[0], u1[0]), SWF8(g1[1], u1[1]), SWF8(g1[2], u1[2]), SWF8(g1[3], u1[3]));
                *(u32x2*)rowp = w; }
#undef SWF8
    }
};

template <class Epi, class Sched, bool ALIGN_EPI = false, bool SP2 = false, bool F8 = false>
__device__ __forceinline__ void gemm_phase(PG8_LAS unsigned char* lds, const Gemm g, const Sched& S, const Epi& E) {
    int tid_ = threadIdx.x; asm volatile("" : "+v"(tid_));
    const int tid = tid_, wid = __builtin_amdgcn_readfirstlane(tid >> 6), lane = tid & 63, wr = wid >> 2, wc = wid & 3, fr = lane & 15, fq = lane >> 4;
    const int K = g.K, RB = F8 ? K : 2 * K;
    const int nt = g.kt > 0 ? g.kt : (F8 ? K / (2 * BK) : K / BK);
    unsigned voffA[2], voffB[2];
#pragma unroll
    for (int i = 0; i < 2; ++i) { int R, C; stage_rc(tid * 16 + i * 8192, R, C); const int Rb = Epi::PERM ? ((R & ~31) + perm32(R & 31)) : R;
        voffA[i] = (unsigned)(R * RB + C * 2); voffB[i] = (unsigned)(Rb * RB + C * 2); }
    const size_t kstep = (size_t)(BK * 2);
    const size_t hstep = (size_t)HALF * RB;
    const size_t tstep = 2 * hstep;
    const unsigned ldsw = (unsigned)wid * 1024u;
    const int aoff = F8 ? lds_byte(wr * 64 + fr, fq * 16) : lds_byte(wr * 64 + fr, fq * 8), boff = F8 ? lds_byte(wc * 32 + fr, fq * 16) : lds_byte(wc * 32 + fr, fq * 8);
#define PG8_SA(b, h) (((b) * 2 + (h)) * HTB)
#define PG8_SB(b, h) ((4 + (b) * 2 + (h)) * HTB)
#define PG8_STAGE(bufoff, gbase, voff) do { _Pragma("unroll") for (int _i = 0; _i < 2; ++_i) \
        __builtin_amdgcn_global_load_lds((const unsigned*)((const char*)(gbase) + (voff)[_i]), (PG8_LAS unsigned*)(lds + (bufoff) + ldsw + _i * 8192), 16, 0, 0); } while (0)
#define PG8_LD16(p) (*(const PG8_LAS i32x4*)(p))
#define PG8_LDA(dst, b, h) do { _Pragma("unroll") for (int m = 0; m < 4; ++m) { if constexpr (F8) { dst##8[m] = __builtin_shufflevector(PG8_LD16(lds + PG8_SA(b, h) + aoff + m * 2048), PG8_LD16(lds + PG8_SA(b, h) + aoff + m * 2048 + 16), 0, 1, 2, 3, 4, 5, 6, 7); } \
        else { _Pragma("unroll") for (int k = 0; k < 2; ++k) dst[m][k] = *(const PG8_LAS bf16x8*)(lds + PG8_SA(b, h) + aoff + m * 2048 + k * 1024); } } } while (0)
#define PG8_LDB(dst, b, h) do { _Pragma("unroll") for (int n = 0; n < 2; ++n) { if constexpr (F8) { dst##8[n] = __builtin_shufflevector(PG8_LD16(lds + PG8_SB(b, h) + boff + n * 2048), PG8_LD16(lds + PG8_SB(b, h) + boff + n * 2048 + 16), 0, 1, 2, 3, 4, 5, 6, 7); } \
        else { _Pragma("unroll") for (int k = 0; k < 2; ++k) dst[n][k] = *(const PG8_LAS bf16x8*)(lds + PG8_SB(b, h) + boff + n * 2048 + k * 1024); } } } while (0)
#define PG8_MMA(ai, bj, At, Bt) do { __builtin_amdgcn_s_setprio(1); _Pragma("unroll") for (int m = 0; m < 4; ++m) _Pragma("unroll") for (int n = 0; n < 2; ++n) { \
        if constexpr (F8) asm volatile("v_mfma_f32_16x16x128_f8f6f4 %0, %1, %2, %0" : "+v"(acc[ai][bj][m][n]) : "v"(Bt##8[n]), "v"(At##8[m])); \
        else { _Pragma("unroll") for (int k = 0; k < 2; ++k) acc[ai][bj][m][n] = __builtin_amdgcn_mfma_f32_16x16x32_bf16(Bt[n][k], At[m][k], acc[ai][bj][m][n], 0, 0, 0); } } __builtin_amdgcn_s_setprio(0); } while (0)
#define PG8_WAIT_V(n) asm volatile("s_waitcnt vmcnt(" #n ")" ::: "memory")
#define PG8_WAIT_L(n) asm volatile("s_waitcnt lgkmcnt(" #n ")" ::: "memory")
#define PG8_BAR __builtin_amdgcn_s_barrier()
#define PG8_SCHED __builtin_amdgcn_sched_barrier(0)
    Unit cur, nxt; int ui = 0;
    if (!S.next(0, cur)) return;
    f32x4 acc[2][2][4][2];
#pragma unroll
    for (int a = 0; a < 2; ++a)
#pragma unroll
        for (int b = 0; b < 2; ++b)
#pragma unroll
            for (int m = 0; m < 4; ++m)
#pragma unroll
                for (int n = 0; n < 2; ++n) acc[a][b][m][n] = (f32x4){0.f, 0.f, 0.f, 0.f};
    bf16x8 At[4][2], B0[2][2], B1[2][2]; i32x8 At8[4], B08[2], B18[2];
    const char* cA = (const char*)g.A + (size_t)cur.pm * tstep + cur.ko; const char* cB = (const char*)g.Bt + (size_t)cur.pn * tstep + cur.ko;
    S.a_ready(cur);
    if constexpr (SP2) {
        PG8_STAGE(PG8_SB(0, 0), cB, voffB); PG8_STAGE(PG8_SB(0, 1), cB + hstep, voffB); PG8_STAGE(PG8_SA(0, 0), cA, voffA); PG8_STAGE(PG8_SA(0, 1), cA + hstep, voffA);
        if (wr == 1) PG8_BAR;
        PG8_WAIT_V(2); PG8_BAR;
        PG8_STAGE(PG8_SB(1, 0), cB + kstep, voffB); PG8_STAGE(PG8_SA(1, 0), cA + kstep, voffA); PG8_STAGE(PG8_SB(1, 1), cB + hstep + kstep, voffB);
        PG8_WAIT_V(6); PG8_BAR;
    } else {
        PG8_STAGE(PG8_SB(0, 0), cB, voffB); PG8_STAGE(PG8_SA(0, 0), cA, voffA); PG8_STAGE(PG8_SB(0, 1), cB + hstep, voffB); PG8_STAGE(PG8_SA(0, 1), cA + hstep, voffA);
        if (wr == 1) PG8_BAR;
        PG8_WAIT_V(4); PG8_BAR;
        PG8_STAGE(PG8_SB(1, 0), cB + kstep, voffB); PG8_STAGE(PG8_SA(1, 0), cA + kstep, voffA); PG8_STAGE(PG8_SB(1, 1), cB + hstep + kstep, voffB);
        PG8_WAIT_V(6); PG8_BAR;
    }
    for (;;) {
        const bool has_next = S.next(ui + 1, nxt);
        const char* nA = has_next ? (const char*)g.A + (size_t)nxt.pm * tstep + nxt.ko : cA; const char* nB = has_next ? (const char*)g.Bt + (size_t)nxt.pn * tstep + nxt.ko : cB;
        for (int t = 0; t < nt; t += 2) {
            const bool last = (t == nt - 2);
            const char* a1 = cA + (size_t)(t + 1) * kstep;
            const char* a2 = last ? nA : cA + (size_t)(t + 2) * kstep; const char* b2 = last ? nB : cB + (size_t)(t + 2) * kstep;
            const char* a3 = a2 + kstep; const char* b3 = b2 + kstep;
            if (last && has_next) S.a_ready(nxt);
            if constexpr (SP2) {
            PG8_LDB(B0, 0, 0); PG8_LDB(B1, 0, 1); PG8_SCHED; PG8_LDA(At, 0, 0); PG8_STAGE(PG8_SA(1, 1), a1 + hstep, voffA);
            PG8_WAIT_V(8); PG8_WAIT_L(0); PG8_BAR; PG8_MMA(0, 0, At, B0); PG8_MMA(0, 1, At, B1); PG8_BAR; PG8_SCHED;
            PG8_LDA(At, 0, 1); PG8_STAGE(PG8_SB(0, 0), b2, voffB); PG8_STAGE(PG8_SB(0, 1), b2 + hstep, voffB); PG8_STAGE(PG8_SA(0, 0), a2, voffA);
            PG8_WAIT_V(8); PG8_WAIT_L(0); PG8_BAR; PG8_MMA(1, 0, At, B0); PG8_MMA(1, 1, At, B1); PG8_BAR; PG8_SCHED;
            PG8_LDB(B0, 1, 0); PG8_LDB(B1, 1, 1); PG8_SCHED; PG8_LDA(At, 1, 0); PG8_STAGE(PG8_SA(0, 1), a2 + hstep, voffA);
            PG8_WAIT_V(8); PG8_WAIT_L(0); PG8_BAR; PG8_MMA(0, 0, At, B0); PG8_MMA(0, 1, At, B1); PG8_BAR; PG8_SCHED;
            PG8_LDA(At, 1, 1); PG8_STAGE(PG8_SB(1, 0), b3, voffB); PG8_STAGE(PG8_SB(1, 1), b3 + hstep, voffB); PG8_STAGE(PG8_SA(1, 0), a3, voffA);
            PG8_WAIT_V(8); PG8_WAIT_L(0); PG8_BAR; PG8_MMA(1, 0, At, B0); PG8_MMA(1, 1, At, B1); PG8_BAR; PG8_SCHED;
            } else {
            PG8_LDB(B0, 0, 0); PG8_SCHED; PG8_LDA(At, 0, 0); PG8_STAGE(PG8_SA(1, 1), a1 + hstep, voffA);
            PG8_WAIT_L(8); PG8_BAR; PG8_WAIT_L(0); PG8_MMA(0, 0, At, B0); PG8_BAR; PG8_SCHED;
            PG8_LDB(B1, 0, 1); PG8_STAGE(PG8_SB(0, 0), b2, voffB);
            PG8_BAR; PG8_WAIT_L(0); PG8_MMA(0, 1, At, B1); PG8_BAR;
            PG8_LDA(At, 0, 1); PG8_STAGE(PG8_SA(0, 0), a2, voffA);
            PG8_BAR; PG8_WAIT_L(0); PG8_MMA(1, 0, At, B0); PG8_BAR; PG8_SCHED;
            PG8_STAGE(PG8_SB(0, 1), b2 + hstep, voffB);
            PG8_WAIT_V(6); PG8_BAR; PG8_MMA(1, 1, At, B1); PG8_BAR;
            PG8_LDB(B0, 1, 0); PG8_SCHED; PG8_LDA(At, 1, 0); PG8_STAGE(PG8_SA(0, 1), a2 + hstep, voffA);
            PG8_WAIT_L(8); PG8_BAR; PG8_WAIT_L(0); PG8_MMA(0, 0, At, B0); PG8_BAR; PG8_SCHED;
            PG8_LDB(B1, 1, 1); PG8_STAGE(PG8_SB(1, 0), b3, voffB);
            PG8_BAR; PG8_WAIT_L(0); PG8_MMA(0, 1, At, B1); PG8_BAR;
            PG8_LDA(At, 1, 1); PG8_STAGE(PG8_SA(1, 0), a3, voffA);
            PG8_BAR; PG8_WAIT_L(0); PG8_MMA(1, 0, At, B0); PG8_BAR; PG8_SCHED;
            PG8_STAGE(PG8_SB(1, 1), b3 + hstep, voffB);
            PG8_WAIT_V(6); PG8_BAR; PG8_MMA(1, 1, At, B1); PG8_BAR;
            }
        }
        if constexpr (ALIGN_EPI) { if (wr == 0) PG8_BAR; }
        if constexpr (F8) {
            asm volatile("s_nop 15\n\ts_nop 15" : "+v"(acc[0][0][0][0]), "+v"(acc[0][0][0][1]), "+v"(acc[0][0][1][0]), "+v"(acc[0][0][1][1]), "+v"(acc[0][0][2][0]), "+v"(acc[0][0][2][1]), "+v"(acc[0][0][3][0]), "+v"(acc[0][0][3][1]) :: "memory");
            asm volatile("" : "+v"(acc[0][1][0][0]), "+v"(acc[0][1][0][1]), "+v"(acc[0][1][1][0]), "+v"(acc[0][1][1][1]), "+v"(acc[0][1][2][0]), "+v"(acc[0][1][2][1]), "+v"(acc[0][1][3][0]), "+v"(acc[0][1][3][1]) :: "memory");
            asm volatile("" : "+v"(acc[1][0][0][0]), "+v"(acc[1][0][0][1]), "+v"(acc[1][0][1][0]), "+v"(acc[1][0][1][1]), "+v"(acc[1][0][2][0]), "+v"(acc[1][0][2][1]), "+v"(acc[1][0][3][0]), "+v"(acc[1][0][3][1]) :: "memory");
            asm volatile("" : "+v"(acc[1][1][0][0]), "+v"(acc[1][1][0][1]), "+v"(acc[1][1][1][0]), "+v"(acc[1][1][1][1]), "+v"(acc[1][1][2][0]), "+v"(acc[1][1][2][1]), "+v"(acc[1][1][3][0]), "+v"(acc[1][1][3][1]) :: "memory");
        }
        if constexpr (!Epi::AFTER_DRAIN) { E(acc, cur, wr, wc, fr, fq); S.done(cur); }
        if (!has_next) break;
#pragma unroll
        for (int a = 0; a < 2; ++a)
#pragma unroll
            for (int b = 0; b < 2; ++b)
#pragma unroll
                for (int m = 0; m < 4; ++m)
#pragma unroll
                    for (int n = 0; n < 2; ++n) acc[a][b][m][n] = (f32x4){0.f, 0.f, 0.f, 0.f};
        cur = nxt; cA = nA; cB = nB; ++ui;
        if constexpr (ALIGN_EPI) { if (wr == 1) PG8_BAR; }
    }
    PG8_WAIT_V(0);
    if constexpr (!ALIGN_EPI) { if (wr == 0) PG8_BAR; }
    PG8_BAR;
    if constexpr (Epi::AFTER_DRAIN) { E.fused(acc, cur, wr, wc, fr, fq, lds, wid, lane); S.done(cur); }
#undef PG8_SA
#undef PG8_SB
#undef PG8_STAGE
#undef PG8_LDA
#undef PG8_LDB
#undef PG8_MMA
#undef PG8_LD16
#undef PG8_WAIT_V
#undef PG8_WAIT_L
#undef PG8_BAR
#undef PG8_SCHED
}
}

namespace att {
typedef unsigned short bf16;
using bf16x8 = __attribute__((ext_vector_type(8))) short;
using s16x4  = __attribute__((ext_vector_type(4))) short;
using f32x16 = __attribute__((ext_vector_type(16))) float;
using u32x4  = __attribute__((ext_vector_type(4))) unsigned;
constexpr int NW = 8, QBLK = 32, KVBLK = 64, DV = 128;
constexpr float THR = 8.f;
constexpr int SHM_V = KVBLK * DV * 2;
#define ATT_SBAR() __builtin_amdgcn_sched_barrier(0)
__device__ __forceinline__ int crow(int r, int hi) { return (r & 3) + 8 * (r >> 2) + 4 * hi; }
__device__ __forceinline__ unsigned cvtpk(float lo, float hi) { unsigned r; asm volatile("v_cvt_pk_bf16_f32 %0, %1, %2" : "=v"(r) : "v"(lo), "v"(hi)); return r; }
template <int DQ> struct Cst { static constexpr float SCALE = (DQ == 128) ? 0.088388347648318440f : 0.072168783648703220f; static constexpr int SHM_K = KVBLK * DQ * 2, ROWB = DQ * 2; };

template <int DQ>
__device__ __forceinline__ void partialSM(f32x16& p0, f32x16& p1, float& m_reg, float& mn, float& alpha) {
  constexpr float SCALE = Cst<DQ>::SCALE, C = SCALE * 1.4426950408889634f;
  float pmax = p0[0];
#pragma unroll
  for (int r = 1; r < 16; ++r) pmax = fmaxf(pmax, p0[r]);
#pragma unroll
  for (int r = 0; r < 16; ++r) pmax = fmaxf(pmax, p1[r]);
  { auto rr = __builtin_amdgcn_permlane32_swap(__float_as_uint(pmax), __float_as_uint(pmax), false, false);
    pmax = fmaxf(__uint_as_float(rr[0]), __uint_as_float(rr[1])); }
  if (__builtin_expect(__all(pmax - m_reg <= THR / SCALE), 1)) { mn = m_reg; alpha = 1.f; }
  else { mn = fmaxf(m_reg, pmax); alpha = __builtin_amdgcn_exp2f((m_reg - mn) * C); m_reg = mn; }
  const float mnC = -mn * C;
#pragma unroll
  for (int r = 0; r < 16; ++r) p0[r] = fmaf(p0[r], C, mnC);
#pragma unroll
  for (int r = 0; r < 16; ++r) p1[r] = fmaf(p1[r], C, mnC);
#pragma unroll
  for (int r = 0; r < 16; ++r) p0[r] = __builtin_amdgcn_exp2f(p0[r]);
}
__device__ __forceinline__ void finishSM(f32x16& p0, f32x16& p1, float alpha, float& l_reg, bf16x8& pa0, bf16x8& pa1, bf16x8& pa2, bf16x8& pa3) {
#pragma unroll
  for (int r = 0; r < 16; ++r) p1[r] = __builtin_amdgcn_exp2f(p1[r]);
  float ps = 0;
#pragma unroll
  for (int r = 0; r < 16; ++r) ps += p0[r];
#pragma unroll
  for (int r = 0; r < 16; ++r) ps += p1[r];
  { auto rr = __builtin_amdgcn_permlane32_swap(__float_as_uint(ps), __float_as_uint(ps), false, false);
    ps = __uint_as_float(rr[0]) + __uint_as_float(rr[1]); }
  l_reg = l_reg * alpha + ps;
#define ATT_PK4(P, BASE, OUT) do { unsigned a0 = cvtpk(P[BASE + 0], P[BASE + 1]), a1 = cvtpk(P[BASE + 2], P[BASE + 3]);   \
    unsigned b0 = cvtpk(P[BASE + 4], P[BASE + 5]), b1 = cvtpk(P[BASE + 6], P[BASE + 7]);                              \
    auto r0 = __builtin_amdgcn_permlane32_swap(a0, b0, false, false); auto r1 = __builtin_amdgcn_permlane32_swap(a1, b1, false, false); \
    u32x4 w = {r0[0], r1[0], r0[1], r1[1]}; OUT = *reinterpret_cast<bf16x8*>(&w); } while (0)
  ATT_PK4(p0, 0, pa0); ATT_PK4(p0, 8, pa1); ATT_PK4(p1, 0, pa2); ATT_PK4(p1, 8, pa3);
#undef ATT_PK4
}
template <int DQ, int NREG>
__device__ __forceinline__ void qkt(f32x16& p0, f32x16& p1, const char* Ks, const bf16x8* qr, const char* qpark, int r32, int hi) {
  constexpr int ROWB = Cst<DQ>::ROWB;
  p0 = f32x16{}; p1 = f32x16{};
#pragma unroll
  for (int d0 = 0; d0 < DQ / 16; ++d0) { const int cb = (d0 * 16 + hi * 8) * 2;
    bf16x8 b0 = *reinterpret_cast<const bf16x8*>(Ks + (r32 * ROWB + (cb ^ ((r32 & 7) << 4))));
    bf16x8 b1 = *reinterpret_cast<const bf16x8*>(Ks + ((32 + r32) * ROWB + (cb ^ ((r32 & 7) << 4))));
    bf16x8 q; if constexpr (true) { if (d0 < NREG) q = qr[d0 < NREG ? d0 : 0]; else q = *reinterpret_cast<const bf16x8*>(qpark + (d0 - NREG) * 1024); }
    p0 = __builtin_amdgcn_mfma_f32_32x32x16_bf16(b0, q, p0, 0, 0, 0);
    p1 = __builtin_amdgcn_mfma_f32_32x32x16_bf16(b1, q, p1, 0, 0, 0); }
}
__device__ __forceinline__ int v_st(int k, int c) { const int kk = (k & ~0xC) | ((k & 4) << 1) | ((k & 8) >> 1); return ((kk >> 3) * 4 + (c >> 5)) * 512 + ((kk & 7) * 32 + (c & 31)) * 2; }
__device__ __forceinline__ int v_rd_base(int lane) { return ((lane & 3) << 3) | (((lane >> 2) & 3) << 6) | (((lane >> 4) & 1) << 5) | (((lane >> 5) & 1) << 8); }
constexpr int v_rd_off(int d0, int ks, int half) { return d0 * 512 + ks * 4096 + half * 2048; }
template <int OFF> __device__ __forceinline__ s16x4 tr_read(int vb) {
  s16x4 r; asm volatile("ds_read_b64_tr_b16 %0, %1 offset:%2" : "=&v"(r) : "v"(vb), "i"(OFF) : "memory"); return r;
}
template <int D0> __device__ __forceinline__ void pv_one(f32x16& od, int vb, bf16x8 pa0, bf16x8 pa1, bf16x8 pa2, bf16x8 pa3) {
  const s16x4 l0 = tr_read<v_rd_off(D0, 0, 0)>(vb), h0 = tr_read<v_rd_off(D0, 0, 1)>(vb), l1 = tr_read<v_rd_off(D0, 1, 0)>(vb), h1 = tr_read<v_rd_off(D0, 1, 1)>(vb);
  const s16x4 l2 = tr_read<v_rd_off(D0, 2, 0)>(vb), h2 = tr_read<v_rd_off(D0, 2, 1)>(vb), l3 = tr_read<v_rd_off(D0, 3, 0)>(vb), h3 = tr_read<v_rd_off(D0, 3, 1)>(vb);
  asm volatile("s_waitcnt lgkmcnt(0)" ::: "memory"); ATT_SBAR();
#define ATT_PK(L, H) (bf16x8){L[0], L[1], L[2], L[3], H[0], H[1], H[2], H[3]}
  od = __builtin_amdgcn_mfma_f32_32x32x16_bf16(pa0, ATT_PK(l0, h0), od, 0, 0, 0);
  od = __builtin_amdgcn_mfma_f32_32x32x16_bf16(pa1, ATT_PK(l1, h1), od, 0, 0, 0);
  od = __builtin_amdgcn_mfma_f32_32x32x16_bf16(pa2, ATT_PK(l2, h2), od, 0, 0, 0);
  od = __builtin_amdgcn_mfma_f32_32x32x16_bf16(pa3, ATT_PK(l3, h3), od, 0, 0, 0);
#undef ATT_PK
}
__device__ __forceinline__ void pv_d0(f32x16* o, int vb, bf16x8 pa0, bf16x8 pa1, bf16x8 pa2, bf16x8 pa3) {
  pv_one<0>(o[0], vb, pa0, pa1, pa2, pa3); pv_one<1>(o[1], vb, pa0, pa1, pa2, pa3); pv_one<2>(o[2], vb, pa0, pa1, pa2, pa3); pv_one<3>(o[3], vb, pa0, pa1, pa2, pa3);
}
__device__ __forceinline__ void natten_mod(f32x16& p0, f32x16& p1, int kr, int rq, int qc, const float* biasT, int hi) {
  const int r0 = min(max(rq - 4, 0), 56), c0 = min(max(qc - 8, 0), 48);
  const float NEG = -__builtin_inff();
  if (kr < r0 || kr >= r0 + 8) {
#pragma unroll
    for (int r = 0; r < 16; ++r) { p0[r] = NEG; p1[r] = NEG; }
  } else {
    const float* bl = biasT + (kr - rq + 7) * 128 + (63 - qc + 4 * hi);
    const int t = 4 * hi - c0;
#pragma unroll
    for (int r = 0; r < 16; ++r) {
      const int kcc = (r & 3) + 8 * (r >> 2);
      const bool ok0 = (unsigned)(t + kcc) < 16u, ok1 = (unsigned)(t + kcc + 32) < 16u;
      const float b0 = bl[kcc], b1 = bl[kcc + 32];
      p0[r] = ok0 ? p0[r] + b0 : NEG; p1[r] = ok1 ? p1[r] + b1 : NEG;
      if ((r & 3) == 3) __builtin_amdgcn_sched_barrier(0);
    }
  }
}

template <int DQ, int LDQ, int LDK, int LDV, int LDO, int MODE, int SDEPTH, int NREG>
__device__ __forceinline__ void attn_body(const bf16* __restrict__ Qb, const bf16* __restrict__ Kh, const bf16* __restrict__ Vh, bf16* __restrict__ Ob, const int NT, char* lds,
                                          const int rq0, const int kr_lo, const float* biasT) {
  constexpr int SHM_K = Cst<DQ>::SHM_K, ROWB = Cst<DQ>::ROWB;
  int tid_ = threadIdx.x; asm volatile("" : "+v"(tid_));
  const int tid = tid_, wid = tid >> 6, lane = tid & 63, r32 = lane & 31, hi = lane >> 5;
  char* V_lds = lds; char* K_lds = lds + 2 * SHM_V;
  float* ws = (float*)(lds + 2 * SHM_V + 2 * SHM_K) + wid * 64; float* li_l = ws; float* al_l = ws + 32;
  float m_reg = -1e30f, l_reg = 0; f32x16 o[4] = {}; bf16x8 qr[NREG > 0 ? NREG : 1];
  const bf16* Qw = Qb + (long)(wid * QBLK + r32) * LDQ + hi * 8;
  char* qpark = lds + 2 * SHM_V + 2 * SHM_K + NW * 64 * 4 + wid * ((DQ / 16 - NREG) * 1024) + hi * 512 + r32 * 16;
#pragma unroll
  for (int d0 = 0; d0 < DQ / 16; ++d0) { const bf16x8 qv = *reinterpret_cast<const bf16x8*>(Qw + d0 * 16); if (d0 < NREG) qr[d0 < NREG ? d0 : 0] = qv; else *reinterpret_cast<bf16x8*>(qpark + (d0 - NREG) * 1024) = qv; }
  const int nrq = rq0 + (wid >> 1), nqc = (wid & 1) * 32 + r32;
  const int sr = tid >> 4, sc = (tid & 15) * 8, vst0 = v_st(sr, sc), vst1 = v_st(32 + sr, sc);
  const int kr3 = tid >> 3, kc3 = 128 + (tid & 7) * 8;
  const int vb0 = (int)(uintptr_t)V_lds + v_rd_base(lane);
  struct { bf16x8 vs0, vs1, ks0, ks1, ks2; } sr_[SDEPTH];
#define ATT_LD8(p) (*reinterpret_cast<const bf16x8*>(p))
#define ATT_SLOAD(i, k0) do { sr_[i].vs0 = ATT_LD8(&Vh[(long)((k0) + sr) * LDV + sc]); sr_[i].vs1 = ATT_LD8(&Vh[(long)((k0) + 32 + sr) * LDV + sc]); \
    sr_[i].ks0 = ATT_LD8(&Kh[(long)((k0) + sr) * LDK + sc]); sr_[i].ks1 = ATT_LD8(&Kh[(long)((k0) + 32 + sr) * LDK + sc]); \
    if constexpr (DQ == 192) sr_[i].ks2 = ATT_LD8(&Kh[(long)((k0) + kr3) * LDK + kc3]); } while (0)
#define ATT_SWRITE(b, i) do { *(bf16x8*)(V_lds + (b) * SHM_V + vst0) = sr_[i].vs0;          \
    *(bf16x8*)(V_lds + (b) * SHM_V + vst1) = sr_[i].vs1; const int kc = sc * 2;               \
    *(bf16x8*)(K_lds + (b) * SHM_K + sr * ROWB + (kc ^ ((sr & 7) << 4))) = sr_[i].ks0;                       \
    *(bf16x8*)(K_lds + (b) * SHM_K + (32 + sr) * ROWB + (kc ^ ((sr & 7) << 4))) = sr_[i].ks1; \
    if constexpr (DQ == 192) *(bf16x8*)(K_lds + (b) * SHM_K + kr3 * ROWB + ((kc3 * 2) ^ ((kr3 & 7) << 4))) = sr_[i].ks2; } while (0)
#define ATT_SWAIT() do { if constexpr (SDEPTH == 2) { if constexpr (DQ == 192) asm volatile("s_waitcnt vmcnt(5)" ::: "memory"); else asm volatile("s_waitcnt vmcnt(4)" ::: "memory"); } \
    else asm volatile("s_waitcnt vmcnt(0)" ::: "memory"); } while (0)
#define ATT_RESC(a) do { if (__any((a) < 1.f)) { if (hi == 0) al_l[r32] = (a); asm volatile("s_waitcnt lgkmcnt(0)" ::: "memory"); \
    _Pragma("unroll") for (int d = 0; d < 4; ++d) _Pragma("unroll") for (int r = 0; r < 16; ++r) o[d][r] *= al_l[crow(r, hi)]; } } while (0)
#define ATT_MOD(P0, P1, J) do { if constexpr (MODE == 1) natten_mod(P0, P1, kr_lo + (J), nrq, nqc, biasT, hi); } while (0)
  f32x16 pA0, pA1, pB0, pB1; float mnA, mnB, alA, alB; bf16x8 pa0, pa1, pa2, pa3;
  constexpr int SE = 0, SO = SDEPTH - 1;
  ATT_SLOAD(SE, 0); asm volatile("s_waitcnt vmcnt(0)" ::: "memory"); ATT_SWRITE(0, SE); __syncthreads();
  qkt<DQ, NREG>(pA0, pA1, K_lds, qr, qpark, r32, hi); ATT_MOD(pA0, pA1, 0); partialSM<DQ>(pA0, pA1, m_reg, mnA, alA);
  ATT_SLOAD(SO, KVBLK); if constexpr (SDEPTH == 2) { if (2 < NT) ATT_SLOAD(SE, 2 * KVBLK); }
  ATT_SWAIT(); ATT_SWRITE(1, SO); __syncthreads();
  for (int j = 1; j + 1 < NT; j += 2) {
    ATT_SBAR(); qkt<DQ, NREG>(pB0, pB1, K_lds + SHM_K, qr, qpark, r32, hi); ATT_MOD(pB0, pB1, j);
    finishSM(pA0, pA1, alA, l_reg, pa0, pa1, pa2, pa3); ATT_SBAR();
    ATT_SLOAD(SO, (j + SDEPTH) * KVBLK); ATT_SBAR();
    pv_d0(o, vb0, pa0, pa1, pa2, pa3); partialSM<DQ>(pB0, pB1, m_reg, mnB, alB);
    __syncthreads(); ATT_SWAIT(); ATT_SWRITE(0, SE);
    ATT_RESC(alB); __syncthreads();
    ATT_SBAR(); qkt<DQ, NREG>(pA0, pA1, K_lds, qr, qpark, r32, hi); ATT_MOD(pA0, pA1, j + 1);
    finishSM(pB0, pB1, alB, l_reg, pa0, pa1, pa2, pa3); ATT_SBAR();
    if (SDEPTH == 1 || j + 3 < NT) ATT_SLOAD(SE, (j + 1 + SDEPTH) * KVBLK); ATT_SBAR();
    pv_d0(o, vb0 + SHM_V, pa0, pa1, pa2, pa3); partialSM<DQ>(pA0, pA1, m_reg, mnA, alA);
    __syncthreads(); ATT_SWAIT(); ATT_SWRITE(1, SO);
    ATT_RESC(alA); __syncthreads();
  }
  ATT_SBAR(); qkt<DQ, NREG>(pB0, pB1, K_lds + SHM_K, qr, qpark, r32, hi); ATT_MOD(pB0, pB1, NT - 1);
  finishSM(pA0, pA1, alA, l_reg, pa0, pa1, pa2, pa3); ATT_SBAR();
  pv_d0(o, vb0, pa0, pa1, pa2, pa3); partialSM<DQ>(pB0, pB1, m_reg, mnB, alB);
  __syncthreads(); ATT_RESC(alB);
  finishSM(pB0, pB1, alB, l_reg, pa0, pa1, pa2, pa3); ATT_SBAR();
  pv_d0(o, vb0 + SHM_V, pa0, pa1, pa2, pa3);
  if (hi == 0) li_l[r32] = l_reg; asm volatile("s_waitcnt lgkmcnt(0)" ::: "memory");
  float rli[16];
#pragma unroll
  for (int r = 0; r < 16; ++r) rli[r] = __builtin_amdgcn_rcpf(li_l[crow(r, hi)]);
  bf16* Ow = Ob + (long)(wid * QBLK) * LDO;
#pragma unroll
  for (int r = 0; r < 16; ++r) { const int orow = crow(r, hi);
#pragma unroll
    for (int d0 = 0; d0 < 4; d0 += 1) { const unsigned w = cvtpk(o[d0][r] * rli[r], 0.f); Ow[(long)orow * LDO + d0 * 32 + r32] = (bf16)(w & 0xffffu); } }
#undef ATT_LD8
#undef ATT_SLOAD
#undef ATT_SWRITE
#undef ATT_SWAIT
#undef ATT_RESC
#undef ATT_MOD
}
}

#ifndef PH_MASK
#define PH_MASK 0xFFFFFFFFu
#endif
#define PHON(k) (((PH_MASK) >> (k)) & 1u)
#ifndef REP_MASK
#define REP_MASK 0u
#endif
#define REP(k) (((REP_MASK) >> (k)) & 1u)
#ifndef FFN_F8
#define FFN_F8 7
#endif
#ifndef MOE_CVT_IN_ATTN
#define MOE_CVT_IN_ATTN 1
#endif
constexpr bool F8DG = (FFN_F8 & 1) != 0, F8DD = (FFN_F8 & 4) != 0, F8M = (FFN_F8 & 2) != 0;
constexpr float SC_H = 4.f, SC_ACT = 8.f, SC_W = 256.f;
constexpr int NWAVES = 8;
constexpr int DM = 2048, BATCH = 4, SEQ = 4096, NTOK = BATCH * SEQ, DEPTH = 2;
constexpr int DIN = 3904, DINP = 4096;
constexpr int DFF = 5632, NE = 8, DFE = 7168;
constexpr int PC_QA = 0, PC_KA = 512, PC_VA = 1024, PC_QB = 1536, PC_KB = 2560, PC_VB = 2816, PC_CQ = 3072, PC_CKV = 3584, PC_KPE = 3840;
constexpr float EPS = 1e-6f;
constexpr int MAXTILES = 136;
constexpr int MAXSLOTS = MAXTILES * 256;

constexpr size_t MiB = 1u << 20;
constexpr size_t WS_CTL = 0, CTL_ZERO_BYTES = 1 * MiB;
constexpr size_t WS_WIN = 1 * MiB;
constexpr size_t WS_WUQ = WS_WIN + 32 * MiB;
constexpr size_t WS_WUKV = WS_WUQ + 2 * MiB;
constexpr size_t WS_WOUT = WS_WUKV + 1 * MiB;
constexpr size_t WS_WGU = WS_WOUT + 16 * MiB;
constexpr size_t WS_WD = WS_WGU + 44 * MiB;
constexpr size_t WS_WEGU = WS_WD + 22 * MiB;
constexpr size_t WS_WED = WS_WEGU + 448 * MiB;
constexpr size_t WS_H = WS_WED + 224 * MiB;
constexpr size_t WS_ACT0 = WS_H + 64 * MiB;
constexpr size_t WS_PROJ = WS_ACT0;
constexpr size_t WS_QA = WS_PROJ + 128 * MiB;
constexpr size_t WS_KA = WS_QA + 16 * MiB;
constexpr size_t WS_QB = WS_KA + 16 * MiB;
constexpr size_t WS_KB = WS_QB + 32 * MiB;
constexpr size_t WS_CQN = WS_KB + 8 * MiB;
constexpr size_t WS_CKVN = WS_CQN + 16 * MiB;
constexpr size_t WS_KPE = WS_CKVN + 8 * MiB;
constexpr size_t WS_QCR = WS_KPE + 2 * MiB;
constexpr size_t WS_KVR = WS_QCR + 24 * MiB;
constexpr size_t WS_QC = WS_KVR + 32 * MiB;
constexpr size_t WS_KC = WS_QC + 24 * MiB;
constexpr size_t WS_O = WS_KC + 24 * MiB;
constexpr size_t WS_ON = WS_O + 64 * MiB;
constexpr size_t WS_ATT_END = WS_ON + 64 * MiB;
constexpr size_t WS_ACT = WS_ACT0;
constexpr size_t WS_HG = WS_ACT0;
constexpr size_t WS_ACTM = WS_HG + 136 * MiB;
constexpr size_t WS_Y = WS_ACTM + 476 * MiB;
constexpr size_t WS_RGATE = WS_Y + 136 * MiB;
constexpr size_t WS_TOKE = WS_RGATE + 1 * MiB;
constexpr size_t WS_TOKP = WS_TOKE + 1 * MiB;
constexpr size_t WS_TOKW = WS_TOKP + 1 * MiB;
constexpr size_t WS_END = WS_TOKW + 1 * MiB;
constexpr size_t WS_XB = WS_END;
constexpr size_t WS_END2 = WS_XB + 64 * MiB;
constexpr size_t WS_PART = WS_END2;
constexpr size_t WS_END3 = WS_PART + 64 * MiB;
constexpr size_t WS_DUMMY = WS_END3;
static_assert(WS_ATT_END <= WS_END, "map");
constexpr int CW_CNT = 64;
constexpr int CW_BAR = 4096;

constexpr int RING_BYTES = 131072;
constexpr int LDS_BYTES = 163840;
constexpr int MISC_OFF = LDS_BYTES - 256;

#define GAS __attribute__((address_space(1)))
#define LAS __attribute__((address_space(3)))
typedef unsigned short bf16;
typedef unsigned v4u __attribute__((ext_vector_type(4)));
typedef unsigned v2u __attribute__((ext_vector_type(2)));
typedef float f32x4 __attribute__((ext_vector_type(4)));
typedef float f32x2 __attribute__((ext_vector_type(2)));
__device__ __forceinline__ unsigned pk2(float lo, float hi) { unsigned r; asm volatile("v_cvt_pk_bf16_f32 %0, %1, %2" : "=v"(r) : "v"(lo), "v"(hi)); return r; }
__device__ __forceinline__ float bf_lo(unsigned w) { return __uint_as_float(w << 16); }
__device__ __forceinline__ float bf_hi(unsigned w) { return __uint_as_float(w & 0xffff0000u); }
__device__ __forceinline__ float wave_sum(float v) {
#pragma unroll
    for (int o = 1; o < 64; o <<= 1) v += __shfl_xor(v, o);
    return v;
}
__device__ __forceinline__ float rsq(float x) { return __builtin_amdgcn_rsqf(x); }
#define XB_TMO      128
#define XB_XCNT(j)  (256  + 64 * (j))
#define XB_XSUB(j)  (1280 + 64 * (j))
#define XB_XGEN(j)  (2304 + 64 * (j))
#define XB_TOP      3328
#define XB_TOPGEN   3392
#define XCD_BAR_WORDS 3456
#define XB_SPIN_CAP (1u << 18)

__device__ __forceinline__ unsigned xb_ld(unsigned* p)              { return __hip_atomic_load(p, __ATOMIC_RELAXED, __HIP_MEMORY_SCOPE_AGENT); }
__device__ __forceinline__ unsigned xb_add(unsigned* p, unsigned v) { return __hip_atomic_fetch_add(p, v, __ATOMIC_RELAXED, __HIP_MEMORY_SCOPE_AGENT); }
__device__ __forceinline__ unsigned xb_xcc_id() { return (unsigned)__builtin_amdgcn_s_getreg((3 << 11) | 20) & 0xFu; }
#define XB_SPIN(cond, bar) do { unsigned _sp = 0; while (cond) { __builtin_amdgcn_s_sleep(1); \
    if ((++_sp & 255u) == 0u) { if (xb_ld(&(bar)[XB_TMO])) break; if (_sp > XB_SPIN_CAP) { atomicAdd(&(bar)[XB_TMO], 1u); break; } } } } while (0)

struct XcdBarrier {
    unsigned* bar; unsigned x;
    volatile LAS unsigned* st;
};

__device__ __forceinline__ XcdBarrier xcd_barrier_post(unsigned* bar, volatile LAS unsigned* st) {
    XcdBarrier b; b.bar = bar; b.x = xb_xcc_id(); b.st = st;
    if (threadIdx.x == 0) (void)xb_add(&bar[XB_XCNT(b.x)], 1u);
    return b;
}
__device__ __forceinline__ void xcd_barrier_complete(unsigned* bar, unsigned x, unsigned& nloc, unsigned& nx) {
    const unsigned G = gridDim.x * gridDim.y * gridDim.z;
    unsigned sum, cnt, mine, sp = 0u;
    for (;;) {
        sum = 0u; cnt = 0u; mine = 0u;
#pragma unroll
        for (unsigned j = 0; j < 16; ++j) { const unsigned c = xb_ld(&bar[XB_XCNT(j)]); sum += c; cnt += (c > 0u) ? 1u : 0u; mine = (j == x) ? c : mine; }
        if (sum == G) break;
        __builtin_amdgcn_s_sleep(1);
        if ((++sp & 255u) == 0u) { if (xb_ld(&bar[XB_TMO])) break; if (sp > XB_SPIN_CAP) { atomicAdd(&bar[XB_TMO], 1u); break; } }
    }
    nloc = mine > 0u ? mine : 1u; nx = cnt > 0u ? cnt : 1u;
}

__device__ __forceinline__ void xcd_barrier(const XcdBarrier& b) {
    asm volatile("s_waitcnt vmcnt(0)" ::: "memory");
    __syncthreads();
    if (threadIdx.x == 0) {
        unsigned* bar = b.bar;
        __builtin_amdgcn_s_waitcnt(0);
        unsigned nloc = b.st[0], nx = b.st[1];
        if (nloc == 0u) { xcd_barrier_complete(bar, b.x, nloc, nx); b.st[0] = nloc; b.st[1] = nx; }
        const unsigned old = xb_add(&bar[XB_XSUB(b.x)], 1u);
        const unsigned gen = old / nloc;
        if (old + 1u == (gen + 1u) * nloc) {
            __builtin_amdgcn_fence(__ATOMIC_RELEASE, "agent");
            asm volatile("s_waitcnt vmcnt(0)" ::: "memory");
            const unsigned og = xb_add(&bar[XB_TOP], 1u);
            const unsigned tg = og / nx;
            if (og + 1u == (tg + 1u) * nx) xb_add(&bar[XB_TOPGEN], 1u);
            else XB_SPIN(xb_ld(&bar[XB_TOPGEN]) == tg, bar);
            __builtin_amdgcn_fence(__ATOMIC_ACQUIRE, "agent");
            xb_add(&bar[XB_XGEN(b.x)], 1u);
            asm volatile("s_waitcnt vmcnt(0)" ::: "memory");
        } else {
            XB_SPIN(xb_ld(&bar[XB_XGEN(b.x)]) == gen, bar);
            __builtin_amdgcn_fence(__ATOMIC_ACQUIRE, "agent");
            asm volatile("s_waitcnt vmcnt(0)" ::: "memory");
        }
    }
    __syncthreads();
}

struct Args { const float* in[26]; float* out; unsigned char* ws; int ph_lo, ph_hi; };
enum { I_X = 0, I_MIXN, I_WIN, I_RPB, I_QNA, I_KNA, I_QNB, I_KNB, I_CQN, I_CKVN, I_WUQ, I_WUKV, I_QNC, I_KNC, I_ONA, I_ONB, I_ONC, I_WOUT, I_FFNN, I_WG, I_WU, I_WDN, I_ROUTER, I_WEG, I_WEU, I_WED };
struct Frame {
    LAS unsigned char* lds; unsigned char* ws; unsigned* ctl;
    int wave, G, bid, gw, ngw;
};

__device__ __forceinline__ void transpose_item(const float* __restrict__ W, int K, int N, bf16* __restrict__ WT, int row_off, int mode, LAS float* scr, int item, int lane) {
    (void)scr;
    const int nblk = N >> 5, kb = item / nblk, nb = item - kb * nblk, k0 = kb << 6, n0 = nb << 5; const int c = lane >> 3, q = lane & 7;
    const float* p = W + (size_t)(k0 + 8 * c) * N + n0 + 4 * q;
    f32x4 v[8];
#pragma unroll
    for (int i = 0; i < 8; ++i) v[i] = *(const f32x4*)(p + (size_t)i * N);
    const int drow0 = (mode == 0) ? (row_off + n0) : (row_off + (n0 >> 7) * 256 + (mode - 1) * 128 + (n0 & 127));
    bf16* d = WT + (size_t)(drow0 + 4 * q) * K + k0 + 8 * c;
#pragma unroll
    for (int j = 0; j < 4; ++j) { v4u o; o.x = pk2(v[0][j], v[1][j]); o.y = pk2(v[2][j], v[3][j]); o.z = pk2(v[4][j], v[5][j]); o.w = pk2(v[6][j], v[7][j]); *(v4u*)(d + (size_t)j * K) = o; }
}

__device__ __forceinline__ unsigned pk4_fp8(float a, float b, float c, float d) { unsigned w = 0u; w = __builtin_amdgcn_cvt_pk_fp8_f32(a, b, w, false); w = __builtin_amdgcn_cvt_pk_fp8_f32(c, d, w, true); return w; }
__device__ __forceinline__ void transpose_item_f8(const float* __restrict__ W, int K, int N, unsigned char* __restrict__ WT, int row_off, int mode, float wsc, LAS float* scr, int item, int lane) {
    (void)scr;
    const int nblk = N >> 5, kb = item / nblk, nb = item - kb * nblk, k0 = kb << 7, n0 = nb << 5; const int c = lane >> 3, q = lane & 7;
    const float* p = W + (size_t)(k0 + 16 * c) * N + n0 + 4 * q;
    f32x4 v[16];
#pragma unroll
    for (int i = 0; i < 16; ++i) v[i] = *(const f32x4*)(p + (size_t)i * N);
    const int drow0 = (mode == 0) ? (row_off + n0) : (row_off + (n0 >> 7) * 256 + (mode - 1) * 128 + (n0 & 127));
    unsigned char* d = WT + (size_t)(drow0 + 4 * q) * K + k0 + 16 * c;
#pragma unroll
    for (int j = 0; j < 4; ++j) {
        v4u o; o.x = pk4_fp8(v[0][j] * wsc, v[1][j] * wsc, v[2][j] * wsc, v[3][j] * wsc); o.y = pk4_fp8(v[4][j] * wsc, v[5][j] * wsc, v[6][j] * wsc, v[7][j] * wsc);
        o.z = pk4_fp8(v[8][j] * wsc, v[9][j] * wsc, v[10][j] * wsc, v[11][j] * wsc); o.w = pk4_fp8(v[12][j] * wsc, v[13][j] * wsc, v[14][j] * wsc, v[15][j] * wsc);
        *(v4u*)(d + (size_t)j * K) = o; }
}

template <bool SRCB>
__device__ __forceinline__ void load_row32(const void* __restrict__ row, int lane, float (&v)[4][8]) {
    if constexpr (SRCB) { const v4u* p = (const v4u*)row + lane;
#pragma unroll
        for (int j = 0; j < 4; ++j) { const v4u w = p[64 * j]; v[j][0] = bf_lo(w.x); v[j][1] = bf_hi(w.x); v[j][2] = bf_lo(w.y); v[j][3] = bf_hi(w.y); v[j][4] = bf_lo(w.z); v[j][5] = bf_hi(w.z); v[j][6] = bf_lo(w.w); v[j][7] = bf_hi(w.w); }
    } else { const f32x4* p = (const f32x4*)row + 2 * lane;
#pragma unroll
        for (int j = 0; j < 4; ++j) { const f32x4 a = p[128 * j], b = p[128 * j + 1]; v[j][0] = a[0]; v[j][1] = a[1]; v[j][2] = a[2]; v[j][3] = a[3]; v[j][4] = b[0]; v[j][5] = b[1]; v[j][6] = b[2]; v[j][7] = b[3]; }
    }
}
__device__ __forceinline__ void load_gain32(const float* __restrict__ gain, int lane, float osc, float (&g)[4][8]) {
    const f32x4* p = (const f32x4*)gain + 2 * lane;
#pragma unroll
    for (int j = 0; j < 4; ++j) { const f32x4 a = p[128 * j], b = p[128 * j + 1]; g[j][0] = a[0] * osc; g[j][1] = a[1] * osc; g[j][2] = a[2] * osc; g[j][3] = a[3] * osc; g[j][4] = b[0] * osc; g[j][5] = b[1] * osc; g[j][6] = b[2] * osc; g[j][7] = b[3] * osc; }
}
template <bool F8OUT, bool SRCB>
__device__ __forceinline__ void phase_rmsnorm(const Frame& F, const void* __restrict__ src, const float* __restrict__ gain, void* __restrict__ dstv, float osc) {
    int tid_ = threadIdx.x; asm volatile("" : "+v"(tid_)); const int tid = tid_, lane = tid & 63; (void)tid; (void)lane;
    float g[4][8]; load_gain32(gain, lane, osc, g);
    for (int m = F.gw; m < NTOK; m += F.ngw) {
        float v[4][8]; load_row32<SRCB>((const unsigned char*)src + (size_t)m * DM * (SRCB ? 2 : 4), lane, v); float s = 0.f;
#pragma unroll
        for (int j = 0; j < 4; ++j)
#pragma unroll
            for (int i = 0; i < 8; ++i) s += v[j][i] * v[j][i];
        const float rstd = rsq(wave_sum(s) * (1.f / DM) + EPS);
        if constexpr (F8OUT) { v2u* o8 = (v2u*)((unsigned char*)dstv + (size_t)m * DM) + lane;
#pragma unroll
            for (int j = 0; j < 4; ++j) { v2u w; w.x = pk4_fp8(v[j][0] * rstd * g[j][0], v[j][1] * rstd * g[j][1], v[j][2] * rstd * g[j][2], v[j][3] * rstd * g[j][3]);
                w.y = pk4_fp8(v[j][4] * rstd * g[j][4], v[j][5] * rstd * g[j][5], v[j][6] * rstd * g[j][6], v[j][7] * rstd * g[j][7]); o8[64 * j] = w; }
        } else { v4u* o16 = (v4u*)((bf16*)dstv + (size_t)m * DM) + lane;
#pragma unroll
            for (int j = 0; j < 4; ++j) { v4u w; w.x = pk2(v[j][0] * rstd * g[j][0], v[j][1] * rstd * g[j][1]); w.y = pk2(v[j][2] * rstd * g[j][2], v[j][3] * rstd * g[j][3]);
                w.z = pk2(v[j][4] * rstd * g[j][4], v[j][5] * rstd * g[j][5]); w.w = pk2(v[j][6] * rstd * g[j][6], v[j][7] * rstd * g[j][7]); o16[64 * j] = w; } }
    }
}

__device__ __forceinline__ float rope_apply(float v, float c, float s, float sgn) { const float p = __shfl_xor(v, 16); return v * c + sgn * p * s; }
__device__ __forceinline__ void sincos_rev(float ang, float& s, float& c) { const float r = ang * 0.15915494309189535f; const float f = r - floorf(r); s = __builtin_amdgcn_sinf(f); c = __builtin_amdgcn_cosf(f); }

__device__ __forceinline__ void phase_postproj(const Frame& F, const Args& a, int l) {
    int tid_ = threadIdx.x; asm volatile("" : "+v"(tid_)); const int tid = tid_, lane = tid & 63; (void)tid; (void)lane;
    const bf16* PROJ = (const bf16*)(F.ws + WS_PROJ);
    bf16* QA = (bf16*)(F.ws + WS_QA); bf16* KA = (bf16*)(F.ws + WS_KA); bf16* QB = (bf16*)(F.ws + WS_QB); bf16* KB = (bf16*)(F.ws + WS_KB);
    bf16* CQN = (bf16*)(F.ws + WS_CQN); bf16* CKVN = (bf16*)(F.ws + WS_CKVN); bf16* KPE = (bf16*)(F.ws + WS_KPE);
    const f32x2 gqa = ((const f32x2*)(a.in[I_QNA] + l * 128))[lane], gka = ((const f32x2*)(a.in[I_KNA] + l * 128))[lane];
    const f32x2 gqb = ((const f32x2*)(a.in[I_QNB] + l * 128))[lane], gkb = ((const f32x2*)(a.in[I_KNB] + l * 128))[lane];
    const f32x4 gcq0 = ((const f32x4*)(a.in[I_CQN] + l * 512))[2 * lane], gcq1 = ((const f32x4*)(a.in[I_CQN] + l * 512))[2 * lane + 1];
    const f32x4 gckv = ((const f32x4*)(a.in[I_CKVN] + l * 256))[lane];
    const float gkpe = a.in[I_KNC][l * 192 + 128 + lane];
    constexpr float LOG2T = 13.287712379549449f;
    const int q = lane & 15;
    const float f128a = __builtin_amdgcn_exp2f(-(float)(2 * q) * (LOG2T / 32.f)), f128b = __builtin_amdgcn_exp2f(-(float)(2 * q + 1) * (LOG2T / 32.f));
    const float f64 = __builtin_amdgcn_exp2f(-(float)q * (LOG2T / 16.f));
    const float sgn = (lane & 16) ? 1.f : -1.f;
    for (int t = F.gw; t < NTOK; t += F.ngw) {
        const int pos = t & (SEQ - 1); const float p = (float)((lane & 32) ? (pos & 63) : (pos >> 6));
        float s0, c0, s1, c1, s2, c2; sincos_rev(p * f128a, s0, c0); sincos_rev(p * f128b, s1, c1); sincos_rev(p * f64, s2, c2);
        const bf16* pr = PROJ + (size_t)t * DINP;
        unsigned hv[18];
#pragma unroll
        for (int i = 0; i < 8; ++i) hv[i] = ((const unsigned*)(pr + i * 128))[lane];
#pragma unroll
        for (int i = 8; i < 18; ++i) hv[i] = ((const unsigned*)(pr + PC_QB + (i - 8) * 128))[lane];
        const v4u cqv = ((const v4u*)(pr + PC_CQ))[lane]; const v2u ckvv = ((const v2u*)(pr + PC_CKV))[lane]; const unsigned kpev = (unsigned)pr[PC_KPE + lane];
#pragma unroll
        for (int i = 0; i < 18; ++i) {
            float v0 = bf_lo(hv[i]), v1 = bf_hi(hv[i]);
            const float rstd = rsq(wave_sum(v0 * v0 + v1 * v1) * (1.f / 128.f) + EPS);
            const f32x2 g = (i < 4) ? gqa : (i < 8) ? gka : (i < 16) ? gqb : gkb;
            v0 = v0 * rstd * g[0]; v1 = v1 * rstd * g[1];
            if (i >= 8) { v0 = rope_apply(v0, c0, s0, sgn); v1 = rope_apply(v1, c1, s1, sgn); }
            bf16* dst = (i < 4) ? (QA + (size_t)t * 512 + i * 128) : (i < 8) ? (KA + (size_t)t * 512 + (i - 4) * 128) : (i < 16) ? (QB + (size_t)t * 1024 + (i - 8) * 128) : (KB + (size_t)t * 256 + (i - 16) * 128);
            ((unsigned*)dst)[lane] = pk2(v0, v1);
        }
        {
            float x[8] = {bf_lo(cqv.x), bf_hi(cqv.x), bf_lo(cqv.y), bf_hi(cqv.y), bf_lo(cqv.z), bf_hi(cqv.z), bf_lo(cqv.w), bf_hi(cqv.w)}; float s = 0.f;
#pragma unroll
            for (int i = 0; i < 8; ++i) s += x[i] * x[i];
            const float rstd = rsq(wave_sum(s) * (1.f / 512.f) + EPS);
            v4u w; w.x = pk2(x[0] * rstd * gcq0[0], x[1] * rstd * gcq0[1]); w.y = pk2(x[2] * rstd * gcq0[2], x[3] * rstd * gcq0[3]);
            w.z = pk2(x[4] * rstd * gcq1[0], x[5] * rstd * gcq1[1]); w.w = pk2(x[6] * rstd * gcq1[2], x[7] * rstd * gcq1[3]);
            ((v4u*)(CQN + (size_t)t * 512))[lane] = w;
        }
        {
            const float x0 = bf_lo(ckvv.x), x1 = bf_hi(ckvv.x), x2 = bf_lo(ckvv.y), x3 = bf_hi(ckvv.y);
            const float rstd = rsq(wave_sum((x0 * x0 + x1 * x1) + (x2 * x2 + x3 * x3)) * (1.f / 256.f) + EPS);
            v2u w; w.x = pk2(x0 * rstd * gckv[0], x1 * rstd * gckv[1]); w.y = pk2(x2 * rstd * gckv[2], x3 * rstd * gckv[3]);
            ((v2u*)(CKVN + (size_t)t * 256))[lane] = w;
        }
        {
            float x = bf_lo(kpev);
            const float rstd = rsq(wave_sum(x * x) * (1.f / 64.f) + EPS);
            x = rope_apply(x * rstd * gkpe, c2, s2, sgn);
            KPE[(size_t)t * 64 + lane] = (bf16)(pk2(x, 0.f) & 0xffffu);
        }
    }
}

__device__ __forceinline__ void phase_postmla(const Frame& F, const Args& a, int l) {
    int tid_ = threadIdx.x; asm volatile("" : "+v"(tid_)); const int tid = tid_, lane = tid & 63; (void)tid; (void)lane;
    const bf16* QCR = (const bf16*)(F.ws + WS_QCR); const bf16* KVR = (const bf16*)(F.ws + WS_KVR); const bf16* KPE = (const bf16*)(F.ws + WS_KPE);
    bf16* QC = (bf16*)(F.ws + WS_QC); bf16* KC = (bf16*)(F.ws + WS_KC);
    const f32x2 gqn = ((const f32x2*)(a.in[I_QNC] + l * 192))[lane], gkn = ((const f32x2*)(a.in[I_KNC] + l * 192))[lane];
    const float gqpe = a.in[I_QNC][l * 192 + 128 + lane];
    constexpr float LOG2T = 13.287712379549449f;
    const float f64 = __builtin_amdgcn_exp2f(-(float)(lane & 15) * (LOG2T / 16.f));
    const float sgn = (lane & 16) ? 1.f : -1.f;
    for (int t = F.gw; t < NTOK; t += F.ngw) {
        const int pos = t & (SEQ - 1); const float p = (float)((lane & 32) ? (pos & 63) : (pos >> 6));
        float s2, c2; sincos_rev(p * f64, s2, c2);
        const bf16* qr = QCR + (size_t)t * 768; const bf16* kr = KVR + (size_t)t * 1024;
        unsigned qn[4], kn[4]; unsigned qp[4];
#pragma unroll
        for (int h = 0; h < 4; ++h) { qn[h] = ((const unsigned*)(qr + h * 192))[lane]; qp[h] = (unsigned)qr[h * 192 + 128 + lane]; kn[h] = ((const unsigned*)(kr + h * 256))[lane]; }
        const bf16 kpe = KPE[(size_t)t * 64 + lane];
#pragma unroll
        for (int h = 0; h < 4; ++h) {
            { float v0 = bf_lo(qn[h]), v1 = bf_hi(qn[h]); const float rstd = rsq(wave_sum(v0 * v0 + v1 * v1) * (1.f / 128.f) + EPS);
              ((unsigned*)(QC + (size_t)t * 768 + h * 192))[lane] = pk2(v0 * rstd * gqn[0], v1 * rstd * gqn[1]); }
            { float x = bf_lo(qp[h]); const float rstd = rsq(wave_sum(x * x) * (1.f / 64.f) + EPS); x = rope_apply(x * rstd * gqpe, c2, s2, sgn);
              QC[(size_t)t * 768 + h * 192 + 128 + lane] = (bf16)(pk2(x, 0.f) & 0xffffu); }
            { float v0 = bf_lo(kn[h]), v1 = bf_hi(kn[h]); const float rstd = rsq(wave_sum(v0 * v0 + v1 * v1) * (1.f / 128.f) + EPS);
              ((unsigned*)(KC + (size_t)t * 768 + h * 192))[lane] = pk2(v0 * rstd * gkn[0], v1 * rstd * gkn[1]); }
            KC[(size_t)t * 768 + h * 192 + 128 + lane] = kpe;
        }
    }
}

__device__ __forceinline__ void phase_groupnorm(const Frame& F, const Args& a, int l) {
    int tid_ = threadIdx.x; asm volatile("" : "+v"(tid_)); const int tid = tid_, lane = tid & 63; (void)tid; (void)lane;
    const bf16* O = (const bf16*)(F.ws + WS_O); bf16* ON = (bf16*)(F.ws + WS_ON);
    f32x4 g[4][2];
    { const f32x4* ga = (const f32x4*)(a.in[I_ONA] + l * 512); const f32x4* gb = (const f32x4*)(a.in[I_ONB] + l * 1024); const f32x4* gc = (const f32x4*)(a.in[I_ONC] + l * 512);
      g[0][0] = ga[2 * lane]; g[0][1] = ga[2 * lane + 1]; g[1][0] = gb[2 * lane]; g[1][1] = gb[2 * lane + 1]; g[2][0] = gb[128 + 2 * lane]; g[2][1] = gb[128 + 2 * lane + 1]; g[3][0] = gc[2 * lane]; g[3][1] = gc[2 * lane + 1]; }
    for (int t = F.gw; t < NTOK; t += F.ngw) {
        const v4u* orow = (const v4u*)(O + (size_t)t * DM) + lane; float x[4][8]; float ss[4];
#pragma unroll
        for (int j = 0; j < 4; ++j) { const v4u w = orow[64 * j]; x[j][0] = bf_lo(w.x); x[j][1] = bf_hi(w.x); x[j][2] = bf_lo(w.y); x[j][3] = bf_hi(w.y); x[j][4] = bf_lo(w.z); x[j][5] = bf_hi(w.z); x[j][6] = bf_lo(w.w); x[j][7] = bf_hi(w.w);
            float s = 0.f;
#pragma unroll
            for (int i = 0; i < 8; ++i) s += x[j][i] * x[j][i];
            ss[j] = s; }
        const float ra = rsq(wave_sum(ss[0]) * (1.f / 512.f) + EPS), rb = rsq(wave_sum(ss[1] + ss[2]) * (1.f / 1024.f) + EPS), rc = rsq(wave_sum(ss[3]) * (1.f / 512.f) + EPS);
        v4u* nrow = (v4u*)(ON + (size_t)t * DM) + lane;
#pragma unroll
        for (int j = 0; j < 4; ++j) { const float r = (j == 0) ? ra : (j == 3) ? rc : rb; v4u w;
            w.x = pk2(x[j][0] * r * g[j][0][0], x[j][1] * r * g[j][0][1]); w.y = pk2(x[j][2] * r * g[j][0][2], x[j][3] * r * g[j][0][3]);
            w.z = pk2(x[j][4] * r * g[j][1][0], x[j][5] * r * g[j][1][1]); w.w = pk2(x[j][6] * r * g[j][1][2], x[j][7] * r * g[j][1][3]); nrow[64 * j] = w; }
    }
}

constexpr int ROUTER_LDS = 0;
constexpr int MOE_LDS_CNT = 65536;
constexpr int MOE_LDS_REC = 65536 + 64;
template <bool F8OUT, bool SRCB>
__device__ __forceinline__ void phase_ffnnorm_route(const Frame& F, const Args& a, const void* __restrict__ src, const float* __restrict__ gain, void* __restrict__ dstv, float osc) {
    int tid_ = threadIdx.x; asm volatile("" : "+v"(tid_)); const int tid = tid_, lane = tid & 63; (void)tid; (void)lane;
    LAS float* rt = (LAS float*)(F.lds + ROUTER_LDS); LAS unsigned* lcnt = (LAS unsigned*)(F.lds + MOE_LDS_CNT); LAS int* rec = (LAS int*)(F.lds + MOE_LDS_REC);
    const float* router = a.in[I_ROUTER];
    for (int i = tid; i < DM * NE / 4; i += NWAVES * 64) ((LAS f32x4*)rt)[i] = ((const f32x4*)router)[i];
    if (tid < 16) lcnt[tid] = 0u;
    __syncthreads();
    const int t0 = (int)(((long)F.bid * NTOK) / F.G), t1 = (int)(((long)(F.bid + 1) * NTOK) / F.G);
    float g[4][8]; load_gain32(gain, lane, 1.f, g);
    for (int m = t0 + F.wave; m < t1; m += NWAVES) {
        float v[4][8]; load_row32<SRCB>((const unsigned char*)src + (size_t)m * DM * (SRCB ? 2 : 4), lane, v); float s = 0.f;
#pragma unroll
        for (int j = 0; j < 4; ++j)
#pragma unroll
            for (int i = 0; i < 8; ++i) s += v[j][i] * v[j][i];
        const float rstd = rsq(wave_sum(s) * (1.f / DM) + EPS);
        v4u* o16 = (v4u*)((bf16*)dstv + (size_t)m * DM) + lane; v2u* o8 = (v2u*)((unsigned char*)dstv + (size_t)m * DM) + lane;
        float lg[8] = {0.f, 0.f, 0.f, 0.f, 0.f, 0.f, 0.f, 0.f};
#pragma unroll
        for (int j = 0; j < 4; ++j) {
            float h[8];
#pragma unroll
            for (int i = 0; i < 8; ++i) h[i] = v[j][i] * rstd * g[j][i];
            if constexpr (F8OUT) { v2u w; w.x = pk4_fp8(h[0] * osc, h[1] * osc, h[2] * osc, h[3] * osc); w.y = pk4_fp8(h[4] * osc, h[5] * osc, h[6] * osc, h[7] * osc); o8[64 * j] = w; }
            else { v4u w; w.x = pk2(h[0], h[1]); w.y = pk2(h[2], h[3]); w.z = pk2(h[4], h[5]); w.w = pk2(h[6], h[7]); o16[64 * j] = w; }
            const int k0 = 512 * j + 8 * lane;
#pragma unroll
            for (int i = 0; i < 8; ++i) { const f32x4 r0 = ((const LAS f32x4*)(rt + (k0 + i) * 8))[0], r1 = ((const LAS f32x4*)(rt + (k0 + i) * 8))[1];
                lg[0] += h[i] * r0[0]; lg[1] += h[i] * r0[1]; lg[2] += h[i] * r0[2]; lg[3] += h[i] * r0[3]; lg[4] += h[i] * r1[0]; lg[5] += h[i] * r1[1]; lg[6] += h[i] * r1[2]; lg[7] += h[i] * r1[3]; }
        }
#pragma unroll
        for (int e = 0; e < 8; ++e) lg[e] = wave_sum(lg[e]);
        int e0 = 0; float v0 = lg[0];
#pragma unroll
        for (int e = 1; e < 8; ++e) if (lg[e] > v0) { v0 = lg[e]; e0 = e; }
        int e1 = -1; float v1 = -3.0e38f;
#pragma unroll
        for (int e = 0; e < 8; ++e) if (e != e0 && lg[e] > v1) { v1 = lg[e]; e1 = e; }
        const float ex = __expf(v1 - v0), w0 = 1.f / (1.f + ex), w1 = ex * w0;
        if (lane == 0) { const int li = m - t0; const unsigned p0 = atomicAdd((unsigned*)&lcnt[e0], 1u), p1 = atomicAdd((unsigned*)&lcnt[e1], 1u);
            rec[li * 6 + 0] = e0; rec[li * 6 + 1] = e1; rec[li * 6 + 2] = (int)p0; rec[li * 6 + 3] = (int)p1; ((LAS float*)rec)[li * 6 + 4] = w0; ((LAS float*)rec)[li * 6 + 5] = w1; }
    }
    __syncthreads();
    if (tid < 8) lcnt[8 + tid] = __hip_atomic_fetch_add(F.ctl + CW_CNT + tid, lcnt[tid], __ATOMIC_RELAXED, __HIP_MEMORY_SCOPE_AGENT);
    __syncthreads();
    int* toke = (int*)(F.ws + WS_TOKE); int* tokp = (int*)(F.ws + WS_TOKP); float* tokw = (float*)(F.ws + WS_TOKW);
    for (int i = tid; i < (t1 - t0) * 2; i += NWAVES * 64) { const int li = i >> 1, k = i & 1, e = rec[li * 6 + k];
        toke[(size_t)(t0 + li) * 2 + k] = e; tokp[(size_t)(t0 + li) * 2 + k] = rec[li * 6 + 2 + k] + (int)lcnt[8 + e]; tokw[(size_t)(t0 + li) * 2 + k] = ((LAS float*)rec)[li * 6 + 4 + k]; }
    __syncthreads();
}
__device__ __forceinline__ void moe_tiles(const Frame& F, int (&tb)[9], int (&cnt)[8]) {
    int acc = 0;
#pragma unroll
    for (int e = 0; e < 8; ++e) { cnt[e] = (int)__hip_atomic_load(F.ctl + CW_CNT + e, __ATOMIC_RELAXED, __HIP_MEMORY_SCOPE_AGENT); tb[e] = acc; acc += (cnt[e] + 255) >> 8; }
    tb[8] = acc;
}
template <bool F8ROWS>
__device__ __forceinline__ void phase_gather(const Frame& F) {
    int tid_ = threadIdx.x; asm volatile("" : "+v"(tid_)); const int tid = tid_, lane = tid & 63; (void)tid; (void)lane;
    int tb[9], cnt[8]; moe_tiles(F, tb, cnt);
    constexpr int RBYTES = F8ROWS ? DM : 2 * DM, NCH = RBYTES / 1024;
    const unsigned char* H = (const unsigned char*)(F.ws + WS_H); unsigned char* HG = (unsigned char*)(F.ws + WS_HG); float* rg = (float*)(F.ws + WS_RGATE);
    const int* toke = (const int*)(F.ws + WS_TOKE); int* tokp = (int*)(F.ws + WS_TOKP); const float* tokw = (const float*)(F.ws + WS_TOKW);
    for (int t = F.gw; t < NTOK; t += F.ngw) {
        const v4u* hr = (const v4u*)(H + (size_t)t * RBYTES) + lane; v4u v[NCH];
#pragma unroll
        for (int j = 0; j < NCH; ++j) v[j] = hr[64 * j];
#pragma unroll
        for (int k = 0; k < 2; ++k) { const int e = toke[(size_t)t * 2 + k], p = tokp[(size_t)t * 2 + k]; int base = 0;
#pragma unroll
            for (int q = 0; q < 8; ++q) base = (q == e) ? tb[q] : base;
            const int slot = base * 256 + p; v4u* dr = (v4u*)(HG + (size_t)slot * RBYTES) + lane;
#pragma unroll
            for (int j = 0; j < NCH; ++j) dr[64 * j] = v[j];
            if (lane == 0) { rg[slot] = tokw[(size_t)t * 2 + k]; tokp[(size_t)t * 2 + k] = slot; } }
    }
#pragma unroll
    for (int e = 0; e < 8; ++e) { const int r0 = tb[e] * 256 + cnt[e], r1 = tb[e + 1] * 256;
        for (int r = r0 + F.gw; r < r1; r += F.ngw) { v4u* dr = (v4u*)(HG + (size_t)r * RBYTES) + lane; const v4u z = {0u, 0u, 0u, 0u};
#pragma unroll
            for (int j = 0; j < NCH; ++j) dr[64 * j] = z;
            if (lane == 0) rg[r] = 0.f; } }
}
__device__ __forceinline__ void phase_tailsum(const Frame& F) {
    int tid_ = threadIdx.x; asm volatile("" : "+v"(tid_)); const int tid = tid_;
    int tb[9], cnt[8]; moe_tiles(F, tb, cnt);
    const int nun = tb[8] * (DM / 256), nfull = (F.G == 256 && F8M) ? (nun / 256) * 256 : nun; if (nfull >= nun) return;
    pg8::StaticOrder S; S.init(tb[8] * 256, DM, F.G, 0);
    const float* P = (const float*)(F.ws + WS_PART); const float* rg = (const float*)(F.ws + WS_RGATE); bf16* Y = (bf16*)(F.ws + WS_Y);
    const float isc = F8M ? 1.f / (SC_ACT * SC_W) : 1.f;
    const int nchunk = (nun - nfull) * 8192;
    for (int i = F.bid * NWAVES * 64 + tid; i < nchunk; i += F.G * NWAVES * 64) {
        const int j = i >> 13, r = (i >> 5) & 255, cc = (i & 31) * 8, ent = nfull + j;
        pg8::Unit u; S.c = ent % F.G; S.next(ent / F.G, u);
        const float* p = P + (size_t)(4 * j) * 65536 + (size_t)r * 256 + cc; f32x4 a = {0.f, 0.f, 0.f, 0.f}, b = {0.f, 0.f, 0.f, 0.f};
#pragma unroll
        for (int s = 0; s < 4; ++s) { a += *(const f32x4*)(p + (size_t)s * 65536); b += *(const f32x4*)(p + (size_t)s * 65536 + 4); }
        const int row = u.pm * 256 + r; const float sc = rg[row] * isc;
        v4u w; w.x = pk2(a[0] * sc, a[1] * sc); w.y = pk2(a[2] * sc, a[3] * sc); w.z = pk2(b[0] * sc, b[1] * sc); w.w = pk2(b[2] * sc, b[3] * sc);
        *(v4u*)(Y + (size_t)row * DM + u.pn * 256 + cc) = w;
    }
}
template <bool XBF>
__device__ __forceinline__ void phase_combine(const Frame& F, const void* __restrict__ xsrc, float* __restrict__ out) {
    int tid_ = threadIdx.x; asm volatile("" : "+v"(tid_)); const int tid = tid_, lane = tid & 63; (void)tid; (void)lane;
    const bf16* Y = (const bf16*)(F.ws + WS_Y); const int* tokp = (const int*)(F.ws + WS_TOKP);
    for (int t = F.gw; t < NTOK; t += F.ngw) {
        const int s0 = tokp[(size_t)t * 2], s1 = tokp[(size_t)t * 2 + 1];
        const v4u* y0 = (const v4u*)(Y + (size_t)s0 * DM) + lane; const v4u* y1 = (const v4u*)(Y + (size_t)s1 * DM) + lane;
        float x[4][8]; load_row32<XBF>((const unsigned char*)xsrc + (size_t)t * DM * (XBF ? 2 : 4), lane, x);
        f32x4* xr = (f32x4*)(out + (size_t)t * DM) + 2 * lane;
#pragma unroll
        for (int j = 0; j < 4; ++j) { const v4u p = y0[64 * j], q = y1[64 * j]; f32x4 xa, xb;
            xa[0] = x[j][0] + bf_lo(p.x) + bf_lo(q.x); xa[1] = x[j][1] + bf_hi(p.x) + bf_hi(q.x); xa[2] = x[j][2] + bf_lo(p.y) + bf_lo(q.y); xa[3] = x[j][3] + bf_hi(p.y) + bf_hi(q.y);
            xb[0] = x[j][4] + bf_lo(p.z) + bf_lo(q.z); xb[1] = x[j][5] + bf_hi(p.z) + bf_hi(q.z); xb[2] = x[j][6] + bf_lo(p.w) + bf_lo(q.w); xb[3] = x[j][7] + bf_hi(p.w) + bf_hi(q.w);
            xr[128 * j] = xa; xr[128 * j + 1] = xb; }
    }
}

__device__ __forceinline__ void convert_experts(const Frame& F, const Args& args, int e_lo, int e_hi, int w, int nw);
__device__ __forceinline__ void phase_attention(const Frame& F, const Args& a, int l) {
    int tid_ = threadIdx.x; asm volatile("" : "+v"(tid_)); const int tid = tid_, lane = tid & 63; (void)tid; (void)lane;
    const bf16* PROJ = (const bf16*)(F.ws + WS_PROJ);
    const bf16* QA = (const bf16*)(F.ws + WS_QA); const bf16* KA = (const bf16*)(F.ws + WS_KA); const bf16* QB = (const bf16*)(F.ws + WS_QB); const bf16* KB = (const bf16*)(F.ws + WS_KB);
    const bf16* KVR = (const bf16*)(F.ws + WS_KVR); const bf16* QC = (const bf16*)(F.ws + WS_QC); const bf16* KC = (const bf16*)(F.ws + WS_KC);
    bf16* O = (bf16*)(F.ws + WS_O);
    char* L = (char*)F.lds;
    const int cslot = MOE_CVT_IN_ATTN ? ((F.bid >> 3) & 3) : -1; bool cvt_done = !MOE_CVT_IN_ATTN;
#define ATT_CVT() do { __syncthreads(); convert_experts(F, a, 4 * l, 4 * l + 4, F.gw, F.ngw); __syncthreads(); cvt_done = true; } while (0)
    if (cslot == 0) ATT_CVT();
    if (PHON(16)) for (int Lu = F.bid; Lu < 256; Lu += F.G) {
        const int id = (Lu & 7) * 32 + (Lu >> 3), b = id >> 6, h = (id >> 4) & 3, qb = id & 15; const size_t tq = (size_t)b * SEQ + qb * 256, tk = (size_t)b * SEQ;
        att::attn_body<192, 768, 768, 1024, 2048, 0, 1, 8>(QC + tq * 768 + h * 192, KC + tk * 768 + h * 192, KVR + tk * 1024 + h * 256 + 128, O + tq * DM + 1536 + h * 128, SEQ / 64, L, 0, 0, nullptr);
    }
    if (cslot == 1) ATT_CVT();
    if (PHON(17)) for (int Lu = F.bid; Lu < 512; Lu += F.G) {
        if (cslot == 2 && !cvt_done && Lu != F.bid) ATT_CVT();
        const int id = (Lu & 7) * 64 + (Lu >> 3), b = id >> 7, kvh = (id >> 6) & 1, g = (id >> 4) & 3, qb = id & 15, h = kvh * 4 + g; const size_t tq = (size_t)b * SEQ + qb * 256, tk = (size_t)b * SEQ;
        att::attn_body<128, 1024, 256, 4096, 2048, 0, 2, 8>(QB + tq * 1024 + h * 128, KB + tk * 256 + kvh * 128, PROJ + tk * DINP + PC_VB + kvh * 128, O + tq * DM + 512 + h * 128, SEQ / 64, L, 0, 0, nullptr);
    }
    float* biasT = (float*)(L + 136 * 1024);
    if (!cvt_done && cslot == 3) ATT_CVT();
    if (PHON(18)) for (int Lu = F.bid; Lu < 256; Lu += F.G) {
        const int id = (Lu & 7) * 32 + (Lu >> 3), b = id >> 6, h = (id >> 4) & 3, rb = id & 15; const size_t tq = (size_t)b * SEQ + rb * 256;
        int lo = min(max(rb * 4 - 4, 0), 56), hi = min(max(rb * 4 + 3 - 4, 0), 56) + 8;
        if ((hi - lo) & 1) { if (hi < 64) ++hi; else --lo; }
        __syncthreads();
        const float* rpb = a.in[I_RPB] + ((size_t)l * 4 + h) * 465;
        for (int i = tid; i < 15 * 128; i += NWAVES * 64) { const int bi = i >> 7, bj = (i & 127) - 48; biasT[i] = (bj >= 0 && bj < 31) ? rpb[bi * 31 + bj] * 11.313708498984761f : 0.f; }
        __syncthreads();
        const size_t tk = (size_t)b * SEQ + lo * 64;
        att::attn_body<128, 512, 512, 4096, 2048, 1, 1, 4>(QA + tq * 512 + h * 128, KA + tk * 512 + h * 128, PROJ + tk * DINP + PC_VA + h * 128, O + tq * DM + h * 128, hi - lo, L, rb * 4, lo, biasT);
    }
    if (!cvt_done) ATT_CVT();
#undef ATT_CVT
}

constexpr int NPHASE = 25;

__device__ __forceinline__ void tr8_decode(const Args& args, unsigned char* ws, int e_lo, int gi, const float*& W, unsigned char*& WT, int& K, int& N, int& mode, int& item) {
    const int m = gi / 3584; item = gi - m * 3584; const int e = e_lo + m / 3, kind = m - (m / 3) * 3;
    if (kind == 2) { W = args.in[I_WED] + (size_t)e * DFE * DM; WT = ws + WS_WED + (size_t)e * DM * DFE; K = DFE; N = DM; mode = 0; }
    else { W = (kind == 0 ? args.in[I_WEG] : args.in[I_WEU]) + (size_t)e * DM * DFE; WT = ws + WS_WEGU + (size_t)e * 2 * DFE * DM; K = DM; N = DFE; mode = 1 + kind; }
}
__device__ __forceinline__ void tr8_load(const float* __restrict__ W, int N, int item, int lane, f32x4 (&v)[16]) {
    const int nblk = N >> 5, kb = item / nblk, nb = item - kb * nblk, k0 = kb << 7, n0 = nb << 5; const int c = lane >> 3, q = lane & 7;
    const float* p = W + (size_t)(k0 + 16 * c) * N + n0 + 4 * q;
#pragma unroll
    for (int i = 0; i < 16; ++i) v[i] = __builtin_nontemporal_load((const f32x4*)(p + (size_t)i * N));
}
__device__ __forceinline__ void tr8_store(unsigned char* __restrict__ WT, int K, int N, int mode, int item, int lane, float wsc, LAS float* scr, const f32x4 (&v)[16]) {
    (void)scr;
    const int nblk = N >> 5, kb = item / nblk, nb = item - kb * nblk, k0 = kb << 7, n0 = nb << 5; const int c = lane >> 3, q = lane & 7;
    const int drow0 = (mode == 0) ? n0 : ((n0 >> 7) * 256 + (mode - 1) * 128 + (n0 & 127));
    unsigned char* p = WT + (size_t)(drow0 + 4 * q) * K + k0 + 16 * c;
#pragma unroll
    for (int j = 0; j < 4; ++j) {
        v4u o; o.x = pk4_fp8(v[0][j] * wsc, v[1][j] * wsc, v[2][j] * wsc, v[3][j] * wsc); o.y = pk4_fp8(v[4][j] * wsc, v[5][j] * wsc, v[6][j] * wsc, v[7][j] * wsc);
        o.z = pk4_fp8(v[8][j] * wsc, v[9][j] * wsc, v[10][j] * wsc, v[11][j] * wsc); o.w = pk4_fp8(v[12][j] * wsc, v[13][j] * wsc, v[14][j] * wsc, v[15][j] * wsc);
        *(v4u*)(p + (size_t)j * K) = o; }
}
__device__ __forceinline__ void convert_experts(const Frame& F, const Args& args, int e_lo, int e_hi, int w, int nw) {
    int tid_ = threadIdx.x; asm volatile("" : "+v"(tid_)); const int lane = tid_ & 63;
    LAS float* scr = (LAS float*)(F.lds + F.wave * 18432);
    if constexpr (F8M) {
        const int total = (e_hi - e_lo) * 3 * 3584;
        f32x4 va[16], vb[16], vc[16]; const float* W; unsigned char* WT; int K, N, mode, item;
#define TR8_LD(buf, gx) do { if ((gx) < total) { tr8_decode(args, F.ws, e_lo, (gx), W, WT, K, N, mode, item); tr8_load(W, N, item, lane, buf); } } while (0)
#define TR8_ST(buf, gx) do { tr8_decode(args, F.ws, e_lo, (gx), W, WT, K, N, mode, item); tr8_store(WT, K, N, mode, item, lane, SC_W, scr, buf); } while (0)
        int gi = w;
        TR8_LD(va, gi); TR8_LD(vb, gi + nw);
        while (gi < total) {
            TR8_LD(vc, gi + 2 * nw); TR8_ST(va, gi); gi += nw; if (gi >= total) break;
            TR8_LD(va, gi + 2 * nw); TR8_ST(vb, gi); gi += nw; if (gi >= total) break;
            TR8_LD(vb, gi + 2 * nw); TR8_ST(vc, gi); gi += nw;
        }
#undef TR8_LD
#undef TR8_ST
    } else {
        int it = w;
#define TR_RUNB(Wp, Kk, Nn, Dp, ROFF, MODE) do { const int cnt_ = ((Kk) >> 6) * ((Nn) >> 5); while (it < cnt_) { transpose_item((Wp), (Kk), (Nn), (Dp), (ROFF), (MODE), scr, it, lane); it += nw; } it -= cnt_; } while (0)
        for (int e = e_lo; e < e_hi; ++e) {
            TR_RUNB(args.in[I_WEG] + (size_t)e * DM * DFE, DM, DFE, (bf16*)(F.ws + WS_WEGU) + (size_t)e * 2 * DFE * DM, 0, 1);
            TR_RUNB(args.in[I_WEU] + (size_t)e * DM * DFE, DM, DFE, (bf16*)(F.ws + WS_WEGU) + (size_t)e * 2 * DFE * DM, 0, 2);
            TR_RUNB(args.in[I_WED] + (size_t)e * DFE * DM, DFE, DM, (bf16*)(F.ws + WS_WED) + (size_t)e * DM * DFE, 0, 0);
        }
#undef TR_RUNB
    }
}
__device__ __forceinline__ void phase_prologue(const Frame& F, const Args& args) {
    int tid_ = threadIdx.x; asm volatile("" : "+v"(tid_)); const int tid = tid_, lane = tid & 63;
    LAS float* scr = (LAS float*)(F.lds + F.wave * 16896);
    int it = F.gw; const int nw = F.ngw;
#define TR_RUN(Wp, Kk, Nn, Dp, ROFF, MODE) do { const int cnt_ = ((Kk) >> 6) * ((Nn) >> 5); while (it < cnt_) { transpose_item((Wp), (Kk), (Nn), (Dp), (ROFF), (MODE), scr, it, lane); it += nw; } it -= cnt_; } while (0)
#define TR_RUN8(Wp, Kk, Nn, Dp, ROFF, MODE) do { const int cnt_ = ((Kk) >> 7) * ((Nn) >> 5); while (it < cnt_) { transpose_item_f8((Wp), (Kk), (Nn), (Dp), (ROFF), (MODE), SC_W, scr, it, lane); it += nw; } it -= cnt_; } while (0)
    for (int l = 0; l < DEPTH; ++l) {
        TR_RUN(args.in[I_WIN] + (size_t)l * DM * DIN, DM, DIN, (bf16*)(F.ws + WS_WIN) + (size_t)l * DINP * DM, 0, 0);
        TR_RUN(args.in[I_WUQ] + (size_t)l * 512 * 768, 512, 768, (bf16*)(F.ws + WS_WUQ) + (size_t)l * 768 * 512, 0, 0);
        TR_RUN(args.in[I_WUKV] + (size_t)l * 256 * 1024, 256, 1024, (bf16*)(F.ws + WS_WUKV) + (size_t)l * 1024 * 256, 0, 0);
        TR_RUN(args.in[I_WOUT] + (size_t)l * DM * DM, DM, DM, (bf16*)(F.ws + WS_WOUT) + (size_t)l * DM * DM, 0, 0);
    }
    if constexpr (F8DG) {
        TR_RUN8(args.in[I_WG], DM, DFF, (unsigned char*)(F.ws + WS_WGU), 0, 1);
        TR_RUN8(args.in[I_WU], DM, DFF, (unsigned char*)(F.ws + WS_WGU), 0, 2);
    } else {
        TR_RUN(args.in[I_WG], DM, DFF, (bf16*)(F.ws + WS_WGU), 0, 1);
        TR_RUN(args.in[I_WU], DM, DFF, (bf16*)(F.ws + WS_WGU), 0, 2);
    }
    if constexpr (F8DD) TR_RUN8(args.in[I_WDN], DFF, DM, (unsigned char*)(F.ws + WS_WD), 0, 0);
    else TR_RUN(args.in[I_WDN], DFF, DM, (bf16*)(F.ws + WS_WD), 0, 0);
#undef TR_RUN
#undef TR_RUN8
    for (int l = 0; l < DEPTH; ++l) { v4u* z = (v4u*)((bf16*)(F.ws + WS_WIN) + ((size_t)l * DINP + DIN) * DM); const v4u zz = {0u, 0u, 0u, 0u};
        for (int i = F.bid * NWAVES * 64 + tid; i < (DINP - DIN) * DM / 8; i += F.G * NWAVES * 64) z[i] = zz; }
    if (!MOE_CVT_IN_ATTN) convert_experts(F, args, 0, NE, F.gw, F.ngw);
    phase_rmsnorm<false, false>(F, args.in[I_X], args.in[I_MIXN], F.ws + WS_H, 1.f);
}

__global__ void __launch_bounds__(NWAVES * 64, 2) mega_fwd(Args args) {
    extern __shared__ __attribute__((aligned(16))) unsigned char lds_raw[];
    Frame F;
    F.lds = (LAS unsigned char*)lds_raw; F.ws = args.ws; F.ctl = (unsigned*)(args.ws + WS_CTL);
    F.wave = __builtin_amdgcn_readfirstlane((int)threadIdx.x >> 6);
    F.G = gridDim.x; F.bid = blockIdx.x; F.gw = F.bid * NWAVES + F.wave; F.ngw = F.G * NWAVES;
    volatile LAS unsigned* MISC = (volatile LAS unsigned*)(F.lds + MISC_OFF);
    if (threadIdx.x < 64) MISC[threadIdx.x] = 0u;
    __syncthreads();
    XcdBarrier bar = xcd_barrier_post(F.ctl + CW_BAR, MISC + 8);
    const int lo = args.ph_lo, hi = args.ph_hi;
#define IN(k) (lo <= (k) && (k) < hi)
#define SEAM(k) do { if (IN(k) && IN((k) + 1)) xcd_barrier(bar); } while (0)
    float* out = args.out;
    bf16* XB = (bf16*)(F.ws + WS_XB);
    LAS unsigned char* ring = F.lds;

    if (PHON(0) && IN(0)) phase_prologue(F, args);
    SEAM(0);

#pragma nounroll
    for (int l = 0; l < DEPTH; ++l) {
        const int P = 11 * l;
        if (PHON(1) && IN(P + 1)) {
            pg8::Gemm g{F.ws + WS_H, (const bf16*)(F.ws + WS_WIN) + (size_t)l * DINP * DM, NTOK, DINP, DM, 0}; pg8::StaticOrder S; S.init(NTOK, DINP, F.G, F.bid);
            pg8::EpiBf16 E{(bf16*)(F.ws + WS_PROJ), DINP};
            pg8::gemm_phase<pg8::EpiBf16, pg8::StaticOrder, true, true>(ring, g, S, E);
        }
        SEAM(P + 1);
        if (PHON(2) && IN(P + 2)) phase_postproj(F, args, l);
        SEAM(P + 2);
        if (PHON(3) && IN(P + 3)) {
            { pg8::Gemm g{F.ws + WS_CQN, (const bf16*)(F.ws + WS_WUQ) + (size_t)l * 768 * 512, NTOK, 768, 512, 0}; pg8::StaticOrder S; S.init(NTOK, 768, F.G, F.bid);
              pg8::EpiBf16 E{(bf16*)(F.ws + WS_QCR), 768}; pg8::gemm_phase<pg8::EpiBf16, pg8::StaticOrder, true, true>(ring, g, S, E); }
            { pg8::Gemm g{F.ws + WS_CKVN, (const bf16*)(F.ws + WS_WUKV) + (size_t)l * 1024 * 256, NTOK, 1024, 256, 0}; pg8::StaticOrder S; S.init(NTOK, 1024, F.G, F.bid);
              pg8::EpiBf16 E{(bf16*)(F.ws + WS_KVR), 1024}; pg8::gemm_phase<pg8::EpiBf16, pg8::StaticOrder, true, true>(ring, g, S, E); }
        }
        SEAM(P + 3);
        if (PHON(4) && IN(P + 4)) phase_postmla(F, args, l);
        SEAM(P + 4);
        if (PHON(5) && IN(P + 5)) { phase_attention(F, args, l); __syncthreads(); }
        SEAM(P + 5);
        if (PHON(6) && IN(P + 6)) phase_groupnorm(F, args, l);
        SEAM(P + 6);
        if (PHON(7) && IN(P + 7)) {
            pg8::Gemm g{F.ws + WS_ON, (const bf16*)(F.ws + WS_WOUT) + (size_t)l * DM * DM, NTOK, DM, DM, 0}; pg8::StaticOrder S; S.init(NTOK, DM, F.G, F.bid);
            if (l == 0) { pg8::EpiResBf16<false> E{args.in[I_X], XB, DM, 1.f}; pg8::gemm_phase<pg8::EpiResBf16<false>, pg8::StaticOrder, true, true>(ring, g, S, E); }
            else { pg8::EpiResBf16<true> E{XB, XB, DM, 1.f}; pg8::gemm_phase<pg8::EpiResBf16<true>, pg8::StaticOrder, true, true>(ring, g, S, E); }
        }
        SEAM(P + 7);
        if (l == 0) {
            if (PHON(8) && IN(P + 8)) phase_rmsnorm<F8DG, true>(F, XB, args.in[I_FFNN] + (size_t)l * DM, F.ws + WS_H, F8DG ? SC_H : 1.f);
            SEAM(P + 8);
            if (PHON(9) && IN(P + 9)) {
                pg8::Gemm g{F.ws + WS_H, F.ws + WS_WGU, NTOK, 2 * DFF, DM, 0}; pg8::StaticOrder S; S.init(NTOK, 2 * DFF, F.G, F.bid);
                constexpr float isc = F8DG ? 1.f / (SC_H * SC_W) : 1.f;
                if constexpr (F8DD) { pg8::EpiSwigluF8 E{F.ws + WS_ACT, DFF, SC_ACT, isc}; pg8::gemm_phase<pg8::EpiSwigluF8, pg8::StaticOrder, true, true, F8DG>(ring, g, S, E); }
                else { pg8::EpiSwiglu E{(bf16*)(F.ws + WS_ACT), DFF, isc}; pg8::gemm_phase<pg8::EpiSwiglu, pg8::StaticOrder, true, true, F8DG>(ring, g, S, E); }
            }
            SEAM(P + 9);
            if (PHON(10) && IN(P + 10)) {
                pg8::Gemm g{F.ws + WS_ACT, F.ws + WS_WD, NTOK, DM, DFF, 0}; pg8::StaticOrder S; S.init(NTOK, DM, F.G, F.bid);
                pg8::EpiResBf16<true> E{XB, XB, DM, F8DD ? 1.f / (SC_ACT * SC_W) : 1.f};
                pg8::gemm_phase<pg8::EpiResBf16<true>, pg8::StaticOrder, true, true, F8DD>(ring, g, S, E);
            }
            SEAM(P + 10);
            if (PHON(8) && IN(P + 11)) phase_rmsnorm<false, true>(F, XB, args.in[I_MIXN] + (size_t)(l + 1) * DM, F.ws + WS_H, 1.f);
            SEAM(P + 11);
        } else {
            if (PHON(11) && IN(P + 8)) phase_ffnnorm_route<F8M, true>(F, args, XB, args.in[I_FFNN] + (size_t)l * DM, F.ws + WS_H, SC_H);
            SEAM(P + 8);
            if (PHON(12) && IN(P + 9)) phase_gather<F8M>(F);
            SEAM(P + 9);
            if (PHON(13) && IN(P + 10)) {
                int tb[9], cnt[8]; moe_tiles(F, tb, cnt);
                pg8::Gemm g{F.ws + WS_HG, F.ws + WS_WEGU, tb[8] * 256, 2 * DFE, DM, 0}; pg8::GroupedOrder S; S.init(tb[8] * 256, 2 * DFE, F.G, F.bid);
#pragma unroll
                for (int k = 0; k < 7; ++k) S.tb[k] = tb[k + 1];
                S.nct = 2 * DFE / 256; S.lim = 0;
                if constexpr (F8M) { pg8::EpiSwigluF8 E{F.ws + WS_ACTM, DFE, SC_ACT, 1.f / (SC_H * SC_W)}; pg8::gemm_phase<pg8::EpiSwigluF8, pg8::GroupedOrder, true, true, true>(ring, g, S, E); }
                else { pg8::EpiSwiglu E{(bf16*)(F.ws + WS_ACTM), DFE, 1.f}; pg8::gemm_phase<pg8::EpiSwiglu, pg8::GroupedOrder, true, true, false>(ring, g, S, E); }
            }
            SEAM(P + 10);
            if (PHON(14) && IN(P + 11)) {
                int tb[9], cnt[8]; moe_tiles(F, tb, cnt);
                const int nun = tb[8] * (DM / 256), nfull = (F.G == 256 && F8M) ? (nun / 256) * 256 : nun;
                { pg8::Gemm g{F.ws + WS_ACTM, F.ws + WS_WED, tb[8] * 256, DM, DFE, 0}; pg8::GroupedOrder S; S.init(tb[8] * 256, DM, F.G, F.bid);
#pragma unroll
                  for (int k = 0; k < 7; ++k) S.tb[k] = tb[k + 1];
                  S.nct = DM / 256; S.lim = nfull;
                  pg8::EpiScaleBf16 E{(bf16*)(F.ws + WS_Y), DM, (const float*)(F.ws + WS_RGATE), F8M ? 1.f / (SC_ACT * SC_W) : 1.f};
                  pg8::gemm_phase<pg8::EpiScaleBf16, pg8::GroupedOrder, true, true, F8M>(ring, g, S, E); }
                if (nfull < nun) { pg8::Gemm g{F.ws + WS_ACTM, F.ws + WS_WED, tb[8] * 256, DM, DFE, DFE / 128 / 4}; pg8::GroupedTail S; S.init(tb[8] * 256, DM, F.G, F.bid);
#pragma unroll
                  for (int k = 0; k < 7; ++k) S.tb[k] = tb[k + 1];
                  S.nct = DM / 256; S.lim = nfull; S.nsp = 4; S.kslice = DFE / 4;
                  pg8::EpiPartF32 E{(float*)(F.ws + WS_PART)};
                  pg8::gemm_phase<pg8::EpiPartF32, pg8::GroupedTail, true, true, F8M>(ring, g, S, E); }
            }
            SEAM(P + 11);
            if (PHON(14) && IN(P + 12)) phase_tailsum(F);
            SEAM(P + 12);
            if (PHON(15) && IN(P + 13)) phase_combine<true>(F, XB, out);
        }
    }
#undef IN
#undef SEAM
}

extern "C" void kernel_launch(void* const* d_in, const int* in_sizes, int n_in, void* d_out, int out_size, void* d_ws, size_t ws_size, hipStream_t stream) {
    static int grid = 0;
    if (grid == 0) {
        if (n_in != 26 || in_sizes[0] != NTOK * DM || out_size != NTOK * DM || ws_size < WS_END3) { fprintf(stderr, "kernel_launch: unexpected shapes (n_in %d, in0 %d, out %d, ws %zu < %zu)\n", n_in, n_in > 0 ? in_sizes[0] : -1, out_size, ws_size, (size_t)WS_END3); grid = -1; return; }
        int dev = 0, cus = 0, per_cu = 0;
        if (hipGetDevice(&dev) != hipSuccess || hipDeviceGetAttribute(&cus, hipDeviceAttributeMultiprocessorCount, dev) != hipSuccess) { grid = -1; return; }
        if (hipFuncSetAttribute((const void*)mega_fwd, hipFuncAttributeMaxDynamicSharedMemorySize, LDS_BYTES) != hipSuccess) { fprintf(stderr, "kernel_launch: hipFuncSetAttribute failed\n"); grid = -1; return; }
        if (hipOccupancyMaxActiveBlocksPerMultiprocessor(&per_cu, (const void*)mega_fwd, NWAVES * 64, LDS_BYTES) != hipSuccess || per_cu < 1) fprintf(stderr, "kernel_launch: occupancy query reports %d\n", per_cu);
        (void)hipGetLastError();
        grid = cus;
    }
    if (grid < 0) return;
    if (hipMemsetAsync((char*)d_ws + WS_CTL, 0, CTL_ZERO_BYTES, stream) != hipSuccess) return;
    Args a{};
    for (int i = 0; i < 26; ++i) a.in[i] = (const float*)d_in[i];
    a.out = (float*)d_out; a.ws = (unsigned char*)d_ws;
#ifndef MK_SPLIT
    a.ph_lo = 0; a.ph_hi = NPHASE;
    hipLaunchKernelGGL(mega_fwd, dim3(grid), dim3(NWAVES * 64), LDS_BYTES, stream, a);
#else
    for (int p = 0; p < NPHASE; ++p) { a.ph_lo = p; a.ph_hi = p + 1; hipLaunchKernelGGL(mega_fwd, dim3(grid), dim3(NWAVES * 64), LDS_BYTES, stream, a); }
#endif
}
```

```cpp
#include <hip/hip_runtime.h>
#include <cstdio>
#include <cstdint>
namespace pg8 {
#define PG8_LAS __attribute__((address_space(3)))
typedef unsigned short bf16_t;
typedef short bf16x8 __attribute__((ext_vector_type(8)));
typedef float f32x4 __attribute__((ext_vector_type(4)));
typedef unsigned u32x4 __attribute__((ext_vector_type(4)));
constexpr int BM = 256, BK = 64, HALF = 128, HTB = HALF * BK * 2  , STAGE_BYTES = 8 * HTB, NXCD = 8, WGM = 8;

__host__ __device__ __forceinline__ int lds_byte(int r, int c) { const int st = (r >> 4) * 2 + (c >> 5), rr = r & 15, cc = c & 31, ob = rr * 64 + cc * 2; return st * 1024 + (ob ^ (((ob >> 9) & 1) << 5)); }
__host__ __device__ __forceinline__ void stage_rc(int b, int& R, int& C) { const int st = b / 1024, sb = b % 1024, swz = sb ^ (((sb >> 9) & 1) << 5); R = (st >> 1) * 16 + swz / 64; C = (st & 1) * 32 + (swz % 64) / 2; }
__host__ __device__ __forceinline__ int perm32(int rho) { const int n = rho >> 4, i = rho & 15; return 8 * (i >> 2) + 4 * n + (i & 3); }


struct Unit { int pm, pn, pc, ko; };
struct Gemm { const void* A; const void* Bt; int M, N, K, kt; };
typedef int i32x4 __attribute__((ext_vector_type(4)));
typedef int i32x8 __attribute__((ext_vector_type(8)));

struct StaticOrder {
    int nM, nN, nwg, G, c;
    __device__ __forceinline__ void init(int M, int N, int G_, int c_) { nM = M / BM; nN = N / BM; nwg = nM * nN; G = G_; c = c_; }
    __device__ __forceinline__ bool next(int i, Unit& u) const {
        const long L = (long)i * G + c; if (L >= nwg) return false;
        int wgid = (int)L; { const int q = nwg / NXCD, r = nwg % NXCD, xcd = wgid % NXCD, off = wgid / NXCD; wgid = (xcd < r ? xcd * (q + 1) : r * (q + 1) + (xcd - r) * q) + off; }
        const int nig = WGM * nN, gid = wgid / nig, fm = gid * WGM, gsz = (nM - fm) < WGM ? (nM - fm) : WGM;
        u.pm = fm + ((wgid % nig) % gsz); u.pn = (wgid % nig) / gsz; u.pc = u.pn; u.ko = 0; return true;
    }
    __device__ __forceinline__ void a_ready(const Unit&) const {}
    __device__ __forceinline__ void done(const Unit&) const {}
};
struct GroupedOrder : StaticOrder {
    int tb[7]; int nct; int lim;
    __device__ __forceinline__ void expert(Unit& u) const { int e = 0;
#pragma unroll
        for (int k = 0; k < 7; ++k) e += (u.pm >= tb[k]) ? 1 : 0;
        u.pc = u.pn; u.pn += e * nct; }
    __device__ __forceinline__ bool next(int i, Unit& u) const {
        if (lim > 0 && (long)i * G + c >= lim) return false;
        if (!StaticOrder::next(i, u)) return false;
        expert(u); return true;
    }
};
struct GroupedTail : GroupedOrder {
    int nsp, kslice;
    __device__ __forceinline__ bool next(int i, Unit& u) const {
        if (i > 0) return false;
        const int ent = lim + c / nsp; if (ent >= nwg) return false;
        StaticOrder s = *this; s.c = ent % G; if (!s.next(ent / G, u)) return false;
        expert(u); u.ko = (c % nsp) * kslice; u.pc = c; return true;
    }
};

__device__ __forceinline__ unsigned cvt_pk_bf16(float lo, float hi) { unsigned r; asm volatile("v_cvt_pk_bf16_f32 %0, %1, %2" : "=v"(r) : "v"(lo), "v"(hi)); return r; }

struct EpiBf16 {
    static constexpr bool PERM = true, AFTER_DRAIN = false;
    bf16_t* O; int ldc;
    __device__ __forceinline__ void operator()(const f32x4 (&acc)[2][2][4][2], const Unit& u, int wr, int wc, int fr, int fq) const {
        const int row0 = u.pm * BM + wr * 64 + fr, col0 = u.pc * BM + wc * 32 + 8 * fq;
#pragma unroll
        for (int ai = 0; ai < 2; ++ai)
#pragma unroll
            for (int m = 0; m < 4; ++m) { bf16_t* rowp = O + (size_t)(row0 + ai * HALF + m * 16) * ldc + col0;
#pragma unroll
                for (int bj = 0; bj < 2; ++bj) { const f32x4 v0 = acc[ai][bj][m][0], v1 = acc[ai][bj][m][1];
                    u32x4 w; w.x = cvt_pk_bf16(v0[0], v0[1]); w.y = cvt_pk_bf16(v0[2], v0[3]); w.z = cvt_pk_bf16(v1[0], v1[1]); w.w = cvt_pk_bf16(v1[2], v1[3]);
                    *(u32x4*)(rowp + bj * HALF) = w; } }
    }
};
struct EpiPartF32 {
    static constexpr bool PERM = true, AFTER_DRAIN = false;
    float* P;
    __device__ __forceinline__ void operator()(const f32x4 (&acc)[2][2][4][2], const Unit& u, int wr, int wc, int fr, int fq) const {
        float* t = P + (size_t)u.pc * 65536 + (size_t)(wr * 64 + fr) * 256 + wc * 32 + 8 * fq;
#pragma unroll
        for (int ai = 0; ai < 2; ++ai)
#pragma unroll
            for (int m = 0; m < 4; ++m)
#pragma unroll
                for (int bj = 0; bj < 2; ++bj) { float* q = t + (size_t)(ai * HALF + m * 16) * 256 + bj * HALF; *(f32x4*)q = acc[ai][bj][m][0]; *(f32x4*)(q + 4) = acc[ai][bj][m][1]; }
    }
};
struct EpiScaleBf16 {
    static constexpr bool PERM = true, AFTER_DRAIN = false;
    bf16_t* O; int ldc; const float* rs; float isc;
    __device__ __forceinline__ void operator()(const f32x4 (&acc)[2][2][4][2], const Unit& u, int wr, int wc, int fr, int fq) const {
        const int row0 = u.pm * BM + wr * 64 + fr, col0 = u.pc * BM + wc * 32 + 8 * fq;
#pragma unroll
        for (int ai = 0; ai < 2; ++ai)
#pragma unroll
            for (int m = 0; m < 4; ++m) { const int row = row0 + ai * HALF + m * 16; const float s = rs[row] * isc; bf16_t* rowp = O + (size_t)row * ldc + col0;
#pragma unroll
                for (int bj = 0; bj < 2; ++bj) { const f32x4 v0 = acc[ai][bj][m][0] * s, v1 = acc[ai][bj][m][1] * s;
                    u32x4 w; w.x = cvt_pk_bf16(v0[0], v0[1]); w.y = cvt_pk_bf16(v0[2], v0[3]); w.z = cvt_pk_bf16(v1[0], v1[1]); w.w = cvt_pk_bf16(v1[2], v1[3]);
                    *(u32x4*)(rowp + bj * HALF) = w; } }
    }
};
struct EpiResF32 {
    static constexpr bool PERM = false, AFTER_DRAIN = false;
    const float* base; float* out; int ldc; float isc;
    __device__ __forceinline__ void operator()(const f32x4 (&acc)[2][2][4][2], const Unit& u, int wr, int wc, int fr, int fq) const {
        const int row0 = u.pm * BM + wr * 64 + fr, col0 = u.pc * BM + wc * 32 + 4 * fq;
#pragma unroll
        for (int ai = 0; ai < 2; ++ai)
#pragma unroll
            for (int m = 0; m < 4; ++m) { const size_t off = (size_t)(row0 + ai * HALF + m * 16) * ldc + col0;
                f32x4 b[2][2];
#pragma unroll
                for (int bj = 0; bj < 2; ++bj)
#pragma unroll
                    for (int n = 0; n < 2; ++n) b[bj][n] = *(const f32x4*)(base + off + bj * HALF + n * 16);
#pragma unroll
                for (int bj = 0; bj < 2; ++bj)
#pragma unroll
                    for (int n = 0; n < 2; ++n) *(f32x4*)(out + off + bj * HALF + n * 16) = b[bj][n] + acc[ai][bj][m][n] * isc;
                asm volatile("" ::: "memory"); }
    }
};
template <bool BASEB> struct EpiResBf16 {
    static constexpr bool PERM = true, AFTER_DRAIN = false;
    const void* base; bf16_t* out; int ldc; float isc;
    __device__ __forceinline__ void operator()(const f32x4 (&acc)[2][2][4][2], const Unit& u, int wr, int wc, int fr, int fq) const {
        const int row0 = u.pm * BM + wr * 64 + fr, col0 = u.pc * BM + wc * 32 + 8 * fq;
        if constexpr (BASEB) {
            constexpr int AH = 2;
            u32x4 w[8][2];
#define PG8_RLOAD(g) do { const size_t off_ = (size_t)(row0 + ((g) >> 2) * HALF + ((g) & 3) * 16) * ldc + col0; \
                w[g][0] = *(const u32x4*)((const bf16_t*)base + off_); w[g][1] = *(const u32x4*)((const bf16_t*)base + off_ + HALF); } while (0)
#pragma unroll
            for (int g = 0; g < AH; ++g) PG8_RLOAD(g);
#pragma unroll
            for (int g = 0; g < 8; ++g) { const int ai = g >> 2, m = g & 3; const size_t off = (size_t)(row0 + ai * HALF + m * 16) * ldc + col0;
                if (g + AH < 8) PG8_RLOAD(g + AH < 8 ? g + AH : 0);
#pragma unroll
                for (int bj = 0; bj < 2; ++bj) { const u32x4 ww = w[g][bj];
                    const f32x4 b0 = (f32x4){__uint_as_float(ww.x << 16), __uint_as_float(ww.x & 0xffff0000u), __uint_as_float(ww.y << 16), __uint_as_float(ww.y & 0xffff0000u)};
                    const f32x4 b1 = (f32x4){__uint_as_float(ww.z << 16), __uint_as_float(ww.z & 0xffff0000u), __uint_as_float(ww.w << 16), __uint_as_float(ww.w & 0xffff0000u)};
                    const f32x4 v0 = b0 + acc[ai][bj][m][0] * isc, v1 = b1 + acc[ai][bj][m][1] * isc;
                    u32x4 o; o.x = cvt_pk_bf16(v0[0], v0[1]); o.y = cvt_pk_bf16(v0[2], v0[3]); o.z = cvt_pk_bf16(v1[0], v1[1]); o.w = cvt_pk_bf16(v1[2], v1[3]);
                    *(u32x4*)(out + off + bj * HALF) = o; }
                asm volatile("" ::: "memory"); }
#undef PG8_RLOAD
        } else {
#pragma unroll
        for (int ai = 0; ai < 2; ++ai)
#pragma unroll
            for (int m = 0; m < 4; ++m) { const size_t off = (size_t)(row0 + ai * HALF + m * 16) * ldc + col0;
#pragma unroll
                for (int bj = 0; bj < 2; ++bj) { f32x4 b0, b1;
                    b0 = *(const f32x4*)((const float*)base + off + bj * HALF); b1 = *(const f32x4*)((const float*)base + off + bj * HALF + 4);
                    const f32x4 v0 = b0 + acc[ai][bj][m][0] * isc, v1 = b1 + acc[ai][bj][m][1] * isc;
                    u32x4 o; o.x = cvt_pk_bf16(v0[0], v0[1]); o.y = cvt_pk_bf16(v0[2], v0[3]); o.z = cvt_pk_bf16(v1[0], v1[1]); o.w = cvt_pk_bf16(v1[2], v1[3]);
                    *(u32x4*)(out + off + bj * HALF) = o; }
                asm volatile("" ::: "memory"); }
        }
    }
};
__device__ __forceinline__ float silu_mul(float g, float u) { return g * u * __builtin_amdgcn_rcpf(1.0f + __builtin_amdgcn_exp2f(-1.44269504089f * g)); }
struct EpiSwiglu {
    static constexpr bool PERM = true, AFTER_DRAIN = false;
    bf16_t* O; int ldc; float isc;
    __device__ __forceinline__ void operator()(const f32x4 (&acc)[2][2][4][2], const Unit& u, int wr, int wc, int fr, int fq) const {
        const int row0 = u.pm * BM + wr * 64 + fr, col0 = u.pc * HALF + wc * 32 + 8 * fq;
#pragma unroll
        for (int ai = 0; ai < 2; ++ai)
#pragma unroll
            for (int m = 0; m < 4; ++m) { bf16_t* rowp = O + (size_t)(row0 + ai * HALF + m * 16) * ldc + col0;
                const f32x4 g0 = acc[ai][0][m][0] * isc, g1 = acc[ai][0][m][1] * isc, u0 = acc[ai][1][m][0] * isc, u1 = acc[ai][1][m][1] * isc;
                u32x4 w; w.x = cvt_pk_bf16(silu_mul(g0[0], u0[0]), silu_mul(g0[1], u0[1])); w.y = cvt_pk_bf16(silu_mul(g0[2], u0[2]), silu_mul(g0[3], u0[3]));
                w.z = cvt_pk_bf16(silu_mul(g1[0], u1[0]), silu_mul(g1[1], u1[1])); w.w = cvt_pk_bf16(silu_mul(g1[2], u1[2]), silu_mul(g1[3], u1[3]));
                *(u32x4*)rowp = w; }
    }
};

__device__ __forceinline__ unsigned cvt_pk4_fp8(float a, float b, float c, float d) { unsigned w = 0u; w = __builtin_amdgcn_cvt_pk_fp8_f32(a, b, w, false); w = __builtin_amdgcn_cvt_pk_fp8_f32(c, d, w, true); return w; }
struct EpiSwigluF8 {
    static constexpr bool PERM = true, AFTER_DRAIN = false;
    unsigned char* O; int ldc; float osc, isc;
    __device__ __forceinline__ void operator()(const f32x4 (&acc)[2][2][4][2], const Unit& u, int wr, int wc, int fr, int fq) const {
        typedef float f32x2 __attribute__((ext_vector_type(2)));
        typedef unsigned u32x2 __attribute__((ext_vector_type(2)));
        const int row0 = u.pm * BM + wr * 64 + fr, col0 = u.pc * HALF + wc * 32 + 8 * fq;
        const float k1i = 1.f / (osc * isc * isc), k2s = -1.44269504089f * isc; const f32x2 K2 = {k2s, k2s}, IK1 = {k1i, k1i};
#define SWF8P(G, U, OUT) do { const f32x2 t_ = (G) * K2; f32x2 e_; e_.x = __builtin_amdgcn_exp2f(t_.x); e_.y = __builtin_amdgcn_exp2f(t_.y); \
            const f32x2 d_ = e_ * IK1 + IK1; f32x2 r_; r_.x = __builtin_amdgcn_rcpf(d_.x); r_.y = __builtin_amdgcn_rcpf(d_.y); OUT = ((G) * (U)) * r_; } while (0)
#pragma unroll
        for (int ai = 0; ai < 2; ++ai)
#pragma unroll
            for (int m = 0; m < 4; ++m) { unsigned char* rowp = O + (size_t)(row0 + ai * HALF + m * 16) * ldc + col0;
                u32x2 w;
#pragma unroll
                for (int h = 0; h < 2; ++h) { const f32x4 g4 = acc[ai][0][m][h], u4 = acc[ai][1][m][h];
                    const f32x2 ga = {g4[0], g4[1]}, gb = {g4[2], g4[3]}, ua = {u4[0], u4[1]}, ub = {u4[2], u4[3]}; f32x2 oa, ob;
                    SWF8P(ga, ua, oa); SWF8P(gb, ub, ob);
                    const unsigned pk = cvt_pk4_fp8(oa.x, oa.y, ob.x, ob.y); if (h == 0) w.x = pk; else w.y = pk; }
                *(u32x2*)rowp = w; }
#undef SWF8P
    }
};

template <class Epi, class Sched, bool ALIGN_EPI = false, bool SP2 = false, bool F8 = false>
__device__ __forceinline__ void gemm_phase(PG8_LAS unsigned char* lds, const Gemm g, const Sched& S, const Epi& E) {
    int tid_ = threadIdx.x; asm volatile("" : "+v"(tid_));
    const int tid = tid_, wid = __builtin_amdgcn_readfirstlane(tid >> 6), lane = tid & 63, wr = wid >> 2, wc = wid & 3, fr = lane & 15, fq = lane >> 4;
    const int K = g.K, RB = F8 ? K : 2 * K;
    const int nt = g.kt > 0 ? g.kt : (F8 ? K / (2 * BK) : K / BK);
    unsigned voffA[2], voffB[2];
#pragma unroll
    for (int i = 0; i < 2; ++i) { int R, C; stage_rc(tid * 16 + i * 8192, R, C); const int Rb = Epi::PERM ? ((R & ~31) + perm32(R & 31)) : R;
        voffA[i] = (unsigned)(R * RB + C * 2); voffB[i] = (unsigned)(Rb * RB + C * 2); }
    const size_t kstep = (size_t)(BK * 2);
    const size_t hstep = (size_t)HALF * RB;
    const size_t tstep = 2 * hstep;
    const unsigned ldsw = (unsigned)wid * 1024u;
    const int aoff = F8 ? lds_byte(wr * 64 + fr, fq * 16) : lds_byte(wr * 64 + fr, fq * 8), boff = F8 ? lds_byte(wc * 32 + fr, fq * 16) : lds_byte(wc * 32 + fr, fq * 8);
#define PG8_SA(b, h) (((b) * 2 + (h)) * HTB)
#define PG8_SB(b, h) ((4 + (b) * 2 + (h)) * HTB)
#define PG8_STAGE(bufoff, gbase, voff) do { _Pragma("unroll") for (int _i = 0; _i < 2; ++_i) \
        __builtin_amdgcn_global_load_lds((const unsigned*)((const char*)(gbase) + (voff)[_i]), (PG8_LAS unsigned*)(lds + (bufoff) + ldsw + _i * 8192), 16, 0, 0); } while (0)
#define PG8_LD16(p) (*(const PG8_LAS i32x4*)(p))
#define PG8_LDA(dst, b, h) do { _Pragma("unroll") for (int m = 0; m < 4; ++m) { if constexpr (F8) { dst##8[m] = __builtin_shufflevector(PG8_LD16(lds + PG8_SA(b, h) + aoff + m * 2048), PG8_LD16(lds + PG8_SA(b, h) + aoff + m * 2048 + 16), 0, 1, 2, 3, 4, 5, 6, 7); } \
        else { _Pragma("unroll") for (int k = 0; k < 2; ++k) dst[m][k] = *(const PG8_LAS bf16x8*)(lds + PG8_SA(b, h) + aoff + m * 2048 + k * 1024); } } } while (0)
#define PG8_LDB(dst, b, h) do { _Pragma("unroll") for (int n = 0; n < 2; ++n) { if constexpr (F8) { dst##8[n] = __builtin_shufflevector(PG8_LD16(lds + PG8_SB(b, h) + boff + n * 2048), PG8_LD16(lds + PG8_SB(b, h) + boff + n * 2048 + 16), 0, 1, 2, 3, 4, 5, 6, 7); } \
        else { _Pragma("unroll") for (int k = 0; k < 2; ++k) dst[n][k] = *(const PG8_LAS bf16x8*)(lds + PG8_SB(b, h) + boff + n * 2048 + k * 1024); } } } while (0)
#define PG8_MMA(ai, bj, At, Bt) do { __builtin_amdgcn_s_setprio(1); _Pragma("unroll") for (int m = 0; m < 4; ++m) _Pragma("unroll") for (int n = 0; n < 2; ++n) { \
        if constexpr (F8) asm volatile("v_mfma_f32_16x16x128_f8f6f4 %0, %1, %2, %0" : "+v"(acc[ai][bj][m][n]) : "v"(Bt##8[n]), "v"(At##8[m])); \
        else { _Pragma("unroll") for (int k = 0; k < 2; ++k) acc[ai][bj][m][n] = __builtin_amdgcn_mfma_f32_16x16x32_bf16(Bt[n][k], At[m][k], acc[ai][bj][m][n], 0, 0, 0); } } __builtin_amdgcn_s_setprio(0); } while (0)
#define PG8_WAIT_V(n) asm volatile("s_waitcnt vmcnt(" #n ")" ::: "memory")
#define PG8_WAIT_L(n) asm volatile("s_waitcnt lgkmcnt(" #n ")" ::: "memory")
#define PG8_BAR __builtin_amdgcn_s_barrier()
#define PG8_SCHED __builtin_amdgcn_sched_barrier(0)
    Unit cur, nxt; int ui = 0;
    if (!S.next(0, cur)) return;
    f32x4 acc[2][2][4][2];
#pragma unroll
    for (int a = 0; a < 2; ++a)
#pragma unroll
        for (int b = 0; b < 2; ++b)
#pragma unroll
            for (int m = 0; m < 4; ++m)
#pragma unroll
                for (int n = 0; n < 2; ++n) acc[a][b][m][n] = (f32x4){0.f, 0.f, 0.f, 0.f};
    bf16x8 At[4][2], B0[2][2], B1[2][2]; i32x8 At8[4], B08[2], B18[2];
    const char* cA = (const char*)g.A + (size_t)cur.pm * tstep + cur.ko; const char* cB = (const char*)g.Bt + (size_t)cur.pn * tstep + cur.ko;
    S.a_ready(cur);
    if constexpr (SP2) {
        PG8_STAGE(PG8_SB(0, 0), cB, voffB); PG8_STAGE(PG8_SB(0, 1), cB + hstep, voffB); PG8_STAGE(PG8_SA(0, 0), cA, voffA); PG8_STAGE(PG8_SA(0, 1), cA + hstep, voffA);
        if (wr == 1) PG8_BAR;
        PG8_WAIT_V(2); PG8_BAR;
        PG8_STAGE(PG8_SB(1, 0), cB + kstep, voffB); PG8_STAGE(PG8_SA(1, 0), cA + kstep, voffA); PG8_STAGE(PG8_SB(1, 1), cB + hstep + kstep, voffB);
        PG8_WAIT_V(6); PG8_BAR;
    } else {
        PG8_STAGE(PG8_SB(0, 0), cB, voffB); PG8_STAGE(PG8_SA(0, 0), cA, voffA); PG8_STAGE(PG8_SB(0, 1), cB + hstep, voffB); PG8_STAGE(PG8_SA(0, 1), cA + hstep, voffA);
        if (wr == 1) PG8_BAR;
        PG8_WAIT_V(4); PG8_BAR;
        PG8_STAGE(PG8_SB(1, 0), cB + kstep, voffB); PG8_STAGE(PG8_SA(1, 0), cA + kstep, voffA); PG8_STAGE(PG8_SB(1, 1), cB + hstep + kstep, voffB);
        PG8_WAIT_V(6); PG8_BAR;
    }
    for (;;) {
        const bool has_next = S.next(ui + 1, nxt);
        const char* nA = has_next ? (const char*)g.A + (size_t)nxt.pm * tstep + nxt.ko : cA; const char* nB = has_next ? (const char*)g.Bt + (size_t)nxt.pn * tstep + nxt.ko : cB;
        for (int t = 0; t < nt; t += 2) {
            const bool last = (t == nt - 2);
            const char* a1 = cA + (size_t)(t + 1) * kstep;
            const char* a2 = last ? nA : cA + (size_t)(t + 2) * kstep; const char* b2 = last ? nB : cB + (size_t)(t + 2) * kstep;
            const char* a3 = a2 + kstep; const char* b3 = b2 + kstep;
            if (last && has_next) S.a_ready(nxt);
            if constexpr (SP2) {
            PG8_LDB(B0, 0, 0); PG8_LDB(B1, 0, 1); PG8_SCHED; PG8_LDA(At, 0, 0); PG8_STAGE(PG8_SA(1, 1), a1 + hstep, voffA);
            PG8_WAIT_V(8); PG8_WAIT_L(0); PG8_BAR; PG8_MMA(0, 0, At, B0); PG8_MMA(0, 1, At, B1); PG8_BAR; PG8_SCHED;
            PG8_LDA(At, 0, 1); PG8_STAGE(PG8_SB(0, 0), b2, voffB); PG8_STAGE(PG8_SB(0, 1), b2 + hstep, voffB); PG8_STAGE(PG8_SA(0, 0), a2, voffA);
            PG8_WAIT_V(8); PG8_WAIT_L(0); PG8_BAR; PG8_MMA(1, 0, At, B0); PG8_MMA(1, 1, At, B1); PG8_BAR; PG8_SCHED;
            PG8_LDB(B0, 1, 0); PG8_LDB(B1, 1, 1); PG8_SCHED; PG8_LDA(At, 1, 0); PG8_STAGE(PG8_SA(0, 1), a2 + hstep, voffA);
            PG8_WAIT_V(8); PG8_WAIT_L(0); PG8_BAR; PG8_MMA(0, 0, At, B0); PG8_MMA(0, 1, At, B1); PG8_BAR; PG8_SCHED;
            PG8_LDA(At, 1, 1); PG8_STAGE(PG8_SB(1, 0), b3, voffB); PG8_STAGE(PG8_SB(1, 1), b3 + hstep, voffB); PG8_STAGE(PG8_SA(1, 0), a3, voffA);
            PG8_WAIT_V(8); PG8_WAIT_L(0); PG8_BAR; PG8_MMA(1, 0, At, B0); PG8_MMA(1, 1, At, B1); PG8_BAR; PG8_SCHED;
            } else {
            PG8_LDB(B0, 0, 0); PG8_SCHED; PG8_LDA(At, 0, 0); PG8_STAGE(PG8_SA(1, 1), a1 + hstep, voffA);
            PG8_WAIT_L(8); PG8_BAR; PG8_WAIT_L(0); PG8_MMA(0, 0, At, B0); PG8_BAR; PG8_SCHED;
            PG8_LDB(B1, 0, 1); PG8_STAGE(PG8_SB(0, 0), b2, voffB);
            PG8_BAR; PG8_WAIT_L(0); PG8_MMA(0, 1, At, B1); PG8_BAR;
            PG8_LDA(At, 0, 1); PG8_STAGE(PG8_SA(0, 0), a2, voffA);
            PG8_BAR; PG8_WAIT_L(0); PG8_MMA(1, 0, At, B0); PG8_BAR; PG8_SCHED;
            PG8_STAGE(PG8_SB(0, 1), b2 + hstep, voffB);
            PG8_WAIT_V(6); PG8_BAR; PG8_MMA(1, 1, At, B1); PG8_BAR;
            PG8_LDB(B0, 1, 0); PG8_SCHED; PG8_LDA(At, 1, 0); PG8_STAGE(PG8_SA(0, 1), a2 + hstep, voffA);
            PG8_WAIT_L(8); PG8_BAR; PG8_WAIT_L(0); PG8_MMA(0, 0, At, B0); PG8_BAR; PG8_SCHED;
            PG8_LDB(B1, 1, 1); PG8_STAGE(PG8_SB(1, 0), b3, voffB);
            PG8_BAR; PG8_WAIT_L(0); PG8_MMA(0, 1, At, B1); PG8_BAR;
            PG8_LDA(At, 1, 1); PG8_STAGE(PG8_SA(1, 0), a3, voffA);
            PG8_BAR; PG8_WAIT_L(0); PG8_MMA(1, 0, At, B0); PG8_BAR; PG8_SCHED;
            PG8_STAGE(PG8_SB(1, 1), b3 + hstep, voffB);
            PG8_WAIT_V(6); PG8_BAR; PG8_MMA(1, 1, At, B1); PG8_BAR;
            }
        }
        if constexpr (ALIGN_EPI) { if (wr == 0) PG8_BAR; }
        if constexpr (F8) {
            asm volatile("s_nop 15\n\ts_nop 15" : "+v"(acc[0][0][0][0]), "+v"(acc[0][0][0][1]), "+v"(acc[0][0][1][0]), "+v"(acc[0][0][1][1]), "+v"(acc[0][0][2][0]), "+v"(acc[0][0][2][1]), "+v"(acc[0][0][3][0]), "+v"(acc[0][0][3][1]) :: "memory");
            asm volatile("" : "+v"(acc[0][1][0][0]), "+v"(acc[0][1][0][1]), "+v"(acc[0][1][1][0]), "+v"(acc[0][1][1][1]), "+v"(acc[0][1][2][0]), "+v"(acc[0][1][2][1]), "+v"(acc[0][1][3][0]), "+v"(acc[0][1][3][1]) :: "memory");
            asm volatile("" : "+v"(acc[1][0][0][0]), "+v"(acc[1][0][0][1]), "+v"(acc[1][0][1][0]), "+v"(acc[1][0][1][1]), "+v"(acc[1][0][2][0]), "+v"(acc[1][0][2][1]), "+v"(acc[1][0][3][0]), "+v"(acc[1][0][3][1]) :: "memory");
            asm volatile("" : "+v"(acc[1][1][0][0]), "+v"(acc[1][1][0][1]), "+v"(acc[1][1][1][0]), "+v"(acc[1][1][1][1]), "+v"(acc[1][1][2][0]), "+v"(acc[1][1][2][1]), "+v"(acc[1][1][3][0]), "+v"(acc[1][1][3][1]) :: "memory");
        }
        if constexpr (!Epi::AFTER_DRAIN) { E(acc, cur, wr, wc, fr, fq); S.done(cur); }
        if (!has_next) break;
#pragma unroll
        for (int a = 0; a < 2; ++a)
#pragma unroll
            for (int b = 0; b < 2; ++b)
#pragma unroll
                for (int m = 0; m < 4; ++m)
#pragma unroll
                    for (int n = 0; n < 2; ++n) acc[a][b][m][n] = (f32x4){0.f, 0.f, 0.f, 0.f};
        cur = nxt; cA = nA; cB = nB; ++ui;
        if constexpr (ALIGN_EPI) { if (wr == 1) PG8_BAR; }
    }
    PG8_WAIT_V(0);
    if constexpr (!ALIGN_EPI) { if (wr == 0) PG8_BAR; }
    PG8_BAR;
    if constexpr (Epi::AFTER_DRAIN) { E.fused(acc, cur, wr, wc, fr, fq, lds, wid, lane); S.done(cur); }
#undef PG8_SA
#undef PG8_SB
#undef PG8_STAGE
#undef PG8_LDA
#undef PG8_LDB
#undef PG8_MMA
#undef PG8_LD16
#undef PG8_WAIT_V
#undef PG8_WAIT_L
#undef PG8_BAR
#undef PG8_SCHED
}
}

namespace att {
typedef unsigned short bf16;
using bf16x8 = __attribute__((ext_vector_type(8))) short;
using s16x4  = __attribute__((ext_vector_type(4))) short;
using f32x16 = __attribute__((ext_vector_type(16))) float;
using u32x4  = __attribute__((ext_vector_type(4))) unsigned;
constexpr int NW = 8, QBLK = 32, KVBLK = 64, DV = 128;
constexpr float THR = 8.f;
constexpr int SHM_V = KVBLK * DV * 2;
#define ATT_SBAR() __builtin_amdgcn_sched_barrier(0)
#ifndef ATT_IGLP_OPT
#define ATT_IGLP_OPT -1
#endif
#if ATT_IGLP_OPT >= 0
#define ATT_IGLP() __builtin_amdgcn_iglp_opt(ATT_IGLP_OPT)
#else
#define ATT_IGLP() do {} while (0)
#endif
__device__ __forceinline__ int crow(int r, int hi) { return (r & 3) + 8 * (r >> 2) + 4 * hi; }
__device__ __forceinline__ unsigned cvtpk(float lo, float hi) { unsigned r; asm volatile("v_cvt_pk_bf16_f32 %0, %1, %2" : "=v"(r) : "v"(lo), "v"(hi)); return r; }
template <int DQ> struct Cst { static constexpr float SCALE = (DQ == 128) ? 0.088388347648318440f : 0.072168783648703220f; static constexpr int SHM_K = KVBLK * DQ * 2, ROWB = DQ * 2; };

template <int DQ>
__device__ __forceinline__ void partialSM(f32x16& p0, f32x16& p1, float& m_reg, float& mn, float& alpha) {
  constexpr float SCALE = Cst<DQ>::SCALE, C = SCALE * 1.4426950408889634f;
  float pmax = p0[0];
#pragma unroll
  for (int r = 1; r < 16; ++r) pmax = fmaxf(pmax, p0[r]);
#pragma unroll
  for (int r = 0; r < 16; ++r) pmax = fmaxf(pmax, p1[r]);
  { auto rr = __builtin_amdgcn_permlane32_swap(__float_as_uint(pmax), __float_as_uint(pmax), false, false);
    pmax = fmaxf(__uint_as_float(rr[0]), __uint_as_float(rr[1])); }
  if (__builtin_expect(__all(pmax - m_reg <= THR / SCALE), 1)) { mn = m_reg; alpha = 1.f; }
  else { mn = fmaxf(m_reg, pmax); alpha = __builtin_amdgcn_exp2f((m_reg - mn) * C); m_reg = mn; }
  const float mnC = -mn * C;
  { typedef float f32x2_ __attribute__((ext_vector_type(2))); const f32x2_ C2 = {C, C}, M2 = {mnC, mnC};
#pragma unroll
    for (int i = 0; i < 8; ++i) { f32x2_ a = {p0[2 * i], p0[2 * i + 1]}, b = {p1[2 * i], p1[2 * i + 1]}; a = a * C2 + M2; b = b * C2 + M2; p0[2 * i] = a.x; p0[2 * i + 1] = a.y; p1[2 * i] = b.x; p1[2 * i + 1] = b.y; } }
#pragma unroll
  for (int r = 0; r < 16; ++r) p0[r] = __builtin_amdgcn_exp2f(p0[r]);
}
__device__ __forceinline__ void finishSM(f32x16& p0, f32x16& p1, float alpha, float& l_reg, bf16x8& pa0, bf16x8& pa1, bf16x8& pa2, bf16x8& pa3) {
#pragma unroll
  for (int r = 0; r < 16; ++r) p1[r] = __builtin_amdgcn_exp2f(p1[r]);
  float ps;
  { typedef float f32x2_ __attribute__((ext_vector_type(2))); f32x2_ s0 = {0.f, 0.f}, s1 = {0.f, 0.f};
#pragma unroll
    for (int i = 0; i < 8; ++i) { const f32x2_ a = {p0[2 * i], p0[2 * i + 1]}; s0 += a; }
#pragma unroll
    for (int i = 0; i < 8; ++i) { const f32x2_ b = {p1[2 * i], p1[2 * i + 1]}; s1 += b; }
    s0 += s1; ps = s0.x + s0.y; }
  { auto rr = __builtin_amdgcn_permlane32_swap(__float_as_uint(ps), __float_as_uint(ps), false, false);
    ps = __uint_as_float(rr[0]) + __uint_as_float(rr[1]); }
  l_reg = l_reg * alpha + ps;
#define ATT_PK4(P, BASE, OUT) do { unsigned a0 = cvtpk(P[BASE + 0], P[BASE + 1]), a1 = cvtpk(P[BASE + 2], P[BASE + 3]);   \
    unsigned b0 = cvtpk(P[BASE + 4], P[BASE + 5]), b1 = cvtpk(P[BASE + 6], P[BASE + 7]);                              \
    auto r0 = __builtin_amdgcn_permlane32_swap(a0, b0, false, false); auto r1 = __builtin_amdgcn_permlane32_swap(a1, b1, false, false); \
    u32x4 w = {r0[0], r1[0], r0[1], r1[1]}; OUT = *reinterpret_cast<bf16x8*>(&w); } while (0)
  ATT_PK4(p0, 0, pa0); ATT_PK4(p0, 8, pa1); ATT_PK4(p1, 0, pa2); ATT_PK4(p1, 8, pa3);
#undef ATT_PK4
}
template <int DQ, int NREG>
__device__ __forceinline__ void qkt(f32x16& p0, f32x16& p1, const char* Ks, const bf16x8* qr, const char* qpark, int r32, int hi) {
  constexpr int ROWB = Cst<DQ>::ROWB;
  p0 = f32x16{}; p1 = f32x16{};
#pragma unroll
  for (int d0 = 0; d0 < DQ / 16; ++d0) { const int cb = (d0 * 16 + hi * 8) * 2;
    bf16x8 b0 = *reinterpret_cast<const bf16x8*>(Ks + (r32 * ROWB + (cb ^ ((r32 & 7) << 4))));
    bf16x8 b1 = *reinterpret_cast<const bf16x8*>(Ks + ((32 + r32) * ROWB + (cb ^ ((r32 & 7) << 4))));
    bf16x8 q; if constexpr (true) { if (d0 < NREG) q = qr[d0 < NREG ? d0 : 0]; else q = *reinterpret_cast<const bf16x8*>(qpark + (d0 - NREG) * 1024); }
    p0 = __builtin_amdgcn_mfma_f32_32x32x16_bf16(b0, q, p0, 0, 0, 0);
    p1 = __builtin_amdgcn_mfma_f32_32x32x16_bf16(b1, q, p1, 0, 0, 0); }
}
__device__ __forceinline__ int v_st(int k, int c) { const int kk = (k & ~0xC) | ((k & 4) << 1) | ((k & 8) >> 1); return ((kk >> 3) * 4 + (c >> 5)) * 512 + ((kk & 7) * 32 + (c & 31)) * 2; }
__device__ __forceinline__ int v_rd_base(int lane) { return ((lane & 3) << 3) | (((lane >> 2) & 3) << 6) | (((lane >> 4) & 1) << 5) | (((lane >> 5) & 1) << 8); }
constexpr int v_rd_off(int d0, int ks, int half) { return d0 * 512 + ks * 4096 + half * 2048; }
template <int OFF> __device__ __forceinline__ s16x4 tr_read(int vb) {
  s16x4 r; asm volatile("ds_read_b64_tr_b16 %0, %1 offset:%2" : "=&v"(r) : "v"(vb), "i"(OFF) : "memory"); return r;
}
template <int D0> __device__ __forceinline__ void pv_one(f32x16& od, int vb, bf16x8 pa0, bf16x8 pa1, bf16x8 pa2, bf16x8 pa3) {
  const s16x4 l0 = tr_read<v_rd_off(D0, 0, 0)>(vb), h0 = tr_read<v_rd_off(D0, 0, 1)>(vb), l1 = tr_read<v_rd_off(D0, 1, 0)>(vb), h1 = tr_read<v_rd_off(D0, 1, 1)>(vb);
  const s16x4 l2 = tr_read<v_rd_off(D0, 2, 0)>(vb), h2 = tr_read<v_rd_off(D0, 2, 1)>(vb), l3 = tr_read<v_rd_off(D0, 3, 0)>(vb), h3 = tr_read<v_rd_off(D0, 3, 1)>(vb);
  asm volatile("s_waitcnt lgkmcnt(0)" ::: "memory"); ATT_SBAR();
#define ATT_PK(L, H) (bf16x8){L[0], L[1], L[2], L[3], H[0], H[1], H[2], H[3]}
  od = __builtin_amdgcn_mfma_f32_32x32x16_bf16(pa0, ATT_PK(l0, h0), od, 0, 0, 0);
  od = __builtin_amdgcn_mfma_f32_32x32x16_bf16(pa1, ATT_PK(l1, h1), od, 0, 0, 0);
  od = __builtin_amdgcn_mfma_f32_32x32x16_bf16(pa2, ATT_PK(l2, h2), od, 0, 0, 0);
  od = __builtin_amdgcn_mfma_f32_32x32x16_bf16(pa3, ATT_PK(l3, h3), od, 0, 0, 0);
#undef ATT_PK
}
__device__ __forceinline__ void pv_d0(f32x16* o, int vb, bf16x8 pa0, bf16x8 pa1, bf16x8 pa2, bf16x8 pa3) {
  pv_one<0>(o[0], vb, pa0, pa1, pa2, pa3); pv_one<1>(o[1], vb, pa0, pa1, pa2, pa3); pv_one<2>(o[2], vb, pa0, pa1, pa2, pa3); pv_one<3>(o[3], vb, pa0, pa1, pa2, pa3);
}
__device__ __forceinline__ void natten_mod(f32x16& p0, f32x16& p1, int kr, int rq, int qc, const float* biasT, int hi) {
  const int r0 = min(max(rq - 4, 0), 56), c0 = min(max(qc - 8, 0), 48);
  const float NEG = -__builtin_inff();
  if (kr < r0 || kr >= r0 + 8) {
#pragma unroll
    for (int r = 0; r < 16; ++r) { p0[r] = NEG; p1[r] = NEG; }
  } else {
    const float* bl = biasT + (kr - rq + 7) * 128 + (63 - qc + 4 * hi);
    const int t = 4 * hi - c0;
#pragma unroll
    for (int r = 0; r < 16; ++r) {
      const int kcc = (r & 3) + 8 * (r >> 2);
      const bool ok0 = (unsigned)(t + kcc) < 16u, ok1 = (unsigned)(t + kcc + 32) < 16u;
      const float b0 = bl[kcc], b1 = bl[kcc + 32];
      p0[r] = ok0 ? p0[r] + b0 : NEG; p1[r] = ok1 ? p1[r] + b1 : NEG;
      if ((r & 3) == 3) __builtin_amdgcn_sched_barrier(0);
    }
  }
}

template <int DQ, int LDQ, int LDK, int LDV, int LDO, int MODE, int SDEPTH, int NREG>
__device__ __forceinline__ void attn_body(const bf16* __restrict__ Qb, const bf16* __restrict__ Kh, const bf16* __restrict__ Vh, bf16* __restrict__ Ob, const int NT, char* lds,
                                          const int rq0, const int kr_lo, const float* biasT) {
  constexpr int SHM_K = Cst<DQ>::SHM_K, ROWB = Cst<DQ>::ROWB;
  int tid_ = threadIdx.x; asm volatile("" : "+v"(tid_));
  const int tid = tid_, wid = tid >> 6, lane = tid & 63, r32 = lane & 31, hi = lane >> 5;
  char* V_lds = lds; char* K_lds = lds + 2 * SHM_V;
  float* ws = (float*)(lds + 2 * SHM_V + 2 * SHM_K) + wid * 64; float* li_l = ws; float* al_l = ws + 32;
  float m_reg = -1e30f, l_reg = 0; f32x16 o[4] = {}; bf16x8 qr[NREG > 0 ? NREG : 1];
  const bf16* Qw = Qb + (long)(wid * QBLK + r32) * LDQ + hi * 8;
  char* qpark = lds + 2 * SHM_V + 2 * SHM_K + NW * 64 * 4 + wid * ((DQ / 16 - NREG) * 1024) + hi * 512 + r32 * 16;
#pragma unroll
  for (int d0 = 0; d0 < DQ / 16; ++d0) { const bf16x8 qv = *reinterpret_cast<const bf16x8*>(Qw + d0 * 16); if (d0 < NREG) qr[d0 < NREG ? d0 : 0] = qv; else *reinterpret_cast<bf16x8*>(qpark + (d0 - NREG) * 1024) = qv; }
  const int nrq = rq0 + (wid >> 1), nqc = (wid & 1) * 32 + r32;
  const int sr = tid >> 4, sc = (tid & 15) * 8, vst0 = v_st(sr, sc), vst1 = v_st(32 + sr, sc);
  const int kr3 = tid >> 3, kc3 = 128 + (tid & 7) * 8;
  const int vb0 = (int)(uintptr_t)V_lds + v_rd_base(lane);
  struct { bf16x8 vs0, vs1, ks0, ks1, ks2; } sr_[SDEPTH];
#define ATT_LD8(p) (*reinterpret_cast<const bf16x8*>(p))
#define ATT_SLOAD(i, k0) do { sr_[i].vs0 = ATT_LD8(&Vh[(long)((k0) + sr) * LDV + sc]); sr_[i].vs1 = ATT_LD8(&Vh[(long)((k0) + 32 + sr) * LDV + sc]); \
    sr_[i].ks0 = ATT_LD8(&Kh[(long)((k0) + sr) * LDK + sc]); sr_[i].ks1 = ATT_LD8(&Kh[(long)((k0) + 32 + sr) * LDK + sc]); \
    if constexpr (DQ == 192) sr_[i].ks2 = ATT_LD8(&Kh[(long)((k0) + kr3) * LDK + kc3]); } while (0)
#define ATT_SWRITE(b, i) do { *(bf16x8*)(V_lds + (b) * SHM_V + vst0) = sr_[i].vs0;          \
    *(bf16x8*)(V_lds + (b) * SHM_V + vst1) = sr_[i].vs1; const int kc = sc * 2;               \
    *(bf16x8*)(K_lds + (b) * SHM_K + sr * ROWB + (kc ^ ((sr & 7) << 4))) = sr_[i].ks0;                       \
    *(bf16x8*)(K_lds + (b) * SHM_K + (32 + sr) * ROWB + (kc ^ ((sr & 7) << 4))) = sr_[i].ks1; \
    if constexpr (DQ == 192) *(bf16x8*)(K_lds + (b) * SHM_K + kr3 * ROWB + ((kc3 * 2) ^ ((kr3 & 7) << 4))) = sr_[i].ks2; } while (0)
#define ATT_SWAIT() do { if constexpr (SDEPTH == 2) { if constexpr (DQ == 192) asm volatile("s_waitcnt vmcnt(5)" ::: "memory"); else asm volatile("s_waitcnt vmcnt(4)" ::: "memory"); } \
    else asm volatile("s_waitcnt vmcnt(0)" ::: "memory"); } while (0)
#define ATT_RESC(a) do { if (__any((a) < 1.f)) { if (hi == 0) al_l[r32] = (a); asm volatile("s_waitcnt lgkmcnt(0)" ::: "memory"); \
    _Pragma("unroll") for (int d = 0; d < 4; ++d) _Pragma("unroll") for (int r = 0; r < 16; ++r) o[d][r] *= al_l[crow(r, hi)]; } } while (0)
#define ATT_MOD(P0, P1, J) do { if constexpr (MODE == 1) natten_mod(P0, P1, kr_lo + (J), nrq, nqc, biasT, hi); } while (0)
  f32x16 pA0, pA1, pB0, pB1; float mnA, mnB, alA, alB; bf16x8 pa0, pa1, pa2, pa3;
  constexpr int SE = 0, SO = SDEPTH - 1;
  ATT_SLOAD(SE, 0); asm volatile("s_waitcnt vmcnt(0)" ::: "memory"); ATT_SWRITE(0, SE); __syncthreads();
  qkt<DQ, NREG>(pA0, pA1, K_lds, qr, qpark, r32, hi); ATT_MOD(pA0, pA1, 0); partialSM<DQ>(pA0, pA1, m_reg, mnA, alA);
  ATT_SLOAD(SO, KVBLK); if constexpr (SDEPTH == 2) { if (2 < NT) ATT_SLOAD(SE, 2 * KVBLK); }
  ATT_SWAIT(); ATT_SWRITE(1, SO); __syncthreads();
  for (int j = 1; j + 1 < NT; j += 2) {
    ATT_SBAR(); ATT_IGLP(); qkt<DQ, NREG>(pB0, pB1, K_lds + SHM_K, qr, qpark, r32, hi); ATT_MOD(pB0, pB1, j);
    finishSM(pA0, pA1, alA, l_reg, pa0, pa1, pa2, pa3); ATT_SBAR();
    ATT_SLOAD(SO, (j + SDEPTH) * KVBLK); ATT_SBAR();
    pv_d0(o, vb0, pa0, pa1, pa2, pa3); partialSM<DQ>(pB0, pB1, m_reg, mnB, alB);
    __syncthreads(); ATT_SWAIT(); ATT_SWRITE(0, SE);
    ATT_RESC(alB); __syncthreads();
    ATT_SBAR(); ATT_IGLP(); qkt<DQ, NREG>(pA0, pA1, K_lds, qr, qpark, r32, hi); ATT_MOD(pA0, pA1, j + 1);
    finishSM(pB0, pB1, alB, l_reg, pa0, pa1, pa2, pa3); ATT_SBAR();
    if (SDEPTH == 1 || j + 3 < NT) ATT_SLOAD(SE, (j + 1 + SDEPTH) * KVBLK); ATT_SBAR();
    pv_d0(o, vb0 + SHM_V, pa0, pa1, pa2, pa3); partialSM<DQ>(pA0, pA1, m_reg, mnA, alA);
    __syncthreads(); ATT_SWAIT(); ATT_SWRITE(1, SO);
    ATT_RESC(alA); __syncthreads();
  }
  ATT_SBAR(); qkt<DQ, NREG>(pB0, pB1, K_lds + SHM_K, qr, qpark, r32, hi); ATT_MOD(pB0, pB1, NT - 1);
  finishSM(pA0, pA1, alA, l_reg, pa0, pa1, pa2, pa3); ATT_SBAR();
  pv_d0(o, vb0, pa0, pa1, pa2, pa3); partialSM<DQ>(pB0, pB1, m_reg, mnB, alB);
  __syncthreads(); ATT_RESC(alB);
  finishSM(pB0, pB1, alB, l_reg, pa0, pa1, pa2, pa3); ATT_SBAR();
  pv_d0(o, vb0 + SHM_V, pa0, pa1, pa2, pa3);
  if (hi == 0) li_l[r32] = l_reg; asm volatile("s_waitcnt lgkmcnt(0)" ::: "memory");
  float rli[16];
#pragma unroll
  for (int r = 0; r < 16; ++r) rli[r] = __builtin_amdgcn_rcpf(li_l[crow(r, hi)]);
  bf16* Ow = Ob + (long)(wid * QBLK) * LDO;
#pragma unroll
  for (int r = 0; r < 16; ++r) { const int orow = crow(r, hi);
#pragma unroll
    for (int d0 = 0; d0 < 4; d0 += 1) { const unsigned w = cvtpk(o[d0][r] * rli[r], 0.f); Ow[(long)orow * LDO + d0 * 32 + r32] = (bf16)(w & 0xffffu); } }
#undef ATT_LD8
#undef ATT_SLOAD
#undef ATT_SWRITE
#undef ATT_SWAIT
#undef ATT_RESC
#undef ATT_MOD
}

template <int DQ, int LDQ, int LDK, int LDV, int LDO, int MODE, int SD, int NREG>
__device__ __forceinline__ void attn_body3(const bf16* __restrict__ Qb, const bf16* __restrict__ Kh, const bf16* __restrict__ Vh, bf16* __restrict__ Ob, const int NT, char* lds,
                                           const int rq0, const int kr_lo, const float* biasT) {
  constexpr int SHM_K = Cst<DQ>::SHM_K, ROWB = Cst<DQ>::ROWB;
  int tid_ = threadIdx.x; asm volatile("" : "+v"(tid_));
  const int tid = tid_, wid = tid >> 6, lane = tid & 63, r32 = lane & 31, hi = lane >> 5;
  char* V_lds = lds; char* K_lds = lds + 3 * SHM_V;
  float* ws = (float*)(lds + 3 * SHM_V + 3 * SHM_K) + wid * 64; float* li_l = ws; float* al_l = ws + 32;
  float m_reg = -1e30f, l_reg = 0; f32x16 o[4] = {}; bf16x8 qr[NREG > 0 ? NREG : 1];
  const bf16* Qw = Qb + (long)(wid * QBLK + r32) * LDQ + hi * 8;
  char* qpark = lds + 3 * SHM_V + 3 * SHM_K + NW * 64 * 4 + wid * ((DQ / 16 - NREG) * 1024) + hi * 512 + r32 * 16;
#pragma unroll
  for (int d0 = 0; d0 < DQ / 16; ++d0) { const bf16x8 qv = *reinterpret_cast<const bf16x8*>(Qw + d0 * 16); if (d0 < NREG) qr[d0 < NREG ? d0 : 0] = qv; else *reinterpret_cast<bf16x8*>(qpark + (d0 - NREG) * 1024) = qv; }
  const int nrq = rq0 + (wid >> 1), nqc = (wid & 1) * 32 + r32;
  const int sr = tid >> 4, sc = (tid & 15) * 8, vst0 = v_st(sr, sc), vst1 = v_st(32 + sr, sc);
  const int kr3 = tid >> 3, kc3 = 128 + (tid & 7) * 8;
  const int vb0 = (int)(uintptr_t)V_lds + v_rd_base(lane);
  struct { bf16x8 vs0, vs1, ks0, ks1, ks2; } sr_[SD];
  const __amdgpu_buffer_rsrc_t rK = __builtin_amdgcn_make_buffer_rsrc((void*)Kh, 0, 0x7fffffff, 0x00020000), rV = __builtin_amdgcn_make_buffer_rsrc((void*)Vh, 0, 0x7fffffff, 0x00020000);
  const int vo_v = (sr * LDV + sc) * 2, vo_k = (sr * LDK + sc) * 2, vo_k3 = (kr3 * LDK + kc3) * 2; (void)vo_k3;
#define ATT_LD8(p) (*reinterpret_cast<const bf16x8*>(p))
#define ATT_BL(R, VO, SO) __builtin_bit_cast(bf16x8, __builtin_amdgcn_raw_buffer_load_b128(R, VO, SO, 0))
#define ATT_SLOAD(i, k0) do { const int sv_ = (k0) * (LDV * 2), sk_ = (k0) * (LDK * 2);    \
    sr_[i].vs0 = ATT_BL(rV, vo_v, sv_); sr_[i].vs1 = ATT_BL(rV, vo_v + 32 * LDV * 2, sv_); \
    sr_[i].ks0 = ATT_BL(rK, vo_k, sk_); sr_[i].ks1 = ATT_BL(rK, vo_k + 32 * LDK * 2, sk_); \
    if constexpr (DQ == 192) sr_[i].ks2 = ATT_BL(rK, vo_k3, sk_); } while (0)
#define ATT_SWRITE(b, i) do { const int b_ = (b); *(bf16x8*)(V_lds + b_ * SHM_V + vst0) = sr_[i].vs0;          \
    *(bf16x8*)(V_lds + b_ * SHM_V + vst1) = sr_[i].vs1; const int kc = sc * 2;               \
    *(bf16x8*)(K_lds + b_ * SHM_K + sr * ROWB + (kc ^ ((sr & 7) << 4))) = sr_[i].ks0;                       \
    *(bf16x8*)(K_lds + b_ * SHM_K + (32 + sr) * ROWB + (kc ^ ((sr & 7) << 4))) = sr_[i].ks1; \
    if constexpr (DQ == 192) *(bf16x8*)(K_lds + b_ * SHM_K + kr3 * ROWB + ((kc3 * 2) ^ ((kr3 & 7) << 4))) = sr_[i].ks2; } while (0)
#define ATT_RESC(a) do { if (__any((a) < 1.f)) { if (hi == 0) al_l[r32] = (a); asm volatile("s_waitcnt lgkmcnt(0)" ::: "memory"); \
    _Pragma("unroll") for (int d = 0; d < 4; ++d) _Pragma("unroll") for (int r = 0; r < 16; ++r) o[d][r] *= al_l[crow(r, hi)]; } } while (0)
#define ATT_MOD(P0, P1, J) do { if constexpr (MODE == 1) natten_mod(P0, P1, kr_lo + (J), nrq, nqc, biasT, hi); } while (0)
#define ATT_SET(x) ((SD == 2) ? ((x) & 1) : 0)
  f32x16 pA0, pA1, pB0, pB1; float mnA, mnB, alA, alB; bf16x8 pa0, pa1, pa2, pa3;
  ATT_SLOAD(0, 0); asm volatile("s_waitcnt vmcnt(0)" ::: "memory"); ATT_SWRITE(0, 0);
  ATT_SLOAD(ATT_SET(1), KVBLK); if constexpr (SD == 2) { if (2 < NT) ATT_SLOAD(0, 2 * KVBLK); }
  __syncthreads();
  ATT_SWRITE(1, ATT_SET(1));
  ATT_SBAR(); qkt<DQ, NREG>(pA0, pA1, K_lds, qr, qpark, r32, hi); ATT_MOD(pA0, pA1, 0); ATT_SBAR();
  if (1 + SD < NT) ATT_SLOAD(ATT_SET(1 + SD), (1 + SD) * KVBLK);
  ATT_SBAR(); partialSM<DQ>(pA0, pA1, m_reg, mnA, alA);
  __syncthreads();
  int bt = 1;
  for (int t = 1; t + 1 < NT; t += 2) {
    const int bn = (bt == 2) ? 0 : bt + 1, bp = (bt == 0) ? 2 : bt - 1;
    ATT_SWRITE(bn, ATT_SET(0));
    ATT_SBAR(); qkt<DQ, NREG>(pB0, pB1, K_lds + bt * SHM_K, qr, qpark, r32, hi); ATT_MOD(pB0, pB1, t);
    finishSM(pA0, pA1, alA, l_reg, pa0, pa1, pa2, pa3); ATT_SBAR();
    if (t + 1 + SD < NT) ATT_SLOAD(ATT_SET(0), (t + 1 + SD) * KVBLK);
    ATT_SBAR();
    pv_d0(o, vb0 + bp * SHM_V, pa0, pa1, pa2, pa3); partialSM<DQ>(pB0, pB1, m_reg, mnB, alB);
    ATT_RESC(alB); __syncthreads();
    if (t + 2 < NT) ATT_SWRITE(bp, ATT_SET(1));
    ATT_SBAR(); qkt<DQ, NREG>(pA0, pA1, K_lds + bn * SHM_K, qr, qpark, r32, hi); ATT_MOD(pA0, pA1, t + 1);
    finishSM(pB0, pB1, alB, l_reg, pa0, pa1, pa2, pa3); ATT_SBAR();
    if (t + 2 + SD < NT) ATT_SLOAD(ATT_SET(1), (t + 2 + SD) * KVBLK);
    ATT_SBAR();
    pv_d0(o, vb0 + bt * SHM_V, pa0, pa1, pa2, pa3); partialSM<DQ>(pA0, pA1, m_reg, mnA, alA);
    ATT_RESC(alA); __syncthreads();
    bt = bp;
  }
  {
    const int bp = (bt == 0) ? 2 : bt - 1;
    ATT_SBAR(); qkt<DQ, NREG>(pB0, pB1, K_lds + bt * SHM_K, qr, qpark, r32, hi); ATT_MOD(pB0, pB1, NT - 1);
    finishSM(pA0, pA1, alA, l_reg, pa0, pa1, pa2, pa3); ATT_SBAR();
    pv_d0(o, vb0 + bp * SHM_V, pa0, pa1, pa2, pa3); partialSM<DQ>(pB0, pB1, m_reg, mnB, alB);
    ATT_RESC(alB);
    finishSM(pB0, pB1, alB, l_reg, pa0, pa1, pa2, pa3); ATT_SBAR();
    pv_d0(o, vb0 + bt * SHM_V, pa0, pa1, pa2, pa3);
  }
  if (hi == 0) li_l[r32] = l_reg; asm volatile("s_waitcnt lgkmcnt(0)" ::: "memory");
  float rli[16];
#pragma unroll
  for (int r = 0; r < 16; ++r) rli[r] = __builtin_amdgcn_rcpf(li_l[crow(r, hi)]);
  bf16* Ow = Ob + (long)(wid * QBLK) * LDO;
#pragma unroll
  for (int r = 0; r < 16; ++r) { const int orow = crow(r, hi);
#pragma unroll
    for (int d0 = 0; d0 < 4; d0 += 1) { const unsigned w = cvtpk(o[d0][r] * rli[r], 0.f); Ow[(long)orow * LDO + d0 * 32 + r32] = (bf16)(w & 0xffffu); } }
  __syncthreads();
#undef ATT_LD8
#undef ATT_BL
#undef ATT_SLOAD
#undef ATT_SWRITE
#undef ATT_RESC
#undef ATT_MOD
#undef ATT_SET
}

template <int DQ, int LDQ, int LDK, int LDV, int LDO, int NTS, int SD, int NREG>
__device__ __forceinline__ void attn_body3s(const bf16* __restrict__ Qb, const bf16* __restrict__ Kh, const bf16* __restrict__ Vh, bf16* __restrict__ Ob, char* lds) {
  static_assert((NTS - 4) % 6 == 0 && NTS >= 4, "tile count");
  constexpr int SHM_K = Cst<DQ>::SHM_K, ROWB = Cst<DQ>::ROWB;
  int tid_ = threadIdx.x; asm volatile("" : "+v"(tid_));
  const int tid = tid_, wid = tid >> 6, lane = tid & 63, r32 = lane & 31, hi = lane >> 5;
  char* V_lds = lds; char* K_lds = lds + 3 * SHM_V;
  float* ws = (float*)(lds + 3 * SHM_V + 3 * SHM_K) + wid * 64; float* li_l = ws; float* al_l = ws + 32;
  float m_reg = -1e30f, l_reg = 0; f32x16 o[4] = {}; bf16x8 qr[NREG > 0 ? NREG : 1];
  const bf16* Qw = Qb + (long)(wid * QBLK + r32) * LDQ + hi * 8;
  char* qpark = lds + 3 * SHM_V + 3 * SHM_K + NW * 64 * 4 + wid * ((DQ / 16 - NREG) * 1024) + hi * 512 + r32 * 16;
#pragma unroll
  for (int d0 = 0; d0 < DQ / 16; ++d0) { const bf16x8 qv = *reinterpret_cast<const bf16x8*>(Qw + d0 * 16); if (d0 < NREG) qr[d0 < NREG ? d0 : 0] = qv; else *reinterpret_cast<bf16x8*>(qpark + (d0 - NREG) * 1024) = qv; }
  const int sr = tid >> 4, sc = (tid & 15) * 8, vst0 = v_st(sr, sc), vst1 = v_st(32 + sr, sc);
  const int kr3 = tid >> 3, kc3 = 128 + (tid & 7) * 8;
  const int vb0 = (int)(uintptr_t)V_lds + v_rd_base(lane);
  struct { bf16x8 vs0, vs1, ks0, ks1, ks2; } sr_[SD];
  const __amdgpu_buffer_rsrc_t rK = __builtin_amdgcn_make_buffer_rsrc((void*)Kh, 0, 0x7fffffff, 0x00020000), rV = __builtin_amdgcn_make_buffer_rsrc((void*)Vh, 0, 0x7fffffff, 0x00020000);
  const int vo_v = (sr * LDV + sc) * 2, vo_k = (sr * LDK + sc) * 2, vo_k3 = (kr3 * LDK + kc3) * 2; (void)vo_k3;
#define ATT_LD8(p) (*reinterpret_cast<const bf16x8*>(p))
#define ATT_BL(R, VO, SO) __builtin_bit_cast(bf16x8, __builtin_amdgcn_raw_buffer_load_b128(R, VO, SO, 0))
#define ATT_SLOAD(i, k0) do { const int sv_ = (k0) * (LDV * 2), sk_ = (k0) * (LDK * 2);    \
    sr_[i].vs0 = ATT_BL(rV, vo_v, sv_); sr_[i].vs1 = ATT_BL(rV, vo_v + 32 * LDV * 2, sv_); \
    sr_[i].ks0 = ATT_BL(rK, vo_k, sk_); sr_[i].ks1 = ATT_BL(rK, vo_k + 32 * LDK * 2, sk_); \
    if constexpr (DQ == 192) sr_[i].ks2 = ATT_BL(rK, vo_k3, sk_); } while (0)
#define ATT_SWRITE(b, i) do { *(bf16x8*)(V_lds + (b) * SHM_V + vst0) = sr_[i].vs0;          \
    *(bf16x8*)(V_lds + (b) * SHM_V + vst1) = sr_[i].vs1; const int kc = sc * 2;               \
    *(bf16x8*)(K_lds + (b) * SHM_K + sr * ROWB + (kc ^ ((sr & 7) << 4))) = sr_[i].ks0;                       \
    *(bf16x8*)(K_lds + (b) * SHM_K + (32 + sr) * ROWB + (kc ^ ((sr & 7) << 4))) = sr_[i].ks1; \
    if constexpr (DQ == 192) *(bf16x8*)(K_lds + (b) * SHM_K + kr3 * ROWB + ((kc3 * 2) ^ ((kr3 & 7) << 4))) = sr_[i].ks2; } while (0)
#define ATT_RESC(a) do { if (__any((a) < 1.f)) { if (hi == 0) al_l[r32] = (a); asm volatile("s_waitcnt lgkmcnt(0)" ::: "memory"); \
    _Pragma("unroll") for (int d = 0; d < 4; ++d) _Pragma("unroll") for (int r = 0; r < 16; ++r) o[d][r] *= al_l[crow(r, hi)]; } } while (0)
#define ATT_SET(x) ((SD == 2) ? ((x) & 1) : 0)
#define ATT_TILE(C0, C1, mnC, alC, P0, P1, alP, BC, BN, BP, PAR, T) do {                                                         \
    if ((T) + 1 < NTS) ATT_SWRITE(BN, ATT_SET(PAR));                                                                              \
    ATT_SBAR(); qkt<DQ, NREG>(C0, C1, K_lds + (BC) * SHM_K, qr, qpark, r32, hi);                                                  \
    finishSM(P0, P1, alP, l_reg, pa0, pa1, pa2, pa3); ATT_SBAR();                                                                 \
    if ((T) + 1 + SD < NTS) ATT_SLOAD(ATT_SET(PAR), ((T) + 1 + SD) * KVBLK);                                                      \
    ATT_SBAR(); pv_d0(o, vb0 + (BP) * SHM_V, pa0, pa1, pa2, pa3); partialSM<DQ>(C0, C1, m_reg, mnC, alC);                         \
    ATT_RESC(alC); __syncthreads(); } while (0)
  f32x16 pA0, pA1, pB0, pB1; float mnA, mnB, alA, alB; bf16x8 pa0, pa1, pa2, pa3;
  ATT_SLOAD(0, 0); asm volatile("s_waitcnt vmcnt(0)" ::: "memory"); ATT_SWRITE(0, 0);
  ATT_SLOAD(ATT_SET(1), KVBLK); if constexpr (SD == 2) ATT_SLOAD(0, 2 * KVBLK);
  __syncthreads();
  ATT_SWRITE(1, ATT_SET(1));
  ATT_SBAR(); qkt<DQ, NREG>(pA0, pA1, K_lds, qr, qpark, r32, hi); ATT_SBAR();
  ATT_SLOAD(ATT_SET(1 + SD), (1 + SD) * KVBLK);
  ATT_SBAR(); partialSM<DQ>(pA0, pA1, m_reg, mnA, alA);
  __syncthreads();
  for (int t = 1; t + 5 < NTS; t += 6) {
    ATT_TILE(pB0, pB1, mnB, alB, pA0, pA1, alA, 1, 2, 0, 0, t);
    ATT_TILE(pA0, pA1, mnA, alA, pB0, pB1, alB, 2, 0, 1, 1, t + 1);
    ATT_TILE(pB0, pB1, mnB, alB, pA0, pA1, alA, 0, 1, 2, 0, t + 2);
    ATT_TILE(pA0, pA1, mnA, alA, pB0, pB1, alB, 1, 2, 0, 1, t + 3);
    ATT_TILE(pB0, pB1, mnB, alB, pA0, pA1, alA, 2, 0, 1, 0, t + 4);
    ATT_TILE(pA0, pA1, mnA, alA, pB0, pB1, alB, 0, 1, 2, 1, t + 5);
  }
  ATT_TILE(pB0, pB1, mnB, alB, pA0, pA1, alA, 1, 2, 0, 0, NTS - 3);
  ATT_TILE(pA0, pA1, mnA, alA, pB0, pB1, alB, 2, 0, 1, 1, NTS - 2);
  {
    ATT_SBAR(); qkt<DQ, NREG>(pB0, pB1, K_lds, qr, qpark, r32, hi);
    finishSM(pA0, pA1, alA, l_reg, pa0, pa1, pa2, pa3); ATT_SBAR();
    pv_d0(o, vb0 + 2 * SHM_V, pa0, pa1, pa2, pa3); partialSM<DQ>(pB0, pB1, m_reg, mnB, alB);
    ATT_RESC(alB);
    finishSM(pB0, pB1, alB, l_reg, pa0, pa1, pa2, pa3); ATT_SBAR();
    pv_d0(o, vb0, pa0, pa1, pa2, pa3);
  }
  if (hi == 0) li_l[r32] = l_reg; asm volatile("s_waitcnt lgkmcnt(0)" ::: "memory");
  float rli[16];
#pragma unroll
  for (int r = 0; r < 16; ++r) rli[r] = __builtin_amdgcn_rcpf(li_l[crow(r, hi)]);
  bf16* Ow = Ob + (long)(wid * QBLK) * LDO;
#pragma unroll
  for (int r = 0; r < 16; ++r) { const int orow = crow(r, hi);
#pragma unroll
    for (int d0 = 0; d0 < 4; d0 += 1) { const unsigned w = cvtpk(o[d0][r] * rli[r], 0.f); Ow[(long)orow * LDO + d0 * 32 + r32] = (bf16)(w & 0xffffu); } }
  __syncthreads();
#undef ATT_TILE
#undef ATT_LD8
#undef ATT_BL
#undef ATT_SLOAD
#undef ATT_SWRITE
#undef ATT_RESC
#undef ATT_SET
}
}
#ifndef ATT_RING3
#define ATT_RING3 7
#endif
#if ATT_RING3 & 1
#define ATT_BODY_C attn_body3
#else
#define ATT_BODY_C attn_body
#endif
#if ATT_RING3 & 2
#define ATT_BODY_B attn_body3
#else
#define ATT_BODY_B attn_body
#endif
#if ATT_RING3 & 4
#define ATT_BODY_A attn_body3
#else
#define ATT_BODY_A attn_body
#endif

#ifndef PH_MASK
#define PH_MASK 0xFFFFFFFFu
#endif
#define PHON(k) (((PH_MASK) >> (k)) & 1u)
#ifndef REP_MASK
#define REP_MASK 0u
#endif
#define REP(k) (((REP_MASK) >> (k)) & 1u)
#ifndef FFN_F8
#define FFN_F8 7
#endif
#ifndef MOE_CVT_IN_ATTN
#define MOE_CVT_IN_ATTN 3
#endif
#ifndef WOUT_F8
#define WOUT_F8 0
#endif
constexpr bool F8WO = WOUT_F8 != 0;
constexpr bool F8DG = (FFN_F8 & 1) != 0, F8DD = (FFN_F8 & 4) != 0, F8M = (FFN_F8 & 2) != 0;
constexpr float SC_H = 4.f, SC_ACT = 8.f, SC_W = 256.f;
constexpr int NWAVES = 8;
constexpr int DM = 2048, BATCH = 4, SEQ = 4096, NTOK = BATCH * SEQ, DEPTH = 2;
constexpr int DIN = 3904, DINP = 4096;
constexpr int DFF = 5632, NE = 8, DFE = 7168;
constexpr int PC_QA = 0, PC_KA = 512, PC_VA = 1024, PC_QB = 1536, PC_KB = 2560, PC_VB = 2816, PC_CQ = 3072, PC_CKV = 3584, PC_KPE = 3840;
constexpr float EPS = 1e-6f;
constexpr int MAXTILES = 136;
constexpr int MAXSLOTS = MAXTILES * 256;

constexpr size_t MiB = 1u << 20;
constexpr size_t WS_CTL = 0, CTL_ZERO_BYTES = 1 * MiB;
constexpr size_t WS_WIN = 1 * MiB;
constexpr size_t WS_WUQ = WS_WIN + 32 * MiB;
constexpr size_t WS_WUKV = WS_WUQ + 2 * MiB;
constexpr size_t WS_WOUT = WS_WUKV + 1 * MiB;
constexpr size_t WS_WGU = WS_WOUT + 16 * MiB;
constexpr size_t WS_WD = WS_WGU + 44 * MiB;
constexpr size_t WS_WEGU = WS_WD + 22 * MiB;
constexpr size_t WS_WED = WS_WEGU + 448 * MiB;
constexpr size_t WS_H = WS_WED + 224 * MiB;
constexpr size_t WS_ACT0 = WS_H + 64 * MiB;
constexpr size_t WS_PROJ = WS_ACT0;
constexpr size_t WS_QA = WS_PROJ + 128 * MiB;
constexpr size_t WS_KA = WS_QA + 16 * MiB;
constexpr size_t WS_QB = WS_KA + 16 * MiB;
constexpr size_t WS_KB = WS_QB + 32 * MiB;
constexpr size_t WS_CQN = WS_KB + 8 * MiB;
constexpr size_t WS_CKVN = WS_CQN + 16 * MiB;
constexpr size_t WS_KPE = WS_CKVN + 8 * MiB;
constexpr size_t WS_QCR = WS_KPE + 2 * MiB;
constexpr size_t WS_KVR = WS_QCR + 24 * MiB;
constexpr size_t WS_QC = WS_KVR + 32 * MiB;
constexpr size_t WS_KC = WS_QC + 24 * MiB;
constexpr size_t WS_O = WS_KC + 24 * MiB;
constexpr size_t WS_ON = WS_O + 64 * MiB;
constexpr size_t WS_ATT_END = WS_ON + 64 * MiB;
constexpr size_t WS_ACT = WS_ACT0;
constexpr size_t WS_HG = WS_ACT0;
constexpr size_t WS_ACTM = WS_HG + 136 * MiB;
constexpr size_t WS_Y = WS_ACTM + 476 * MiB;
constexpr size_t WS_RGATE = WS_Y + 136 * MiB;
constexpr size_t WS_TOKE = WS_RGATE + 1 * MiB;
constexpr size_t WS_TOKP = WS_TOKE + 1 * MiB;
constexpr size_t WS_TOKW = WS_TOKP + 1 * MiB;
constexpr size_t WS_END = WS_TOKW + 1 * MiB;
constexpr size_t WS_XB = WS_END;
constexpr size_t WS_END2 = WS_XB + 64 * MiB;
constexpr size_t WS_PART = WS_END2;
constexpr size_t WS_END3 = WS_PART + 64 * MiB;
constexpr size_t WS_DUMMY = WS_END3;
static_assert(WS_ATT_END <= WS_END, "map");
constexpr int CW_CNT = 64;
constexpr int CW_CQ = 128;
constexpr int CW_AQ = 8192;
constexpr int CW_BAR = 4096;

constexpr int RING_BYTES = 131072;
constexpr int LDS_BYTES = 163840;
constexpr int MISC_OFF = LDS_BYTES - 256;

#define GAS __attribute__((address_space(1)))
#define LAS __attribute__((address_space(3)))
typedef unsigned short bf16;
typedef unsigned v4u __attribute__((ext_vector_type(4)));
typedef unsigned v2u __attribute__((ext_vector_type(2)));
typedef float f32x4 __attribute__((ext_vector_type(4)));
typedef float f32x2 __attribute__((ext_vector_type(2)));
__device__ __forceinline__ unsigned pk2(float lo, float hi) { unsigned r; asm volatile("v_cvt_pk_bf16_f32 %0, %1, %2" : "=v"(r) : "v"(lo), "v"(hi)); return r; }
__device__ __forceinline__ float bf_lo(unsigned w) { return __uint_as_float(w << 16); }
__device__ __forceinline__ float bf_hi(unsigned w) { return __uint_as_float(w & 0xffff0000u); }
#define WS_DPP_STEP(v, CTRL) do { const int x_ = __builtin_bit_cast(int, v); v += __builtin_bit_cast(float, __builtin_amdgcn_update_dpp(x_, x_, CTRL, 0xF, 0xF, false)); } while (0)
__device__ __forceinline__ float row16_sum(float v) { WS_DPP_STEP(v, 0xB1); WS_DPP_STEP(v, 0x4E); WS_DPP_STEP(v, 0x141); WS_DPP_STEP(v, 0x140); return v; }
__device__ __forceinline__ float wave_sum(float v) {
    v = row16_sum(v);
    { auto rr = __builtin_amdgcn_permlane16_swap(__float_as_uint(v), __float_as_uint(v), false, false); v = __uint_as_float(rr[0]) + __uint_as_float(rr[1]); }
    { auto rr = __builtin_amdgcn_permlane32_swap(__float_as_uint(v), __float_as_uint(v), false, false); v = __uint_as_float(rr[0]) + __uint_as_float(rr[1]); }
    return v;
}
__device__ __forceinline__ float rsq(float x) { return __builtin_amdgcn_rsqf(x); }
#define XB_TMO      128
#define XB_XCNT(j)  (256  + 64 * (j))
#define XB_XSUB(j)  (1280 + 64 * (j))
#define XB_XGEN(j)  (2304 + 64 * (j))
#define XB_TOP      3328
#define XB_TOPGEN   3392
#define XCD_BAR_WORDS 3456
#define XB_SPIN_CAP (1u << 18)

__device__ __forceinline__ unsigned xb_ld(unsigned* p)              { return __hip_atomic_load(p, __ATOMIC_RELAXED, __HIP_MEMORY_SCOPE_AGENT); }
__device__ __forceinline__ unsigned xb_add(unsigned* p, unsigned v) { return __hip_atomic_fetch_add(p, v, __ATOMIC_RELAXED, __HIP_MEMORY_SCOPE_AGENT); }
__device__ __forceinline__ unsigned xb_xcc_id() { return (unsigned)__builtin_amdgcn_s_getreg((3 << 11) | 20) & 0xFu; }
#define XB_SPIN(cond, bar) do { unsigned _sp = 0; while (cond) { __builtin_amdgcn_s_sleep(1); \
    if ((++_sp & 255u) == 0u) { if (xb_ld(&(bar)[XB_TMO])) break; if (_sp > XB_SPIN_CAP) { atomicAdd(&(bar)[XB_TMO], 1u); break; } } } } while (0)

struct XcdBarrier {
    unsigned* bar; unsigned x;
    volatile LAS unsigned* st;
};

__device__ __forceinline__ XcdBarrier xcd_barrier_post(unsigned* bar, volatile LAS unsigned* st) {
    XcdBarrier b; b.bar = bar; b.x = xb_xcc_id(); b.st = st;
    if (threadIdx.x == 0) (void)xb_add(&bar[XB_XCNT(b.x)], 1u);
    return b;
}
__device__ __forceinline__ void xcd_barrier_complete(unsigned* bar, unsigned x, unsigned& nloc, unsigned& nx) {
    const unsigned G = gridDim.x * gridDim.y * gridDim.z;
    unsigned sum, cnt, mine, sp = 0u;
    for (;;) {
        sum = 0u; cnt = 0u; mine = 0u;
#pragma unroll
        for (unsigned j = 0; j < 16; ++j) { const unsigned c = xb_ld(&bar[XB_XCNT(j)]); sum += c; cnt += (c > 0u) ? 1u : 0u; mine = (j == x) ? c : mine; }
        if (sum == G) break;
        __builtin_amdgcn_s_sleep(1);
        if ((++sp & 255u) == 0u) { if (xb_ld(&bar[XB_TMO])) break; if (sp > XB_SPIN_CAP) { atomicAdd(&bar[XB_TMO], 1u); break; } }
    }
    nloc = mine > 0u ? mine : 1u; nx = cnt > 0u ? cnt : 1u;
}

__device__ __forceinline__ void xcd_barrier(const XcdBarrier& b) {
    asm volatile("s_waitcnt vmcnt(0)" ::: "memory");
    __syncthreads();
    if (threadIdx.x == 0) {
        unsigned* bar = b.bar;
        __builtin_amdgcn_s_waitcnt(0);
        unsigned nloc = b.st[0], nx = b.st[1];
        if (nloc == 0u) { xcd_barrier_complete(bar, b.x, nloc, nx); b.st[0] = nloc; b.st[1] = nx; }
        const unsigned old = xb_add(&bar[XB_XSUB(b.x)], 1u);
        const unsigned gen = old / nloc;
        if (old + 1u == (gen + 1u) * nloc) {
            __builtin_amdgcn_fence(__ATOMIC_RELEASE, "agent");
            asm volatile("s_waitcnt vmcnt(0)" ::: "memory");
            const unsigned og = xb_add(&bar[XB_TOP], 1u);
            const unsigned tg = og / nx;
            if (og + 1u == (tg + 1u) * nx) xb_add(&bar[XB_TOPGEN], 1u);
            else XB_SPIN(xb_ld(&bar[XB_TOPGEN]) == tg, bar);
            __builtin_amdgcn_fence(__ATOMIC_ACQUIRE, "agent");
            xb_add(&bar[XB_XGEN(b.x)], 1u);
            asm volatile("s_waitcnt vmcnt(0)" ::: "memory");
        } else {
            XB_SPIN(xb_ld(&bar[XB_XGEN(b.x)]) == gen, bar);
            __builtin_amdgcn_fence(__ATOMIC_ACQUIRE, "agent");
            asm volatile("s_waitcnt vmcnt(0)" ::: "memory");
        }
    }
    __syncthreads();
}

struct Args { const float* in[26]; float* out; unsigned char* ws; int ph_lo, ph_hi; };
enum { I_X = 0, I_MIXN, I_WIN, I_RPB, I_QNA, I_KNA, I_QNB, I_KNB, I_CQN, I_CKVN, I_WUQ, I_WUKV, I_QNC, I_KNC, I_ONA, I_ONB, I_ONC, I_WOUT, I_FFNN, I_WG, I_WU, I_WDN, I_ROUTER, I_WEG, I_WEU, I_WED };
struct Frame {
    LAS unsigned char* lds; unsigned char* ws; unsigned* ctl;
    int wave, G, bid, gw, ngw;
};

__device__ __forceinline__ void transpose_item(const float* __restrict__ W, int K, int N, bf16* __restrict__ WT, int row_off, int mode, LAS float* scr, int item, int lane) {
    (void)scr;
    const int nblk = N >> 5, kb = item / nblk, nb = item - kb * nblk, k0 = kb << 6, n0 = nb << 5; const int c = lane >> 3, q = lane & 7;
    const float* p = W + (size_t)(k0 + 8 * c) * N + n0 + 4 * q;
    f32x4 v[8];
#pragma unroll
    for (int i = 0; i < 8; ++i) v[i] = *(const f32x4*)(p + (size_t)i * N);
    const int drow0 = (mode == 0) ? (row_off + n0) : (row_off + (n0 >> 7) * 256 + (mode - 1) * 128 + (n0 & 127));
    bf16* d = WT + (size_t)(drow0 + 4 * q) * K + k0 + 8 * c;
#pragma unroll
    for (int j = 0; j < 4; ++j) { v4u o; o.x = pk2(v[0][j], v[1][j]); o.y = pk2(v[2][j], v[3][j]); o.z = pk2(v[4][j], v[5][j]); o.w = pk2(v[6][j], v[7][j]); *(v4u*)(d + (size_t)j * K) = o; }
}

__device__ __forceinline__ unsigned pk4_fp8(float a, float b, float c, float d) { unsigned w = 0u; w = __builtin_amdgcn_cvt_pk_fp8_f32(a, b, w, false); w = __builtin_amdgcn_cvt_pk_fp8_f32(c, d, w, true); return w; }
__device__ __forceinline__ void transpose_item_f8(const float* __restrict__ W, int K, int N, unsigned char* __restrict__ WT, int row_off, int mode, float wsc, LAS float* scr, int item, int lane) {
    (void)scr;
    const int nblk = N >> 5, kb = item / nblk, nb = item - kb * nblk, k0 = kb << 7, n0 = nb << 5; const int c = lane >> 3, q = lane & 7;
    const float* p = W + (size_t)(k0 + 16 * c) * N + n0 + 4 * q;
    f32x4 v[16];
#pragma unroll
    for (int i = 0; i < 16; ++i) v[i] = *(const f32x4*)(p + (size_t)i * N);
    const int drow0 = (mode == 0) ? (row_off + n0) : (row_off + (n0 >> 7) * 256 + (mode - 1) * 128 + (n0 & 127));
    unsigned char* d = WT + (size_t)(drow0 + 4 * q) * K + k0 + 16 * c;
#pragma unroll
    for (int j = 0; j < 4; ++j) {
        v4u o; o.x = pk4_fp8(v[0][j] * wsc, v[1][j] * wsc, v[2][j] * wsc, v[3][j] * wsc); o.y = pk4_fp8(v[4][j] * wsc, v[5][j] * wsc, v[6][j] * wsc, v[7][j] * wsc);
        o.z = pk4_fp8(v[8][j] * wsc, v[9][j] * wsc, v[10][j] * wsc, v[11][j] * wsc); o.w = pk4_fp8(v[12][j] * wsc, v[13][j] * wsc, v[14][j] * wsc, v[15][j] * wsc);
        *(v4u*)(d + (size_t)j * K) = o; }
}

template <bool SRCB>
__device__ __forceinline__ void load_row32(const void* __restrict__ row, int lane, float (&v)[4][8]) {
    if constexpr (SRCB) { const v4u* p = (const v4u*)row + lane;
#pragma unroll
        for (int j = 0; j < 4; ++j) { const v4u w = p[64 * j]; v[j][0] = bf_lo(w.x); v[j][1] = bf_hi(w.x); v[j][2] = bf_lo(w.y); v[j][3] = bf_hi(w.y); v[j][4] = bf_lo(w.z); v[j][5] = bf_hi(w.z); v[j][6] = bf_lo(w.w); v[j][7] = bf_hi(w.w); }
    } else { const f32x4* p = (const f32x4*)row + 2 * lane;
#pragma unroll
        for (int j = 0; j < 4; ++j) { const f32x4 a = p[128 * j], b = p[128 * j + 1]; v[j][0] = a[0]; v[j][1] = a[1]; v[j][2] = a[2]; v[j][3] = a[3]; v[j][4] = b[0]; v[j][5] = b[1]; v[j][6] = b[2]; v[j][7] = b[3]; }
    }
}
__device__ __forceinline__ void load_gain32(const float* __restrict__ gain, int lane, float osc, float (&g)[4][8]) {
    const f32x4* p = (const f32x4*)gain + 2 * lane;
#pragma unroll
    for (int j = 0; j < 4; ++j) { const f32x4 a = p[128 * j], b = p[128 * j + 1]; g[j][0] = a[0] * osc; g[j][1] = a[1] * osc; g[j][2] = a[2] * osc; g[j][3] = a[3] * osc; g[j][4] = b[0] * osc; g[j][5] = b[1] * osc; g[j][6] = b[2] * osc; g[j][7] = b[3] * osc; }
}
template <bool F8OUT, bool SRCB>
__device__ __forceinline__ void phase_rmsnorm(const Frame& F, const void* __restrict__ src, const float* __restrict__ gain, void* __restrict__ dstv, float osc) {
    int tid_ = threadIdx.x; asm volatile("" : "+v"(tid_)); const int tid = tid_, lane = tid & 63; (void)tid; (void)lane;
    float g[4][8]; load_gain32(gain, lane, osc, g);
    for (int m = F.gw; m < NTOK; m += F.ngw) {
        float v[4][8]; load_row32<SRCB>((const unsigned char*)src + (size_t)m * DM * (SRCB ? 2 : 4), lane, v); float s = 0.f;
#pragma unroll
        for (int j = 0; j < 4; ++j)
#pragma unroll
            for (int i = 0; i < 8; ++i) s += v[j][i] * v[j][i];
        const float rstd = rsq(wave_sum(s) * (1.f / DM) + EPS);
        if constexpr (F8OUT) { v2u* o8 = (v2u*)((unsigned char*)dstv + (size_t)m * DM) + lane;
#pragma unroll
            for (int j = 0; j < 4; ++j) { v2u w; w.x = pk4_fp8(v[j][0] * rstd * g[j][0], v[j][1] * rstd * g[j][1], v[j][2] * rstd * g[j][2], v[j][3] * rstd * g[j][3]);
                w.y = pk4_fp8(v[j][4] * rstd * g[j][4], v[j][5] * rstd * g[j][5], v[j][6] * rstd * g[j][6], v[j][7] * rstd * g[j][7]); o8[64 * j] = w; }
        } else { v4u* o16 = (v4u*)((bf16*)dstv + (size_t)m * DM) + lane;
#pragma unroll
            for (int j = 0; j < 4; ++j) { v4u w; w.x = pk2(v[j][0] * rstd * g[j][0], v[j][1] * rstd * g[j][1]); w.y = pk2(v[j][2] * rstd * g[j][2], v[j][3] * rstd * g[j][3]);
                w.z = pk2(v[j][4] * rstd * g[j][4], v[j][5] * rstd * g[j][5]); w.w = pk2(v[j][6] * rstd * g[j][6], v[j][7] * rstd * g[j][7]); o16[64 * j] = w; } }
    }
}

__device__ __forceinline__ float rope_apply(float v, float c, float s, float sgn) {
    auto rr = __builtin_amdgcn_permlane16_swap(__float_as_uint(v), __float_as_uint(v), false, false);
    const float p = __uint_as_float(sgn > 0.f ? rr[0] : rr[1]); return v * c + sgn * p * s; }
__device__ __forceinline__ void sincos_rev(float ang, float& s, float& c) { const float r = ang * 0.15915494309189535f; const float f = r - floorf(r); s = __builtin_amdgcn_sinf(f); c = __builtin_amdgcn_cosf(f); }

__device__ __forceinline__ void phase_postproj(const Frame& F, const Args& a, int l) {
    int tid_ = threadIdx.x; asm volatile("" : "+v"(tid_)); const int tid = tid_, lane = tid & 63; (void)tid; (void)lane;
    const bf16* PROJ = (const bf16*)(F.ws + WS_PROJ);
    bf16* QA = (bf16*)(F.ws + WS_QA); bf16* KA = (bf16*)(F.ws + WS_KA); bf16* QB = (bf16*)(F.ws + WS_QB); bf16* KB = (bf16*)(F.ws + WS_KB);
    bf16* CQN = (bf16*)(F.ws + WS_CQN); bf16* CKVN = (bf16*)(F.ws + WS_CKVN); bf16* KPE = (bf16*)(F.ws + WS_KPE);
    const f32x2 gqa = ((const f32x2*)(a.in[I_QNA] + l * 128))[lane], gka = ((const f32x2*)(a.in[I_KNA] + l * 128))[lane];
    const f32x2 gqb = ((const f32x2*)(a.in[I_QNB] + l * 128))[lane], gkb = ((const f32x2*)(a.in[I_KNB] + l * 128))[lane];
    const f32x4 gcq0 = ((const f32x4*)(a.in[I_CQN] + l * 512))[2 * lane], gcq1 = ((const f32x4*)(a.in[I_CQN] + l * 512))[2 * lane + 1];
    const f32x4 gckv = ((const f32x4*)(a.in[I_CKVN] + l * 256))[lane];
    const float gkpe = a.in[I_KNC][l * 192 + 128 + lane];
    constexpr float LOG2T = 13.287712379549449f;
    const int q = lane & 15;
    const float f128a = __builtin_amdgcn_exp2f(-(float)(2 * q) * (LOG2T / 32.f)), f128b = __builtin_amdgcn_exp2f(-(float)(2 * q + 1) * (LOG2T / 32.f));
    const float f64 = __builtin_amdgcn_exp2f(-(float)q * (LOG2T / 16.f));
    const float sgn = (lane & 16) ? 1.f : -1.f;
    for (int t = F.gw; t < NTOK; t += F.ngw) {
        const int pos = t & (SEQ - 1); const float p = (float)((lane & 32) ? (pos & 63) : (pos >> 6));
        float s0, c0, s1, c1, s2, c2; sincos_rev(p * f128a, s0, c0); sincos_rev(p * f128b, s1, c1); sincos_rev(p * f64, s2, c2);
        const bf16* pr = PROJ + (size_t)t * DINP;
        unsigned hv[18];
#pragma unroll
        for (int i = 0; i < 8; ++i) hv[i] = ((const unsigned*)(pr + i * 128))[lane];
#pragma unroll
        for (int i = 8; i < 18; ++i) hv[i] = ((const unsigned*)(pr + PC_QB + (i - 8) * 128))[lane];
        const v4u cqv = ((const v4u*)(pr + PC_CQ))[lane]; const v2u ckvv = ((const v2u*)(pr + PC_CKV))[lane]; const unsigned kpev = (unsigned)pr[PC_KPE + lane];
#pragma unroll
        for (int i = 0; i < 18; ++i) {
            float v0 = bf_lo(hv[i]), v1 = bf_hi(hv[i]);
            const float rstd = rsq(wave_sum(v0 * v0 + v1 * v1) * (1.f / 128.f) + EPS);
            const f32x2 g = (i < 4) ? gqa : (i < 8) ? gka : (i < 16) ? gqb : gkb;
            v0 = v0 * rstd * g[0]; v1 = v1 * rstd * g[1];
            if (i >= 8) { v0 = rope_apply(v0, c0, s0, sgn); v1 = rope_apply(v1, c1, s1, sgn); }
            bf16* dst = (i < 4) ? (QA + (size_t)t * 512 + i * 128) : (i < 8) ? (KA + (size_t)t * 512 + (i - 4) * 128) : (i < 16) ? (QB + (size_t)t * 1024 + (i - 8) * 128) : (KB + (size_t)t * 256 + (i - 16) * 128);
            ((unsigned*)dst)[lane] = pk2(v0, v1);
        }
        {
            float x[8] = {bf_lo(cqv.x), bf_hi(cqv.x), bf_lo(cqv.y), bf_hi(cqv.y), bf_lo(cqv.z), bf_hi(cqv.z), bf_lo(cqv.w), bf_hi(cqv.w)}; float s = 0.f;
#pragma unroll
            for (int i = 0; i < 8; ++i) s += x[i] * x[i];
            const float rstd = rsq(wave_sum(s) * (1.f / 512.f) + EPS);
            v4u w; w.x = pk2(x[0] * rstd * gcq0[0], x[1] * rstd * gcq0[1]); w.y = pk2(x[2] * rstd * gcq0[2], x[3] * rstd * gcq0[3]);
            w.z = pk2(x[4] * rstd * gcq1[0], x[5] * rstd * gcq1[1]); w.w = pk2(x[6] * rstd * gcq1[2], x[7] * rstd * gcq1[3]);
            ((v4u*)(CQN + (size_t)t * 512))[lane] = w;
        }
        {
            const float x0 = bf_lo(ckvv.x), x1 = bf_hi(ckvv.x), x2 = bf_lo(ckvv.y), x3 = bf_hi(ckvv.y);
            const float rstd = rsq(wave_sum((x0 * x0 + x1 * x1) + (x2 * x2 + x3 * x3)) * (1.f / 256.f) + EPS);
            v2u w; w.x = pk2(x0 * rstd * gckv[0], x1 * rstd * gckv[1]); w.y = pk2(x2 * rstd * gckv[2], x3 * rstd * gckv[3]);
            ((v2u*)(CKVN + (size_t)t * 256))[lane] = w;
        }
        {
            float x = bf_lo(kpev);
            const float rstd = rsq(wave_sum(x * x) * (1.f / 64.f) + EPS);
            x = rope_apply(x * rstd * gkpe, c2, s2, sgn);
            KPE[(size_t)t * 64 + lane] = (bf16)(pk2(x, 0.f) & 0xffffu);
        }
    }
}

__device__ __forceinline__ void phase_postmla(const Frame& F, const Args& a, int l) {
    int tid_ = threadIdx.x; asm volatile("" : "+v"(tid_)); const int tid = tid_, lane = tid & 63; (void)tid; (void)lane;
    const bf16* QCR = (const bf16*)(F.ws + WS_QCR); const bf16* KVR = (const bf16*)(F.ws + WS_KVR); const bf16* KPE = (const bf16*)(F.ws + WS_KPE);
    bf16* QC = (bf16*)(F.ws + WS_QC); bf16* KC = (bf16*)(F.ws + WS_KC);
    const f32x2 gqn = ((const f32x2*)(a.in[I_QNC] + l * 192))[lane], gkn = ((const f32x2*)(a.in[I_KNC] + l * 192))[lane];
    const float gqpe = a.in[I_QNC][l * 192 + 128 + lane];
    constexpr float LOG2T = 13.287712379549449f;
    const float f64 = __builtin_amdgcn_exp2f(-(float)(lane & 15) * (LOG2T / 16.f));
    const float sgn = (lane & 16) ? 1.f : -1.f;
    for (int t = F.gw; t < NTOK; t += F.ngw) {
        const int pos = t & (SEQ - 1); const float p = (float)((lane & 32) ? (pos & 63) : (pos >> 6));
        float s2, c2; sincos_rev(p * f64, s2, c2);
        const bf16* qr = QCR + (size_t)t * 768; const bf16* kr = KVR + (size_t)t * 1024;
        unsigned qn[4], kn[4]; unsigned qp[4];
#pragma unroll
        for (int h = 0; h < 4; ++h) { qn[h] = ((const unsigned*)(qr + h * 192))[lane]; qp[h] = (unsigned)qr[h * 192 + 128 + lane]; kn[h] = ((const unsigned*)(kr + h * 256))[lane]; }
        const bf16 kpe = KPE[(size_t)t * 64 + lane];
#pragma unroll
        for (int h = 0; h < 4; ++h) {
            { float v0 = bf_lo(qn[h]), v1 = bf_hi(qn[h]); const float rstd = rsq(wave_sum(v0 * v0 + v1 * v1) * (1.f / 128.f) + EPS);
              ((unsigned*)(QC + (size_t)t * 768 + h * 192))[lane] = pk2(v0 * rstd * gqn[0], v1 * rstd * gqn[1]); }
            { float x = bf_lo(qp[h]); const float rstd = rsq(wave_sum(x * x) * (1.f / 64.f) + EPS); x = rope_apply(x * rstd * gqpe, c2, s2, sgn);
              QC[(size_t)t * 768 + h * 192 + 128 + lane] = (bf16)(pk2(x, 0.f) & 0xffffu); }
            { float v0 = bf_lo(kn[h]), v1 = bf_hi(kn[h]); const float rstd = rsq(wave_sum(v0 * v0 + v1 * v1) * (1.f / 128.f) + EPS);
              ((unsigned*)(KC + (size_t)t * 768 + h * 192))[lane] = pk2(v0 * rstd * gkn[0], v1 * rstd * gkn[1]); }
            KC[(size_t)t * 768 + h * 192 + 128 + lane] = kpe;
        }
    }
}

__device__ __forceinline__ void phase_groupnorm(const Frame& F, const Args& a, int l) {
    int tid_ = threadIdx.x; asm volatile("" : "+v"(tid_)); const int tid = tid_, lane = tid & 63; (void)tid; (void)lane;
    const bf16* O = (const bf16*)(F.ws + WS_O); bf16* ON = (bf16*)(F.ws + WS_ON);
    f32x4 g[4][2];
    { const f32x4* ga = (const f32x4*)(a.in[I_ONA] + l * 512); const f32x4* gb = (const f32x4*)(a.in[I_ONB] + l * 1024); const f32x4* gc = (const f32x4*)(a.in[I_ONC] + l * 512);
      g[0][0] = ga[2 * lane]; g[0][1] = ga[2 * lane + 1]; g[1][0] = gb[2 * lane]; g[1][1] = gb[2 * lane + 1]; g[2][0] = gb[128 + 2 * lane]; g[2][1] = gb[128 + 2 * lane + 1]; g[3][0] = gc[2 * lane]; g[3][1] = gc[2 * lane + 1]; }
    for (int t = F.gw; t < NTOK; t += F.ngw) {
        const v4u* orow = (const v4u*)(O + (size_t)t * DM) + lane; float x[4][8]; float ss[4];
#pragma unroll
        for (int j = 0; j < 4; ++j) { const v4u w = orow[64 * j]; x[j][0] = bf_lo(w.x); x[j][1] = bf_hi(w.x); x[j][2] = bf_lo(w.y); x[j][3] = bf_hi(w.y); x[j][4] = bf_lo(w.z); x[j][5] = bf_hi(w.z); x[j][6] = bf_lo(w.w); x[j][7] = bf_hi(w.w);
            float s = 0.f;
#pragma unroll
            for (int i = 0; i < 8; ++i) s += x[j][i] * x[j][i];
            ss[j] = s; }
        const float ra = rsq(wave_sum(ss[0]) * (1.f / 512.f) + EPS), rb = rsq(wave_sum(ss[1] + ss[2]) * (1.f / 1024.f) + EPS), rc = rsq(wave_sum(ss[3]) * (1.f / 512.f) + EPS);
        if constexpr (F8WO) { v2u* nrow8 = (v2u*)((unsigned char*)ON + (size_t)t * DM) + lane;
#pragma unroll
            for (int j = 0; j < 4; ++j) { const float r = ((j == 0) ? ra : (j == 3) ? rc : rb) * SC_H; v2u w;
                w.x = pk4_fp8(x[j][0] * r * g[j][0][0], x[j][1] * r * g[j][0][1], x[j][2] * r * g[j][0][2], x[j][3] * r * g[j][0][3]);
                w.y = pk4_fp8(x[j][4] * r * g[j][1][0], x[j][5] * r * g[j][1][1], x[j][6] * r * g[j][1][2], x[j][7] * r * g[j][1][3]); nrow8[64 * j] = w; }
            continue; }
        v4u* nrow = (v4u*)(ON + (size_t)t * DM) + lane;
#pragma unroll
        for (int j = 0; j < 4; ++j) { const float r = (j == 0) ? ra : (j == 3) ? rc : rb; v4u w;
            w.x = pk2(x[j][0] * r * g[j][0][0], x[j][1] * r * g[j][0][1]); w.y = pk2(x[j][2] * r * g[j][0][2], x[j][3] * r * g[j][0][3]);
            w.z = pk2(x[j][4] * r * g[j][1][0], x[j][5] * r * g[j][1][1]); w.w = pk2(x[j][6] * r * g[j][1][2], x[j][7] * r * g[j][1][3]); nrow[64 * j] = w; }
    }
}

constexpr int ROUTER_LDS = 0;
constexpr int MOE_LDS_CNT = 65536;
constexpr int MOE_LDS_REC = 65536 + 64;
template <bool F8OUT, bool SRCB>
__device__ __forceinline__ void phase_ffnnorm_route(const Frame& F, const Args& a, const void* __restrict__ src, const float* __restrict__ gain, void* __restrict__ dstv, float osc) {
    int tid_ = threadIdx.x; asm volatile("" : "+v"(tid_)); const int tid = tid_, lane = tid & 63; (void)tid; (void)lane;
    LAS float* rt = (LAS float*)(F.lds + ROUTER_LDS); LAS unsigned* lcnt = (LAS unsigned*)(F.lds + MOE_LDS_CNT); LAS int* rec = (LAS int*)(F.lds + MOE_LDS_REC);
    const float* router = a.in[I_ROUTER];
    for (int t = tid; t < DM * NE / 4; t += NWAVES * 64) { const int k = t >> 1, half = t & 1; ((LAS f32x4*)rt)[half * 2048 + (((k >> 9) * 8 + (k & 7)) * 64 + ((k >> 3) & 63))] = ((const f32x4*)router)[t]; }
    if (tid < 16) lcnt[tid] = 0u;
    __syncthreads();
    const int t0 = (int)(((long)F.bid * NTOK) / F.G), t1 = (int)(((long)(F.bid + 1) * NTOK) / F.G);
    float g[4][8]; load_gain32(gain, lane, 1.f, g);
    for (int m = t0 + F.wave; m < t1; m += NWAVES) {
        float v[4][8]; load_row32<SRCB>((const unsigned char*)src + (size_t)m * DM * (SRCB ? 2 : 4), lane, v); float s = 0.f;
#pragma unroll
        for (int j = 0; j < 4; ++j)
#pragma unroll
            for (int i = 0; i < 8; ++i) s += v[j][i] * v[j][i];
        const float rstd = rsq(wave_sum(s) * (1.f / DM) + EPS);
        v4u* o16 = (v4u*)((bf16*)dstv + (size_t)m * DM) + lane; v2u* o8 = (v2u*)((unsigned char*)dstv + (size_t)m * DM) + lane;
        float lg[8] = {0.f, 0.f, 0.f, 0.f, 0.f, 0.f, 0.f, 0.f};
#pragma unroll
        for (int j = 0; j < 4; ++j) {
            float h[8];
#pragma unroll
            for (int i = 0; i < 8; ++i) h[i] = v[j][i] * rstd * g[j][i];
            if constexpr (F8OUT) { v2u w; w.x = pk4_fp8(h[0] * osc, h[1] * osc, h[2] * osc, h[3] * osc); w.y = pk4_fp8(h[4] * osc, h[5] * osc, h[6] * osc, h[7] * osc); o8[64 * j] = w; }
            else { v4u w; w.x = pk2(h[0], h[1]); w.y = pk2(h[2], h[3]); w.z = pk2(h[4], h[5]); w.w = pk2(h[6], h[7]); o16[64 * j] = w; }
#pragma unroll
            for (int i = 0; i < 8; ++i) { const f32x4 r0 = ((const LAS f32x4*)rt)[(j * 8 + i) * 64 + lane], r1 = ((const LAS f32x4*)rt)[2048 + (j * 8 + i) * 64 + lane];
                lg[0] += h[i] * r0[0]; lg[1] += h[i] * r0[1]; lg[2] += h[i] * r0[2]; lg[3] += h[i] * r0[3]; lg[4] += h[i] * r1[0]; lg[5] += h[i] * r1[1]; lg[6] += h[i] * r1[2]; lg[7] += h[i] * r1[3]; }
        }
#pragma unroll
        for (int e = 0; e < 8; ++e) lg[e] = wave_sum(lg[e]);
        int e0 = 0; float v0 = lg[0];
#pragma unroll
        for (int e = 1; e < 8; ++e) if (lg[e] > v0) { v0 = lg[e]; e0 = e; }
        int e1 = -1; float v1 = -3.0e38f;
#pragma unroll
        for (int e = 0; e < 8; ++e) if (e != e0 && lg[e] > v1) { v1 = lg[e]; e1 = e; }
        const float ex = __expf(v1 - v0), w0 = 1.f / (1.f + ex), w1 = ex * w0;
        if (lane == 0) { const int li = m - t0; const unsigned p0 = atomicAdd((unsigned*)&lcnt[e0], 1u), p1 = atomicAdd((unsigned*)&lcnt[e1], 1u);
            rec[li * 6 + 0] = e0; rec[li * 6 + 1] = e1; rec[li * 6 + 2] = (int)p0; rec[li * 6 + 3] = (int)p1; ((LAS float*)rec)[li * 6 + 4] = w0; ((LAS float*)rec)[li * 6 + 5] = w1; }
    }
    __syncthreads();
    if (tid < 8) lcnt[8 + tid] = __hip_atomic_fetch_add(F.ctl + CW_CNT + tid, lcnt[tid], __ATOMIC_RELAXED, __HIP_MEMORY_SCOPE_AGENT);
    __syncthreads();
    int* toke = (int*)(F.ws + WS_TOKE); int* tokp = (int*)(F.ws + WS_TOKP); float* tokw = (float*)(F.ws + WS_TOKW);
    for (int i = tid; i < (t1 - t0) * 2; i += NWAVES * 64) { const int li = i >> 1, k = i & 1, e = rec[li * 6 + k];
        toke[(size_t)(t0 + li) * 2 + k] = e; tokp[(size_t)(t0 + li) * 2 + k] = rec[li * 6 + 2 + k] + (int)lcnt[8 + e]; tokw[(size_t)(t0 + li) * 2 + k] = ((LAS float*)rec)[li * 6 + 4 + k]; }
    __syncthreads();
}
__device__ __forceinline__ void moe_tiles(const Frame& F, int (&tb)[9], int (&cnt)[8]) {
    int acc = 0;
#pragma unroll
    for (int e = 0; e < 8; ++e) { cnt[e] = (int)__hip_atomic_load(F.ctl + CW_CNT + e, __ATOMIC_RELAXED, __HIP_MEMORY_SCOPE_AGENT); tb[e] = acc; acc += (cnt[e] + 255) >> 8; }
    tb[8] = acc;
}
template <bool F8ROWS>
__device__ __forceinline__ void phase_gather(const Frame& F) {
    int tid_ = threadIdx.x; asm volatile("" : "+v"(tid_)); const int tid = tid_, lane = tid & 63; (void)tid; (void)lane;
    int tb[9], cnt[8]; moe_tiles(F, tb, cnt);
    constexpr int RBYTES = F8ROWS ? DM : 2 * DM, NCH = RBYTES / 1024;
    const unsigned char* H = (const unsigned char*)(F.ws + WS_H); unsigned char* HG = (unsigned char*)(F.ws + WS_HG); float* rg = (float*)(F.ws + WS_RGATE);
    const int* toke = (const int*)(F.ws + WS_TOKE); int* tokp = (int*)(F.ws + WS_TOKP); const float* tokw = (const float*)(F.ws + WS_TOKW);
    for (int t = F.gw; t < NTOK; t += F.ngw) {
        const v4u* hr = (const v4u*)(H + (size_t)t * RBYTES) + lane; v4u v[NCH];
#pragma unroll
        for (int j = 0; j < NCH; ++j) v[j] = hr[64 * j];
#pragma unroll
        for (int k = 0; k < 2; ++k) { const int e = toke[(size_t)t * 2 + k], p = tokp[(size_t)t * 2 + k]; int base = 0;
#pragma unroll
            for (int q = 0; q < 8; ++q) base = (q == e) ? tb[q] : base;
            const int slot = base * 256 + p; v4u* dr = (v4u*)(HG + (size_t)slot * RBYTES) + lane;
#pragma unroll
            for (int j = 0; j < NCH; ++j) dr[64 * j] = v[j];
            if (lane == 0) { rg[slot] = tokw[(size_t)t * 2 + k]; tokp[(size_t)t * 2 + k] = slot; } }
    }
#pragma unroll
    for (int e = 0; e < 8; ++e) { const int r0 = tb[e] * 256 + cnt[e], r1 = tb[e + 1] * 256;
        for (int r = r0 + F.gw; r < r1; r += F.ngw) { v4u* dr = (v4u*)(HG + (size_t)r * RBYTES) + lane; const v4u z = {0u, 0u, 0u, 0u};
#pragma unroll
            for (int j = 0; j < NCH; ++j) dr[64 * j] = z;
            if (lane == 0) rg[r] = 0.f; } }
}
__device__ __forceinline__ void phase_tailsum(const Frame& F) {
    int tid_ = threadIdx.x; asm volatile("" : "+v"(tid_)); const int tid = tid_;
    int tb[9], cnt[8]; moe_tiles(F, tb, cnt);
    const int nun = tb[8] * (DM / 256), nfull = (F.G == 256 && F8M) ? (nun / 256) * 256 : nun; if (nfull >= nun) return;
    pg8::StaticOrder S; S.init(tb[8] * 256, DM, F.G, 0);
    const float* P = (const float*)(F.ws + WS_PART); const float* rg = (const float*)(F.ws + WS_RGATE); bf16* Y = (bf16*)(F.ws + WS_Y);
    const float isc = F8M ? 1.f / (SC_ACT * SC_W) : 1.f;
    const int nsp = 4;
    const int nchunk = (nun - nfull) * 8192;
    for (int i = F.bid * NWAVES * 64 + tid; i < nchunk; i += F.G * NWAVES * 64) {
        const int j = i >> 13, r = (i >> 5) & 255, cc = (i & 31) * 8, ent = nfull + j;
        pg8::Unit u; S.c = ent % F.G; S.next(ent / F.G, u);
        const float* p = P + (size_t)(nsp * j) * 65536 + (size_t)r * 256 + cc; f32x4 a = {0.f, 0.f, 0.f, 0.f}, b = {0.f, 0.f, 0.f, 0.f};
        for (int s = 0; s < nsp; ++s) { a += *(const f32x4*)(p + (size_t)s * 65536); b += *(const f32x4*)(p + (size_t)s * 65536 + 4); }
        const int row = u.pm * 256 + r; const float sc = rg[row] * isc;
        v4u w; w.x = pk2(a[0] * sc, a[1] * sc); w.y = pk2(a[2] * sc, a[3] * sc); w.z = pk2(b[0] * sc, b[1] * sc); w.w = pk2(b[2] * sc, b[3] * sc);
        *(v4u*)(Y + (size_t)row * DM + u.pn * 256 + cc) = w;
    }
}
template <bool XBF>
__device__ __forceinline__ void phase_combine(const Frame& F, const void* __restrict__ xsrc, float* __restrict__ out) {
    int tid_ = threadIdx.x; asm volatile("" : "+v"(tid_)); const int tid = tid_, lane = tid & 63; (void)tid; (void)lane;
    const bf16* Y = (const bf16*)(F.ws + WS_Y); const int* tokp = (const int*)(F.ws + WS_TOKP);
    for (int t = F.gw; t < NTOK; t += F.ngw) {
        const int s0 = tokp[(size_t)t * 2], s1 = tokp[(size_t)t * 2 + 1];
        const v4u* y0 = (const v4u*)(Y + (size_t)s0 * DM) + lane; const v4u* y1 = (const v4u*)(Y + (size_t)s1 * DM) + lane;
        float x[4][8]; load_row32<XBF>((const unsigned char*)xsrc + (size_t)t * DM * (XBF ? 2 : 4), lane, x);
        f32x4* xr = (f32x4*)(out + (size_t)t * DM) + 2 * lane;
#pragma unroll
        for (int j = 0; j < 4; ++j) { const v4u p = y0[64 * j], q = y1[64 * j]; f32x4 xa, xb;
            xa[0] = x[j][0] + bf_lo(p.x) + bf_lo(q.x); xa[1] = x[j][1] + bf_hi(p.x) + bf_hi(q.x); xa[2] = x[j][2] + bf_lo(p.y) + bf_lo(q.y); xa[3] = x[j][3] + bf_hi(p.y) + bf_hi(q.y);
            xb[0] = x[j][4] + bf_lo(p.z) + bf_lo(q.z); xb[1] = x[j][5] + bf_hi(p.z) + bf_hi(q.z); xb[2] = x[j][6] + bf_lo(p.w) + bf_lo(q.w); xb[3] = x[j][7] + bf_hi(p.w) + bf_hi(q.w);
            xr[128 * j] = xa; xr[128 * j + 1] = xb; }
    }
}

__device__ __forceinline__ void convert_experts(const Frame& F, const Args& args, int e_lo, int e_hi, int w, int nw);
__device__ __forceinline__ void phase_attention(const Frame& F, const Args& a, int l) {
    int tid_ = threadIdx.x; asm volatile("" : "+v"(tid_)); const int tid = tid_, lane = tid & 63; (void)tid; (void)lane;
    const bf16* PROJ = (const bf16*)(F.ws + WS_PROJ);
    const bf16* QA = (const bf16*)(F.ws + WS_QA); const bf16* KA = (const bf16*)(F.ws + WS_KA); const bf16* QB = (const bf16*)(F.ws + WS_QB); const bf16* KB = (const bf16*)(F.ws + WS_KB);
    const bf16* KVR = (const bf16*)(F.ws + WS_KVR); const bf16* QC = (const bf16*)(F.ws + WS_QC); const bf16* KC = (const bf16*)(F.ws + WS_KC);
    bf16* O = (bf16*)(F.ws + WS_O);
    char* L = (char*)F.lds;
    const int cslot = (MOE_CVT_IN_ATTN == 1) ? ((F.bid >> 3) & 3) : -1; bool cvt_done = (MOE_CVT_IN_ATTN != 1);
#ifndef ATT_PP
#define ATT_PP 0
#endif
#ifndef ATT_STATIC
#define ATT_STATIC 0
#endif
#if ATT_STATIC
#define ATT_C3(q, k, v, o) att::attn_body3s<192, 768, 768, 1024, 2048, SEQ / 64, 1, 8>(q, k, v, o, L)
#define ATT_B3(q, k, v, o) att::attn_body3s<128, 1024, 256, 4096, 2048, SEQ / 64, 2, 8>(q, k, v, o, L)
#else
#if ATT_PP & 1
#define ATT_C3(q, k, v, o) att::attn_body_pp<192, 768, 768, 1024, 2048, 0, 8>(q, k, v, o, SEQ / 64, L, 0, 0, nullptr)
#else
#define ATT_C3(q, k, v, o) att::attn_body3<192, 768, 768, 1024, 2048, 0, 1, 8>(q, k, v, o, SEQ / 64, L, 0, 0, nullptr)
#endif
#if ATT_PP & 2
#define ATT_B3(q, k, v, o) att::attn_body_pp<128, 1024, 256, 4096, 2048, 0, 8>(q, k, v, o, SEQ / 64, L, 0, 0, nullptr)
#else
#define ATT_B3(q, k, v, o) att::attn_body3<128, 1024, 256, 4096, 2048, 0, 2, 8>(q, k, v, o, SEQ / 64, L, 0, 0, nullptr)
#endif
#endif
#define ATT_CVT() do { __syncthreads(); convert_experts(F, a, 4 * l, 4 * l + 4, F.gw, F.ngw); __syncthreads(); cvt_done = true; } while (0)
    if (cslot == 0) ATT_CVT();
    if (PHON(16)) for (int Lu = F.bid; Lu < 256; Lu += F.G) {
        const int id = (Lu & 7) * 32 + (Lu >> 3), b = id >> 6, h = (id >> 4) & 3, qb = id & 15; const size_t tq = (size_t)b * SEQ + qb * 256, tk = (size_t)b * SEQ;
        #if ATT_RING3 & 1
        ATT_C3(QC + tq * 768 + h * 192, KC + tk * 768 + h * 192, KVR + tk * 1024 + h * 256 + 128, O + tq * DM + 1536 + h * 128);
#else
        att::attn_body<192, 768, 768, 1024, 2048, 0, 1, 8>(QC + tq * 768 + h * 192, KC + tk * 768 + h * 192, KVR + tk * 1024 + h * 256 + 128, O + tq * DM + 1536 + h * 128, SEQ / 64, L, 0, 0, nullptr);
#endif
    }
    if (cslot == 1) ATT_CVT();
    if (PHON(17)) for (int Lu = F.bid; Lu < 512; Lu += F.G) {
        if (cslot == 2 && !cvt_done && Lu != F.bid) ATT_CVT();
        const int id = (Lu & 7) * 64 + (Lu >> 3), b = id >> 7, kvh = (id >> 6) & 1, g = (id >> 4) & 3, qb = id & 15, h = kvh * 4 + g; const size_t tq = (size_t)b * SEQ + qb * 256, tk = (size_t)b * SEQ;
        #if ATT_RING3 & 2
        ATT_B3(QB + tq * 1024 + h * 128, KB + tk * 256 + kvh * 128, PROJ + tk * DINP + PC_VB + kvh * 128, O + tq * DM + 512 + h * 128);
#else
        att::attn_body<128, 1024, 256, 4096, 2048, 0, 2, 8>(QB + tq * 1024 + h * 128, KB + tk * 256 + kvh * 128, PROJ + tk * DINP + PC_VB + kvh * 128, O + tq * DM + 512 + h * 128, SEQ / 64, L, 0, 0, nullptr);
#endif
    }
    float* biasT = (float*)(L + 136 * 1024);
    if (!cvt_done && cslot == 3) ATT_CVT();
    if (PHON(18)) {
        LAS int* claim = (LAS int*)(F.lds + 160 * 1024 - 512);
        const int home = (int)(xb_xcc_id() & 7u);
        for (int li = 0; li < 8; ++li) {
            const int list = (home + li) & 7;
            for (;;) {
                __syncthreads();
                if (tid == 0) claim[0] = (int)__hip_atomic_fetch_add(F.ctl + CW_AQ + 64 * (8 * l + list), 1u, __ATOMIC_RELAXED, __HIP_MEMORY_SCOPE_AGENT);
                __syncthreads();
                const int idx = claim[0]; if (idx >= 32) break;
                const int id = list * 32 + idx, b = id >> 6, h = (id >> 4) & 3, rb = id & 15; const size_t tq = (size_t)b * SEQ + rb * 256;
                int lo = min(max(rb * 4 - 4, 0), 56), hi = min(max(rb * 4 + 3 - 4, 0), 56) + 8;
                if ((hi - lo) & 1) { if (hi < 64) ++hi; else --lo; }
                const float* rpb = a.in[I_RPB] + ((size_t)l * 4 + h) * 465;
                for (int i = tid; i < 15 * 128; i += NWAVES * 64) { const int bi = i >> 7, bj = (i & 127) - 48; biasT[i] = (bj >= 0 && bj < 31) ? rpb[bi * 31 + bj] * 11.313708498984761f : 0.f; }
                __syncthreads();
                const size_t tk = (size_t)b * SEQ + lo * 64;
                #if ATT_PP & 4
                att::attn_body_pp<128, 512, 512, 4096, 2048, 1, 4>(QA + tq * 512 + h * 128, KA + tk * 512 + h * 128, PROJ + tk * DINP + PC_VA + h * 128, O + tq * DM + h * 128, hi - lo, L, rb * 4, lo, biasT);
#else
                att::ATT_BODY_A<128, 512, 512, 4096, 2048, 1, 1, 4>(QA + tq * 512 + h * 128, KA + tk * 512 + h * 128, PROJ + tk * DINP + PC_VA + h * 128, O + tq * DM + h * 128, hi - lo, L, rb * 4, lo, biasT);
#endif
            }
        }
    }
    if (!cvt_done) ATT_CVT();
#undef ATT_CVT
}

constexpr int NPHASE = 25;

__device__ __forceinline__ void tr8_decode(const Args& args, unsigned char* ws, int e_lo, int gi, const float*& W, unsigned char*& WT, int& K, int& N, int& mode, int& item) {
    const int m = gi / 3584; item = gi - m * 3584; const int e = e_lo + m / 3, kind = m - (m / 3) * 3;
    if (kind == 2) { W = args.in[I_WED] + (size_t)e * DFE * DM; WT = ws + WS_WED + (size_t)e * DM * DFE; K = DFE; N = DM; mode = 0; }
    else { W = (kind == 0 ? args.in[I_WEG] : args.in[I_WEU]) + (size_t)e * DM * DFE; WT = ws + WS_WEGU + (size_t)e * 2 * DFE * DM; K = DM; N = DFE; mode = 1 + kind; }
}
__device__ __forceinline__ void tr8_load(const float* __restrict__ W, int N, int item, int lane, f32x4 (&v)[16]) {
    const int nblk = N >> 5, kb = item / nblk, nb = item - kb * nblk, k0 = kb << 7, n0 = nb << 5; const int c = lane >> 3, q = lane & 7;
    const float* p = W + (size_t)(k0 + 16 * c) * N + n0 + 4 * q;
#pragma unroll
    for (int i = 0; i < 16; ++i) v[i] = __builtin_nontemporal_load((const f32x4*)(p + (size_t)i * N));
}
__device__ __forceinline__ void tr8_store(unsigned char* __restrict__ WT, int K, int N, int mode, int item, int lane, float wsc, LAS float* scr, const f32x4 (&v)[16]) {
    (void)scr;
    const int nblk = N >> 5, kb = item / nblk, nb = item - kb * nblk, k0 = kb << 7, n0 = nb << 5; const int c = lane >> 3, q = lane & 7;
    const int drow0 = (mode == 0) ? n0 : ((n0 >> 7) * 256 + (mode - 1) * 128 + (n0 & 127));
    unsigned char* p = WT + (size_t)(drow0 + 4 * q) * K + k0 + 16 * c;
#pragma unroll
    for (int j = 0; j < 4; ++j) {
        v4u o; o.x = pk4_fp8(v[0][j] * wsc, v[1][j] * wsc, v[2][j] * wsc, v[3][j] * wsc); o.y = pk4_fp8(v[4][j] * wsc, v[5][j] * wsc, v[6][j] * wsc, v[7][j] * wsc);
        o.z = pk4_fp8(v[8][j] * wsc, v[9][j] * wsc, v[10][j] * wsc, v[11][j] * wsc); o.w = pk4_fp8(v[12][j] * wsc, v[13][j] * wsc, v[14][j] * wsc, v[15][j] * wsc);
        *(v4u*)(p + (size_t)j * K) = o; }
}
__device__ __forceinline__ void convert_experts(const Frame& F, const Args& args, int e_lo, int e_hi, int w, int nw) {
    int tid_ = threadIdx.x; asm volatile("" : "+v"(tid_)); const int lane = tid_ & 63;
    LAS float* scr = (LAS float*)(F.lds + F.wave * 18432);
    if constexpr (F8M) {
        const int total = (e_hi - e_lo) * 3 * 3584;
        f32x4 va[16], vb[16], vc[16]; const float* W; unsigned char* WT; int K, N, mode, item;
#define TR8_LD(buf, gx) do { if ((gx) < total) { tr8_decode(args, F.ws, e_lo, (gx), W, WT, K, N, mode, item); tr8_load(W, N, item, lane, buf); } } while (0)
#define TR8_ST(buf, gx) do { tr8_decode(args, F.ws, e_lo, (gx), W, WT, K, N, mode, item); tr8_store(WT, K, N, mode, item, lane, SC_W, scr, buf); } while (0)
        int gi = w;
        TR8_LD(va, gi); TR8_LD(vb, gi + nw);
        while (gi < total) {
            TR8_LD(vc, gi + 2 * nw); TR8_ST(va, gi); gi += nw; if (gi >= total) break;
            TR8_LD(va, gi + 2 * nw); TR8_ST(vb, gi); gi += nw; if (gi >= total) break;
            TR8_LD(vb, gi + 2 * nw); TR8_ST(vc, gi); gi += nw;
        }
#undef TR8_LD
#undef TR8_ST
    } else {
        int it = w;
#define TR_RUNB(Wp, Kk, Nn, Dp, ROFF, MODE) do { const int cnt_ = ((Kk) >> 6) * ((Nn) >> 5); while (it < cnt_) { transpose_item((Wp), (Kk), (Nn), (Dp), (ROFF), (MODE), scr, it, lane); it += nw; } it -= cnt_; } while (0)
        for (int e = e_lo; e < e_hi; ++e) {
            TR_RUNB(args.in[I_WEG] + (size_t)e * DM * DFE, DM, DFE, (bf16*)(F.ws + WS_WEGU) + (size_t)e * 2 * DFE * DM, 0, 1);
            TR_RUNB(args.in[I_WEU] + (size_t)e * DM * DFE, DM, DFE, (bf16*)(F.ws + WS_WEGU) + (size_t)e * 2 * DFE * DM, 0, 2);
            TR_RUNB(args.in[I_WED] + (size_t)e * DFE * DM, DFE, DM, (bf16*)(F.ws + WS_WED) + (size_t)e * DM * DFE, 0, 0);
        }
#undef TR_RUNB
    }
}
constexpr int CVT_TOTAL = NE * 3 * 3584;
constexpr int CVT_GU_ITEMS = NE * 2 * 3584;
__device__ __forceinline__ void cvt_queue_item(const Frame& F, const Args& args, int gi, int lane) {
    if (gi >= CVT_TOTAL) return;
    const float* W; unsigned char* WT; int K, N, mode, item;
    if (gi < CVT_GU_ITEMS) { const int m = gi / 3584, e = m >> 1, kind = m & 1; item = gi - m * 3584;
        W = (kind == 0 ? args.in[I_WEG] : args.in[I_WEU]) + (size_t)e * DM * DFE; WT = F.ws + WS_WEGU + (size_t)e * 2 * DFE * DM; K = DM; N = DFE; mode = 1 + kind; }
    else { const int r = gi - CVT_GU_ITEMS, e = r / 3584; item = r - e * 3584; W = args.in[I_WED] + (size_t)e * DFE * DM; WT = F.ws + WS_WED + (size_t)e * DM * DFE; K = DFE; N = DM; mode = 0; }
    f32x4 v[16]; tr8_load(W, N, item, lane, v); tr8_store(WT, K, N, mode, item, lane, SC_W, nullptr, v);
}
__device__ __forceinline__ void cvt_queue_decode(const Frame& F, const Args& args, int gi, const float*& W, unsigned char*& WT, int& K, int& N, int& mode, int& item) {
    if (gi < CVT_GU_ITEMS) { const int m = gi / 3584, e = m >> 1, kind = m & 1; item = gi - m * 3584;
        W = (kind == 0 ? args.in[I_WEG] : args.in[I_WEU]) + (size_t)e * DM * DFE; WT = F.ws + WS_WEGU + (size_t)e * 2 * DFE * DM; K = DM; N = DFE; mode = 1 + kind; }
    else { const int r = gi - CVT_GU_ITEMS, e = r / 3584; item = r - e * 3584; W = args.in[I_WED] + (size_t)e * DFE * DM; WT = F.ws + WS_WED + (size_t)e * DM * DFE; K = DFE; N = DM; mode = 0; }
}
__device__ __forceinline__ void cvt_queue_item2(const Frame& F, const Args& args, int g0, int g1, int lane) {
    if (g1 >= CVT_TOTAL) { cvt_queue_item(F, args, g0, lane); return; }
    const float* W0; unsigned char* WT0; int K0, N0, mode0, item0; const float* W1; unsigned char* WT1; int K1, N1, mode1, item1;
    cvt_queue_decode(F, args, g0, W0, WT0, K0, N0, mode0, item0); cvt_queue_decode(F, args, g1, W1, WT1, K1, N1, mode1, item1);
    f32x4 va[16], vb[16]; tr8_load(W0, N0, item0, lane, va); tr8_load(W1, N1, item1, lane, vb);
    tr8_store(WT0, K0, N0, mode0, item0, lane, SC_W, nullptr, va); tr8_store(WT1, K1, N1, mode1, item1, lane, SC_W, nullptr, vb);
}
__device__ __forceinline__ void xcd_barrier_w(const XcdBarrier& b, const Frame& F, const Args& args, volatile LAS unsigned* bx) {
    asm volatile("s_waitcnt vmcnt(0)" ::: "memory");
    __syncthreads();
    int tid_ = threadIdx.x; asm volatile("" : "+v"(tid_)); const int lane = tid_ & 63;
    if (threadIdx.x == 0) {
        unsigned* bar = b.bar;
        __builtin_amdgcn_s_waitcnt(0);
        unsigned nloc = b.st[0], nx = b.st[1];
        if (nloc == 0u) { xcd_barrier_complete(bar, b.x, nloc, nx); b.st[0] = nloc; b.st[1] = nx; }
        const unsigned old = xb_add(&bar[XB_XSUB(b.x)], 1u);
        const unsigned gen = old / nloc;
        if (old + 1u == (gen + 1u) * nloc) {
            __builtin_amdgcn_fence(__ATOMIC_RELEASE, "agent");
            asm volatile("s_waitcnt vmcnt(0)" ::: "memory");
            const unsigned og = xb_add(&bar[XB_TOP], 1u);
            const unsigned tg = og / nx;
            if (og + 1u == (tg + 1u) * nx) xb_add(&bar[XB_TOPGEN], 1u);
            else XB_SPIN(xb_ld(&bar[XB_TOPGEN]) == tg, bar);
            __builtin_amdgcn_fence(__ATOMIC_ACQUIRE, "agent");
            xb_add(&bar[XB_XGEN(b.x)], 1u);
            asm volatile("s_waitcnt vmcnt(0)" ::: "memory");
            bx[0] = 1u;
        } else { bx[0] = 0u; bx[2] = gen; }
    }
    __syncthreads();
    unsigned spins = 0u; bool dry = false;
    while (bx[0] == 0u) {
        __syncthreads();
        if (threadIdx.x == 0) {
            unsigned* bar = b.bar;
            bool rel = xb_ld(&bar[XB_XGEN(b.x)]) != bx[2];
            if (!rel && ((++spins & 63u) == 0u)) { if (xb_ld(&bar[XB_TMO])) rel = true; else if (spins > (XB_SPIN_CAP >> 1)) { atomicAdd(&bar[XB_TMO], 1u); rel = true; } }
            if (rel) { __builtin_amdgcn_fence(__ATOMIC_ACQUIRE, "agent"); asm volatile("s_waitcnt vmcnt(0)" ::: "memory"); bx[0] = 1u; }
            else if (!dry) { const unsigned c = xb_add(F.ctl + CW_CQ, 16u); bx[1] = c; dry = c >= (unsigned)CVT_TOTAL; }
            else { bx[1] = (unsigned)CVT_TOTAL; __builtin_amdgcn_s_sleep(2); }
        }
        __syncthreads();
        if (bx[0] == 0u) cvt_queue_item2(F, args, (int)bx[1] + F.wave, (int)bx[1] + 8 + F.wave, lane);
    }
    __syncthreads();
}
__device__ __forceinline__ void cvt_drain(const Frame& F, const Args& args, volatile LAS unsigned* bx, int limit) {
    int tid_ = threadIdx.x; asm volatile("" : "+v"(tid_)); const int lane = tid_ & 63;
    for (;;) {
        __syncthreads();
        if (threadIdx.x == 0) { const unsigned c = xb_ld(F.ctl + CW_CQ); bx[1] = (c >= (unsigned)limit) ? 0xFFFFFFFFu : xb_add(F.ctl + CW_CQ, 8u); }
        __syncthreads();
        const unsigned base = bx[1]; if (base >= (unsigned)CVT_TOTAL) break;
        cvt_queue_item(F, args, (int)base + F.wave, lane);
        if (base >= (unsigned)limit) break;
    }
    __syncthreads();
}
__device__ __forceinline__ void phase_prologue(const Frame& F, const Args& args) {
    int tid_ = threadIdx.x; asm volatile("" : "+v"(tid_)); const int tid = tid_, lane = tid & 63;
    LAS float* scr = (LAS float*)(F.lds + F.wave * 16896);
    int it = F.gw; const int nw = F.ngw;
#define TR_RUN(Wp, Kk, Nn, Dp, ROFF, MODE) do { const int cnt_ = ((Kk) >> 6) * ((Nn) >> 5); while (it < cnt_) { transpose_item((Wp), (Kk), (Nn), (Dp), (ROFF), (MODE), scr, it, lane); it += nw; } it -= cnt_; } while (0)
#define TR_RUN8(Wp, Kk, Nn, Dp, ROFF, MODE) do { const int cnt_ = ((Kk) >> 7) * ((Nn) >> 5); while (it < cnt_) { transpose_item_f8((Wp), (Kk), (Nn), (Dp), (ROFF), (MODE), SC_W, scr, it, lane); it += nw; } it -= cnt_; } while (0)
    for (int l = 0; l < DEPTH; ++l) {
        TR_RUN(args.in[I_WIN] + (size_t)l * DM * DIN, DM, DIN, (bf16*)(F.ws + WS_WIN) + (size_t)l * DINP * DM, 0, 0);
        TR_RUN(args.in[I_WUQ] + (size_t)l * 512 * 768, 512, 768, (bf16*)(F.ws + WS_WUQ) + (size_t)l * 768 * 512, 0, 0);
        TR_RUN(args.in[I_WUKV] + (size_t)l * 256 * 1024, 256, 1024, (bf16*)(F.ws + WS_WUKV) + (size_t)l * 1024 * 256, 0, 0);
        if constexpr (F8WO) TR_RUN8(args.in[I_WOUT] + (size_t)l * DM * DM, DM, DM, (unsigned char*)(F.ws + WS_WOUT) + (size_t)l * DM * DM, 0, 0);
        else TR_RUN(args.in[I_WOUT] + (size_t)l * DM * DM, DM, DM, (bf16*)(F.ws + WS_WOUT) + (size_t)l * DM * DM, 0, 0);
    }
    if constexpr (F8DG) {
        TR_RUN8(args.in[I_WG], DM, DFF, (unsigned char*)(F.ws + WS_WGU), 0, 1);
        TR_RUN8(args.in[I_WU], DM, DFF, (unsigned char*)(F.ws + WS_WGU), 0, 2);
    } else {
        TR_RUN(args.in[I_WG], DM, DFF, (bf16*)(F.ws + WS_WGU), 0, 1);
        TR_RUN(args.in[I_WU], DM, DFF, (bf16*)(F.ws + WS_WGU), 0, 2);
    }
    if constexpr (F8DD) TR_RUN8(args.in[I_WDN], DFF, DM, (unsigned char*)(F.ws + WS_WD), 0, 0);
    else TR_RUN(args.in[I_WDN], DFF, DM, (bf16*)(F.ws + WS_WD), 0, 0);
#undef TR_RUN
#undef TR_RUN8
    for (int l = 0; l < DEPTH; ++l) { v4u* z = (v4u*)((bf16*)(F.ws + WS_WIN) + ((size_t)l * DINP + DIN) * DM); const v4u zz = {0u, 0u, 0u, 0u};
        for (int i = F.bid * NWAVES * 64 + tid; i < (DINP - DIN) * DM / 8; i += F.G * NWAVES * 64) z[i] = zz; }
    if (MOE_CVT_IN_ATTN == 0 || (MOE_CVT_IN_ATTN >= 2 && !F8M)) convert_experts(F, args, 0, NE, F.gw, F.ngw);
    phase_rmsnorm<false, false>(F, args.in[I_X], args.in[I_MIXN], F.ws + WS_H, 1.f);
}

__global__ void __launch_bounds__(NWAVES * 64, 2) mega_fwd(Args args) {
    extern __shared__ __attribute__((aligned(16))) unsigned char lds_raw[];
    Frame F;
    F.lds = (LAS unsigned char*)lds_raw; F.ws = args.ws; F.ctl = (unsigned*)(args.ws + WS_CTL);
    F.wave = __builtin_amdgcn_readfirstlane((int)threadIdx.x >> 6);
    F.G = gridDim.x; F.bid = blockIdx.x; F.gw = F.bid * NWAVES + F.wave; F.ngw = F.G * NWAVES;
    volatile LAS unsigned* MISC = (volatile LAS unsigned*)(F.lds + MISC_OFF);
    if (threadIdx.x < 64) MISC[threadIdx.x] = 0u;
    __syncthreads();
    XcdBarrier bar = xcd_barrier_post(F.ctl + CW_BAR, MISC + 8);
    const int lo = args.ph_lo, hi = args.ph_hi;
#define IN(k) (lo <= (k) && (k) < hi)
#if defined(PROBE_WHAT)
    unsigned long long pb_acc = 0ull, pb_t0 = 0ull, pb_cyc = 0ull, pb_c0 = 0ull;
#define PB_START(id) do { if ((id) == PROBE_WHAT) { pb_t0 = __builtin_amdgcn_s_memrealtime(); pb_c0 = __builtin_amdgcn_s_memtime(); } } while (0)
#define PB_STOP(id) do { if ((id) == PROBE_WHAT) { pb_acc += __builtin_amdgcn_s_memrealtime() - pb_t0; pb_cyc += __builtin_amdgcn_s_memtime() - pb_c0; } } while (0)
#else
#define PB_START(id) do {} while (0)
#define PB_STOP(id) do {} while (0)
#endif
#define SEAM_CLASS(k) (((k) == 1 || (k) == 3 || (k) == 7 || (k) == 9 || (k) == 10 || (k) == 12 || (k) == 14 || (k) == 18 || (k) == 21 || (k) == 22) ? 20 : (((k) == 5 || (k) == 16) ? 21 : 22))
#define SEAM(k) do { if (IN(k) && IN((k) + 1)) { PB_START(1); PB_START(SEAM_CLASS(k)); if (MOE_CVT_IN_ATTN == 3 && F8M && (k) < 19) xcd_barrier_w(bar, F, args, MISC + 16); else xcd_barrier(bar); PB_STOP(SEAM_CLASS(k)); PB_STOP(1); } } while (0)
    float* out = args.out;
    bf16* XB = (bf16*)(F.ws + WS_XB);
    LAS unsigned char* ring = F.lds;

    if (PHON(0) && IN(0)) { PB_START(58); phase_prologue(F, args); PB_STOP(58); }
    SEAM(0);

#pragma nounroll
    for (int l = 0; l < DEPTH; ++l) {
        const int P = 11 * l;
        if (PHON(1) && IN(P + 1)) { PB_START(30); PB_START(60);
            pg8::Gemm g{F.ws + WS_H, (const bf16*)(F.ws + WS_WIN) + (size_t)l * DINP * DM, NTOK, DINP, DM, 0}; pg8::StaticOrder S; S.init(NTOK, DINP, F.G, F.bid);
            pg8::EpiBf16 E{(bf16*)(F.ws + WS_PROJ), DINP};
            pg8::gemm_phase<pg8::EpiBf16, pg8::StaticOrder, true, true>(ring, g, S, E); PB_STOP(30); PB_STOP(60);
        }
        SEAM(P + 1);
        if (PHON(2) && IN(P + 2)) { PB_START(50); phase_postproj(F, args, l); PB_STOP(50); }
        SEAM(P + 2);
        if (PHON(3) && IN(P + 3)) { PB_START(61);
            { pg8::Gemm g{F.ws + WS_CQN, (const bf16*)(F.ws + WS_WUQ) + (size_t)l * 768 * 512, NTOK, 768, 512, 0}; pg8::StaticOrder S; S.init(NTOK, 768, F.G, F.bid);
              pg8::EpiBf16 E{(bf16*)(F.ws + WS_QCR), 768}; pg8::gemm_phase<pg8::EpiBf16, pg8::StaticOrder, true, true>(ring, g, S, E); }
            { pg8::Gemm g{F.ws + WS_CKVN, (const bf16*)(F.ws + WS_WUKV) + (size_t)l * 1024 * 256, NTOK, 1024, 256, 0}; pg8::StaticOrder S; S.init(NTOK, 1024, F.G, F.bid);
              pg8::EpiBf16 E{(bf16*)(F.ws + WS_KVR), 1024}; pg8::gemm_phase<pg8::EpiBf16, pg8::StaticOrder, true, true>(ring, g, S, E); }
            PB_STOP(61);
        }
        SEAM(P + 3);
        if (PHON(4) && IN(P + 4)) { PB_START(51); phase_postmla(F, args, l); PB_STOP(51); }
        SEAM(P + 4);
        if (PHON(5) && IN(P + 5)) { PB_START(2); PB_START(32); phase_attention(F, args, l); __syncthreads(); PB_STOP(32); PB_STOP(2); }
        SEAM(P + 5);
        if (PHON(6) && IN(P + 6)) { PB_START(52); phase_groupnorm(F, args, l); PB_STOP(52); }
        SEAM(P + 6);
        if (PHON(7) && IN(P + 7)) { PB_START(62);
            pg8::Gemm g{F.ws + WS_ON, F.ws + WS_WOUT + (size_t)l * DM * DM * (F8WO ? 1 : 2), NTOK, DM, DM, 0}; pg8::StaticOrder S; S.init(NTOK, DM, F.G, F.bid);
            constexpr float isc = F8WO ? 1.f / (SC_H * SC_W) : 1.f;
            if (l == 0) { pg8::EpiResBf16<false> E{args.in[I_X], XB, DM, isc}; pg8::gemm_phase<pg8::EpiResBf16<false>, pg8::StaticOrder, true, true, F8WO>(ring, g, S, E); }
            else { pg8::EpiResBf16<true> E{XB, XB, DM, isc}; pg8::gemm_phase<pg8::EpiResBf16<true>, pg8::StaticOrder, true, true, F8WO>(ring, g, S, E); }
            PB_STOP(62);
        }
        SEAM(P + 7);
        if (l == 0) {
            if (PHON(8) && IN(P + 8)) { PB_START(53); phase_rmsnorm<F8DG, true>(F, XB, args.in[I_FFNN] + (size_t)l * DM, F.ws + WS_H, F8DG ? SC_H : 1.f); PB_STOP(53); }
            SEAM(P + 8);
            if (PHON(9) && IN(P + 9)) { PB_START(63);
                pg8::Gemm g{F.ws + WS_H, F.ws + WS_WGU, NTOK, 2 * DFF, DM, 0}; pg8::StaticOrder S; S.init(NTOK, 2 * DFF, F.G, F.bid);
                constexpr float isc = F8DG ? 1.f / (SC_H * SC_W) : 1.f;
                if constexpr (F8DD) { pg8::EpiSwigluF8 E{F.ws + WS_ACT, DFF, SC_ACT, isc}; pg8::gemm_phase<pg8::EpiSwigluF8, pg8::StaticOrder, true, true, F8DG>(ring, g, S, E); }
                else { pg8::EpiSwiglu E{(bf16*)(F.ws + WS_ACT), DFF, isc}; pg8::gemm_phase<pg8::EpiSwiglu, pg8::StaticOrder, true, true, F8DG>(ring, g, S, E); }
                PB_STOP(63);
            }
            SEAM(P + 9);
            if (PHON(10) && IN(P + 10)) { PB_START(64);
                pg8::Gemm g{F.ws + WS_ACT, F.ws + WS_WD, NTOK, DM, DFF, 0}; pg8::StaticOrder S; S.init(NTOK, DM, F.G, F.bid);
                pg8::EpiResBf16<true> E{XB, XB, DM, F8DD ? 1.f / (SC_ACT * SC_W) : 1.f};
                pg8::gemm_phase<pg8::EpiResBf16<true>, pg8::StaticOrder, true, true, F8DD>(ring, g, S, E); PB_STOP(64);
            }
            SEAM(P + 10);
            if (PHON(8) && IN(P + 11)) { PB_START(53); phase_rmsnorm<false, true>(F, XB, args.in[I_MIXN] + (size_t)(l + 1) * DM, F.ws + WS_H, 1.f); PB_STOP(53); }
            SEAM(P + 11);
        } else {
            if (PHON(11) && IN(P + 8) && MOE_CVT_IN_ATTN == 3 && F8M) cvt_drain(F, args, MISC + 16, CVT_TOTAL);
            if (PHON(11) && IN(P + 8)) { PB_START(54); phase_ffnnorm_route<F8M, true>(F, args, XB, args.in[I_FFNN] + (size_t)l * DM, F.ws + WS_H, SC_H); PB_STOP(54); }
            SEAM(P + 8);
            if (PHON(12) && IN(P + 9)) { PB_START(55); phase_gather<F8M>(F); PB_STOP(55); }
            SEAM(P + 9);
            if (PHON(13) && IN(P + 10)) { PB_START(31); PB_START(65);
                int tb[9], cnt[8]; moe_tiles(F, tb, cnt);
                pg8::Gemm g{F.ws + WS_HG, F.ws + WS_WEGU, tb[8] * 256, 2 * DFE, DM, 0}; pg8::GroupedOrder S; S.init(tb[8] * 256, 2 * DFE, F.G, F.bid);
#pragma unroll
                for (int k = 0; k < 7; ++k) S.tb[k] = tb[k + 1];
                S.nct = 2 * DFE / 256; S.lim = 0;
                if constexpr (F8M) { pg8::EpiSwigluF8 E{F.ws + WS_ACTM, DFE, SC_ACT, 1.f / (SC_H * SC_W)}; pg8::gemm_phase<pg8::EpiSwigluF8, pg8::GroupedOrder, true, true, true>(ring, g, S, E); }
                else { pg8::EpiSwiglu E{(bf16*)(F.ws + WS_ACTM), DFE, 1.f}; pg8::gemm_phase<pg8::EpiSwiglu, pg8::GroupedOrder, true, true, false>(ring, g, S, E); }
                PB_STOP(31); PB_STOP(65);
            }
            SEAM(P + 10);
            if (PHON(14) && IN(P + 11)) { PB_START(66);
                int tb[9], cnt[8]; moe_tiles(F, tb, cnt);
                const int nun = tb[8] * (DM / 256), nfull = (F.G == 256 && F8M) ? (nun / 256) * 256 : nun;
                { pg8::Gemm g{F.ws + WS_ACTM, F.ws + WS_WED, tb[8] * 256, DM, DFE, 0}; pg8::GroupedOrder S; S.init(tb[8] * 256, DM, F.G, F.bid);
#pragma unroll
                  for (int k = 0; k < 7; ++k) S.tb[k] = tb[k + 1];
                  S.nct = DM / 256; S.lim = nfull;
                  pg8::EpiScaleBf16 E{(bf16*)(F.ws + WS_Y), DM, (const float*)(F.ws + WS_RGATE), F8M ? 1.f / (SC_ACT * SC_W) : 1.f};
                  pg8::gemm_phase<pg8::EpiScaleBf16, pg8::GroupedOrder, true, true, F8M>(ring, g, S, E); }
                if (nfull < nun) { const int nsp = 4;
                  pg8::Gemm g{F.ws + WS_ACTM, F.ws + WS_WED, tb[8] * 256, DM, DFE, DFE / 128 / nsp}; pg8::GroupedTail S; S.init(tb[8] * 256, DM, F.G, F.bid);
#pragma unroll
                  for (int k = 0; k < 7; ++k) S.tb[k] = tb[k + 1];
                  S.nct = DM / 256; S.lim = nfull; S.nsp = nsp; S.kslice = DFE / nsp;
                  pg8::EpiPartF32 E{(float*)(F.ws + WS_PART)};
                  pg8::gemm_phase<pg8::EpiPartF32, pg8::GroupedTail, true, true, F8M>(ring, g, S, E); }
                PB_STOP(66);
            }
            SEAM(P + 11);
            if (PHON(14) && IN(P + 12)) { PB_START(56); phase_tailsum(F); PB_STOP(56); }
            SEAM(P + 12);
            if (PHON(15) && IN(P + 13)) { PB_START(57); phase_combine<true>(F, XB, out); PB_STOP(57); }
        }
    }
#if defined(PROBE_WHAT)
    if (blockIdx.x == PROBE_BLOCK && threadIdx.x < 64) { const unsigned long long t0 = __builtin_amdgcn_s_memrealtime(); const unsigned long long spin = (PROBE_WHAT >= 30 && PROBE_WHAT < 50) ? (pb_acc ? (pb_cyc * 100ull / pb_acc) * 50ull : 0ull) : (unsigned long long)PROBE_AMP * pb_acc;
        while (__builtin_amdgcn_s_memrealtime() - t0 < spin) __builtin_amdgcn_s_sleep(8); }
#endif
#undef IN
#undef SEAM
}

extern "C" void kernel_launch(void* const* d_in, const int* in_sizes, int n_in, void* d_out, int out_size, void* d_ws, size_t ws_size, hipStream_t stream) {
    static int grid = 0;
    if (grid == 0) {
        if (n_in != 26 || in_sizes[0] != NTOK * DM || out_size != NTOK * DM || ws_size < WS_END3) { fprintf(stderr, "kernel_launch: unexpected shapes (n_in %d, in0 %d, out %d, ws %zu < %zu)\n", n_in, n_in > 0 ? in_sizes[0] : -1, out_size, ws_size, (size_t)WS_END3); grid = -1; return; }
        int dev = 0, cus = 0, per_cu = 0;
        if (hipGetDevice(&dev) != hipSuccess || hipDeviceGetAttribute(&cus, hipDeviceAttributeMultiprocessorCount, dev) != hipSuccess) { grid = -1; return; }
        if (hipFuncSetAttribute((const void*)mega_fwd, hipFuncAttributeMaxDynamicSharedMemorySize, LDS_BYTES) != hipSuccess) { fprintf(stderr, "kernel_launch: hipFuncSetAttribute failed\n"); grid = -1; return; }
        if (hipOccupancyMaxActiveBlocksPerMultiprocessor(&per_cu, (const void*)mega_fwd, NWAVES * 64, LDS_BYTES) != hipSuccess || per_cu < 1) fprintf(stderr, "kernel_launch: occupancy query reports %d\n", per_cu);
        (void)hipGetLastError();
        grid = cus;
    }
    if (grid < 0) return;
    if (hipMemsetAsync((char*)d_ws + WS_CTL, 0, CTL_ZERO_BYTES, stream) != hipSuccess) return;
    Args a{};
    for (int i = 0; i < 26; ++i) a.in[i] = (const float*)d_in[i];
    a.out = (float*)d_out; a.ws = (unsigned char*)d_ws;
#ifndef MK_SPLIT
    a.ph_lo = 0; a.ph_hi = NPHASE;
    hipLaunchKernelGGL(mega_fwd, dim3(grid), dim3(NWAVES * 64), LDS_BYTES, stream, a);
#else
    for (int p = 0; p < NPHASE; ++p) { a.ph_lo = p; a.ph_hi = p + 1; hipLaunchKernelGGL(mega_fwd, dim3(grid), dim3(NWAVES * 64), LDS_BYTES, stream, a); }
#endif
}
```

```cpp
#include <hip/hip_runtime.h>
#include <cstdio>
#include <cstdint>
namespace pg8 {
#define PG8_LAS __attribute__((address_space(3)))
typedef unsigned short bf16_t;
typedef short bf16x8 __attribute__((ext_vector_type(8)));
typedef float f32x4 __attribute__((ext_vector_type(4)));
typedef unsigned u32x4 __attribute__((ext_vector_type(4)));
constexpr int BM = 256, BK = 64, HALF = 128, HTB = HALF * BK * 2  , STAGE_BYTES = 8 * HTB, NXCD = 8, WGM = 8;

__host__ __device__ __forceinline__ int lds_byte(int r, int c) { const int st = (r >> 4) * 2 + (c >> 5), rr = r & 15, cc = c & 31, ob = rr * 64 + cc * 2; return st * 1024 + (ob ^ (((ob >> 9) & 1) << 5)); }
__host__ __device__ __forceinline__ void stage_rc(int b, int& R, int& C) { const int st = b / 1024, sb = b % 1024, swz = sb ^ (((sb >> 9) & 1) << 5); R = (st >> 1) * 16 + swz / 64; C = (st & 1) * 32 + (swz % 64) / 2; }
__host__ __device__ __forceinline__ int perm32(int rho) { const int n = rho >> 4, i = rho & 15; return 8 * (i >> 2) + 4 * n + (i & 3); }


struct Unit { int pm, pn, pc, ko; };
struct Gemm { const void* A; const void* Bt; int M, N, K, kt; };
typedef int i32x4 __attribute__((ext_vector_type(4)));
typedef int i32x8 __attribute__((ext_vector_type(8)));

struct StaticOrder {
    int nM, nN, nwg, G, c;
    __device__ __forceinline__ void init(int M, int N, int G_, int c_) { nM = M / BM; nN = N / BM; nwg = nM * nN; G = G_; c = c_; }
    __device__ __forceinline__ bool next(int i, Unit& u) const {
        const long L = (long)i * G + c; if (L >= nwg) return false;
        int wgid = (int)L; { const int q = nwg / NXCD, r = nwg % NXCD, xcd = wgid % NXCD, off = wgid / NXCD; wgid = (xcd < r ? xcd * (q + 1) : r * (q + 1) + (xcd - r) * q) + off; }
        const int nig = WGM * nN, gid = wgid / nig, fm = gid * WGM, gsz = (nM - fm) < WGM ? (nM - fm) : WGM;
        u.pm = fm + ((wgid % nig) % gsz); u.pn = (wgid % nig) / gsz; u.pc = u.pn; u.ko = 0; return true;
    }
    __device__ __forceinline__ void a_ready(const Unit&) const {}
    __device__ __forceinline__ void done(const Unit&) const {}
};
struct GroupedOrder : StaticOrder {
    int tb[7]; int nct; int lim;
    __device__ __forceinline__ void expert(Unit& u) const { int e = 0;
#pragma unroll
        for (int k = 0; k < 7; ++k) e += (u.pm >= tb[k]) ? 1 : 0;
        u.pc = u.pn; u.pn += e * nct; }
    __device__ __forceinline__ bool next(int i, Unit& u) const {
        if (lim > 0 && (long)i * G + c >= lim) return false;
        if (!StaticOrder::next(i, u)) return false;
        expert(u); return true;
    }
};
struct GroupedTail : GroupedOrder {
    int nsp, kslice;
    __device__ __forceinline__ bool next(int i, Unit& u) const {
        if (i > 0) return false;
        const int ent = lim + c / nsp; if (ent >= nwg) return false;
        StaticOrder s = *this; s.c = ent % G; if (!s.next(ent / G, u)) return false;
        expert(u); u.ko = (c % nsp) * kslice; u.pc = c; return true;
    }
};

__device__ __forceinline__ unsigned cvt_pk_bf16(float lo, float hi) { unsigned r; asm volatile("v_cvt_pk_bf16_f32 %0, %1, %2" : "=v"(r) : "v"(lo), "v"(hi)); return r; }

struct EpiBf16 {
    static constexpr bool PERM = true, AFTER_DRAIN = false;
    bf16_t* O; int ldc;
    __device__ __forceinline__ void operator()(const f32x4 (&acc)[2][2][4][2], const Unit& u, int wr, int wc, int fr, int fq) const {
        const int row0 = u.pm * BM + wr * 64 + fr, col0 = u.pc * BM + wc * 32 + 8 * fq;
#pragma unroll
        for (int ai = 0; ai < 2; ++ai)
#pragma unroll
            for (int m = 0; m < 4; ++m) { bf16_t* rowp = O + (size_t)(row0 + ai * HALF + m * 16) * ldc + col0;
#pragma unroll
                for (int bj = 0; bj < 2; ++bj) { const f32x4 v0 = acc[ai][bj][m][0], v1 = acc[ai][bj][m][1];
                    u32x4 w; w.x = cvt_pk_bf16(v0[0], v0[1]); w.y = cvt_pk_bf16(v0[2], v0[3]); w.z = cvt_pk_bf16(v1[0], v1[1]); w.w = cvt_pk_bf16(v1[2], v1[3]);
                    *(u32x4*)(rowp + bj * HALF) = w; } }
    }
};
struct EpiPartF32 {
    static constexpr bool PERM = true, AFTER_DRAIN = false;
    float* P;
    __device__ __forceinline__ void operator()(const f32x4 (&acc)[2][2][4][2], const Unit& u, int wr, int wc, int fr, int fq) const {
        float* t = P + (size_t)u.pc * 65536 + (size_t)(wr * 64 + fr) * 256 + wc * 32 + 8 * fq;
#pragma unroll
        for (int ai = 0; ai < 2; ++ai)
#pragma unroll
            for (int m = 0; m < 4; ++m)
#pragma unroll
                for (int bj = 0; bj < 2; ++bj) { float* q = t + (size_t)(ai * HALF + m * 16) * 256 + bj * HALF; *(f32x4*)q = acc[ai][bj][m][0]; *(f32x4*)(q + 4) = acc[ai][bj][m][1]; }
    }
};
struct EpiScaleBf16 {
    static constexpr bool PERM = true, AFTER_DRAIN = false;
    bf16_t* O; int ldc; const float* rs; float isc;
    __device__ __forceinline__ void operator()(const f32x4 (&acc)[2][2][4][2], const Unit& u, int wr, int wc, int fr, int fq) const {
        const int row0 = u.pm * BM + wr * 64 + fr, col0 = u.pc * BM + wc * 32 + 8 * fq;
#pragma unroll
        for (int ai = 0; ai < 2; ++ai)
#pragma unroll
            for (int m = 0; m < 4; ++m) { const int row = row0 + ai * HALF + m * 16; const float s = rs[row] * isc; bf16_t* rowp = O + (size_t)row * ldc + col0;
#pragma unroll
                for (int bj = 0; bj < 2; ++bj) { const f32x4 v0 = acc[ai][bj][m][0] * s, v1 = acc[ai][bj][m][1] * s;
                    u32x4 w; w.x = cvt_pk_bf16(v0[0], v0[1]); w.y = cvt_pk_bf16(v0[2], v0[3]); w.z = cvt_pk_bf16(v1[0], v1[1]); w.w = cvt_pk_bf16(v1[2], v1[3]);
                    *(u32x4*)(rowp + bj * HALF) = w; } }
    }
};
struct EpiResF32 {
    static constexpr bool PERM = false, AFTER_DRAIN = false;
    const float* base; float* out; int ldc; float isc;
    __device__ __forceinline__ void operator()(const f32x4 (&acc)[2][2][4][2], const Unit& u, int wr, int wc, int fr, int fq) const {
        const int row0 = u.pm * BM + wr * 64 + fr, col0 = u.pc * BM + wc * 32 + 4 * fq;
#pragma unroll
        for (int ai = 0; ai < 2; ++ai)
#pragma unroll
            for (int m = 0; m < 4; ++m) { const size_t off = (size_t)(row0 + ai * HALF + m * 16) * ldc + col0;
                f32x4 b[2][2];
#pragma unroll
                for (int bj = 0; bj < 2; ++bj)
#pragma unroll
                    for (int n = 0; n < 2; ++n) b[bj][n] = *(const f32x4*)(base + off + bj * HALF + n * 16);
#pragma unroll
                for (int bj = 0; bj < 2; ++bj)
#pragma unroll
                    for (int n = 0; n < 2; ++n) *(f32x4*)(out + off + bj * HALF + n * 16) = b[bj][n] + acc[ai][bj][m][n] * isc;
                asm volatile("" ::: "memory"); }
    }
};
template <bool BASEB> struct EpiResBf16 {
    static constexpr bool PERM = true, AFTER_DRAIN = false;
    const void* base; bf16_t* out; int ldc; float isc;
    __device__ __forceinline__ void operator()(const f32x4 (&acc)[2][2][4][2], const Unit& u, int wr, int wc, int fr, int fq) const {
        const int row0 = u.pm * BM + wr * 64 + fr, col0 = u.pc * BM + wc * 32 + 8 * fq;
        if constexpr (BASEB) {
            constexpr int AH = 2;
            u32x4 w[8][2];
#define PG8_RLOAD(g) do { const size_t off_ = (size_t)(row0 + ((g) >> 2) * HALF + ((g) & 3) * 16) * ldc + col0; \
                w[g][0] = *(const u32x4*)((const bf16_t*)base + off_); w[g][1] = *(const u32x4*)((const bf16_t*)base + off_ + HALF); } while (0)
#pragma unroll
            for (int g = 0; g < AH; ++g) PG8_RLOAD(g);
#pragma unroll
            for (int g = 0; g < 8; ++g) { const int ai = g >> 2, m = g & 3; const size_t off = (size_t)(row0 + ai * HALF + m * 16) * ldc + col0;
                if (g + AH < 8) PG8_RLOAD(g + AH < 8 ? g + AH : 0);
#pragma unroll
                for (int bj = 0; bj < 2; ++bj) { const u32x4 ww = w[g][bj];
                    const f32x4 b0 = (f32x4){__uint_as_float(ww.x << 16), __uint_as_float(ww.x & 0xffff0000u), __uint_as_float(ww.y << 16), __uint_as_float(ww.y & 0xffff0000u)};
                    const f32x4 b1 = (f32x4){__uint_as_float(ww.z << 16), __uint_as_float(ww.z & 0xffff0000u), __uint_as_float(ww.w << 16), __uint_as_float(ww.w & 0xffff0000u)};
                    const f32x4 v0 = b0 + acc[ai][bj][m][0] * isc, v1 = b1 + acc[ai][bj][m][1] * isc;
                    u32x4 o; o.x = cvt_pk_bf16(v0[0], v0[1]); o.y = cvt_pk_bf16(v0[2], v0[3]); o.z = cvt_pk_bf16(v1[0], v1[1]); o.w = cvt_pk_bf16(v1[2], v1[3]);
                    *(u32x4*)(out + off + bj * HALF) = o; }
                asm volatile("" ::: "memory"); }
#undef PG8_RLOAD
        } else {
#pragma unroll
        for (int ai = 0; ai < 2; ++ai)
#pragma unroll
            for (int m = 0; m < 4; ++m) { const size_t off = (size_t)(row0 + ai * HALF + m * 16) * ldc + col0;
#pragma unroll
                for (int bj = 0; bj < 2; ++bj) { f32x4 b0, b1;
                    b0 = *(const f32x4*)((const float*)base + off + bj * HALF); b1 = *(const f32x4*)((const float*)base + off + bj * HALF + 4);
                    const f32x4 v0 = b0 + acc[ai][bj][m][0] * isc, v1 = b1 + acc[ai][bj][m][1] * isc;
                    u32x4 o; o.x = cvt_pk_bf16(v0[0], v0[1]); o.y = cvt_pk_bf16(v0[2], v0[3]); o.z = cvt_pk_bf16(v1[0], v1[1]); o.w = cvt_pk_bf16(v1[2], v1[3]);
                    *(u32x4*)(out + off + bj * HALF) = o; }
                asm volatile("" ::: "memory"); }
        }
    }
};
__device__ __forceinline__ float silu_mul(float g, float u) { return g * u * __builtin_amdgcn_rcpf(1.0f + __builtin_amdgcn_exp2f(-1.44269504089f * g)); }
struct EpiSwiglu {
    static constexpr bool PERM = true, AFTER_DRAIN = false;
    bf16_t* O; int ldc; float isc;
    __device__ __forceinline__ void operator()(const f32x4 (&acc)[2][2][4][2], const Unit& u, int wr, int wc, int fr, int fq) const {
        const int row0 = u.pm * BM + wr * 64 + fr, col0 = u.pc * HALF + wc * 32 + 8 * fq;
#pragma unroll
        for (int ai = 0; ai < 2; ++ai)
#pragma unroll
            for (int m = 0; m < 4; ++m) { bf16_t* rowp = O + (size_t)(row0 + ai * HALF + m * 16) * ldc + col0;
                const f32x4 g0 = acc[ai][0][m][0] * isc, g1 = acc[ai][0][m][1] * isc, u0 = acc[ai][1][m][0] * isc, u1 = acc[ai][1][m][1] * isc;
                u32x4 w; w.x = cvt_pk_bf16(silu_mul(g0[0], u0[0]), silu_mul(g0[1], u0[1])); w.y = cvt_pk_bf16(silu_mul(g0[2], u0[2]), silu_mul(g0[3], u0[3]));
                w.z = cvt_pk_bf16(silu_mul(g1[0], u1[0]), silu_mul(g1[1], u1[1])); w.w = cvt_pk_bf16(silu_mul(g1[2], u1[2]), silu_mul(g1[3], u1[3]));
                *(u32x4*)rowp = w; }
    }
};

__device__ __forceinline__ unsigned cvt_pk4_fp8(float a, float b, float c, float d) { unsigned w = 0u; w = __builtin_amdgcn_cvt_pk_fp8_f32(a, b, w, false); w = __builtin_amdgcn_cvt_pk_fp8_f32(c, d, w, true); return w; }
struct EpiSwigluF8 {
    static constexpr bool PERM = true, AFTER_DRAIN = false;
    unsigned char* O; int ldc; float osc, isc;
    __device__ __forceinline__ void operator()(const f32x4 (&acc)[2][2][4][2], const Unit& u, int wr, int wc, int fr, int fq) const {
        typedef float f32x2 __attribute__((ext_vector_type(2)));
        typedef unsigned u32x2 __attribute__((ext_vector_type(2)));
        const int row0 = u.pm * BM + wr * 64 + fr, col0 = u.pc * HALF + wc * 32 + 8 * fq;
        const float k1i = 1.f / (osc * isc * isc), k2s = -1.44269504089f * isc; const f32x2 K2 = {k2s, k2s}, IK1 = {k1i, k1i};
#define SWF8P(G, U, OUT) do { const f32x2 t_ = (G) * K2; f32x2 e_; e_.x = __builtin_amdgcn_exp2f(t_.x); e_.y = __builtin_amdgcn_exp2f(t_.y); \
            const f32x2 d_ = e_ * IK1 + IK1; f32x2 r_; r_.x = __builtin_amdgcn_rcpf(d_.x); r_.y = __builtin_amdgcn_rcpf(d_.y); OUT = ((G) * (U)) * r_; } while (0)
#pragma unroll
        for (int ai = 0; ai < 2; ++ai)
#pragma unroll
            for (int m = 0; m < 4; ++m) { unsigned char* rowp = O + (size_t)(row0 + ai * HALF + m * 16) * ldc + col0;
                u32x2 w;
#pragma unroll
                for (int h = 0; h < 2; ++h) { const f32x4 g4 = acc[ai][0][m][h], u4 = acc[ai][1][m][h];
                    const f32x2 ga = {g4[0], g4[1]}, gb = {g4[2], g4[3]}, ua = {u4[0], u4[1]}, ub = {u4[2], u4[3]}; f32x2 oa, ob;
                    SWF8P(ga, ua, oa); SWF8P(gb, ub, ob);
                    const unsigned pk = cvt_pk4_fp8(oa.x, oa.y, ob.x, ob.y); if (h == 0) w.x = pk; else w.y = pk; }
                *(u32x2*)rowp = w; }
#undef SWF8P
    }
};

template <class Epi, class Sched, bool ALIGN_EPI = false, bool SP2 = false, bool F8 = false>
__device__ __forceinline__ void gemm_phase(PG8_LAS unsigned char* lds, const Gemm g, const Sched& S, const Epi& E) {
    int tid_ = threadIdx.x; asm volatile("" : "+v"(tid_));
    const int tid = tid_, wid = __builtin_amdgcn_readfirstlane(tid >> 6), lane = tid & 63, wr = wid >> 2, wc = wid & 3, fr = lane & 15, fq = lane >> 4;
    const int K = g.K, RB = F8 ? K : 2 * K;
    const int nt = g.kt > 0 ? g.kt : (F8 ? K / (2 * BK) : K / BK);
    unsigned voffA[2], voffB[2];
#pragma unroll
    for (int i = 0; i < 2; ++i) { int R, C; stage_rc(tid * 16 + i * 8192, R, C); const int Rb = Epi::PERM ? ((R & ~31) + perm32(R & 31)) : R;
        voffA[i] = (unsigned)(R * RB + C * 2); voffB[i] = (unsigned)(Rb * RB + C * 2); }
    const size_t kstep = (size_t)(BK * 2);
    const size_t hstep = (size_t)HALF * RB;
    const size_t tstep = 2 * hstep;
    const unsigned ldsw = (unsigned)wid * 1024u;
    const int aoff = F8 ? lds_byte(wr * 64 + fr, fq * 16) : lds_byte(wr * 64 + fr, fq * 8), boff = F8 ? lds_byte(wc * 32 + fr, fq * 16) : lds_byte(wc * 32 + fr, fq * 8);
#define PG8_SA(b, h) (((b) * 2 + (h)) * HTB)
#define PG8_SB(b, h) ((4 + (b) * 2 + (h)) * HTB)
#define PG8_STAGE(bufoff, gbase, voff) do { _Pragma("unroll") for (int _i = 0; _i < 2; ++_i) \
        __builtin_amdgcn_global_load_lds((const unsigned*)((const char*)(gbase) + (voff)[_i]), (PG8_LAS unsigned*)(lds + (bufoff) + ldsw + _i * 8192), 16, 0, 0); } while (0)
#define PG8_LD16(p) (*(const PG8_LAS i32x4*)(p))
#define PG8_LDA(dst, b, h) do { _Pragma("unroll") for (int m = 0; m < 4; ++m) { if constexpr (F8) { dst##8[m] = __builtin_shufflevector(PG8_LD16(lds + PG8_SA(b, h) + aoff + m * 2048), PG8_LD16(lds + PG8_SA(b, h) + aoff + m * 2048 + 16), 0, 1, 2, 3, 4, 5, 6, 7); } \
        else { _Pragma("unroll") for (int k = 0; k < 2; ++k) dst[m][k] = *(const PG8_LAS bf16x8*)(lds + PG8_SA(b, h) + aoff + m * 2048 + k * 1024); } } } while (0)
#define PG8_LDB(dst, b, h) do { _Pragma("unroll") for (int n = 0; n < 2; ++n) { if constexpr (F8) { dst##8[n] = __builtin_shufflevector(PG8_LD16(lds + PG8_SB(b, h) + boff + n * 2048), PG8_LD16(lds + PG8_SB(b, h) + boff + n * 2048 + 16), 0, 1, 2, 3, 4, 5, 6, 7); } \
        else { _Pragma("unroll") for (int k = 0; k < 2; ++k) dst[n][k] = *(const PG8_LAS bf16x8*)(lds + PG8_SB(b, h) + boff + n * 2048 + k * 1024); } } } while (0)
#define PG8_MMA(ai, bj, At, Bt) do { __builtin_amdgcn_s_setprio(1); _Pragma("unroll") for (int m = 0; m < 4; ++m) _Pragma("unroll") for (int n = 0; n < 2; ++n) { \
        if constexpr (F8) asm volatile("v_mfma_f32_16x16x128_f8f6f4 %0, %1, %2, %0" : "+v"(acc[ai][bj][m][n]) : "v"(Bt##8[n]), "v"(At##8[m])); \
        else { _Pragma("unroll") for (int k = 0; k < 2; ++k) acc[ai][bj][m][n] = __builtin_amdgcn_mfma_f32_16x16x32_bf16(Bt[n][k], At[m][k], acc[ai][bj][m][n], 0, 0, 0); } } __builtin_amdgcn_s_setprio(0); } while (0)
#define PG8_WAIT_V(n) asm volatile("s_waitcnt vmcnt(" #n ")" ::: "memory")
#define PG8_WAIT_L(n) asm volatile("s_waitcnt lgkmcnt(" #n ")" ::: "memory")
#define PG8_BAR __builtin_amdgcn_s_barrier()
#define PG8_SCHED __builtin_amdgcn_sched_barrier(0)
    Unit cur, nxt; int ui = 0;
    if (!S.next(0, cur)) return;
    f32x4 acc[2][2][4][2];
#pragma unroll
    for (int a = 0; a < 2; ++a)
#pragma unroll
        for (int b = 0; b < 2; ++b)
#pragma unroll
            for (int m = 0; m < 4; ++m)
#pragma unroll
                for (int n = 0; n < 2; ++n) acc[a][b][m][n] = (f32x4){0.f, 0.f, 0.f, 0.f};
    bf16x8 At[4][2], B0[2][2], B1[2][2]; i32x8 At8[4], B08[2], B18[2];
    const char* cA = (const char*)g.A + (size_t)cur.pm * tstep + cur.ko; const char* cB = (const char*)g.Bt + (size_t)cur.pn * tstep + cur.ko;
    S.a_ready(cur);
    if constexpr (SP2) {
        PG8_STAGE(PG8_SB(0, 0), cB, voffB); PG8_STAGE(PG8_SB(0, 1), cB + hstep, voffB); PG8_STAGE(PG8_SA(0, 0), cA, voffA); PG8_STAGE(PG8_SA(0, 1), cA + hstep, voffA);
        if (wr == 1) PG8_BAR;
        PG8_WAIT_V(2); PG8_BAR;
        PG8_STAGE(PG8_SB(1, 0), cB + kstep, voffB); PG8_STAGE(PG8_SA(1, 0), cA + kstep, voffA); PG8_STAGE(PG8_SB(1, 1), cB + hstep + kstep, voffB);
        PG8_WAIT_V(6); PG8_BAR;
    } else {
        PG8_STAGE(PG8_SB(0, 0), cB, voffB); PG8_STAGE(PG8_SA(0, 0), cA, voffA); PG8_STAGE(PG8_SB(0, 1), cB + hstep, voffB); PG8_STAGE(PG8_SA(0, 1), cA + hstep, voffA);
        if (wr == 1) PG8_BAR;
        PG8_WAIT_V(4); PG8_BAR;
        PG8_STAGE(PG8_SB(1, 0), cB + kstep, voffB); PG8_STAGE(PG8_SA(1, 0), cA + kstep, voffA); PG8_STAGE(PG8_SB(1, 1), cB + hstep + kstep, voffB);
        PG8_WAIT_V(6); PG8_BAR;
    }
    for (;;) {
        const bool has_next = S.next(ui + 1, nxt);
        const char* nA = has_next ? (const char*)g.A + (size_t)nxt.pm * tstep + nxt.ko : cA; const char* nB = has_next ? (const char*)g.Bt + (size_t)nxt.pn * tstep + nxt.ko : cB;
        for (int t = 0; t < nt; t += 2) {
            const bool last = (t == nt - 2);
            const char* a1 = cA + (size_t)(t + 1) * kstep;
            const char* a2 = last ? nA : cA + (size_t)(t + 2) * kstep; const char* b2 = last ? nB : cB + (size_t)(t + 2) * kstep;
            const char* a3 = a2 + kstep; const char* b3 = b2 + kstep;
            if (last && has_next) S.a_ready(nxt);
            if constexpr (SP2) {
            PG8_LDB(B0, 0, 0); PG8_LDB(B1, 0, 1); PG8_SCHED; PG8_LDA(At, 0, 0); PG8_STAGE(PG8_SA(1, 1), a1 + hstep, voffA);
            PG8_WAIT_V(8); PG8_WAIT_L(0); PG8_BAR; PG8_MMA(0, 0, At, B0); PG8_MMA(0, 1, At, B1); PG8_BAR; PG8_SCHED;
            PG8_LDA(At, 0, 1); PG8_STAGE(PG8_SB(0, 0), b2, voffB); PG8_STAGE(PG8_SB(0, 1), b2 + hstep, voffB); PG8_STAGE(PG8_SA(0, 0), a2, voffA);
            PG8_WAIT_V(8); PG8_WAIT_L(0); PG8_BAR; PG8_MMA(1, 0, At, B0); PG8_MMA(1, 1, At, B1); PG8_BAR; PG8_SCHED;
            PG8_LDB(B0, 1, 0); PG8_LDB(B1, 1, 1); PG8_SCHED; PG8_LDA(At, 1, 0); PG8_STAGE(PG8_SA(0, 1), a2 + hstep, voffA);
            PG8_WAIT_V(8); PG8_WAIT_L(0); PG8_BAR; PG8_MMA(0, 0, At, B0); PG8_MMA(0, 1, At, B1); PG8_BAR; PG8_SCHED;
            PG8_LDA(At, 1, 1); PG8_STAGE(PG8_SB(1, 0), b3, voffB); PG8_STAGE(PG8_SB(1, 1), b3 + hstep, voffB); PG8_STAGE(PG8_SA(1, 0), a3, voffA);
            PG8_WAIT_V(8); PG8_WAIT_L(0); PG8_BAR; PG8_MMA(1, 0, At, B0); PG8_MMA(1, 1, At, B1); PG8_BAR; PG8_SCHED;
            } else {
            PG8_LDB(B0, 0, 0); PG8_SCHED; PG8_LDA(At, 0, 0); PG8_STAGE(PG8_SA(1, 1), a1 + hstep, voffA);
            PG8_WAIT_L(8); PG8_BAR; PG8_WAIT_L(0); PG8_MMA(0, 0, At, B0); PG8_BAR; PG8_SCHED;
            PG8_LDB(B1, 0, 1); PG8_STAGE(PG8_SB(0, 0), b2, voffB);
            PG8_BAR; PG8_WAIT_L(0); PG8_MMA(0, 1, At, B1); PG8_BAR;
            PG8_LDA(At, 0, 1); PG8_STAGE(PG8_SA(0, 0), a2, voffA);
            PG8_BAR; PG8_WAIT_L(0); PG8_MMA(1, 0, At, B0); PG8_BAR; PG8_SCHED;
            PG8_STAGE(PG8_SB(0, 1), b2 + hstep, voffB);
            PG8_WAIT_V(6); PG8_BAR; PG8_MMA(1, 1, At, B1); PG8_BAR;
            PG8_LDB(B0, 1, 0); PG8_SCHED; PG8_LDA(At, 1, 0); PG8_STAGE(PG8_SA(0, 1), a2 + hstep, voffA);
            PG8_WAIT_L(8); PG8_BAR; PG8_WAIT_L(0); PG8_MMA(0, 0, At, B0); PG8_BAR; PG8_SCHED;
            PG8_LDB(B1, 1, 1); PG8_STAGE(PG8_SB(1, 0), b3, voffB);
            PG8_BAR; PG8_WAIT_L(0); PG8_MMA(0, 1, At, B1); PG8_BAR;
            PG8_LDA(At, 1, 1); PG8_STAGE(PG8_SA(1, 0), a3, voffA);
            PG8_BAR; PG8_WAIT_L(0); PG8_MMA(1, 0, At, B0); PG8_BAR; PG8_SCHED;
            PG8_STAGE(PG8_SB(1, 1), b3 + hstep, voffB);
            PG8_WAIT_V(6); PG8_BAR; PG8_MMA(1, 1, At, B1); PG8_BAR;
            }
        }
        if constexpr (ALIGN_EPI) { if (wr == 0) PG8_BAR; }
        if constexpr (F8) {
            asm volatile("s_nop 15\n\ts_nop 15" : "+v"(acc[0][0][0][0]), "+v"(acc[0][0][0][1]), "+v"(acc[0][0][1][0]), "+v"(acc[0][0][1][1]), "+v"(acc[0][0][2][0]), "+v"(acc[0][0][2][1]), "+v"(acc[0][0][3][0]), "+v"(acc[0][0][3][1]) :: "memory");
            asm volatile("" : "+v"(acc[0][1][0][0]), "+v"(acc[0][1][0][1]), "+v"(acc[0][1][1][0]), "+v"(acc[0][1][1][1]), "+v"(acc[0][1][2][0]), "+v"(acc[0][1][2][1]), "+v"(acc[0][1][3][0]), "+v"(acc[0][1][3][1]) :: "memory");
            asm volatile("" : "+v"(acc[1][0][0][0]), "+v"(acc[1][0][0][1]), "+v"(acc[1][0][1][0]), "+v"(acc[1][0][1][1]), "+v"(acc[1][0][2][0]), "+v"(acc[1][0][2][1]), "+v"(acc[1][0][3][0]), "+v"(acc[1][0][3][1]) :: "memory");
            asm volatile("" : "+v"(acc[1][1][0][0]), "+v"(acc[1][1][0][1]), "+v"(acc[1][1][1][0]), "+v"(acc[1][1][1][1]), "+v"(acc[1][1][2][0]), "+v"(acc[1][1][2][1]), "+v"(acc[1][1][3][0]), "+v"(acc[1][1][3][1]) :: "memory");
        }
        if constexpr (!Epi::AFTER_DRAIN) { E(acc, cur, wr, wc, fr, fq); S.done(cur); }
        if (!has_next) break;
#pragma unroll
        for (int a = 0; a < 2; ++a)
#pragma unroll
            for (int b = 0; b < 2; ++b)
#pragma unroll
                for (int m = 0; m < 4; ++m)
#pragma unroll
                    for (int n = 0; n < 2; ++n) acc[a][b][m][n] = (f32x4){0.f, 0.f, 0.f, 0.f};
        cur = nxt; cA = nA; cB = nB; ++ui;
        if constexpr (ALIGN_EPI) { if (wr == 1) PG8_BAR; }
    }
    PG8_WAIT_V(0);
    if constexpr (!ALIGN_EPI) { if (wr == 0) PG8_BAR; }
    PG8_BAR;
    if constexpr (Epi::AFTER_DRAIN) { E.fused(acc, cur, wr, wc, fr, fq, lds, wid, lane); S.done(cur); }
#undef PG8_SA
#undef PG8_SB
#undef PG8_STAGE
#undef PG8_LDA
#undef PG8_LDB
#undef PG8_MMA
#undef PG8_LD16
#undef PG8_WAIT_V
#undef PG8_WAIT_L
#undef PG8_BAR
#undef PG8_SCHED
}
}

namespace att {
typedef unsigned short bf16;
using bf16x8 = __attribute__((ext_vector_type(8))) short;
using s16x4  = __attribute__((ext_vector_type(4))) short;
using f32x16 = __attribute__((ext_vector_type(16))) float;
using u32x4  = __attribute__((ext_vector_type(4))) unsigned;
constexpr int NW = 8, QBLK = 32, KVBLK = 64, DV = 128;
constexpr float THR = 8.f;
constexpr int SHM_V = KVBLK * DV * 2;
#define ATT_SBAR() __builtin_amdgcn_sched_barrier(0)
#ifndef ATT_IGLP_OPT
#define ATT_IGLP_OPT -1
#endif
#if ATT_IGLP_OPT >= 0
#define ATT_IGLP() __builtin_amdgcn_iglp_opt(ATT_IGLP_OPT)
#else
#define ATT_IGLP() do {} while (0)
#endif
__device__ __forceinline__ int crow(int r, int hi) { return (r & 3) + 8 * (r >> 2) + 4 * hi; }
__device__ __forceinline__ unsigned cvtpk(float lo, float hi) { unsigned r; asm volatile("v_cvt_pk_bf16_f32 %0, %1, %2" : "=v"(r) : "v"(lo), "v"(hi)); return r; }
template <int DQ> struct Cst { static constexpr float SCALE = (DQ == 128) ? 0.088388347648318440f : 0.072168783648703220f; static constexpr int SHM_K = KVBLK * DQ * 2, ROWB = DQ * 2; };

template <int DQ>
__device__ __forceinline__ void partialSM(f32x16& p0, f32x16& p1, float& m_reg, float& mn, float& alpha) {
  constexpr float SCALE = Cst<DQ>::SCALE, C = SCALE * 1.4426950408889634f;
  float pmax = p0[0];
#pragma unroll
  for (int r = 1; r < 16; ++r) pmax = fmaxf(pmax, p0[r]);
#pragma unroll
  for (int r = 0; r < 16; ++r) pmax = fmaxf(pmax, p1[r]);
  { auto rr = __builtin_amdgcn_permlane32_swap(__float_as_uint(pmax), __float_as_uint(pmax), false, false);
    pmax = fmaxf(__uint_as_float(rr[0]), __uint_as_float(rr[1])); }
  if (__builtin_expect(__all(pmax - m_reg <= THR / SCALE), 1)) { mn = m_reg; alpha = 1.f; }
  else { mn = fmaxf(m_reg, pmax); alpha = __builtin_amdgcn_exp2f((m_reg - mn) * C); m_reg = mn; }
  const float mnC = -mn * C;
  { typedef float f32x2_ __attribute__((ext_vector_type(2))); const f32x2_ C2 = {C, C}, M2 = {mnC, mnC};
#pragma unroll
    for (int i = 0; i < 8; ++i) { f32x2_ a = {p0[2 * i], p0[2 * i + 1]}, b = {p1[2 * i], p1[2 * i + 1]}; a = a * C2 + M2; b = b * C2 + M2; p0[2 * i] = a.x; p0[2 * i + 1] = a.y; p1[2 * i] = b.x; p1[2 * i + 1] = b.y; } }
#pragma unroll
  for (int r = 0; r < 16; ++r) p0[r] = __builtin_amdgcn_exp2f(p0[r]);
}
__device__ __forceinline__ void finishSM(f32x16& p0, f32x16& p1, float alpha, float& l_reg, bf16x8& pa0, bf16x8& pa1, bf16x8& pa2, bf16x8& pa3) {
#pragma unroll
  for (int r = 0; r < 16; ++r) p1[r] = __builtin_amdgcn_exp2f(p1[r]);
  float ps;
  { typedef float f32x2_ __attribute__((ext_vector_type(2))); f32x2_ s0 = {0.f, 0.f}, s1 = {0.f, 0.f};
#pragma unroll
    for (int i = 0; i < 8; ++i) { const f32x2_ a = {p0[2 * i], p0[2 * i + 1]}; s0 += a; }
#pragma unroll
    for (int i = 0; i < 8; ++i) { const f32x2_ b = {p1[2 * i], p1[2 * i + 1]}; s1 += b; }
    s0 += s1; ps = s0.x + s0.y; }
  { auto rr = __builtin_amdgcn_permlane32_swap(__float_as_uint(ps), __float_as_uint(ps), false, false);
    ps = __uint_as_float(rr[0]) + __uint_as_float(rr[1]); }
  l_reg = l_reg * alpha + ps;
#define ATT_PK4(P, BASE, OUT) do { unsigned a0 = cvtpk(P[BASE + 0], P[BASE + 1]), a1 = cvtpk(P[BASE + 2], P[BASE + 3]);   \
    unsigned b0 = cvtpk(P[BASE + 4], P[BASE + 5]), b1 = cvtpk(P[BASE + 6], P[BASE + 7]);                              \
    auto r0 = __builtin_amdgcn_permlane32_swap(a0, b0, false, false); auto r1 = __builtin_amdgcn_permlane32_swap(a1, b1, false, false); \
    u32x4 w = {r0[0], r1[0], r0[1], r1[1]}; OUT = *reinterpret_cast<bf16x8*>(&w); } while (0)
  ATT_PK4(p0, 0, pa0); ATT_PK4(p0, 8, pa1); ATT_PK4(p1, 0, pa2); ATT_PK4(p1, 8, pa3);
#undef ATT_PK4
}
template <int DQ, int NREG>
__device__ __forceinline__ void qkt(f32x16& p0, f32x16& p1, const char* Ks, const bf16x8* qr, const char* qpark, int r32, int hi) {
  constexpr int ROWB = Cst<DQ>::ROWB;
  p0 = f32x16{}; p1 = f32x16{};
#pragma unroll
  for (int d0 = 0; d0 < DQ / 16; ++d0) { const int cb = (d0 * 16 + hi * 8) * 2;
    bf16x8 b0 = *reinterpret_cast<const bf16x8*>(Ks + (r32 * ROWB + (cb ^ ((r32 & 7) << 4))));
    bf16x8 b1 = *reinterpret_cast<const bf16x8*>(Ks + ((32 + r32) * ROWB + (cb ^ ((r32 & 7) << 4))));
    bf16x8 q; if constexpr (true) { if (d0 < NREG) q = qr[d0 < NREG ? d0 : 0]; else q = *reinterpret_cast<const bf16x8*>(qpark + (d0 - NREG) * 1024); }
    p0 = __builtin_amdgcn_mfma_f32_32x32x16_bf16(b0, q, p0, 0, 0, 0);
    p1 = __builtin_amdgcn_mfma_f32_32x32x16_bf16(b1, q, p1, 0, 0, 0); }
}
__device__ __forceinline__ int v_st(int k, int c) { const int kk = (k & ~0xC) | ((k & 4) << 1) | ((k & 8) >> 1); return ((kk >> 3) * 4 + (c >> 5)) * 512 + ((kk & 7) * 32 + (c & 31)) * 2; }
__device__ __forceinline__ int v_rd_base(int lane) { return ((lane & 3) << 3) | (((lane >> 2) & 3) << 6) | (((lane >> 4) & 1) << 5) | (((lane >> 5) & 1) << 8); }
constexpr int v_rd_off(int d0, int ks, int half) { return d0 * 512 + ks * 4096 + half * 2048; }
template <int OFF> __device__ __forceinline__ s16x4 tr_read(int vb) {
  s16x4 r; asm volatile("ds_read_b64_tr_b16 %0, %1 offset:%2" : "=&v"(r) : "v"(vb), "i"(OFF) : "memory"); return r;
}
template <int D0> __device__ __forceinline__ void pv_one(f32x16& od, int vb, bf16x8 pa0, bf16x8 pa1, bf16x8 pa2, bf16x8 pa3) {
  const s16x4 l0 = tr_read<v_rd_off(D0, 0, 0)>(vb), h0 = tr_read<v_rd_off(D0, 0, 1)>(vb), l1 = tr_read<v_rd_off(D0, 1, 0)>(vb), h1 = tr_read<v_rd_off(D0, 1, 1)>(vb);
  const s16x4 l2 = tr_read<v_rd_off(D0, 2, 0)>(vb), h2 = tr_read<v_rd_off(D0, 2, 1)>(vb), l3 = tr_read<v_rd_off(D0, 3, 0)>(vb), h3 = tr_read<v_rd_off(D0, 3, 1)>(vb);
  asm volatile("s_waitcnt lgkmcnt(0)" ::: "memory"); ATT_SBAR();
#define ATT_PK(L, H) (bf16x8){L[0], L[1], L[2], L[3], H[0], H[1], H[2], H[3]}
  od = __builtin_amdgcn_mfma_f32_32x32x16_bf16(pa0, ATT_PK(l0, h0), od, 0, 0, 0);
  od = __builtin_amdgcn_mfma_f32_32x32x16_bf16(pa1, ATT_PK(l1, h1), od, 0, 0, 0);
  od = __builtin_amdgcn_mfma_f32_32x32x16_bf16(pa2, ATT_PK(l2, h2), od, 0, 0, 0);
  od = __builtin_amdgcn_mfma_f32_32x32x16_bf16(pa3, ATT_PK(l3, h3), od, 0, 0, 0);
#undef ATT_PK
}
__device__ __forceinline__ void pv_d0(f32x16* o, int vb, bf16x8 pa0, bf16x8 pa1, bf16x8 pa2, bf16x8 pa3) {
  pv_one<0>(o[0], vb, pa0, pa1, pa2, pa3); pv_one<1>(o[1], vb, pa0, pa1, pa2, pa3); pv_one<2>(o[2], vb, pa0, pa1, pa2, pa3); pv_one<3>(o[3], vb, pa0, pa1, pa2, pa3);
}
__device__ __forceinline__ void natten_mod(f32x16& p0, f32x16& p1, int kr, int rq, int qc, const float* biasT, int hi) {
  const int r0 = min(max(rq - 4, 0), 56), c0 = min(max(qc - 8, 0), 48);
  const float NEG = -__builtin_inff();
  if (kr < r0 || kr >= r0 + 8) {
#pragma unroll
    for (int r = 0; r < 16; ++r) { p0[r] = NEG; p1[r] = NEG; }
  } else {
    const float* bl = biasT + (kr - rq + 7) * 128 + (63 - qc + 4 * hi);
    const int t = 4 * hi - c0;
#pragma unroll
    for (int r = 0; r < 16; ++r) {
      const int kcc = (r & 3) + 8 * (r >> 2);
      const bool ok0 = (unsigned)(t + kcc) < 16u, ok1 = (unsigned)(t + kcc + 32) < 16u;
      const float b0 = bl[kcc], b1 = bl[kcc + 32];
      p0[r] = ok0 ? p0[r] + b0 : NEG; p1[r] = ok1 ? p1[r] + b1 : NEG;
      if ((r & 3) == 3) __builtin_amdgcn_sched_barrier(0);
    }
  }
}

template <int DQ, int LDQ, int LDK, int LDV, int LDO, int MODE, int SDEPTH, int NREG>
__device__ __forceinline__ void attn_body(const bf16* __restrict__ Qb, const bf16* __restrict__ Kh, const bf16* __restrict__ Vh, bf16* __restrict__ Ob, const int NT, char* lds,
                                          const int rq0, const int kr_lo, const float* biasT) {
  constexpr int SHM_K = Cst<DQ>::SHM_K, ROWB = Cst<DQ>::ROWB;
  int tid_ = threadIdx.x; asm volatile("" : "+v"(tid_));
  const int tid = tid_, wid = tid >> 6, lane = tid & 63, r32 = lane & 31, hi = lane >> 5;
  char* V_lds = lds; char* K_lds = lds + 2 * SHM_V;
  float* ws = (float*)(lds + 2 * SHM_V + 2 * SHM_K) + wid * 64; float* li_l = ws; float* al_l = ws + 32;
  float m_reg = -1e30f, l_reg = 0; f32x16 o[4] = {}; bf16x8 qr[NREG > 0 ? NREG : 1];
  const bf16* Qw = Qb + (long)(wid * QBLK + r32) * LDQ + hi * 8;
  char* qpark = lds + 2 * SHM_V + 2 * SHM_K + NW * 64 * 4 + wid * ((DQ / 16 - NREG) * 1024) + hi * 512 + r32 * 16;
#pragma unroll
  for (int d0 = 0; d0 < DQ / 16; ++d0) { const bf16x8 qv = *reinterpret_cast<const bf16x8*>(Qw + d0 * 16); if (d0 < NREG) qr[d0 < NREG ? d0 : 0] = qv; else *reinterpret_cast<bf16x8*>(qpark + (d0 - NREG) * 1024) = qv; }
  const int nrq = rq0 + (wid >> 1), nqc = (wid & 1) * 32 + r32;
  const int sr = tid >> 4, sc = (tid & 15) * 8, vst0 = v_st(sr, sc), vst1 = v_st(32 + sr, sc);
  const int kr3 = tid >> 3, kc3 = 128 + (tid & 7) * 8;
  const int vb0 = (int)(uintptr_t)V_lds + v_rd_base(lane);
  struct { bf16x8 vs0, vs1, ks0, ks1, ks2; } sr_[SDEPTH];
#define ATT_LD8(p) (*reinterpret_cast<const bf16x8*>(p))
#define ATT_SLOAD(i, k0) do { sr_[i].vs0 = ATT_LD8(&Vh[(long)((k0) + sr) * LDV + sc]); sr_[i].vs1 = ATT_LD8(&Vh[(long)((k0) + 32 + sr) * LDV + sc]); \
    sr_[i].ks0 = ATT_LD8(&Kh[(long)((k0) + sr) * LDK + sc]); sr_[i].ks1 = ATT_LD8(&Kh[(long)((k0) + 32 + sr) * LDK + sc]); \
    if constexpr (DQ == 192) sr_[i].ks2 = ATT_LD8(&Kh[(long)((k0) + kr3) * LDK + kc3]); } while (0)
#define ATT_SWRITE(b, i) do { *(bf16x8*)(V_lds + (b) * SHM_V + vst0) = sr_[i].vs0;          \
    *(bf16x8*)(V_lds + (b) * SHM_V + vst1) = sr_[i].vs1; const int kc = sc * 2;               \
    *(bf16x8*)(K_lds + (b) * SHM_K + sr * ROWB + (kc ^ ((sr & 7) << 4))) = sr_[i].ks0;                       \
    *(bf16x8*)(K_lds + (b) * SHM_K + (32 + sr) * ROWB + (kc ^ ((sr & 7) << 4))) = sr_[i].ks1; \
    if constexpr (DQ == 192) *(bf16x8*)(K_lds + (b) * SHM_K + kr3 * ROWB + ((kc3 * 2) ^ ((kr3 & 7) << 4))) = sr_[i].ks2; } while (0)
#define ATT_SWAIT() do { if constexpr (SDEPTH == 2) { if constexpr (DQ == 192) asm volatile("s_waitcnt vmcnt(5)" ::: "memory"); else asm volatile("s_waitcnt vmcnt(4)" ::: "memory"); } \
    else asm volatile("s_waitcnt vmcnt(0)" ::: "memory"); } while (0)
#define ATT_RESC(a) do { if (__any((a) < 1.f)) { if (hi == 0) al_l[r32] = (a); asm volatile("s_waitcnt lgkmcnt(0)" ::: "memory"); \
    _Pragma("unroll") for (int d = 0; d < 4; ++d) _Pragma("unroll") for (int r = 0; r < 16; ++r) o[d][r] *= al_l[crow(r, hi)]; } } while (0)
#define ATT_MOD(P0, P1, J) do { if constexpr (MODE == 1) natten_mod(P0, P1, kr_lo + (J), nrq, nqc, biasT, hi); } while (0)
  f32x16 pA0, pA1, pB0, pB1; float mnA, mnB, alA, alB; bf16x8 pa0, pa1, pa2, pa3;
  constexpr int SE = 0, SO = SDEPTH - 1;
  ATT_SLOAD(SE, 0); asm volatile("s_waitcnt vmcnt(0)" ::: "memory"); ATT_SWRITE(0, SE); __syncthreads();
  qkt<DQ, NREG>(pA0, pA1, K_lds, qr, qpark, r32, hi); ATT_MOD(pA0, pA1, 0); partialSM<DQ>(pA0, pA1, m_reg, mnA, alA);
  ATT_SLOAD(SO, KVBLK); if constexpr (SDEPTH == 2) { if (2 < NT) ATT_SLOAD(SE, 2 * KVBLK); }
  ATT_SWAIT(); ATT_SWRITE(1, SO); __syncthreads();
  for (int j = 1; j + 1 < NT; j += 2) {
    ATT_SBAR(); ATT_IGLP(); qkt<DQ, NREG>(pB0, pB1, K_lds + SHM_K, qr, qpark, r32, hi); ATT_MOD(pB0, pB1, j);
    finishSM(pA0, pA1, alA, l_reg, pa0, pa1, pa2, pa3); ATT_SBAR();
    ATT_SLOAD(SO, (j + SDEPTH) * KVBLK); ATT_SBAR();
    pv_d0(o, vb0, pa0, pa1, pa2, pa3); partialSM<DQ>(pB0, pB1, m_reg, mnB, alB);
    __syncthreads(); ATT_SWAIT(); ATT_SWRITE(0, SE);
    ATT_RESC(alB); __syncthreads();
    ATT_SBAR(); ATT_IGLP(); qkt<DQ, NREG>(pA0, pA1, K_lds, qr, qpark, r32, hi); ATT_MOD(pA0, pA1, j + 1);
    finishSM(pB0, pB1, alB, l_reg, pa0, pa1, pa2, pa3); ATT_SBAR();
    if (SDEPTH == 1 || j + 3 < NT) ATT_SLOAD(SE, (j + 1 + SDEPTH) * KVBLK); ATT_SBAR();
    pv_d0(o, vb0 + SHM_V, pa0, pa1, pa2, pa3); partialSM<DQ>(pA0, pA1, m_reg, mnA, alA);
    __syncthreads(); ATT_SWAIT(); ATT_SWRITE(1, SO);
    ATT_RESC(alA); __syncthreads();
  }
  ATT_SBAR(); qkt<DQ, NREG>(pB0, pB1, K_lds + SHM_K, qr, qpark, r32, hi); ATT_MOD(pB0, pB1, NT - 1);
  finishSM(pA0, pA1, alA, l_reg, pa0, pa1, pa2, pa3); ATT_SBAR();
  pv_d0(o, vb0, pa0, pa1, pa2, pa3); partialSM<DQ>(pB0, pB1, m_reg, mnB, alB);
  __syncthreads(); ATT_RESC(alB);
  finishSM(pB0, pB1, alB, l_reg, pa0, pa1, pa2, pa3); ATT_SBAR();
  pv_d0(o, vb0 + SHM_V, pa0, pa1, pa2, pa3);
  if (hi == 0) li_l[r32] = l_reg; asm volatile("s_waitcnt lgkmcnt(0)" ::: "memory");
  float rli[16];
#pragma unroll
  for (int r = 0; r < 16; ++r) rli[r] = __builtin_amdgcn_rcpf(li_l[crow(r, hi)]);
  bf16* Ow = Ob + (long)(wid * QBLK) * LDO;
#pragma unroll
  for (int r = 0; r < 16; ++r) { const int orow = crow(r, hi);
#pragma unroll
    for (int d0 = 0; d0 < 4; d0 += 1) { const unsigned w = cvtpk(o[d0][r] * rli[r], 0.f); Ow[(long)orow * LDO + d0 * 32 + r32] = (bf16)(w & 0xffffu); } }
#undef ATT_LD8
#undef ATT_SLOAD
#undef ATT_SWRITE
#undef ATT_SWAIT
#undef ATT_RESC
#undef ATT_MOD
}

template <int DQ, int LDQ, int LDK, int LDV, int LDO, int MODE, int SD, int NREG>
__device__ __forceinline__ void attn_body3(const bf16* __restrict__ Qb, const bf16* __restrict__ Kh, const bf16* __restrict__ Vh, bf16* __restrict__ Ob, const int NT, char* lds,
                                           const int rq0, const int kr_lo, const float* biasT) {
  constexpr int SHM_K = Cst<DQ>::SHM_K, ROWB = Cst<DQ>::ROWB;
  int tid_ = threadIdx.x; asm volatile("" : "+v"(tid_));
  const int tid = tid_, wid = tid >> 6, lane = tid & 63, r32 = lane & 31, hi = lane >> 5;
  char* V_lds = lds; char* K_lds = lds + 3 * SHM_V;
  float* ws = (float*)(lds + 3 * SHM_V + 3 * SHM_K) + wid * 64; float* li_l = ws; float* al_l = ws + 32;
  float m_reg = -1e30f, l_reg = 0; f32x16 o[4] = {}; bf16x8 qr[NREG > 0 ? NREG : 1];
  const bf16* Qw = Qb + (long)(wid * QBLK + r32) * LDQ + hi * 8;
  char* qpark = lds + 3 * SHM_V + 3 * SHM_K + NW * 64 * 4 + wid * ((DQ / 16 - NREG) * 1024) + hi * 512 + r32 * 16;
#pragma unroll
  for (int d0 = 0; d0 < DQ / 16; ++d0) { const bf16x8 qv = *reinterpret_cast<const bf16x8*>(Qw + d0 * 16); if (d0 < NREG) qr[d0 < NREG ? d0 : 0] = qv; else *reinterpret_cast<bf16x8*>(qpark + (d0 - NREG) * 1024) = qv; }
  const int nrq = rq0 + (wid >> 1), nqc = (wid & 1) * 32 + r32;
  const int sr = tid >> 4, sc = (tid & 15) * 8, vst0 = v_st(sr, sc), vst1 = v_st(32 + sr, sc);
  const int kr3 = tid >> 3, kc3 = 128 + (tid & 7) * 8;
  const int vb0 = (int)(uintptr_t)V_lds + v_rd_base(lane);
  struct { bf16x8 vs0, vs1, ks0, ks1, ks2; } sr_[SD];
  const __amdgpu_buffer_rsrc_t rK = __builtin_amdgcn_make_buffer_rsrc((void*)Kh, 0, 0x7fffffff, 0x00020000), rV = __builtin_amdgcn_make_buffer_rsrc((void*)Vh, 0, 0x7fffffff, 0x00020000);
  const int vo_v = (sr * LDV + sc) * 2, vo_k = (sr * LDK + sc) * 2, vo_k3 = (kr3 * LDK + kc3) * 2; (void)vo_k3;
#define ATT_LD8(p) (*reinterpret_cast<const bf16x8*>(p))
#define ATT_BL(R, VO, SO) __builtin_bit_cast(bf16x8, __builtin_amdgcn_raw_buffer_load_b128(R, VO, SO, 0))
#define ATT_SLOAD(i, k0) do { const int sv_ = (k0) * (LDV * 2), sk_ = (k0) * (LDK * 2);    \
    sr_[i].vs0 = ATT_BL(rV, vo_v, sv_); sr_[i].vs1 = ATT_BL(rV, vo_v + 32 * LDV * 2, sv_); \
    sr_[i].ks0 = ATT_BL(rK, vo_k, sk_); sr_[i].ks1 = ATT_BL(rK, vo_k + 32 * LDK * 2, sk_); \
    if constexpr (DQ == 192) sr_[i].ks2 = ATT_BL(rK, vo_k3, sk_); } while (0)
#define ATT_SWRITE(b, i) do { const int b_ = (b); *(bf16x8*)(V_lds + b_ * SHM_V + vst0) = sr_[i].vs0;          \
    *(bf16x8*)(V_lds + b_ * SHM_V + vst1) = sr_[i].vs1; const int kc = sc * 2;               \
    *(bf16x8*)(K_lds + b_ * SHM_K + sr * ROWB + (kc ^ ((sr & 7) << 4))) = sr_[i].ks0;                       \
    *(bf16x8*)(K_lds + b_ * SHM_K + (32 + sr) * ROWB + (kc ^ ((sr & 7) << 4))) = sr_[i].ks1; \
    if constexpr (DQ == 192) *(bf16x8*)(K_lds + b_ * SHM_K + kr3 * ROWB + ((kc3 * 2) ^ ((kr3 & 7) << 4))) = sr_[i].ks2; } while (0)
#define ATT_RESC(a) do { if (__any((a) < 1.f)) { if (hi == 0) al_l[r32] = (a); asm volatile("s_waitcnt lgkmcnt(0)" ::: "memory"); \
    _Pragma("unroll") for (int d = 0; d < 4; ++d) _Pragma("unroll") for (int r = 0; r < 16; ++r) o[d][r] *= al_l[crow(r, hi)]; } } while (0)
#define ATT_MOD(P0, P1, J) do { if constexpr (MODE == 1) natten_mod(P0, P1, kr_lo + (J), nrq, nqc, biasT, hi); } while (0)
#define ATT_SET(x) ((SD == 2) ? ((x) & 1) : 0)
  f32x16 pA0, pA1, pB0, pB1; float mnA, mnB, alA, alB; bf16x8 pa0, pa1, pa2, pa3;
  ATT_SLOAD(0, 0); asm volatile("s_waitcnt vmcnt(0)" ::: "memory"); ATT_SWRITE(0, 0);
  ATT_SLOAD(ATT_SET(1), KVBLK); if constexpr (SD == 2) { if (2 < NT) ATT_SLOAD(0, 2 * KVBLK); }
  __syncthreads();
  ATT_SWRITE(1, ATT_SET(1));
  ATT_SBAR(); qkt<DQ, NREG>(pA0, pA1, K_lds, qr, qpark, r32, hi); ATT_MOD(pA0, pA1, 0); ATT_SBAR();
  if (1 + SD < NT) ATT_SLOAD(ATT_SET(1 + SD), (1 + SD) * KVBLK);
  ATT_SBAR(); partialSM<DQ>(pA0, pA1, m_reg, mnA, alA);
  __syncthreads();
  int bt = 1;
  for (int t = 1; t + 1 < NT; t += 2) {
    const int bn = (bt == 2) ? 0 : bt + 1, bp = (bt == 0) ? 2 : bt - 1;
    ATT_SWRITE(bn, ATT_SET(0));
    ATT_SBAR(); qkt<DQ, NREG>(pB0, pB1, K_lds + bt * SHM_K, qr, qpark, r32, hi); ATT_MOD(pB0, pB1, t);
    finishSM(pA0, pA1, alA, l_reg, pa0, pa1, pa2, pa3); ATT_SBAR();
    if (t + 1 + SD < NT) ATT_SLOAD(ATT_SET(0), (t + 1 + SD) * KVBLK);
    ATT_SBAR();
    pv_d0(o, vb0 + bp * SHM_V, pa0, pa1, pa2, pa3); partialSM<DQ>(pB0, pB1, m_reg, mnB, alB);
    ATT_RESC(alB); __syncthreads();
    if (t + 2 < NT) ATT_SWRITE(bp, ATT_SET(1));
    ATT_SBAR(); qkt<DQ, NREG>(pA0, pA1, K_lds + bn * SHM_K, qr, qpark, r32, hi); ATT_MOD(pA0, pA1, t + 1);
    finishSM(pB0, pB1, alB, l_reg, pa0, pa1, pa2, pa3); ATT_SBAR();
    if (t + 2 + SD < NT) ATT_SLOAD(ATT_SET(1), (t + 2 + SD) * KVBLK);
    ATT_SBAR();
    pv_d0(o, vb0 + bt * SHM_V, pa0, pa1, pa2, pa3); partialSM<DQ>(pA0, pA1, m_reg, mnA, alA);
    ATT_RESC(alA); __syncthreads();
    bt = bp;
  }
  {
    const int bp = (bt == 0) ? 2 : bt - 1;
    ATT_SBAR(); qkt<DQ, NREG>(pB0, pB1, K_lds + bt * SHM_K, qr, qpark, r32, hi); ATT_MOD(pB0, pB1, NT - 1);
    finishSM(pA0, pA1, alA, l_reg, pa0, pa1, pa2, pa3); ATT_SBAR();
    pv_d0(o, vb0 + bp * SHM_V, pa0, pa1, pa2, pa3); partialSM<DQ>(pB0, pB1, m_reg, mnB, alB);
    ATT_RESC(alB);
    finishSM(pB0, pB1, alB, l_reg, pa0, pa1, pa2, pa3); ATT_SBAR();
    pv_d0(o, vb0 + bt * SHM_V, pa0, pa1, pa2, pa3);
  }
  if (hi == 0) li_l[r32] = l_reg; asm volatile("s_waitcnt lgkmcnt(0)" ::: "memory");
  float rli[16];
#pragma unroll
  for (int r = 0; r < 16; ++r) rli[r] = __builtin_amdgcn_rcpf(li_l[crow(r, hi)]);
  bf16* Ow = Ob + (long)(wid * QBLK) * LDO;
#pragma unroll
  for (int r = 0; r < 16; ++r) { const int orow = crow(r, hi);
#pragma unroll
    for (int d0 = 0; d0 < 4; d0 += 1) { const unsigned w = cvtpk(o[d0][r] * rli[r], 0.f); Ow[(long)orow * LDO + d0 * 32 + r32] = (bf16)(w & 0xffffu); } }
  __syncthreads();
#undef ATT_LD8
#undef ATT_BL
#undef ATT_SLOAD
#undef ATT_SWRITE
#undef ATT_RESC
#undef ATT_MOD
#undef ATT_SET
}

template <int DQ, int LDQ, int LDK, int LDV, int LDO, int NTS, int SD, int NREG>
__device__ __forceinline__ void attn_body3s(const bf16* __restrict__ Qb, const bf16* __restrict__ Kh, const bf16* __restrict__ Vh, bf16* __restrict__ Ob, char* lds) {
  static_assert((NTS - 4) % 6 == 0 && NTS >= 4, "tile count");
  constexpr int SHM_K = Cst<DQ>::SHM_K, ROWB = Cst<DQ>::ROWB;
  int tid_ = threadIdx.x; asm volatile("" : "+v"(tid_));
  const int tid = tid_, wid = tid >> 6, lane = tid & 63, r32 = lane & 31, hi = lane >> 5;
  char* V_lds = lds; char* K_lds = lds + 3 * SHM_V;
  float* ws = (float*)(lds + 3 * SHM_V + 3 * SHM_K) + wid * 64; float* li_l = ws; float* al_l = ws + 32;
  float m_reg = -1e30f, l_reg = 0; f32x16 o[4] = {}; bf16x8 qr[NREG > 0 ? NREG : 1];
  const bf16* Qw = Qb + (long)(wid * QBLK + r32) * LDQ + hi * 8;
  char* qpark = lds + 3 * SHM_V + 3 * SHM_K + NW * 64 * 4 + wid * ((DQ / 16 - NREG) * 1024) + hi * 512 + r32 * 16;
#pragma unroll
  for (int d0 = 0; d0 < DQ / 16; ++d0) { const bf16x8 qv = *reinterpret_cast<const bf16x8*>(Qw + d0 * 16); if (d0 < NREG) qr[d0 < NREG ? d0 : 0] = qv; else *reinterpret_cast<bf16x8*>(qpark + (d0 - NREG) * 1024) = qv; }
  const int sr = tid >> 4, sc = (tid & 15) * 8, vst0 = v_st(sr, sc), vst1 = v_st(32 + sr, sc);
  const int kr3 = tid >> 3, kc3 = 128 + (tid & 7) * 8;
  const int vb0 = (int)(uintptr_t)V_lds + v_rd_base(lane);
  struct { bf16x8 vs0, vs1, ks0, ks1, ks2; } sr_[SD];
  const __amdgpu_buffer_rsrc_t rK = __builtin_amdgcn_make_buffer_rsrc((void*)Kh, 0, 0x7fffffff, 0x00020000), rV = __builtin_amdgcn_make_buffer_rsrc((void*)Vh, 0, 0x7fffffff, 0x00020000);
  const int vo_v = (sr * LDV + sc) * 2, vo_k = (sr * LDK + sc) * 2, vo_k3 = (kr3 * LDK + kc3) * 2; (void)vo_k3;
#define ATT_LD8(p) (*reinterpret_cast<const bf16x8*>(p))
#define ATT_BL(R, VO, SO) __builtin_bit_cast(bf16x8, __builtin_amdgcn_raw_buffer_load_b128(R, VO, SO, 0))
#define ATT_SLOAD(i, k0) do { const int sv_ = (k0) * (LDV * 2), sk_ = (k0) * (LDK * 2);    \
    sr_[i].vs0 = ATT_BL(rV, vo_v, sv_); sr_[i].vs1 = ATT_BL(rV, vo_v + 32 * LDV * 2, sv_); \
    sr_[i].ks0 = ATT_BL(rK, vo_k, sk_); sr_[i].ks1 = ATT_BL(rK, vo_k + 32 * LDK * 2, sk_); \
    if constexpr (DQ == 192) sr_[i].ks2 = ATT_BL(rK, vo_k3, sk_); } while (0)
#define ATT_SWRITE(b, i) do { *(bf16x8*)(V_lds + (b) * SHM_V + vst0) = sr_[i].vs0;          \
    *(bf16x8*)(V_lds + (b) * SHM_V + vst1) = sr_[i].vs1; const int kc = sc * 2;               \
    *(bf16x8*)(K_lds + (b) * SHM_K + sr * ROWB + (kc ^ ((sr & 7) << 4))) = sr_[i].ks0;                       \
    *(bf16x8*)(K_lds + (b) * SHM_K + (32 + sr) * ROWB + (kc ^ ((sr & 7) << 4))) = sr_[i].ks1; \
    if constexpr (DQ == 192) *(bf16x8*)(K_lds + (b) * SHM_K + kr3 * ROWB + ((kc3 * 2) ^ ((kr3 & 7) << 4))) = sr_[i].ks2; } while (0)
#define ATT_RESC(a) do { if (__any((a) < 1.f)) { if (hi == 0) al_l[r32] = (a); asm volatile("s_waitcnt lgkmcnt(0)" ::: "memory"); \
    _Pragma("unroll") for (int d = 0; d < 4; ++d) _Pragma("unroll") for (int r = 0; r < 16; ++r) o[d][r] *= al_l[crow(r, hi)]; } } while (0)
#define ATT_SET(x) ((SD == 2) ? ((x) & 1) : 0)
#define ATT_TILE(C0, C1, mnC, alC, P0, P1, alP, BC, BN, BP, PAR, T) do {                                                         \
    if ((T) + 1 < NTS) ATT_SWRITE(BN, ATT_SET(PAR));                                                                              \
    ATT_SBAR(); qkt<DQ, NREG>(C0, C1, K_lds + (BC) * SHM_K, qr, qpark, r32, hi);                                                  \
    finishSM(P0, P1, alP, l_reg, pa0, pa1, pa2, pa3); ATT_SBAR();                                                                 \
    if ((T) + 1 + SD < NTS) ATT_SLOAD(ATT_SET(PAR), ((T) + 1 + SD) * KVBLK);                                                      \
    ATT_SBAR(); pv_d0(o, vb0 + (BP) * SHM_V, pa0, pa1, pa2, pa3); partialSM<DQ>(C0, C1, m_reg, mnC, alC);                         \
    ATT_RESC(alC); __syncthreads(); } while (0)
  f32x16 pA0, pA1, pB0, pB1; float mnA, mnB, alA, alB; bf16x8 pa0, pa1, pa2, pa3;
  ATT_SLOAD(0, 0); asm volatile("s_waitcnt vmcnt(0)" ::: "memory"); ATT_SWRITE(0, 0);
  ATT_SLOAD(ATT_SET(1), KVBLK); if constexpr (SD == 2) ATT_SLOAD(0, 2 * KVBLK);
  __syncthreads();
  ATT_SWRITE(1, ATT_SET(1));
  ATT_SBAR(); qkt<DQ, NREG>(pA0, pA1, K_lds, qr, qpark, r32, hi); ATT_SBAR();
  ATT_SLOAD(ATT_SET(1 + SD), (1 + SD) * KVBLK);
  ATT_SBAR(); partialSM<DQ>(pA0, pA1, m_reg, mnA, alA);
  __syncthreads();
  for (int t = 1; t + 5 < NTS; t += 6) {
    ATT_TILE(pB0, pB1, mnB, alB, pA0, pA1, alA, 1, 2, 0, 0, t);
    ATT_TILE(pA0, pA1, mnA, alA, pB0, pB1, alB, 2, 0, 1, 1, t + 1);
    ATT_TILE(pB0, pB1, mnB, alB, pA0, pA1, alA, 0, 1, 2, 0, t + 2);
    ATT_TILE(pA0, pA1, mnA, alA, pB0, pB1, alB, 1, 2, 0, 1, t + 3);
    ATT_TILE(pB0, pB1, mnB, alB, pA0, pA1, alA, 2, 0, 1, 0, t + 4);
    ATT_TILE(pA0, pA1, mnA, alA, pB0, pB1, alB, 0, 1, 2, 1, t + 5);
  }
  ATT_TILE(pB0, pB1, mnB, alB, pA0, pA1, alA, 1, 2, 0, 0, NTS - 3);
  ATT_TILE(pA0, pA1, mnA, alA, pB0, pB1, alB, 2, 0, 1, 1, NTS - 2);
  {
    ATT_SBAR(); qkt<DQ, NREG>(pB0, pB1, K_lds, qr, qpark, r32, hi);
    finishSM(pA0, pA1, alA, l_reg, pa0, pa1, pa2, pa3); ATT_SBAR();
    pv_d0(o, vb0 + 2 * SHM_V, pa0, pa1, pa2, pa3); partialSM<DQ>(pB0, pB1, m_reg, mnB, alB);
    ATT_RESC(alB);
    finishSM(pB0, pB1, alB, l_reg, pa0, pa1, pa2, pa3); ATT_SBAR();
    pv_d0(o, vb0, pa0, pa1, pa2, pa3);
  }
  if (hi == 0) li_l[r32] = l_reg; asm volatile("s_waitcnt lgkmcnt(0)" ::: "memory");
  float rli[16];
#pragma unroll
  for (int r = 0; r < 16; ++r) rli[r] = __builtin_amdgcn_rcpf(li_l[crow(r, hi)]);
  bf16* Ow = Ob + (long)(wid * QBLK) * LDO;
#pragma unroll
  for (int r = 0; r < 16; ++r) { const int orow = crow(r, hi);
#pragma unroll
    for (int d0 = 0; d0 < 4; d0 += 1) { const unsigned w = cvtpk(o[d0][r] * rli[r], 0.f); Ow[(long)orow * LDO + d0 * 32 + r32] = (bf16)(w & 0xffffu); } }
  __syncthreads();
#undef ATT_TILE
#undef ATT_LD8
#undef ATT_BL
#undef ATT_SLOAD
#undef ATT_SWRITE
#undef ATT_RESC
#undef ATT_SET
}
}
#ifndef ATT_RING3
#define ATT_RING3 7
#endif
#if ATT_RING3 & 1
#define ATT_BODY_C attn_body3
#else
#define ATT_BODY_C attn_body
#endif
#if ATT_RING3 & 2
#define ATT_BODY_B attn_body3
#else
#define ATT_BODY_B attn_body
#endif
#if ATT_RING3 & 4
#define ATT_BODY_A attn_body3
#else
#define ATT_BODY_A attn_body
#endif

#ifndef PH_MASK
#define PH_MASK 0xFFFFFFFFu
#endif
#define PHON(k) (((PH_MASK) >> (k)) & 1u)
#ifndef REP_MASK
#define REP_MASK 0u
#endif
#define REP(k) (((REP_MASK) >> (k)) & 1u)
#ifndef FFN_F8
#define FFN_F8 7
#endif
#ifndef MOE_CVT_IN_ATTN
#define MOE_CVT_IN_ATTN 3
#endif
#ifndef WOUT_F8
#define WOUT_F8 0
#endif
constexpr bool F8WO = WOUT_F8 != 0;
constexpr bool F8DG = (FFN_F8 & 1) != 0, F8DD = (FFN_F8 & 4) != 0, F8M = (FFN_F8 & 2) != 0;
constexpr float SC_H = 4.f, SC_ACT = 8.f, SC_W = 256.f;
constexpr int NWAVES = 8;
constexpr int DM = 2048, BATCH = 4, SEQ = 4096, NTOK = BATCH * SEQ, DEPTH = 2;
constexpr int DIN = 3904, DINP = 4096;
constexpr int DFF = 5632, NE = 8, DFE = 7168;
constexpr int PC_QA = 0, PC_KA = 512, PC_VA = 1024, PC_QB = 1536, PC_KB = 2560, PC_VB = 2816, PC_CQ = 3072, PC_CKV = 3584, PC_KPE = 3840;
constexpr float EPS = 1e-6f;
constexpr int MAXTILES = 136;
constexpr int MAXSLOTS = MAXTILES * 256;

constexpr size_t MiB = 1u << 20;
constexpr size_t WS_CTL = 0, CTL_ZERO_BYTES = 1 * MiB;
constexpr size_t WS_WIN = 1 * MiB;
constexpr size_t WS_WUQ = WS_WIN + 32 * MiB;
constexpr size_t WS_WUKV = WS_WUQ + 2 * MiB;
constexpr size_t WS_WOUT = WS_WUKV + 1 * MiB;
constexpr size_t WS_WGU = WS_WOUT + 16 * MiB;
constexpr size_t WS_WD = WS_WGU + 44 * MiB;
constexpr size_t WS_WEGU = WS_WD + 22 * MiB;
constexpr size_t WS_WED = WS_WEGU + 448 * MiB;
constexpr size_t WS_H = WS_WED + 224 * MiB;
constexpr size_t WS_ACT0 = WS_H + 64 * MiB;
constexpr size_t WS_PROJ = WS_ACT0;
constexpr size_t WS_QA = WS_PROJ + 128 * MiB;
constexpr size_t WS_KA = WS_QA + 16 * MiB;
constexpr size_t WS_QB = WS_KA + 16 * MiB;
constexpr size_t WS_KB = WS_QB + 32 * MiB;
constexpr size_t WS_CQN = WS_KB + 8 * MiB;
constexpr size_t WS_CKVN = WS_CQN + 16 * MiB;
constexpr size_t WS_KPE = WS_CKVN + 8 * MiB;
constexpr size_t WS_QCR = WS_KPE + 2 * MiB;
constexpr size_t WS_KVR = WS_QCR + 24 * MiB;
constexpr size_t WS_QC = WS_KVR + 32 * MiB;
constexpr size_t WS_KC = WS_QC + 24 * MiB;
constexpr size_t WS_O = WS_KC + 24 * MiB;
constexpr size_t WS_ON = WS_O + 64 * MiB;
constexpr size_t WS_ATT_END = WS_ON + 64 * MiB;
constexpr size_t WS_ACT = WS_ACT0;
constexpr size_t WS_HG = WS_ACT0;
constexpr size_t WS_ACTM = WS_HG + 136 * MiB;
constexpr size_t WS_Y = WS_ACTM + 476 * MiB;
constexpr size_t WS_RGATE = WS_Y + 136 * MiB;
constexpr size_t WS_TOKE = WS_RGATE + 1 * MiB;
constexpr size_t WS_TOKP = WS_TOKE + 1 * MiB;
constexpr size_t WS_TOKW = WS_TOKP + 1 * MiB;
constexpr size_t WS_END = WS_TOKW + 1 * MiB;
constexpr size_t WS_XB = WS_END;
constexpr size_t WS_END2 = WS_XB + 64 * MiB;
constexpr size_t WS_PART = WS_END2;
constexpr size_t WS_END3 = WS_PART + 64 * MiB;
constexpr size_t WS_DUMMY = WS_END3;
static_assert(WS_ATT_END <= WS_END, "map");
constexpr int CW_CNT = 64;
constexpr int CW_CQ = 128;
constexpr int CW_AQ = 8192;
constexpr int CW_BAR = 4096;

constexpr int RING_BYTES = 131072;
constexpr int LDS_BYTES = 163840;
constexpr int MISC_OFF = LDS_BYTES - 256;

#define GAS __attribute__((address_space(1)))
#define LAS __attribute__((address_space(3)))
typedef unsigned short bf16;
typedef unsigned v4u __attribute__((ext_vector_type(4)));
typedef unsigned v2u __attribute__((ext_vector_type(2)));
typedef float f32x4 __attribute__((ext_vector_type(4)));
typedef float f32x2 __attribute__((ext_vector_type(2)));
__device__ __forceinline__ unsigned pk2(float lo, float hi) { unsigned r; asm volatile("v_cvt_pk_bf16_f32 %0, %1, %2" : "=v"(r) : "v"(lo), "v"(hi)); return r; }
__device__ __forceinline__ float bf_lo(unsigned w) { return __uint_as_float(w << 16); }
__device__ __forceinline__ float bf_hi(unsigned w) { return __uint_as_float(w & 0xffff0000u); }
#define WS_DPP_STEP(v, CTRL) do { const int x_ = __builtin_bit_cast(int, v); v += __builtin_bit_cast(float, __builtin_amdgcn_update_dpp(x_, x_, CTRL, 0xF, 0xF, false)); } while (0)
__device__ __forceinline__ float row16_sum(float v) { WS_DPP_STEP(v, 0xB1); WS_DPP_STEP(v, 0x4E); WS_DPP_STEP(v, 0x141); WS_DPP_STEP(v, 0x140); return v; }
__device__ __forceinline__ float wave_sum(float v) {
    v = row16_sum(v);
    { auto rr = __builtin_amdgcn_permlane16_swap(__float_as_uint(v), __float_as_uint(v), false, false); v = __uint_as_float(rr[0]) + __uint_as_float(rr[1]); }
    { auto rr = __builtin_amdgcn_permlane32_swap(__float_as_uint(v), __float_as_uint(v), false, false); v = __uint_as_float(rr[0]) + __uint_as_float(rr[1]); }
    return v;
}
__device__ __forceinline__ float rsq(float x) { return __builtin_amdgcn_rsqf(x); }
#define XB_TMO      128
#define XB_XCNT(j)  (256  + 64 * (j))
#define XB_XSUB(j)  (1280 + 64 * (j))
#define XB_XGEN(j)  (2304 + 64 * (j))
#define XB_TOP      3328
#define XB_TOPGEN   3392
#define XCD_BAR_WORDS 3456
#define XB_SPIN_CAP (1u << 18)

__device__ __forceinline__ unsigned xb_ld(unsigned* p)              { return __hip_atomic_load(p, __ATOMIC_RELAXED, __HIP_MEMORY_SCOPE_AGENT); }
__device__ __forceinline__ unsigned xb_add(unsigned* p, unsigned v) { return __hip_atomic_fetch_add(p, v, __ATOMIC_RELAXED, __HIP_MEMORY_SCOPE_AGENT); }
__device__ __forceinline__ unsigned xb_xcc_id() { return (unsigned)__builtin_amdgcn_s_getreg((3 << 11) | 20) & 0xFu; }
#define XB_SPIN(cond, bar) do { unsigned _sp = 0; while (cond) { __builtin_amdgcn_s_sleep(1); \
    if ((++_sp & 255u) == 0u) { if (xb_ld(&(bar)[XB_TMO])) break; if (_sp > XB_SPIN_CAP) { atomicAdd(&(bar)[XB_TMO], 1u); break; } } } } while (0)

struct XcdBarrier {
    unsigned* bar; unsigned x;
    volatile LAS unsigned* st;
};

__device__ __forceinline__ XcdBarrier xcd_barrier_post(unsigned* bar, volatile LAS unsigned* st) {
    XcdBarrier b; b.bar = bar; b.x = xb_xcc_id(); b.st = st;
    if (threadIdx.x == 0) (void)xb_add(&bar[XB_XCNT(b.x)], 1u);
    return b;
}
__device__ __forceinline__ void xcd_barrier_complete(unsigned* bar, unsigned x, unsigned& nloc, unsigned& nx) {
    const unsigned G = gridDim.x * gridDim.y * gridDim.z;
    unsigned sum, cnt, mine, sp = 0u;
    for (;;) {
        sum = 0u; cnt = 0u; mine = 0u;
#pragma unroll
        for (unsigned j = 0; j < 16; ++j) { const unsigned c = xb_ld(&bar[XB_XCNT(j)]); sum += c; cnt += (c > 0u) ? 1u : 0u; mine = (j == x) ? c : mine; }
        if (sum == G) break;
        __builtin_amdgcn_s_sleep(1);
        if ((++sp & 255u) == 0u) { if (xb_ld(&bar[XB_TMO])) break; if (sp > XB_SPIN_CAP) { atomicAdd(&bar[XB_TMO], 1u); break; } }
    }
    nloc = mine > 0u ? mine : 1u; nx = cnt > 0u ? cnt : 1u;
}

__device__ __forceinline__ void xcd_barrier(const XcdBarrier& b) {
    asm volatile("s_waitcnt vmcnt(0)" ::: "memory");
    __syncthreads();
    if (threadIdx.x == 0) {
        unsigned* bar = b.bar;
        __builtin_amdgcn_s_waitcnt(0);
        unsigned nloc = b.st[0], nx = b.st[1];
        if (nloc == 0u) { xcd_barrier_complete(bar, b.x, nloc, nx); b.st[0] = nloc; b.st[1] = nx; }
        const unsigned old = xb_add(&bar[XB_XSUB(b.x)], 1u);
        const unsigned gen = old / nloc;
        if (old + 1u == (gen + 1u) * nloc) {
            __builtin_amdgcn_fence(__ATOMIC_RELEASE, "agent");
            asm volatile("s_waitcnt vmcnt(0)" ::: "memory");
            const unsigned og = xb_add(&bar[XB_TOP], 1u);
            const unsigned tg = og / nx;
            if (og + 1u == (tg + 1u) * nx) xb_add(&bar[XB_TOPGEN], 1u);
            else XB_SPIN(xb_ld(&bar[XB_TOPGEN]) == tg, bar);
            __builtin_amdgcn_fence(__ATOMIC_ACQUIRE, "agent");
            xb_add(&bar[XB_XGEN(b.x)], 1u);
            asm volatile("s_waitcnt vmcnt(0)" ::: "memory");
        } else {
            XB_SPIN(xb_ld(&bar[XB_XGEN(b.x)]) == gen, bar);
            __builtin_amdgcn_fence(__ATOMIC_ACQUIRE, "agent");
            asm volatile("s_waitcnt vmcnt(0)" ::: "memory");
        }
    }
    __syncthreads();
}

struct Args { const float* in[26]; float* out; unsigned char* ws; int ph_lo, ph_hi; };
enum { I_X = 0, I_MIXN, I_WIN, I_RPB, I_QNA, I_KNA, I_QNB, I_KNB, I_CQN, I_CKVN, I_WUQ, I_WUKV, I_QNC, I_KNC, I_ONA, I_ONB, I_ONC, I_WOUT, I_FFNN, I_WG, I_WU, I_WDN, I_ROUTER, I_WEG, I_WEU, I_WED };
struct Frame {
    LAS unsigned char* lds; unsigned char* ws; unsigned* ctl;
    int wave, G, bid, gw, ngw;
};

__device__ __forceinline__ void transpose_item(const float* __restrict__ W, int K, int N, bf16* __restrict__ WT, int row_off, int mode, LAS float* scr, int item, int lane) {
    (void)scr;
    const int nblk = N >> 5, kb = item / nblk, nb = item - kb * nblk, k0 = kb << 6, n0 = nb << 5; const int c = lane >> 3, q = lane & 7;
    const float* p = W + (size_t)(k0 + 8 * c) * N + n0 + 4 * q;
    f32x4 v[8];
#pragma unroll
    for (int i = 0; i < 8; ++i) v[i] = *(const f32x4*)(p + (size_t)i * N);
    const int drow0 = (mode == 0) ? (row_off + n0) : (row_off + (n0 >> 7) * 256 + (mode - 1) * 128 + (n0 & 127));
    bf16* d = WT + (size_t)(drow0 + 4 * q) * K + k0 + 8 * c;
#pragma unroll
    for (int j = 0; j < 4; ++j) { v4u o; o.x = pk2(v[0][j], v[1][j]); o.y = pk2(v[2][j], v[3][j]); o.z = pk2(v[4][j], v[5][j]); o.w = pk2(v[6][j], v[7][j]); *(v4u*)(d + (size_t)j * K) = o; }
}

__device__ __forceinline__ unsigned pk4_fp8(float a, float b, float c, float d) { unsigned w = 0u; w = __builtin_amdgcn_cvt_pk_fp8_f32(a, b, w, false); w = __builtin_amdgcn_cvt_pk_fp8_f32(c, d, w, true); return w; }
__device__ __forceinline__ void transpose_item_f8(const float* __restrict__ W, int K, int N, unsigned char* __restrict__ WT, int row_off, int mode, float wsc, LAS float* scr, int item, int lane) {
    (void)scr;
    const int nblk = N >> 5, kb = item / nblk, nb = item - kb * nblk, k0 = kb << 7, n0 = nb << 5; const int c = lane >> 3, q = lane & 7;
    const float* p = W + (size_t)(k0 + 16 * c) * N + n0 + 4 * q;
    f32x4 v[16];
#pragma unroll
    for (int i = 0; i < 16; ++i) v[i] = *(const f32x4*)(p + (size_t)i * N);
    const int drow0 = (mode == 0) ? (row_off + n0) : (row_off + (n0 >> 7) * 256 + (mode - 1) * 128 + (n0 & 127));
    unsigned char* d = WT + (size_t)(drow0 + 4 * q) * K + k0 + 16 * c;
#pragma unroll
    for (int j = 0; j < 4; ++j) {
        v4u o; o.x = pk4_fp8(v[0][j] * wsc, v[1][j] * wsc, v[2][j] * wsc, v[3][j] * wsc); o.y = pk4_fp8(v[4][j] * wsc, v[5][j] * wsc, v[6][j] * wsc, v[7][j] * wsc);
        o.z = pk4_fp8(v[8][j] * wsc, v[9][j] * wsc, v[10][j] * wsc, v[11][j] * wsc); o.w = pk4_fp8(v[12][j] * wsc, v[13][j] * wsc, v[14][j] * wsc, v[15][j] * wsc);
        *(v4u*)(d + (size_t)j * K) = o; }
}

template <bool SRCB>
__device__ __forceinline__ void load_row32(const void* __restrict__ row, int lane, float (&v)[4][8]) {
    if constexpr (SRCB) { const v4u* p = (const v4u*)row + lane;
#pragma unroll
        for (int j = 0; j < 4; ++j) { const v4u w = p[64 * j]; v[j][0] = bf_lo(w.x); v[j][1] = bf_hi(w.x); v[j][2] = bf_lo(w.y); v[j][3] = bf_hi(w.y); v[j][4] = bf_lo(w.z); v[j][5] = bf_hi(w.z); v[j][6] = bf_lo(w.w); v[j][7] = bf_hi(w.w); }
    } else { const f32x4* p = (const f32x4*)row + 2 * lane;
#pragma unroll
        for (int j = 0; j < 4; ++j) { const f32x4 a = p[128 * j], b = p[128 * j + 1]; v[j][0] = a[0]; v[j][1] = a[1]; v[j][2] = a[2]; v[j][3] = a[3]; v[j][4] = b[0]; v[j][5] = b[1]; v[j][6] = b[2]; v[j][7] = b[3]; }
    }
}
__device__ __forceinline__ void load_gain32(const float* __restrict__ gain, int lane, float osc, float (&g)[4][8]) {
    const f32x4* p = (const f32x4*)gain + 2 * lane;
#pragma unroll
    for (int j = 0; j < 4; ++j) { const f32x4 a = p[128 * j], b = p[128 * j + 1]; g[j][0] = a[0] * osc; g[j][1] = a[1] * osc; g[j][2] = a[2] * osc; g[j][3] = a[3] * osc; g[j][4] = b[0] * osc; g[j][5] = b[1] * osc; g[j][6] = b[2] * osc; g[j][7] = b[3] * osc; }
}
template <bool F8OUT, bool SRCB>
__device__ __forceinline__ void phase_rmsnorm(const Frame& F, const void* __restrict__ src, const float* __restrict__ gain, void* __restrict__ dstv, float osc) {
    int tid_ = threadIdx.x; asm volatile("" : "+v"(tid_)); const int tid = tid_, lane = tid & 63; (void)tid; (void)lane;
    float g[4][8]; load_gain32(gain, lane, osc, g);
    for (int m = F.gw; m < NTOK; m += F.ngw) {
        float v[4][8]; load_row32<SRCB>((const unsigned char*)src + (size_t)m * DM * (SRCB ? 2 : 4), lane, v); float s = 0.f;
#pragma unroll
        for (int j = 0; j < 4; ++j)
#pragma unroll
            for (int i = 0; i < 8; ++i) s += v[j][i] * v[j][i];
        const float rstd = rsq(wave_sum(s) * (1.f / DM) + EPS);
        if constexpr (F8OUT) { v2u* o8 = (v2u*)((unsigned char*)dstv + (size_t)m * DM) + lane;
#pragma unroll
            for (int j = 0; j < 4; ++j) { v2u w; w.x = pk4_fp8(v[j][0] * rstd * g[j][0], v[j][1] * rstd * g[j][1], v[j][2] * rstd * g[j][2], v[j][3] * rstd * g[j][3]);
                w.y = pk4_fp8(v[j][4] * rstd * g[j][4], v[j][5] * rstd * g[j][5], v[j][6] * rstd * g[j][6], v[j][7] * rstd * g[j][7]); o8[64 * j] = w; }
        } else { v4u* o16 = (v4u*)((bf16*)dstv + (size_t)m * DM) + lane;
#pragma unroll
            for (int j = 0; j < 4; ++j) { v4u w; w.x = pk2(v[j][0] * rstd * g[j][0], v[j][1] * rstd * g[j][1]); w.y = pk2(v[j][2] * rstd * g[j][2], v[j][3] * rstd * g[j][3]);
                w.z = pk2(v[j][4] * rstd * g[j][4], v[j][5] * rstd * g[j][5]); w.w = pk2(v[j][6] * rstd * g[j][6], v[j][7] * rstd * g[j][7]); o16[64 * j] = w; } }
    }
}

__device__ __forceinline__ float rope_apply(float v, float c, float s, float sgn) {
    auto rr = __builtin_amdgcn_permlane16_swap(__float_as_uint(v), __float_as_uint(v), false, false);
    const float p = __uint_as_float(sgn > 0.f ? rr[0] : rr[1]); return v * c + sgn * p * s; }
__device__ __forceinline__ void sincos_rev(float ang, float& s, float& c) { const float r = ang * 0.15915494309189535f; const float f = r - floorf(r); s = __builtin_amdgcn_sinf(f); c = __builtin_amdgcn_cosf(f); }

__device__ __forceinline__ void phase_postproj(const Frame& F, const Args& a, int l) {
    int tid_ = threadIdx.x; asm volatile("" : "+v"(tid_)); const int tid = tid_, lane = tid & 63; (void)tid; (void)lane;
    const bf16* PROJ = (const bf16*)(F.ws + WS_PROJ);
    bf16* QA = (bf16*)(F.ws + WS_QA); bf16* KA = (bf16*)(F.ws + WS_KA); bf16* QB = (bf16*)(F.ws + WS_QB); bf16* KB = (bf16*)(F.ws + WS_KB);
    bf16* CQN = (bf16*)(F.ws + WS_CQN); bf16* CKVN = (bf16*)(F.ws + WS_CKVN); bf16* KPE = (bf16*)(F.ws + WS_KPE);
    const f32x2 gqa = ((const f32x2*)(a.in[I_QNA] + l * 128))[lane], gka = ((const f32x2*)(a.in[I_KNA] + l * 128))[lane];
    const f32x2 gqb = ((const f32x2*)(a.in[I_QNB] + l * 128))[lane], gkb = ((const f32x2*)(a.in[I_KNB] + l * 128))[lane];
    const f32x4 gcq0 = ((const f32x4*)(a.in[I_CQN] + l * 512))[2 * lane], gcq1 = ((const f32x4*)(a.in[I_CQN] + l * 512))[2 * lane + 1];
    const f32x4 gckv = ((const f32x4*)(a.in[I_CKVN] + l * 256))[lane];
    const float gkpe = a.in[I_KNC][l * 192 + 128 + lane];
    constexpr float LOG2T = 13.287712379549449f;
    const int q = lane & 15;
    const float f128a = __builtin_amdgcn_exp2f(-(float)(2 * q) * (LOG2T / 32.f)), f128b = __builtin_amdgcn_exp2f(-(float)(2 * q + 1) * (LOG2T / 32.f));
    const float f64 = __builtin_amdgcn_exp2f(-(float)q * (LOG2T / 16.f));
    const float sgn = (lane & 16) ? 1.f : -1.f;
    for (int t = F.gw; t < NTOK; t += F.ngw) {
        const int pos = t & (SEQ - 1); const float p = (float)((lane & 32) ? (pos & 63) : (pos >> 6));
        float s0, c0, s1, c1, s2, c2; sincos_rev(p * f128a, s0, c0); sincos_rev(p * f128b, s1, c1); sincos_rev(p * f64, s2, c2);
        const bf16* pr = PROJ + (size_t)t * DINP;
        unsigned hv[18];
#pragma unroll
        for (int i = 0; i < 8; ++i) hv[i] = ((const unsigned*)(pr + i * 128))[lane];
#pragma unroll
        for (int i = 8; i < 18; ++i) hv[i] = ((const unsigned*)(pr + PC_QB + (i - 8) * 128))[lane];
        const v4u cqv = ((const v4u*)(pr + PC_CQ))[lane]; const v2u ckvv = ((const v2u*)(pr + PC_CKV))[lane]; const unsigned kpev = (unsigned)pr[PC_KPE + lane];
#pragma unroll
        for (int i = 0; i < 18; ++i) {
            float v0 = bf_lo(hv[i]), v1 = bf_hi(hv[i]);
            const float rstd = rsq(wave_sum(v0 * v0 + v1 * v1) * (1.f / 128.f) + EPS);
            const f32x2 g = (i < 4) ? gqa : (i < 8) ? gka : (i < 16) ? gqb : gkb;
            v0 = v0 * rstd * g[0]; v1 = v1 * rstd * g[1];
            if (i >= 8) { v0 = rope_apply(v0, c0, s0, sgn); v1 = rope_apply(v1, c1, s1, sgn); }
            bf16* dst = (i < 4) ? (QA + (size_t)t * 512 + i * 128) : (i < 8) ? (KA + (size_t)t * 512 + (i - 4) * 128) : (i < 16) ? (QB + (size_t)t * 1024 + (i - 8) * 128) : (KB + (size_t)t * 256 + (i - 16) * 128);
            ((unsigned*)dst)[lane] = pk2(v0, v1);
        }
        {
            float x[8] = {bf_lo(cqv.x), bf_hi(cqv.x), bf_lo(cqv.y), bf_hi(cqv.y), bf_lo(cqv.z), bf_hi(cqv.z), bf_lo(cqv.w), bf_hi(cqv.w)}; float s = 0.f;
#pragma unroll
            for (int i = 0; i < 8; ++i) s += x[i] * x[i];
            const float rstd = rsq(wave_sum(s) * (1.f / 512.f) + EPS);
            v4u w; w.x = pk2(x[0] * rstd * gcq0[0], x[1] * rstd * gcq0[1]); w.y = pk2(x[2] * rstd * gcq0[2], x[3] * rstd * gcq0[3]);
            w.z = pk2(x[4] * rstd * gcq1[0], x[5] * rstd * gcq1[1]); w.w = pk2(x[6] * rstd * gcq1[2], x[7] * rstd * gcq1[3]);
            ((v4u*)(CQN + (size_t)t * 512))[lane] = w;
        }
        {
            const float x0 = bf_lo(ckvv.x), x1 = bf_hi(ckvv.x), x2 = bf_lo(ckvv.y), x3 = bf_hi(ckvv.y);
            const float rstd = rsq(wave_sum((x0 * x0 + x1 * x1) + (x2 * x2 + x3 * x3)) * (1.f / 256.f) + EPS);
            v2u w; w.x = pk2(x0 * rstd * gckv[0], x1 * rstd * gckv[1]); w.y = pk2(x2 * rstd * gckv[2], x3 * rstd * gckv[3]);
            ((v2u*)(CKVN + (size_t)t * 256))[lane] = w;
        }
        {
            float x = bf_lo(kpev);
            const float rstd = rsq(wave_sum(x * x) * (1.f / 64.f) + EPS);
            x = rope_apply(x * rstd * gkpe, c2, s2, sgn);
            KPE[(size_t)t * 64 + lane] = (bf16)(pk2(x, 0.f) & 0xffffu);
        }
    }
}

__device__ __forceinline__ void phase_postmla(const Frame& F, const Args& a, int l) {
    int tid_ = threadIdx.x; asm volatile("" : "+v"(tid_)); const int tid = tid_, lane = tid & 63; (void)tid; (void)lane;
    const bf16* QCR = (const bf16*)(F.ws + WS_QCR); const bf16* KVR = (const bf16*)(F.ws + WS_KVR); const bf16* KPE = (const bf16*)(F.ws + WS_KPE);
    bf16* QC = (bf16*)(F.ws + WS_QC); bf16* KC = (bf16*)(F.ws + WS_KC);
    const f32x2 gqn = ((const f32x2*)(a.in[I_QNC] + l * 192))[lane], gkn = ((const f32x2*)(a.in[I_KNC] + l * 192))[lane];
    const float gqpe = a.in[I_QNC][l * 192 + 128 + lane];
    constexpr float LOG2T = 13.287712379549449f;
    const float f64 = __builtin_amdgcn_exp2f(-(float)(lane & 15) * (LOG2T / 16.f));
    const float sgn = (lane & 16) ? 1.f : -1.f;
    for (int t = F.gw; t < NTOK; t += F.ngw) {
        const int pos = t & (SEQ - 1); const float p = (float)((lane & 32) ? (pos & 63) : (pos >> 6));
        float s2, c2; sincos_rev(p * f64, s2, c2);
        const bf16* qr = QCR + (size_t)t * 768; const bf16* kr = KVR + (size_t)t * 1024;
        unsigned qn[4], kn[4]; unsigned qp[4];
#pragma unroll
        for (int h = 0; h < 4; ++h) { qn[h] = ((const unsigned*)(qr + h * 192))[lane]; qp[h] = (unsigned)qr[h * 192 + 128 + lane]; kn[h] = ((const unsigned*)(kr + h * 256))[lane]; }
        const bf16 kpe = KPE[(size_t)t * 64 + lane];
#pragma unroll
        for (int h = 0; h < 4; ++h) {
            { float v0 = bf_lo(qn[h]), v1 = bf_hi(qn[h]); const float rstd = rsq(wave_sum(v0 * v0 + v1 * v1) * (1.f / 128.f) + EPS);
              ((unsigned*)(QC + (size_t)t * 768 + h * 192))[lane] = pk2(v0 * rstd * gqn[0], v1 * rstd * gqn[1]); }
            { float x = bf_lo(qp[h]); const float rstd = rsq(wave_sum(x * x) * (1.f / 64.f) + EPS); x = rope_apply(x * rstd * gqpe, c2, s2, sgn);
              QC[(size_t)t * 768 + h * 192 + 128 + lane] = (bf16)(pk2(x, 0.f) & 0xffffu); }
            { float v0 = bf_lo(kn[h]), v1 = bf_hi(kn[h]); const float rstd = rsq(wave_sum(v0 * v0 + v1 * v1) * (1.f / 128.f) + EPS);
              ((unsigned*)(KC + (size_t)t * 768 + h * 192))[lane] = pk2(v0 * rstd * gkn[0], v1 * rstd * gkn[1]); }
            KC[(size_t)t * 768 + h * 192 + 128 + lane] = kpe;
        }
    }
}

__device__ __forceinline__ void phase_groupnorm(const Frame& F, const Args& a, int l) {
    int tid_ = threadIdx.x; asm volatile("" : "+v"(tid_)); const int tid = tid_, lane = tid & 63; (void)tid; (void)lane;
    const bf16* O = (const bf16*)(F.ws + WS_O); bf16* ON = (bf16*)(F.ws + WS_ON);
    f32x4 g[4][2];
    { const f32x4* ga = (const f32x4*)(a.in[I_ONA] + l * 512); const f32x4* gb = (const f32x4*)(a.in[I_ONB] + l * 1024); const f32x4* gc = (const f32x4*)(a.in[I_ONC] + l * 512);
      g[0][0] = ga[2 * lane]; g[0][1] = ga[2 * lane + 1]; g[1][0] = gb[2 * lane]; g[1][1] = gb[2 * lane + 1]; g[2][0] = gb[128 + 2 * lane]; g[2][1] = gb[128 + 2 * lane + 1]; g[3][0] = gc[2 * lane]; g[3][1] = gc[2 * lane + 1]; }
    for (int t = F.gw; t < NTOK; t += F.ngw) {
        const v4u* orow = (const v4u*)(O + (size_t)t * DM) + lane; float x[4][8]; float ss[4];
#pragma unroll
        for (int j = 0; j < 4; ++j) { const v4u w = orow[64 * j]; x[j][0] = bf_lo(w.x); x[j][1] = bf_hi(w.x); x[j][2] = bf_lo(w.y); x[j][3] = bf_hi(w.y); x[j][4] = bf_lo(w.z); x[j][5] = bf_hi(w.z); x[j][6] = bf_lo(w.w); x[j][7] = bf_hi(w.w);
            float s = 0.f;
#pragma unroll
            for (int i = 0; i < 8; ++i) s += x[j][i] * x[j][i];
            ss[j] = s; }
        const float ra = rsq(wave_sum(ss[0]) * (1.f / 512.f) + EPS), rb = rsq(wave_sum(ss[1] + ss[2]) * (1.f / 1024.f) + EPS), rc = rsq(wave_sum(ss[3]) * (1.f / 512.f) + EPS);
        if constexpr (F8WO) { v2u* nrow8 = (v2u*)((unsigned char*)ON + (size_t)t * DM) + lane;
#pragma unroll
            for (int j = 0; j < 4; ++j) { const float r = ((j == 0) ? ra : (j == 3) ? rc : rb) * SC_H; v2u w;
                w.x = pk4_fp8(x[j][0] * r * g[j][0][0], x[j][1] * r * g[j][0][1], x[j][2] * r * g[j][0][2], x[j][3] * r * g[j][0][3]);
                w.y = pk4_fp8(x[j][4] * r * g[j][1][0], x[j][5] * r * g[j][1][1], x[j][6] * r * g[j][1][2], x[j][7] * r * g[j][1][3]); nrow8[64 * j] = w; }
            continue; }
        v4u* nrow = (v4u*)(ON + (size_t)t * DM) + lane;
#pragma unroll
        for (int j = 0; j < 4; ++j) { const float r = (j == 0) ? ra : (j == 3) ? rc : rb; v4u w;
            w.x = pk2(x[j][0] * r * g[j][0][0], x[j][1] * r * g[j][0][1]); w.y = pk2(x[j][2] * r * g[j][0][2], x[j][3] * r * g[j][0][3]);
            w.z = pk2(x[j][4] * r * g[j][1][0], x[j][5] * r * g[j][1][1]); w.w = pk2(x[j][6] * r * g[j][1][2], x[j][7] * r * g[j][1][3]); nrow[64 * j] = w; }
    }
}

constexpr int ROUTER_LDS = 0;
constexpr int MOE_LDS_CNT = 65536;
constexpr int MOE_LDS_REC = 65536 + 64;
template <bool F8OUT, bool SRCB>
__device__ __forceinline__ void phase_ffnnorm_route(const Frame& F, const Args& a, const void* __restrict__ src, const float* __restrict__ gain, void* __restrict__ dstv, float osc) {
    int tid_ = threadIdx.x; asm volatile("" : "+v"(tid_)); const int tid = tid_, lane = tid & 63; (void)tid; (void)lane;
    LAS float* rt = (LAS float*)(F.lds + ROUTER_LDS); LAS unsigned* lcnt = (LAS unsigned*)(F.lds + MOE_LDS_CNT); LAS int* rec = (LAS int*)(F.lds + MOE_LDS_REC);
    const float* router = a.in[I_ROUTER];
    for (int t = tid; t < DM * NE / 4; t += NWAVES * 64) { const int k = t >> 1, half = t & 1; ((LAS f32x4*)rt)[half * 2048 + (((k >> 9) * 8 + (k & 7)) * 64 + ((k >> 3) & 63))] = ((const f32x4*)router)[t]; }
    if (tid < 16) lcnt[tid] = 0u;
    __syncthreads();
    const int t0 = (int)(((long)F.bid * NTOK) / F.G), t1 = (int)(((long)(F.bid + 1) * NTOK) / F.G);
    float g[4][8]; load_gain32(gain, lane, 1.f, g);
    float v[4][8], vn[4][8];
    if (t0 + F.wave < t1) load_row32<SRCB>((const unsigned char*)src + (size_t)(t0 + F.wave) * DM * (SRCB ? 2 : 4), lane, vn);
    for (int m = t0 + F.wave; m < t1; m += NWAVES) {
#pragma unroll
        for (int j = 0; j < 4; ++j)
#pragma unroll
            for (int i = 0; i < 8; ++i) v[j][i] = vn[j][i];
        if (m + NWAVES < t1) load_row32<SRCB>((const unsigned char*)src + (size_t)(m + NWAVES) * DM * (SRCB ? 2 : 4), lane, vn);
        float s = 0.f;
#pragma unroll
        for (int j = 0; j < 4; ++j)
#pragma unroll
            for (int i = 0; i < 8; ++i) s += v[j][i] * v[j][i];
        const float rstd = rsq(wave_sum(s) * (1.f / DM) + EPS);
        v4u* o16 = (v4u*)((bf16*)dstv + (size_t)m * DM) + lane; v2u* o8 = (v2u*)((unsigned char*)dstv + (size_t)m * DM) + lane;
        float lg[8] = {0.f, 0.f, 0.f, 0.f, 0.f, 0.f, 0.f, 0.f};
#pragma unroll
        for (int j = 0; j < 4; ++j) {
            float h[8];
#pragma unroll
            for (int i = 0; i < 8; ++i) h[i] = v[j][i] * rstd * g[j][i];
            if constexpr (F8OUT) { v2u w; w.x = pk4_fp8(h[0] * osc, h[1] * osc, h[2] * osc, h[3] * osc); w.y = pk4_fp8(h[4] * osc, h[5] * osc, h[6] * osc, h[7] * osc); o8[64 * j] = w; }
            else { v4u w; w.x = pk2(h[0], h[1]); w.y = pk2(h[2], h[3]); w.z = pk2(h[4], h[5]); w.w = pk2(h[6], h[7]); o16[64 * j] = w; }
#pragma unroll
            for (int i = 0; i < 8; ++i) { const f32x4 r0 = ((const LAS f32x4*)rt)[(j * 8 + i) * 64 + lane], r1 = ((const LAS f32x4*)rt)[2048 + (j * 8 + i) * 64 + lane];
                lg[0] += h[i] * r0[0]; lg[1] += h[i] * r0[1]; lg[2] += h[i] * r0[2]; lg[3] += h[i] * r0[3]; lg[4] += h[i] * r1[0]; lg[5] += h[i] * r1[1]; lg[6] += h[i] * r1[2]; lg[7] += h[i] * r1[3]; }
        }
#pragma unroll
        for (int e = 0; e < 8; ++e) lg[e] = wave_sum(lg[e]);
        int e0 = 0; float v0 = lg[0];
#pragma unroll
        for (int e = 1; e < 8; ++e) if (lg[e] > v0) { v0 = lg[e]; e0 = e; }
        int e1 = -1; float v1 = -3.0e38f;
#pragma unroll
        for (int e = 0; e < 8; ++e) if (e != e0 && lg[e] > v1) { v1 = lg[e]; e1 = e; }
        const float ex = __expf(v1 - v0), w0 = 1.f / (1.f + ex), w1 = ex * w0;
        if (lane == 0) { const int li = m - t0; const unsigned p0 = atomicAdd((unsigned*)&lcnt[e0], 1u), p1 = atomicAdd((unsigned*)&lcnt[e1], 1u);
            rec[li * 6 + 0] = e0; rec[li * 6 + 1] = e1; rec[li * 6 + 2] = (int)p0; rec[li * 6 + 3] = (int)p1; ((LAS float*)rec)[li * 6 + 4] = w0; ((LAS float*)rec)[li * 6 + 5] = w1; }
    }
    __syncthreads();
    if (tid < 8) lcnt[8 + tid] = __hip_atomic_fetch_add(F.ctl + CW_CNT + tid, lcnt[tid], __ATOMIC_RELAXED, __HIP_MEMORY_SCOPE_AGENT);
    __syncthreads();
    int* toke = (int*)(F.ws + WS_TOKE); int* tokp = (int*)(F.ws + WS_TOKP); float* tokw = (float*)(F.ws + WS_TOKW);
    for (int i = tid; i < (t1 - t0) * 2; i += NWAVES * 64) { const int li = i >> 1, k = i & 1, e = rec[li * 6 + k];
        toke[(size_t)(t0 + li) * 2 + k] = e; tokp[(size_t)(t0 + li) * 2 + k] = rec[li * 6 + 2 + k] + (int)lcnt[8 + e]; tokw[(size_t)(t0 + li) * 2 + k] = ((LAS float*)rec)[li * 6 + 4 + k]; }
    __syncthreads();
}
__device__ __forceinline__ void moe_tiles(const Frame& F, int (&tb)[9], int (&cnt)[8]) {
    int acc = 0;
#pragma unroll
    for (int e = 0; e < 8; ++e) { cnt[e] = (int)__hip_atomic_load(F.ctl + CW_CNT + e, __ATOMIC_RELAXED, __HIP_MEMORY_SCOPE_AGENT); tb[e] = acc; acc += (cnt[e] + 255) >> 8; }
    tb[8] = acc;
}
template <bool F8ROWS>
__device__ __forceinline__ void phase_gather(const Frame& F) {
    int tid_ = threadIdx.x; asm volatile("" : "+v"(tid_)); const int tid = tid_, lane = tid & 63; (void)tid; (void)lane;
    int tb[9], cnt[8]; moe_tiles(F, tb, cnt);
    constexpr int RBYTES = F8ROWS ? DM : 2 * DM, NCH = RBYTES / 1024;
    const unsigned char* H = (const unsigned char*)(F.ws + WS_H); unsigned char* HG = (unsigned char*)(F.ws + WS_HG); float* rg = (float*)(F.ws + WS_RGATE);
    const int* toke = (const int*)(F.ws + WS_TOKE); int* tokp = (int*)(F.ws + WS_TOKP); const float* tokw = (const float*)(F.ws + WS_TOKW);
    constexpr int GB = 4;
    for (int t0 = F.gw; t0 < NTOK; t0 += GB * F.ngw) {
        v4u v[GB][NCH]; int ee[GB][2], pp[GB][2]; float ww[GB][2];
#pragma unroll
        for (int b = 0; b < GB; ++b) { const int t = t0 + b * F.ngw; if (t < NTOK) { const v4u* hr = (const v4u*)(H + (size_t)t * RBYTES) + lane;
#pragma unroll
            for (int j = 0; j < NCH; ++j) v[b][j] = hr[64 * j];
#pragma unroll
            for (int k = 0; k < 2; ++k) { ee[b][k] = toke[(size_t)t * 2 + k]; pp[b][k] = tokp[(size_t)t * 2 + k]; ww[b][k] = tokw[(size_t)t * 2 + k]; } } }
#pragma unroll
        for (int b = 0; b < GB; ++b) { const int t = t0 + b * F.ngw; if (t < NTOK) {
#pragma unroll
            for (int k = 0; k < 2; ++k) { const int e = ee[b][k], p = pp[b][k]; int base = 0;
#pragma unroll
                for (int q = 0; q < 8; ++q) base = (q == e) ? tb[q] : base;
                const int slot = base * 256 + p; v4u* dr = (v4u*)(HG + (size_t)slot * RBYTES) + lane;
#pragma unroll
                for (int j = 0; j < NCH; ++j) dr[64 * j] = v[b][j];
                if (lane == 0) { rg[slot] = ww[b][k]; tokp[(size_t)t * 2 + k] = slot; } } } }
    }
#pragma unroll
    for (int e = 0; e < 8; ++e) { const int r0 = tb[e] * 256 + cnt[e], r1 = tb[e + 1] * 256;
        for (int r = r0 + F.gw; r < r1; r += F.ngw) { v4u* dr = (v4u*)(HG + (size_t)r * RBYTES) + lane; const v4u z = {0u, 0u, 0u, 0u};
#pragma unroll
            for (int j = 0; j < NCH; ++j) dr[64 * j] = z;
            if (lane == 0) rg[r] = 0.f; } }
}
__device__ __forceinline__ void phase_tailsum(const Frame& F) {
    int tid_ = threadIdx.x; asm volatile("" : "+v"(tid_)); const int tid = tid_;
    int tb[9], cnt[8]; moe_tiles(F, tb, cnt);
    const int nun = tb[8] * (DM / 256), nfull = (F.G == 256 && F8M) ? (nun / 256) * 256 : nun; if (nfull >= nun) return;
    pg8::StaticOrder S; S.init(tb[8] * 256, DM, F.G, 0);
    const float* P = (const float*)(F.ws + WS_PART); const float* rg = (const float*)(F.ws + WS_RGATE); bf16* Y = (bf16*)(F.ws + WS_Y);
    const float isc = F8M ? 1.f / (SC_ACT * SC_W) : 1.f;
    const int nsp = 4;
    const int nchunk = (nun - nfull) * 8192;
    for (int i = F.bid * NWAVES * 64 + tid; i < nchunk; i += F.G * NWAVES * 64) {
        const int j = i >> 13, r = (i >> 5) & 255, cc = (i & 31) * 8, ent = nfull + j;
        pg8::Unit u; S.c = ent % F.G; S.next(ent / F.G, u);
        const float* p = P + (size_t)(nsp * j) * 65536 + (size_t)r * 256 + cc; f32x4 a = {0.f, 0.f, 0.f, 0.f}, b = {0.f, 0.f, 0.f, 0.f};
        for (int s = 0; s < nsp; ++s) { a += *(const f32x4*)(p + (size_t)s * 65536); b += *(const f32x4*)(p + (size_t)s * 65536 + 4); }
        const int row = u.pm * 256 + r; const float sc = rg[row] * isc;
        v4u w; w.x = pk2(a[0] * sc, a[1] * sc); w.y = pk2(a[2] * sc, a[3] * sc); w.z = pk2(b[0] * sc, b[1] * sc); w.w = pk2(b[2] * sc, b[3] * sc);
        *(v4u*)(Y + (size_t)row * DM + u.pn * 256 + cc) = w;
    }
}
template <bool XBF>
__device__ __forceinline__ void phase_combine(const Frame& F, const void* __restrict__ xsrc, float* __restrict__ out) {
    int tid_ = threadIdx.x; asm volatile("" : "+v"(tid_)); const int tid = tid_, lane = tid & 63; (void)tid; (void)lane;
    const bf16* Y = (const bf16*)(F.ws + WS_Y); const int* tokp = (const int*)(F.ws + WS_TOKP);
    for (int t = F.gw; t < NTOK; t += F.ngw) {
        const int s0 = tokp[(size_t)t * 2], s1 = tokp[(size_t)t * 2 + 1];
        const v4u* y0 = (const v4u*)(Y + (size_t)s0 * DM) + lane; const v4u* y1 = (const v4u*)(Y + (size_t)s1 * DM) + lane;
        float x[4][8]; load_row32<XBF>((const unsigned char*)xsrc + (size_t)t * DM * (XBF ? 2 : 4), lane, x);
        f32x4* xr = (f32x4*)(out + (size_t)t * DM) + 2 * lane;
#pragma unroll
        for (int j = 0; j < 4; ++j) { const v4u p = y0[64 * j], q = y1[64 * j]; f32x4 xa, xb;
            xa[0] = x[j][0] + bf_lo(p.x) + bf_lo(q.x); xa[1] = x[j][1] + bf_hi(p.x) + bf_hi(q.x); xa[2] = x[j][2] + bf_lo(p.y) + bf_lo(q.y); xa[3] = x[j][3] + bf_hi(p.y) + bf_hi(q.y);
            xb[0] = x[j][4] + bf_lo(p.z) + bf_lo(q.z); xb[1] = x[j][5] + bf_hi(p.z) + bf_hi(q.z); xb[2] = x[j][6] + bf_lo(p.w) + bf_lo(q.w); xb[3] = x[j][7] + bf_hi(p.w) + bf_hi(q.w);
            xr[128 * j] = xa; xr[128 * j + 1] = xb; }
    }
}

__device__ __forceinline__ void convert_experts(const Frame& F, const Args& args, int e_lo, int e_hi, int w, int nw);
__device__ __forceinline__ void phase_attention(const Frame& F, const Args& a, int l) {
    int tid_ = threadIdx.x; asm volatile("" : "+v"(tid_)); const int tid = tid_, lane = tid & 63; (void)tid; (void)lane;
    const bf16* PROJ = (const bf16*)(F.ws + WS_PROJ);
    const bf16* QA = (const bf16*)(F.ws + WS_QA); const bf16* KA = (const bf16*)(F.ws + WS_KA); const bf16* QB = (const bf16*)(F.ws + WS_QB); const bf16* KB = (const bf16*)(F.ws + WS_KB);
    const bf16* KVR = (const bf16*)(F.ws + WS_KVR); const bf16* QC = (const bf16*)(F.ws + WS_QC); const bf16* KC = (const bf16*)(F.ws + WS_KC);
    bf16* O = (bf16*)(F.ws + WS_O);
    char* L = (char*)F.lds;
    const int cslot = (MOE_CVT_IN_ATTN == 1) ? ((F.bid >> 3) & 3) : -1; bool cvt_done = (MOE_CVT_IN_ATTN != 1);
#ifndef ATT_PP
#define ATT_PP 0
#endif
#ifndef ATT_STATIC
#define ATT_STATIC 0
#endif
#if ATT_STATIC
#define ATT_C3(q, k, v, o) att::attn_body3s<192, 768, 768, 1024, 2048, SEQ / 64, 1, 8>(q, k, v, o, L)
#define ATT_B3(q, k, v, o) att::attn_body3s<128, 1024, 256, 4096, 2048, SEQ / 64, 2, 8>(q, k, v, o, L)
#else
#if ATT_PP & 1
#define ATT_C3(q, k, v, o) att::attn_body_pp<192, 768, 768, 1024, 2048, 0, 8>(q, k, v, o, SEQ / 64, L, 0, 0, nullptr)
#else
#define ATT_C3(q, k, v, o) att::attn_body3<192, 768, 768, 1024, 2048, 0, 1, 8>(q, k, v, o, SEQ / 64, L, 0, 0, nullptr)
#endif
#if ATT_PP & 2
#define ATT_B3(q, k, v, o) att::attn_body_pp<128, 1024, 256, 4096, 2048, 0, 8>(q, k, v, o, SEQ / 64, L, 0, 0, nullptr)
#else
#define ATT_B3(q, k, v, o) att::attn_body3<128, 1024, 256, 4096, 2048, 0, 2, 8>(q, k, v, o, SEQ / 64, L, 0, 0, nullptr)
#endif
#endif
#define ATT_CVT() do { __syncthreads(); convert_experts(F, a, 4 * l, 4 * l + 4, F.gw, F.ngw); __syncthreads(); cvt_done = true; } while (0)
    if (cslot == 0) ATT_CVT();
    if (PHON(16)) for (int Lu = F.bid; Lu < 256; Lu += F.G) {
        const int id = (Lu & 7) * 32 + (Lu >> 3), b = id >> 6, h = (id >> 4) & 3, qb = id & 15; const size_t tq = (size_t)b * SEQ + qb * 256, tk = (size_t)b * SEQ;
        #if ATT_RING3 & 1
        ATT_C3(QC + tq * 768 + h * 192, KC + tk * 768 + h * 192, KVR + tk * 1024 + h * 256 + 128, O + tq * DM + 1536 + h * 128);
#else
        att::attn_body<192, 768, 768, 1024, 2048, 0, 1, 8>(QC + tq * 768 + h * 192, KC + tk * 768 + h * 192, KVR + tk * 1024 + h * 256 + 128, O + tq * DM + 1536 + h * 128, SEQ / 64, L, 0, 0, nullptr);
#endif
    }
    if (cslot == 1) ATT_CVT();
    if (PHON(17)) for (int Lu = F.bid; Lu < 512; Lu += F.G) {
        if (cslot == 2 && !cvt_done && Lu != F.bid) ATT_CVT();
        const int id = (Lu & 7) * 64 + (Lu >> 3), b = id >> 7, kvh = (id >> 6) & 1, g = (id >> 4) & 3, qb = id & 15, h = kvh * 4 + g; const size_t tq = (size_t)b * SEQ + qb * 256, tk = (size_t)b * SEQ;
        #if ATT_RING3 & 2
        ATT_B3(QB + tq * 1024 + h * 128, KB + tk * 256 + kvh * 128, PROJ + tk * DINP + PC_VB + kvh * 128, O + tq * DM + 512 + h * 128);
#else
        att::attn_body<128, 1024, 256, 4096, 2048, 0, 2, 8>(QB + tq * 1024 + h * 128, KB + tk * 256 + kvh * 128, PROJ + tk * DINP + PC_VB + kvh * 128, O + tq * DM + 512 + h * 128, SEQ / 64, L, 0, 0, nullptr);
#endif
    }
    float* biasT = (float*)(L + 136 * 1024);
    if (!cvt_done && cslot == 3) ATT_CVT();
    if (PHON(18)) {
        LAS int* claim = (LAS int*)(F.lds + 160 * 1024 - 512);
        const int home = (int)(xb_xcc_id() & 7u);
        for (int li = 0; li < 8; ++li) {
            const int list = (home + li) & 7;
            for (;;) {
                __syncthreads();
                if (tid == 0) claim[0] = (int)__hip_atomic_fetch_add(F.ctl + CW_AQ + 64 * (8 * l + list), 1u, __ATOMIC_RELAXED, __HIP_MEMORY_SCOPE_AGENT);
                __syncthreads();
                const int idx = claim[0]; if (idx >= 32) break;
                const int id = list * 32 + idx, b = id >> 6, h = (id >> 4) & 3, rb = id & 15; const size_t tq = (size_t)b * SEQ + rb * 256;
                int lo = min(max(rb * 4 - 4, 0), 56), hi = min(max(rb * 4 + 3 - 4, 0), 56) + 8;
                if ((hi - lo) & 1) { if (hi < 64) ++hi; else --lo; }
                const float* rpb = a.in[I_RPB] + ((size_t)l * 4 + h) * 465;
                for (int i = tid; i < 15 * 128; i += NWAVES * 64) { const int bi = i >> 7, bj = (i & 127) - 48; biasT[i] = (bj >= 0 && bj < 31) ? rpb[bi * 31 + bj] * 11.313708498984761f : 0.f; }
                __syncthreads();
                const size_t tk = (size_t)b * SEQ + lo * 64;
                #if ATT_PP & 4
                att::attn_body_pp<128, 512, 512, 4096, 2048, 1, 4>(QA + tq * 512 + h * 128, KA + tk * 512 + h * 128, PROJ + tk * DINP + PC_VA + h * 128, O + tq * DM + h * 128, hi - lo, L, rb * 4, lo, biasT);
#else
                att::ATT_BODY_A<128, 512, 512, 4096, 2048, 1, 1, 4>(QA + tq * 512 + h * 128, KA + tk * 512 + h * 128, PROJ + tk * DINP + PC_VA + h * 128, O + tq * DM + h * 128, hi - lo, L, rb * 4, lo, biasT);
#endif
            }
        }
    }
    if (!cvt_done) ATT_CVT();
#undef ATT_CVT
}

constexpr int NPHASE = 25;

__device__ __forceinline__ void tr8_decode(const Args& args, unsigned char* ws, int e_lo, int gi, const float*& W, unsigned char*& WT, int& K, int& N, int& mode, int& item) {
    const int m = gi / 3584; item = gi - m * 3584; const int e = e_lo + m / 3, kind = m - (m / 3) * 3;
    if (kind == 2) { W = args.in[I_WED] + (size_t)e * DFE * DM; WT = ws + WS_WED + (size_t)e * DM * DFE; K = DFE; N = DM; mode = 0; }
    else { W = (kind == 0 ? args.in[I_WEG] : args.in[I_WEU]) + (size_t)e * DM * DFE; WT = ws + WS_WEGU + (size_t)e * 2 * DFE * DM; K = DM; N = DFE; mode = 1 + kind; }
}
__device__ __forceinline__ void tr8_load(const float* __restrict__ W, int N, int item, int lane, f32x4 (&v)[16]) {
    const int nblk = N >> 5, kb = item / nblk, nb = item - kb * nblk, k0 = kb << 7, n0 = nb << 5; const int c = lane >> 3, q = lane & 7;
    const float* p = W + (size_t)(k0 + 16 * c) * N + n0 + 4 * q;
#pragma unroll
    for (int i = 0; i < 16; ++i) v[i] = __builtin_nontemporal_load((const f32x4*)(p + (size_t)i * N));
}
__device__ __forceinline__ void tr8_store(unsigned char* __restrict__ WT, int K, int N, int mode, int item, int lane, float wsc, LAS float* scr, const f32x4 (&v)[16]) {
    (void)scr;
    const int nblk = N >> 5, kb = item / nblk, nb = item - kb * nblk, k0 = kb << 7, n0 = nb << 5; const int c = lane >> 3, q = lane & 7;
    const int drow0 = (mode == 0) ? n0 : ((n0 >> 7) * 256 + (mode - 1) * 128 + (n0 & 127));
    unsigned char* p = WT + (size_t)(drow0 + 4 * q) * K + k0 + 16 * c;
#pragma unroll
    for (int j = 0; j < 4; ++j) {
        v4u o; o.x = pk4_fp8(v[0][j] * wsc, v[1][j] * wsc, v[2][j] * wsc, v[3][j] * wsc); o.y = pk4_fp8(v[4][j] * wsc, v[5][j] * wsc, v[6][j] * wsc, v[7][j] * wsc);
        o.z = pk4_fp8(v[8][j] * wsc, v[9][j] * wsc, v[10][j] * wsc, v[11][j] * wsc); o.w = pk4_fp8(v[12][j] * wsc, v[13][j] * wsc, v[14][j] * wsc, v[15][j] * wsc);
        *(v4u*)(p + (size_t)j * K) = o; }
}
__device__ __forceinline__ void convert_experts(const Frame& F, const Args& args, int e_lo, int e_hi, int w, int nw) {
    int tid_ = threadIdx.x; asm volatile("" : "+v"(tid_)); const int lane = tid_ & 63;
    LAS float* scr = (LAS float*)(F.lds + F.wave * 18432);
    if constexpr (F8M) {
        const int total = (e_hi - e_lo) * 3 * 3584;
        f32x4 va[16], vb[16], vc[16]; const float* W; unsigned char* WT; int K, N, mode, item;
#define TR8_LD(buf, gx) do { if ((gx) < total) { tr8_decode(args, F.ws, e_lo, (gx), W, WT, K, N, mode, item); tr8_load(W, N, item, lane, buf); } } while (0)
#define TR8_ST(buf, gx) do { tr8_decode(args, F.ws, e_lo, (gx), W, WT, K, N, mode, item); tr8_store(WT, K, N, mode, item, lane, SC_W, scr, buf); } while (0)
        int gi = w;
        TR8_LD(va, gi); TR8_LD(vb, gi + nw);
        while (gi < total) {
            TR8_LD(vc, gi + 2 * nw); TR8_ST(va, gi); gi += nw; if (gi >= total) break;
            TR8_LD(va, gi + 2 * nw); TR8_ST(vb, gi); gi += nw; if (gi >= total) break;
            TR8_LD(vb, gi + 2 * nw); TR8_ST(vc, gi); gi += nw;
        }
#undef TR8_LD
#undef TR8_ST
    } else {
        int it = w;
#define TR_RUNB(Wp, Kk, Nn, Dp, ROFF, MODE) do { const int cnt_ = ((Kk) >> 6) * ((Nn) >> 5); while (it < cnt_) { transpose_item((Wp), (Kk), (Nn), (Dp), (ROFF), (MODE), scr, it, lane); it += nw; } it -= cnt_; } while (0)
        for (int e = e_lo; e < e_hi; ++e) {
            TR_RUNB(args.in[I_WEG] + (size_t)e * DM * DFE, DM, DFE, (bf16*)(F.ws + WS_WEGU) + (size_t)e * 2 * DFE * DM, 0, 1);
            TR_RUNB(args.in[I_WEU] + (size_t)e * DM * DFE, DM, DFE, (bf16*)(F.ws + WS_WEGU) + (size_t)e * 2 * DFE * DM, 0, 2);
            TR_RUNB(args.in[I_WED] + (size_t)e * DFE * DM, DFE, DM, (bf16*)(F.ws + WS_WED) + (size_t)e * DM * DFE, 0, 0);
        }
#undef TR_RUNB
    }
}
constexpr int CVT_TOTAL = NE * 3 * 3584;
constexpr int CVT_GU_ITEMS = NE * 2 * 3584;
__device__ __forceinline__ void cvt_queue_item(const Frame& F, const Args& args, int gi, int lane) {
    if (gi >= CVT_TOTAL) return;
    const float* W; unsigned char* WT; int K, N, mode, item;
    if (gi < CVT_GU_ITEMS) { const int m = gi / 3584, e = m >> 1, kind = m & 1; item = gi - m * 3584;
        W = (kind == 0 ? args.in[I_WEG] : args.in[I_WEU]) + (size_t)e * DM * DFE; WT = F.ws + WS_WEGU + (size_t)e * 2 * DFE * DM; K = DM; N = DFE; mode = 1 + kind; }
    else { const int r = gi - CVT_GU_ITEMS, e = r / 3584; item = r - e * 3584; W = args.in[I_WED] + (size_t)e * DFE * DM; WT = F.ws + WS_WED + (size_t)e * DM * DFE; K = DFE; N = DM; mode = 0; }
    f32x4 v[16]; tr8_load(W, N, item, lane, v); tr8_store(WT, K, N, mode, item, lane, SC_W, nullptr, v);
}
__device__ __forceinline__ void xcd_barrier_w(const XcdBarrier& b, const Frame& F, const Args& args, volatile LAS unsigned* bx) {
    asm volatile("s_waitcnt vmcnt(0)" ::: "memory");
    __syncthreads();
    int tid_ = threadIdx.x; asm volatile("" : "+v"(tid_)); const int lane = tid_ & 63;
    if (threadIdx.x == 0) {
        unsigned* bar = b.bar;
        __builtin_amdgcn_s_waitcnt(0);
        unsigned nloc = b.st[0], nx = b.st[1];
        if (nloc == 0u) { xcd_barrier_complete(bar, b.x, nloc, nx); b.st[0] = nloc; b.st[1] = nx; }
        const unsigned old = xb_add(&bar[XB_XSUB(b.x)], 1u);
        const unsigned gen = old / nloc;
        if (old + 1u == (gen + 1u) * nloc) {
            __builtin_amdgcn_fence(__ATOMIC_RELEASE, "agent");
            asm volatile("s_waitcnt vmcnt(0)" ::: "memory");
            const unsigned og = xb_add(&bar[XB_TOP], 1u);
            const unsigned tg = og / nx;
            if (og + 1u == (tg + 1u) * nx) xb_add(&bar[XB_TOPGEN], 1u);
            else XB_SPIN(xb_ld(&bar[XB_TOPGEN]) == tg, bar);
            __builtin_amdgcn_fence(__ATOMIC_ACQUIRE, "agent");
            xb_add(&bar[XB_XGEN(b.x)], 1u);
            asm volatile("s_waitcnt vmcnt(0)" ::: "memory");
            bx[0] = 1u;
        } else { bx[0] = 0u; bx[2] = gen; }
    }
    __syncthreads();
    unsigned spins = 0u; bool dry = false;
    while (bx[0] == 0u) {
        __syncthreads();
        if (threadIdx.x == 0) {
            unsigned* bar = b.bar;
            bool rel = xb_ld(&bar[XB_XGEN(b.x)]) != bx[2];
            if (!rel && ((++spins & 63u) == 0u)) { if (xb_ld(&bar[XB_TMO])) rel = true; else if (spins > (XB_SPIN_CAP >> 1)) { atomicAdd(&bar[XB_TMO], 1u); rel = true; } }
            if (rel) { __builtin_amdgcn_fence(__ATOMIC_ACQUIRE, "agent"); asm volatile("s_waitcnt vmcnt(0)" ::: "memory"); bx[0] = 1u; }
            else if (!dry) { const unsigned c = xb_add(F.ctl + CW_CQ, 8u); bx[1] = c; dry = c >= (unsigned)CVT_TOTAL; }
            else { bx[1] = (unsigned)CVT_TOTAL; __builtin_amdgcn_s_sleep(2); }
        }
        __syncthreads();
        if (bx[0] == 0u) cvt_queue_item(F, args, (int)bx[1] + F.wave, lane);
    }
    __syncthreads();
}
__device__ __forceinline__ void cvt_drain(const Frame& F, const Args& args, volatile LAS unsigned* bx, int limit) {
    int tid_ = threadIdx.x; asm volatile("" : "+v"(tid_)); const int lane = tid_ & 63;
    for (;;) {
        __syncthreads();
        if (threadIdx.x == 0) { const unsigned c = xb_ld(F.ctl + CW_CQ); bx[1] = (c >= (unsigned)limit) ? 0xFFFFFFFFu : xb_add(F.ctl + CW_CQ, 8u); }
        __syncthreads();
        const unsigned base = bx[1]; if (base >= (unsigned)CVT_TOTAL) break;
        cvt_queue_item(F, args, (int)base + F.wave, lane);
        if (base >= (unsigned)limit) break;
    }
    __syncthreads();
}
__device__ __forceinline__ void phase_prologue(const Frame& F, const Args& args) {
    int tid_ = threadIdx.x; asm volatile("" : "+v"(tid_)); const int tid = tid_, lane = tid & 63;
    LAS float* scr = (LAS float*)(F.lds + F.wave * 16896);
    int it = F.gw; const int nw = F.ngw;
#define TR_RUN(Wp, Kk, Nn, Dp, ROFF, MODE) do { const int cnt_ = ((Kk) >> 6) * ((Nn) >> 5); while (it < cnt_) { transpose_item((Wp), (Kk), (Nn), (Dp), (ROFF), (MODE), scr, it, lane); it += nw; } it -= cnt_; } while (0)
#define TR_RUN8(Wp, Kk, Nn, Dp, ROFF, MODE) do { const int cnt_ = ((Kk) >> 7) * ((Nn) >> 5); while (it < cnt_) { transpose_item_f8((Wp), (Kk), (Nn), (Dp), (ROFF), (MODE), SC_W, scr, it, lane); it += nw; } it -= cnt_; } while (0)
    for (int l = 0; l < DEPTH; ++l) {
        TR_RUN(args.in[I_WIN] + (size_t)l * DM * DIN, DM, DIN, (bf16*)(F.ws + WS_WIN) + (size_t)l * DINP * DM, 0, 0);
        TR_RUN(args.in[I_WUQ] + (size_t)l * 512 * 768, 512, 768, (bf16*)(F.ws + WS_WUQ) + (size_t)l * 768 * 512, 0, 0);
        TR_RUN(args.in[I_WUKV] + (size_t)l * 256 * 1024, 256, 1024, (bf16*)(F.ws + WS_WUKV) + (size_t)l * 1024 * 256, 0, 0);
        if constexpr (F8WO) TR_RUN8(args.in[I_WOUT] + (size_t)l * DM * DM, DM, DM, (unsigned char*)(F.ws + WS_WOUT) + (size_t)l * DM * DM, 0, 0);
        else TR_RUN(args.in[I_WOUT] + (size_t)l * DM * DM, DM, DM, (bf16*)(F.ws + WS_WOUT) + (size_t)l * DM * DM, 0, 0);
    }
    if constexpr (F8DG) {
        TR_RUN8(args.in[I_WG], DM, DFF, (unsigned char*)(F.ws + WS_WGU), 0, 1);
        TR_RUN8(args.in[I_WU], DM, DFF, (unsigned char*)(F.ws + WS_WGU), 0, 2);
    } else {
        TR_RUN(args.in[I_WG], DM, DFF, (bf16*)(F.ws + WS_WGU), 0, 1);
        TR_RUN(args.in[I_WU], DM, DFF, (bf16*)(F.ws + WS_WGU), 0, 2);
    }
    if constexpr (F8DD) TR_RUN8(args.in[I_WDN], DFF, DM, (unsigned char*)(F.ws + WS_WD), 0, 0);
    else TR_RUN(args.in[I_WDN], DFF, DM, (bf16*)(F.ws + WS_WD), 0, 0);
#undef TR_RUN
#undef TR_RUN8
    for (int l = 0; l < DEPTH; ++l) { v4u* z = (v4u*)((bf16*)(F.ws + WS_WIN) + ((size_t)l * DINP + DIN) * DM); const v4u zz = {0u, 0u, 0u, 0u};
        for (int i = F.bid * NWAVES * 64 + tid; i < (DINP - DIN) * DM / 8; i += F.G * NWAVES * 64) z[i] = zz; }
    if (MOE_CVT_IN_ATTN == 0 || (MOE_CVT_IN_ATTN >= 2 && !F8M)) convert_experts(F, args, 0, NE, F.gw, F.ngw);
    phase_rmsnorm<false, false>(F, args.in[I_X], args.in[I_MIXN], F.ws + WS_H, 1.f);
}

__global__ void __launch_bounds__(NWAVES * 64, 2) mega_fwd(Args args) {
    extern __shared__ __attribute__((aligned(16))) unsigned char lds_raw[];
    Frame F;
    F.lds = (LAS unsigned char*)lds_raw; F.ws = args.ws; F.ctl = (unsigned*)(args.ws + WS_CTL);
    F.wave = __builtin_amdgcn_readfirstlane((int)threadIdx.x >> 6);
    F.G = gridDim.x; F.bid = blockIdx.x; F.gw = F.bid * NWAVES + F.wave; F.ngw = F.G * NWAVES;
    volatile LAS unsigned* MISC = (volatile LAS unsigned*)(F.lds + MISC_OFF);
    if (threadIdx.x < 64) MISC[threadIdx.x] = 0u;
    __syncthreads();
    XcdBarrier bar = xcd_barrier_post(F.ctl + CW_BAR, MISC + 8);
    const int lo = args.ph_lo, hi = args.ph_hi;
#define IN(k) (lo <= (k) && (k) < hi)
#if defined(PROBE_WHAT)
    unsigned long long pb_acc = 0ull, pb_t0 = 0ull, pb_cyc = 0ull, pb_c0 = 0ull;
#define PB_START(id) do { if ((id) == PROBE_WHAT) { pb_t0 = __builtin_amdgcn_s_memrealtime(); pb_c0 = __builtin_amdgcn_s_memtime(); } } while (0)
#define PB_STOP(id) do { if ((id) == PROBE_WHAT) { pb_acc += __builtin_amdgcn_s_memrealtime() - pb_t0; pb_cyc += __builtin_amdgcn_s_memtime() - pb_c0; } } while (0)
#else
#define PB_START(id) do {} while (0)
#define PB_STOP(id) do {} while (0)
#endif
#define SEAM_CLASS(k) (((k) == 1 || (k) == 3 || (k) == 7 || (k) == 9 || (k) == 10 || (k) == 12 || (k) == 14 || (k) == 18 || (k) == 21 || (k) == 22) ? 20 : (((k) == 5 || (k) == 16) ? 21 : 22))
#define SEAM(k) do { if (IN(k) && IN((k) + 1)) { PB_START(1); PB_START(SEAM_CLASS(k)); if (MOE_CVT_IN_ATTN == 3 && F8M && (k) < 19) xcd_barrier_w(bar, F, args, MISC + 16); else xcd_barrier(bar); PB_STOP(SEAM_CLASS(k)); PB_STOP(1); } } while (0)
    float* out = args.out;
    bf16* XB = (bf16*)(F.ws + WS_XB);
    LAS unsigned char* ring = F.lds;

    if (PHON(0) && IN(0)) { PB_START(58); phase_prologue(F, args); PB_STOP(58); }
    SEAM(0);

#pragma nounroll
    for (int l = 0; l < DEPTH; ++l) {
        const int P = 11 * l;
        if (PHON(1) && IN(P + 1)) { PB_START(30); PB_START(60);
            pg8::Gemm g{F.ws + WS_H, (const bf16*)(F.ws + WS_WIN) + (size_t)l * DINP * DM, NTOK, DINP, DM, 0}; pg8::StaticOrder S; S.init(NTOK, DINP, F.G, F.bid);
            pg8::EpiBf16 E{(bf16*)(F.ws + WS_PROJ), DINP};
            pg8::gemm_phase<pg8::EpiBf16, pg8::StaticOrder, true, true>(ring, g, S, E); PB_STOP(30); PB_STOP(60);
        }
        SEAM(P + 1);
        if (PHON(2) && IN(P + 2)) { PB_START(50); phase_postproj(F, args, l); PB_STOP(50); }
        SEAM(P + 2);
        if (PHON(3) && IN(P + 3)) { PB_START(61);
            { pg8::Gemm g{F.ws + WS_CQN, (const bf16*)(F.ws + WS_WUQ) + (size_t)l * 768 * 512, NTOK, 768, 512, 0}; pg8::StaticOrder S; S.init(NTOK, 768, F.G, F.bid);
              pg8::EpiBf16 E{(bf16*)(F.ws + WS_QCR), 768}; pg8::gemm_phase<pg8::EpiBf16, pg8::StaticOrder, true, true>(ring, g, S, E); }
            { pg8::Gemm g{F.ws + WS_CKVN, (const bf16*)(F.ws + WS_WUKV) + (size_t)l * 1024 * 256, NTOK, 1024, 256, 0}; pg8::StaticOrder S; S.init(NTOK, 1024, F.G, F.bid);
              pg8::EpiBf16 E{(bf16*)(F.ws + WS_KVR), 1024}; pg8::gemm_phase<pg8::EpiBf16, pg8::StaticOrder, true, true>(ring, g, S, E); }
            PB_STOP(61);
        }
        SEAM(P + 3);
        if (PHON(4) && IN(P + 4)) { PB_START(51); phase_postmla(F, args, l); PB_STOP(51); }
        SEAM(P + 4);
        if (PHON(5) && IN(P + 5)) { PB_START(2); PB_START(32); phase_attention(F, args, l); __syncthreads(); PB_STOP(32); PB_STOP(2); }
        SEAM(P + 5);
        if (PHON(6) && IN(P + 6)) { PB_START(52); phase_groupnorm(F, args, l); PB_STOP(52); }
        SEAM(P + 6);
        if (PHON(7) && IN(P + 7)) { PB_START(62);
            pg8::Gemm g{F.ws + WS_ON, F.ws + WS_WOUT + (size_t)l * DM * DM * (F8WO ? 1 : 2), NTOK, DM, DM, 0}; pg8::StaticOrder S; S.init(NTOK, DM, F.G, F.bid);
            constexpr float isc = F8WO ? 1.f / (SC_H * SC_W) : 1.f;
            if (l == 0) { pg8::EpiResBf16<false> E{args.in[I_X], XB, DM, isc}; pg8::gemm_phase<pg8::EpiResBf16<false>, pg8::StaticOrder, true, true, F8WO>(ring, g, S, E); }
            else { pg8::EpiResBf16<true> E{XB, XB, DM, isc}; pg8::gemm_phase<pg8::EpiResBf16<true>, pg8::StaticOrder, true, true, F8WO>(ring, g, S, E); }
            PB_STOP(62);
        }
        SEAM(P + 7);
        if (l == 0) {
            if (PHON(8) && IN(P + 8)) { PB_START(53); phase_rmsnorm<F8DG, true>(F, XB, args.in[I_FFNN] + (size_t)l * DM, F.ws + WS_H, F8DG ? SC_H : 1.f); PB_STOP(53); }
            SEAM(P + 8);
            if (PHON(9) && IN(P + 9)) { PB_START(63);
                pg8::Gemm g{F.ws + WS_H, F.ws + WS_WGU, NTOK, 2 * DFF, DM, 0}; pg8::StaticOrder S; S.init(NTOK, 2 * DFF, F.G, F.bid);
                constexpr float isc = F8DG ? 1.f / (SC_H * SC_W) : 1.f;
                if constexpr (F8DD) { pg8::EpiSwigluF8 E{F.ws + WS_ACT, DFF, SC_ACT, isc}; pg8::gemm_phase<pg8::EpiSwigluF8, pg8::StaticOrder, true, true, F8DG>(ring, g, S, E); }
                else { pg8::EpiSwiglu E{(bf16*)(F.ws + WS_ACT), DFF, isc}; pg8::gemm_phase<pg8::EpiSwiglu, pg8::StaticOrder, true, true, F8DG>(ring, g, S, E); }
                PB_STOP(63);
            }
            SEAM(P + 9);
            if (PHON(10) && IN(P + 10)) { PB_START(64);
                pg8::Gemm g{F.ws + WS_ACT, F.ws + WS_WD, NTOK, DM, DFF, 0}; pg8::StaticOrder S; S.init(NTOK, DM, F.G, F.bid);
                pg8::EpiResBf16<true> E{XB, XB, DM, F8DD ? 1.f / (SC_ACT * SC_W) : 1.f};
                pg8::gemm_phase<pg8::EpiResBf16<true>, pg8::StaticOrder, true, true, F8DD>(ring, g, S, E); PB_STOP(64);
            }
            SEAM(P + 10);
            if (PHON(8) && IN(P + 11)) { PB_START(53); phase_rmsnorm<false, true>(F, XB, args.in[I_MIXN] + (size_t)(l + 1) * DM, F.ws + WS_H, 1.f); PB_STOP(53); }
            SEAM(P + 11);
        } else {
            if (PHON(11) && IN(P + 8) && MOE_CVT_IN_ATTN == 3 && F8M) cvt_drain(F, args, MISC + 16, CVT_TOTAL);
            if (PHON(11) && IN(P + 8)) { PB_START(54); phase_ffnnorm_route<F8M, true>(F, args, XB, args.in[I_FFNN] + (size_t)l * DM, F.ws + WS_H, SC_H); PB_STOP(54); }
            SEAM(P + 8);
            if (PHON(12) && IN(P + 9)) { PB_START(55); phase_gather<F8M>(F); PB_STOP(55); }
            SEAM(P + 9);
            if (PHON(13) && IN(P + 10)) { PB_START(31); PB_START(65);
                int tb[9], cnt[8]; moe_tiles(F, tb, cnt);
                pg8::Gemm g{F.ws + WS_HG, F.ws + WS_WEGU, tb[8] * 256, 2 * DFE, DM, 0}; pg8::GroupedOrder S; S.init(tb[8] * 256, 2 * DFE, F.G, F.bid);
#pragma unroll
                for (int k = 0; k < 7; ++k) S.tb[k] = tb[k + 1];
                S.nct = 2 * DFE / 256; S.lim = 0;
                if constexpr (F8M) { pg8::EpiSwigluF8 E{F.ws + WS_ACTM, DFE, SC_ACT, 1.f / (SC_H * SC_W)}; pg8::gemm_phase<pg8::EpiSwigluF8, pg8::GroupedOrder, true, true, true>(ring, g, S, E); }
                else { pg8::EpiSwiglu E{(bf16*)(F.ws + WS_ACTM), DFE, 1.f}; pg8::gemm_phase<pg8::EpiSwiglu, pg8::GroupedOrder, true, true, false>(ring, g, S, E); }
                PB_STOP(31); PB_STOP(65);
            }
            SEAM(P + 10);
            if (PHON(14) && IN(P + 11)) { PB_START(66);
                int tb[9], cnt[8]; moe_tiles(F, tb, cnt);
                const int nun = tb[8] * (DM / 256), nfull = (F.G == 256 && F8M) ? (nun / 256) * 256 : nun;
                { pg8::Gemm g{F.ws + WS_ACTM, F.ws + WS_WED, tb[8] * 256, DM, DFE, 0}; pg8::GroupedOrder S; S.init(tb[8] * 256, DM, F.G, F.bid);
#pragma unroll
                  for (int k = 0; k < 7; ++k) S.tb[k] = tb[k + 1];
                  S.nct = DM / 256; S.lim = nfull;
                  pg8::EpiScaleBf16 E{(bf16*)(F.ws + WS_Y), DM, (const float*)(F.ws + WS_RGATE), F8M ? 1.f / (SC_ACT * SC_W) : 1.f};
                  pg8::gemm_phase<pg8::EpiScaleBf16, pg8::GroupedOrder, true, true, F8M>(ring, g, S, E); }
                if (nfull < nun) { const int nsp = 4;
                  pg8::Gemm g{F.ws + WS_ACTM, F.ws + WS_WED, tb[8] * 256, DM, DFE, DFE / 128 / nsp}; pg8::GroupedTail S; S.init(tb[8] * 256, DM, F.G, F.bid);
#pragma unroll
                  for (int k = 0; k < 7; ++k) S.tb[k] = tb[k + 1];
                  S.nct = DM / 256; S.lim = nfull; S.nsp = nsp; S.kslice = DFE / nsp;
                  pg8::EpiPartF32 E{(float*)(F.ws + WS_PART)};
                  pg8::gemm_phase<pg8::EpiPartF32, pg8::GroupedTail, true, true, F8M>(ring, g, S, E); }
                PB_STOP(66);
            }
            SEAM(P + 11);
            if (PHON(14) && IN(P + 12)) { PB_START(56); phase_tailsum(F); PB_STOP(56); }
            SEAM(P + 12);
            if (PHON(15) && IN(P + 13)) { PB_START(57); phase_combine<true>(F, XB, out); PB_STOP(57); }
        }
    }
#if defined(PROBE_WHAT)
    if (blockIdx.x == PROBE_BLOCK && threadIdx.x < 64) { const unsigned long long t0 = __builtin_amdgcn_s_memrealtime(); const unsigned long long spin = (PROBE_WHAT >= 30 && PROBE_WHAT < 50) ? (pb_acc ? (pb_cyc * 100ull / pb_acc) * 50ull : 0ull) : (unsigned long long)PROBE_AMP * pb_acc;
        while (__builtin_amdgcn_s_memrealtime() - t0 < spin) __builtin_amdgcn_s_sleep(8); }
#endif
#undef IN
#undef SEAM
}

extern "C" void kernel_launch(void* const* d_in, const int* in_sizes, int n_in, void* d_out, int out_size, void* d_ws, size_t ws_size, hipStream_t stream) {
    static int grid = 0;
    if (grid == 0) {
        if (n_in != 26 || in_sizes[0] != NTOK * DM || out_size != NTOK * DM || ws_size < WS_END3) { fprintf(stderr, "kernel_launch: unexpected shapes (n_in %d, in0 %d, out %d, ws %zu < %zu)\n", n_in, n_in > 0 ? in_sizes[0] : -1, out_size, ws_size, (size_t)WS_END3); grid = -1; return; }
        int dev = 0, cus = 0, per_cu = 0;
        if (hipGetDevice(&dev) != hipSuccess || hipDeviceGetAttribute(&cus, hipDeviceAttributeMultiprocessorCount, dev) != hipSuccess) { grid = -1; return; }
        if (hipFuncSetAttribute((const void*)mega_fwd, hipFuncAttributeMaxDynamicSharedMemorySize, LDS_BYTES) != hipSuccess) { fprintf(stderr, "kernel_launch: hipFuncSetAttribute failed\n"); grid = -1; return; }
        if (hipOccupancyMaxActiveBlocksPerMultiprocessor(&per_cu, (const void*)mega_fwd, NWAVES * 64, LDS_BYTES) != hipSuccess || per_cu < 1) fprintf(stderr, "kernel_launch: occupancy query reports %d\n", per_cu);
        (void)hipGetLastError();
        grid = cus;
    }
    if (grid < 0) return;
    if (hipMemsetAsync((char*)d_ws + WS_CTL, 0, CTL_ZERO_BYTES, stream) != hipSuccess) return;
    Args a{};
    for (int i = 0; i < 26; ++i) a.in[i] = (const float*)d_in[i];
    a.out = (float*)d_out; a.ws = (unsigned char*)d_ws;
#ifndef MK_SPLIT
    a.ph_lo = 0; a.ph_hi = NPHASE;
    hipLaunchKernelGGL(mega_fwd, dim3(grid), dim3(NWAVES * 64), LDS_BYTES, stream, a);
#else
    for (int p = 0; p < NPHASE; ++p) { a.ph_lo = p; a.ph_hi = p + 1; hipLaunchKernelGGL(mega_fwd, dim3(grid), dim3(NWAVES * 64), LDS_BYTES, stream, a); }
#endif
}
```

```cpp
#include <hip/hip_runtime.h>
#include <cstdio>
#include <cstdint>
namespace pg8 {
#define PG8_LAS __attribute__((address_space(3)))
typedef unsigned short bf16_t;
typedef short bf16x8 __attribute__((ext_vector_type(8)));
typedef float f32x4 __attribute__((ext_vector_type(4)));
typedef unsigned u32x4 __attribute__((ext_vector_type(4)));
constexpr int BM = 256, BK = 64, HALF = 128, HTB = HALF * BK * 2  , STAGE_BYTES = 8 * HTB, NXCD = 8, WGM = 8;

__host__ __device__ __forceinline__ int lds_byte(int r, int c) { const int st = (r >> 4) * 2 + (c >> 5), rr = r & 15, cc = c & 31, ob = rr * 64 + cc * 2; return st * 1024 + (ob ^ (((ob >> 9) & 1) << 5)); }
__host__ __device__ __forceinline__ void stage_rc(int b, int& R, int& C) { const int st = b / 1024, sb = b % 1024, swz = sb ^ (((sb >> 9) & 1) << 5); R = (st >> 1) * 16 + swz / 64; C = (st & 1) * 32 + (swz % 64) / 2; }
__host__ __device__ __forceinline__ int perm32(int rho) { const int n = rho >> 4, i = rho & 15; return 8 * (i >> 2) + 4 * n + (i & 3); }


struct Unit { int pm, pn, pc, ko; };
struct Gemm { const void* A; const void* Bt; int M, N, K, kt; };
typedef int i32x4 __attribute__((ext_vector_type(4)));
typedef int i32x8 __attribute__((ext_vector_type(8)));

struct StaticOrder {
    int nM, nN, nwg, G, c;
    __device__ __forceinline__ void init(int M, int N, int G_, int c_) { nM = M / BM; nN = N / BM; nwg = nM * nN; G = G_; c = c_; }
    __device__ __forceinline__ bool next(int i, Unit& u) const {
        const long L = (long)i * G + c; if (L >= nwg) return false;
        int wgid = (int)L; { const int q = nwg / NXCD, r = nwg % NXCD, xcd = wgid % NXCD, off = wgid / NXCD; wgid = (xcd < r ? xcd * (q + 1) : r * (q + 1) + (xcd - r) * q) + off; }
        const int nig = WGM * nN, gid = wgid / nig, fm = gid * WGM, gsz = (nM - fm) < WGM ? (nM - fm) : WGM;
        u.pm = fm + ((wgid % nig) % gsz); u.pn = (wgid % nig) / gsz; u.pc = u.pn; u.ko = 0; return true;
    }
    __device__ __forceinline__ void a_ready(const Unit&) const {}
    __device__ __forceinline__ void done(const Unit&) const {}
};
struct GroupedOrder : StaticOrder {
    int tb[7]; int nct; int lim;
    __device__ __forceinline__ void expert(Unit& u) const { int e = 0;
#pragma unroll
        for (int k = 0; k < 7; ++k) e += (u.pm >= tb[k]) ? 1 : 0;
        u.pc = u.pn; u.pn += e * nct; }
    __device__ __forceinline__ bool next(int i, Unit& u) const {
        if (lim > 0 && (long)i * G + c >= lim) return false;
        if (!StaticOrder::next(i, u)) return false;
        expert(u); return true;
    }
};
struct GroupedTail : GroupedOrder {
    int nsp, kslice;
    __device__ __forceinline__ bool next(int i, Unit& u) const {
        if (i > 0) return false;
        const int ent = lim + c / nsp; if (ent >= nwg) return false;
        StaticOrder s = *this; s.c = ent % G; if (!s.next(ent / G, u)) return false;
        expert(u); u.ko = (c % nsp) * kslice; u.pc = c; return true;
    }
};

__device__ __forceinline__ unsigned cvt_pk_bf16(float lo, float hi) { unsigned r; asm volatile("v_cvt_pk_bf16_f32 %0, %1, %2" : "=v"(r) : "v"(lo), "v"(hi)); return r; }

struct EpiBf16 {
    static constexpr bool PERM = true, AFTER_DRAIN = false;
    bf16_t* O; int ldc;
    __device__ __forceinline__ void operator()(const f32x4 (&acc)[2][2][4][2], const Unit& u, int wr, int wc, int fr, int fq) const {
        const int row0 = u.pm * BM + wr * 64 + fr, col0 = u.pc * BM + wc * 32 + 8 * fq;
#pragma unroll
        for (int ai = 0; ai < 2; ++ai)
#pragma unroll
            for (int m = 0; m < 4; ++m) { bf16_t* rowp = O + (size_t)(row0 + ai * HALF + m * 16) * ldc + col0;
#pragma unroll
                for (int bj = 0; bj < 2; ++bj) { const f32x4 v0 = acc[ai][bj][m][0], v1 = acc[ai][bj][m][1];
                    u32x4 w; w.x = cvt_pk_bf16(v0[0], v0[1]); w.y = cvt_pk_bf16(v0[2], v0[3]); w.z = cvt_pk_bf16(v1[0], v1[1]); w.w = cvt_pk_bf16(v1[2], v1[3]);
                    *(u32x4*)(rowp + bj * HALF) = w; } }
    }
};
struct EpiPartF32 {
    static constexpr bool PERM = true, AFTER_DRAIN = false;
    float* P;
    __device__ __forceinline__ void operator()(const f32x4 (&acc)[2][2][4][2], const Unit& u, int wr, int wc, int fr, int fq) const {
        float* t = P + (size_t)u.pc * 65536 + (size_t)(wr * 64 + fr) * 256 + wc * 32 + 8 * fq;
#pragma unroll
        for (int ai = 0; ai < 2; ++ai)
#pragma unroll
            for (int m = 0; m < 4; ++m)
#pragma unroll
                for (int bj = 0; bj < 2; ++bj) { float* q = t + (size_t)(ai * HALF + m * 16) * 256 + bj * HALF; *(f32x4*)q = acc[ai][bj][m][0]; *(f32x4*)(q + 4) = acc[ai][bj][m][1]; }
    }
};
struct EpiScaleBf16 {
    static constexpr bool PERM = true, AFTER_DRAIN = false;
    bf16_t* O; int ldc; const float* rs; float isc;
    __device__ __forceinline__ void operator()(const f32x4 (&acc)[2][2][4][2], const Unit& u, int wr, int wc, int fr, int fq) const {
        const int row0 = u.pm * BM + wr * 64 + fr, col0 = u.pc * BM + wc * 32 + 8 * fq;
#pragma unroll
        for (int ai = 0; ai < 2; ++ai)
#pragma unroll
            for (int m = 0; m < 4; ++m) { const int row = row0 + ai * HALF + m * 16; const float s = rs[row] * isc; bf16_t* rowp = O + (size_t)row * ldc + col0;
#pragma unroll
                for (int bj = 0; bj < 2; ++bj) { const f32x4 v0 = acc[ai][bj][m][0] * s, v1 = acc[ai][bj][m][1] * s;
                    u32x4 w; w.x = cvt_pk_bf16(v0[0], v0[1]); w.y = cvt_pk_bf16(v0[2], v0[3]); w.z = cvt_pk_bf16(v1[0], v1[1]); w.w = cvt_pk_bf16(v1[2], v1[3]);
                    *(u32x4*)(rowp + bj * HALF) = w; } }
    }
};
struct EpiResF32 {
    static constexpr bool PERM = false, AFTER_DRAIN = false;
    const float* base; float* out; int ldc; float isc;
    __device__ __forceinline__ void operator()(const f32x4 (&acc)[2][2][4][2], const Unit& u, int wr, int wc, int fr, int fq) const {
        const int row0 = u.pm * BM + wr * 64 + fr, col0 = u.pc * BM + wc * 32 + 4 * fq;
#pragma unroll
        for (int ai = 0; ai < 2; ++ai)
#pragma unroll
            for (int m = 0; m < 4; ++m) { const size_t off = (size_t)(row0 + ai * HALF + m * 16) * ldc + col0;
                f32x4 b[2][2];
#pragma unroll
                for (int bj = 0; bj < 2; ++bj)
#pragma unroll
                    for (int n = 0; n < 2; ++n) b[bj][n] = *(const f32x4*)(base + off + bj * HALF + n * 16);
#pragma unroll
                for (int bj = 0; bj < 2; ++bj)
#pragma unroll
                    for (int n = 0; n < 2; ++n) *(f32x4*)(out + off + bj * HALF + n * 16) = b[bj][n] + acc[ai][bj][m][n] * isc;
                asm volatile("" ::: "memory"); }
    }
};
template <bool BASEB> struct EpiResBf16 {
    static constexpr bool PERM = true, AFTER_DRAIN = false;
    const void* base; bf16_t* out; int ldc; float isc;
    __device__ __forceinline__ void operator()(const f32x4 (&acc)[2][2][4][2], const Unit& u, int wr, int wc, int fr, int fq) const {
        const int row0 = u.pm * BM + wr * 64 + fr, col0 = u.pc * BM + wc * 32 + 8 * fq;
        if constexpr (BASEB) {
            constexpr int AH = 2;
            u32x4 w[8][2];
#define PG8_RLOAD(g) do { const size_t off_ = (size_t)(row0 + ((g) >> 2) * HALF + ((g) & 3) * 16) * ldc + col0; \
                w[g][0] = *(const u32x4*)((const bf16_t*)base + off_); w[g][1] = *(const u32x4*)((const bf16_t*)base + off_ + HALF); } while (0)
#pragma unroll
            for (int g = 0; g < AH; ++g) PG8_RLOAD(g);
#pragma unroll
            for (int g = 0; g < 8; ++g) { const int ai = g >> 2, m = g & 3; const size_t off = (size_t)(row0 + ai * HALF + m * 16) * ldc + col0;
                if (g + AH < 8) PG8_RLOAD(g + AH < 8 ? g + AH : 0);
#pragma unroll
                for (int bj = 0; bj < 2; ++bj) { const u32x4 ww = w[g][bj];
                    const f32x4 b0 = (f32x4){__uint_as_float(ww.x << 16), __uint_as_float(ww.x & 0xffff0000u), __uint_as_float(ww.y << 16), __uint_as_float(ww.y & 0xffff0000u)};
                    const f32x4 b1 = (f32x4){__uint_as_float(ww.z << 16), __uint_as_float(ww.z & 0xffff0000u), __uint_as_float(ww.w << 16), __uint_as_float(ww.w & 0xffff0000u)};
                    const f32x4 v0 = b0 + acc[ai][bj][m][0] * isc, v1 = b1 + acc[ai][bj][m][1] * isc;
                    u32x4 o; o.x = cvt_pk_bf16(v0[0], v0[1]); o.y = cvt_pk_bf16(v0[2], v0[3]); o.z = cvt_pk_bf16(v1[0], v1[1]); o.w = cvt_pk_bf16(v1[2], v1[3]);
                    *(u32x4*)(out + off + bj * HALF) = o; }
                asm volatile("" ::: "memory"); }
#undef PG8_RLOAD
        } else {
#pragma unroll
        for (int ai = 0; ai < 2; ++ai)
#pragma unroll
            for (int m = 0; m < 4; ++m) { const size_t off = (size_t)(row0 + ai * HALF + m * 16) * ldc + col0;
#pragma unroll
                for (int bj = 0; bj < 2; ++bj) { f32x4 b0, b1;
                    b0 = *(const f32x4*)((const float*)base + off + bj * HALF); b1 = *(const f32x4*)((const float*)base + off + bj * HALF + 4);
                    const f32x4 v0 = b0 + acc[ai][bj][m][0] * isc, v1 = b1 + acc[ai][bj][m][1] * isc;
                    u32x4 o; o.x = cvt_pk_bf16(v0[0], v0[1]); o.y = cvt_pk_bf16(v0[2], v0[3]); o.z = cvt_pk_bf16(v1[0], v1[1]); o.w = cvt_pk_bf16(v1[2], v1[3]);
                    *(u32x4*)(out + off + bj * HALF) = o; }
                asm volatile("" ::: "memory"); }
        }
    }
};
__device__ __forceinline__ float silu_mul(float g, float u) { return g * u * __builtin_amdgcn_rcpf(1.0f + __builtin_amdgcn_exp2f(-1.44269504089f * g)); }
struct EpiSwiglu {
    static constexpr bool PERM = true, AFTER_DRAIN = false;
    bf16_t* O; int ldc; float isc;
    __device__ __forceinline__ void operator()(const f32x4 (&acc)[2][2][4][2], const Unit& u, int wr, int wc, int fr, int fq) const {
        const int row0 = u.pm * BM + wr * 64 + fr, col0 = u.pc * HALF + wc * 32 + 8 * fq;
#pragma unroll
        for (int ai = 0; ai < 2; ++ai)
#pragma unroll
            for (int m = 0; m < 4; ++m) { bf16_t* rowp = O + (size_t)(row0 + ai * HALF + m * 16) * ldc + col0;
                const f32x4 g0 = acc[ai][0][m][0] * isc, g1 = acc[ai][0][m][1] * isc, u0 = acc[ai][1][m][0] * isc, u1 = acc[ai][1][m][1] * isc;
                u32x4 w; w.x = cvt_pk_bf16(silu_mul(g0[0], u0[0]), silu_mul(g0[1], u0[1])); w.y = cvt_pk_bf16(silu_mul(g0[2], u0[2]), silu_mul(g0[3], u0[3]));
                w.z = cvt_pk_bf16(silu_mul(g1[0], u1[0]), silu_mul(g1[1], u1[1])); w.w = cvt_pk_bf16(silu_mul(g1[2], u1[2]), silu_mul(g1[3], u1[3]));
                *(u32x4*)rowp = w; }
    }
};

__device__ __forceinline__ unsigned cvt_pk4_fp8(float a, float b, float c, float d) { unsigned w = 0u; w = __builtin_amdgcn_cvt_pk_fp8_f32(a, b, w, false); w = __builtin_amdgcn_cvt_pk_fp8_f32(c, d, w, true); return w; }
struct EpiSwigluF8 {
    static constexpr bool PERM = true, AFTER_DRAIN = false;
    unsigned char* O; int ldc; float osc, isc;
    __device__ __forceinline__ void operator()(const f32x4 (&acc)[2][2][4][2], const Unit& u, int wr, int wc, int fr, int fq) const {
        typedef float f32x2 __attribute__((ext_vector_type(2)));
        typedef unsigned u32x2 __attribute__((ext_vector_type(2)));
        const int row0 = u.pm * BM + wr * 64 + fr, col0 = u.pc * HALF + wc * 32 + 8 * fq;
        const float k1i = 1.f / (osc * isc * isc), k2s = -1.44269504089f * isc; const f32x2 K2 = {k2s, k2s}, IK1 = {k1i, k1i};
#define SWF8P(G, U, OUT) do { const f32x2 t_ = (G) * K2; f32x2 e_; e_.x = __builtin_amdgcn_exp2f(t_.x); e_.y = __builtin_amdgcn_exp2f(t_.y); \
            const f32x2 d_ = e_ * IK1 + IK1; f32x2 r_; r_.x = __builtin_amdgcn_rcpf(d_.x); r_.y = __builtin_amdgcn_rcpf(d_.y); OUT = ((G) * (U)) * r_; } while (0)
#pragma unroll
        for (int ai = 0; ai < 2; ++ai)
#pragma unroll
            for (int m = 0; m < 4; ++m) { unsigned char* rowp = O + (size_t)(row0 + ai * HALF + m * 16) * ldc + col0;
                u32x2 w;
#pragma unroll
                for (int h = 0; h < 2; ++h) { const f32x4 g4 = acc[ai][0][m][h], u4 = acc[ai][1][m][h];
                    const f32x2 ga = {g4[0], g4[1]}, gb = {g4[2], g4[3]}, ua = {u4[0], u4[1]}, ub = {u4[2], u4[3]}; f32x2 oa, ob;
                    SWF8P(ga, ua, oa); SWF8P(gb, ub, ob);
                    const unsigned pk = cvt_pk4_fp8(oa.x, oa.y, ob.x, ob.y); if (h == 0) w.x = pk; else w.y = pk; }
                *(u32x2*)rowp = w; }
#undef SWF8P
    }
};

template <class Epi, class Sched, bool ALIGN_EPI = false, bool SP2 = false, bool F8 = false>
__device__ __forceinline__ void gemm_phase(PG8_LAS unsigned char* lds, const Gemm g, const Sched& S, const Epi& E, const void* wsbase) {
    int tid_ = threadIdx.x; asm volatile("" : "+v"(tid_));
    const int tid = tid_, wid = __builtin_amdgcn_readfirstlane(tid >> 6), lane = tid & 63, wr = wid >> 2, wc = wid & 3, fr = lane & 15, fq = lane >> 4;
    const int K = g.K, RB = F8 ? K : 2 * K;
    const int nt = g.kt > 0 ? g.kt : (F8 ? K / (2 * BK) : K / BK);
    unsigned voffA[2], voffB[2];
#pragma unroll
    for (int i = 0; i < 2; ++i) { int R, C; stage_rc(tid * 16 + i * 8192, R, C); const int Rb = Epi::PERM ? ((R & ~31) + perm32(R & 31)) : R;
        voffA[i] = (unsigned)(R * RB + C * 2); voffB[i] = (unsigned)(Rb * RB + C * 2); }
    const size_t kstep = (size_t)(BK * 2);
    const size_t hstep = (size_t)HALF * RB;
    const size_t tstep = 2 * hstep;
    const unsigned ldsw = (unsigned)wid * 1024u;
    const int aoff = F8 ? lds_byte(wr * 64 + fr, fq * 16) : lds_byte(wr * 64 + fr, fq * 8), boff = F8 ? lds_byte(wc * 32 + fr, fq * 16) : lds_byte(wc * 32 + fr, fq * 8);
#define PG8_SA(b, h) (((b) * 2 + (h)) * HTB)
#define PG8_SB(b, h) ((4 + (b) * 2 + (h)) * HTB)
    const __amdgpu_buffer_rsrc_t rsW = __builtin_amdgcn_make_buffer_rsrc((void*)wsbase, 0, 0x7fffffff, 0x00020000);
#define PG8_STAGE(bufoff, gbase, voff) do { const unsigned so_ = (unsigned)__builtin_amdgcn_readfirstlane((int)((const char*)(gbase) - (const char*)wsbase)); _Pragma("unroll") for (int _i = 0; _i < 2; ++_i) \
        __builtin_amdgcn_raw_ptr_buffer_load_lds(rsW, (PG8_LAS void*)(lds + (bufoff) + ldsw + _i * 8192), 16, (voff)[_i], so_, 0, 0); } while (0)
#define PG8_LD16(p) (*(const PG8_LAS i32x4*)(p))
#define PG8_LDA(dst, b, h) do { _Pragma("unroll") for (int m = 0; m < 4; ++m) { if constexpr (F8) { dst##8[m] = __builtin_shufflevector(PG8_LD16(lds + PG8_SA(b, h) + aoff + m * 2048), PG8_LD16(lds + PG8_SA(b, h) + aoff + m * 2048 + 16), 0, 1, 2, 3, 4, 5, 6, 7); } \
        else { _Pragma("unroll") for (int k = 0; k < 2; ++k) dst[m][k] = *(const PG8_LAS bf16x8*)(lds + PG8_SA(b, h) + aoff + m * 2048 + k * 1024); } } } while (0)
#define PG8_LDB(dst, b, h) do { _Pragma("unroll") for (int n = 0; n < 2; ++n) { if constexpr (F8) { dst##8[n] = __builtin_shufflevector(PG8_LD16(lds + PG8_SB(b, h) + boff + n * 2048), PG8_LD16(lds + PG8_SB(b, h) + boff + n * 2048 + 16), 0, 1, 2, 3, 4, 5, 6, 7); } \
        else { _Pragma("unroll") for (int k = 0; k < 2; ++k) dst[n][k] = *(const PG8_LAS bf16x8*)(lds + PG8_SB(b, h) + boff + n * 2048 + k * 1024); } } } while (0)
#define PG8_MMA(ai, bj, At, Bt) do { __builtin_amdgcn_s_setprio(1); _Pragma("unroll") for (int m = 0; m < 4; ++m) _Pragma("unroll") for (int n = 0; n < 2; ++n) { \
        if constexpr (F8) asm volatile("v_mfma_f32_16x16x128_f8f6f4 %0, %1, %2, %0" : "+v"(acc[ai][bj][m][n]) : "v"(Bt##8[n]), "v"(At##8[m])); \
        else { _Pragma("unroll") for (int k = 0; k < 2; ++k) acc[ai][bj][m][n] = __builtin_amdgcn_mfma_f32_16x16x32_bf16(Bt[n][k], At[m][k], acc[ai][bj][m][n], 0, 0, 0); } } __builtin_amdgcn_s_setprio(0); } while (0)
#define PG8_WAIT_V(n) asm volatile("s_waitcnt vmcnt(" #n ")" ::: "memory")
#define PG8_WAIT_L(n) asm volatile("s_waitcnt lgkmcnt(" #n ")" ::: "memory")
#define PG8_BAR __builtin_amdgcn_s_barrier()
#define PG8_SCHED __builtin_amdgcn_sched_barrier(0)
    Unit cur, nxt; int ui = 0;
    if (!S.next(0, cur)) return;
    f32x4 acc[2][2][4][2];
#pragma unroll
    for (int a = 0; a < 2; ++a)
#pragma unroll
        for (int b = 0; b < 2; ++b)
#pragma unroll
            for (int m = 0; m < 4; ++m)
#pragma unroll
                for (int n = 0; n < 2; ++n) acc[a][b][m][n] = (f32x4){0.f, 0.f, 0.f, 0.f};
    bf16x8 At[4][2], B0[2][2], B1[2][2]; i32x8 At8[4], B08[2], B18[2];
    const char* cA = (const char*)g.A + (size_t)cur.pm * tstep + cur.ko; const char* cB = (const char*)g.Bt + (size_t)cur.pn * tstep + cur.ko;
    S.a_ready(cur);
    if constexpr (SP2) {
        PG8_STAGE(PG8_SB(0, 0), cB, voffB); PG8_STAGE(PG8_SB(0, 1), cB + hstep, voffB); PG8_STAGE(PG8_SA(0, 0), cA, voffA); PG8_STAGE(PG8_SA(0, 1), cA + hstep, voffA);
        if (wr == 1) PG8_BAR;
        PG8_WAIT_V(2); PG8_BAR;
        PG8_STAGE(PG8_SB(1, 0), cB + kstep, voffB); PG8_STAGE(PG8_SA(1, 0), cA + kstep, voffA); PG8_STAGE(PG8_SB(1, 1), cB + hstep + kstep, voffB);
        PG8_WAIT_V(6); PG8_BAR;
    } else {
        PG8_STAGE(PG8_SB(0, 0), cB, voffB); PG8_STAGE(PG8_SA(0, 0), cA, voffA); PG8_STAGE(PG8_SB(0, 1), cB + hstep, voffB); PG8_STAGE(PG8_SA(0, 1), cA + hstep, voffA);
        if (wr == 1) PG8_BAR;
        PG8_WAIT_V(4); PG8_BAR;
        PG8_STAGE(PG8_SB(1, 0), cB + kstep, voffB); PG8_STAGE(PG8_SA(1, 0), cA + kstep, voffA); PG8_STAGE(PG8_SB(1, 1), cB + hstep + kstep, voffB);
        PG8_WAIT_V(6); PG8_BAR;
    }
    for (;;) {
        const bool has_next = S.next(ui + 1, nxt);
        const char* nA = has_next ? (const char*)g.A + (size_t)nxt.pm * tstep + nxt.ko : cA; const char* nB = has_next ? (const char*)g.Bt + (size_t)nxt.pn * tstep + nxt.ko : cB;
        for (int t = 0; t < nt; t += 2) {
            const bool last = (t == nt - 2);
            const char* a1 = cA + (size_t)(t + 1) * kstep;
            const char* a2 = last ? nA : cA + (size_t)(t + 2) * kstep; const char* b2 = last ? nB : cB + (size_t)(t + 2) * kstep;
            const char* a3 = a2 + kstep; const char* b3 = b2 + kstep;
            if (last && has_next) S.a_ready(nxt);
            if constexpr (SP2) {
            PG8_LDB(B0, 0, 0); PG8_LDB(B1, 0, 1); PG8_SCHED; PG8_LDA(At, 0, 0); PG8_STAGE(PG8_SA(1, 1), a1 + hstep, voffA);
            PG8_WAIT_V(8); PG8_WAIT_L(0); PG8_BAR; PG8_MMA(0, 0, At, B0); PG8_MMA(0, 1, At, B1); PG8_BAR; PG8_SCHED;
            PG8_LDA(At, 0, 1); PG8_STAGE(PG8_SB(0, 0), b2, voffB); PG8_STAGE(PG8_SB(0, 1), b2 + hstep, voffB); PG8_STAGE(PG8_SA(0, 0), a2, voffA);
            PG8_WAIT_V(8); PG8_WAIT_L(0); PG8_BAR; PG8_MMA(1, 0, At, B0); PG8_MMA(1, 1, At, B1); PG8_BAR; PG8_SCHED;
            PG8_LDB(B0, 1, 0); PG8_LDB(B1, 1, 1); PG8_SCHED; PG8_LDA(At, 1, 0); PG8_STAGE(PG8_SA(0, 1), a2 + hstep, voffA);
            PG8_WAIT_V(8); PG8_WAIT_L(0); PG8_BAR; PG8_MMA(0, 0, At, B0); PG8_MMA(0, 1, At, B1); PG8_BAR; PG8_SCHED;
            PG8_LDA(At, 1, 1); PG8_STAGE(PG8_SB(1, 0), b3, voffB); PG8_STAGE(PG8_SB(1, 1), b3 + hstep, voffB); PG8_STAGE(PG8_SA(1, 0), a3, voffA);
            PG8_WAIT_V(8); PG8_WAIT_L(0); PG8_BAR; PG8_MMA(1, 0, At, B0); PG8_MMA(1, 1, At, B1); PG8_BAR; PG8_SCHED;
            } else {
            PG8_LDB(B0, 0, 0); PG8_SCHED; PG8_LDA(At, 0, 0); PG8_STAGE(PG8_SA(1, 1), a1 + hstep, voffA);
            PG8_WAIT_L(8); PG8_BAR; PG8_WAIT_L(0); PG8_MMA(0, 0, At, B0); PG8_BAR; PG8_SCHED;
            PG8_LDB(B1, 0, 1); PG8_STAGE(PG8_SB(0, 0), b2, voffB);
            PG8_BAR; PG8_WAIT_L(0); PG8_MMA(0, 1, At, B1); PG8_BAR;
            PG8_LDA(At, 0, 1); PG8_STAGE(PG8_SA(0, 0), a2, voffA);
            PG8_BAR; PG8_WAIT_L(0); PG8_MMA(1, 0, At, B0); PG8_BAR; PG8_SCHED;
            PG8_STAGE(PG8_SB(0, 1), b2 + hstep, voffB);
            PG8_WAIT_V(6); PG8_BAR; PG8_MMA(1, 1, At, B1); PG8_BAR;
            PG8_LDB(B0, 1, 0); PG8_SCHED; PG8_LDA(At, 1, 0); PG8_STAGE(PG8_SA(0, 1), a2 + hstep, voffA);
            PG8_WAIT_L(8); PG8_BAR; PG8_WAIT_L(0); PG8_MMA(0, 0, At, B0); PG8_BAR; PG8_SCHED;
            PG8_LDB(B1, 1, 1); PG8_STAGE(PG8_SB(1, 0), b3, voffB);
            PG8_BAR; PG8_WAIT_L(0); PG8_MMA(0, 1, At, B1); PG8_BAR;
            PG8_LDA(At, 1, 1); PG8_STAGE(PG8_SA(1, 0), a3, voffA);
            PG8_BAR; PG8_WAIT_L(0); PG8_MMA(1, 0, At, B0); PG8_BAR; PG8_SCHED;
            PG8_STAGE(PG8_SB(1, 1), b3 + hstep, voffB);
            PG8_WAIT_V(6); PG8_BAR; PG8_MMA(1, 1, At, B1); PG8_BAR;
            }
        }
        if constexpr (ALIGN_EPI) { if (wr == 0) PG8_BAR; }
        if constexpr (F8) {
            asm volatile("s_nop 15\n\ts_nop 15" : "+v"(acc[0][0][0][0]), "+v"(acc[0][0][0][1]), "+v"(acc[0][0][1][0]), "+v"(acc[0][0][1][1]), "+v"(acc[0][0][2][0]), "+v"(acc[0][0][2][1]), "+v"(acc[0][0][3][0]), "+v"(acc[0][0][3][1]) :: "memory");
            asm volatile("" : "+v"(acc[0][1][0][0]), "+v"(acc[0][1][0][1]), "+v"(acc[0][1][1][0]), "+v"(acc[0][1][1][1]), "+v"(acc[0][1][2][0]), "+v"(acc[0][1][2][1]), "+v"(acc[0][1][3][0]), "+v"(acc[0][1][3][1]) :: "memory");
            asm volatile("" : "+v"(acc[1][0][0][0]), "+v"(acc[1][0][0][1]), "+v"(acc[1][0][1][0]), "+v"(acc[1][0][1][1]), "+v"(acc[1][0][2][0]), "+v"(acc[1][0][2][1]), "+v"(acc[1][0][3][0]), "+v"(acc[1][0][3][1]) :: "memory");
            asm volatile("" : "+v"(acc[1][1][0][0]), "+v"(acc[1][1][0][1]), "+v"(acc[1][1][1][0]), "+v"(acc[1][1][1][1]), "+v"(acc[1][1][2][0]), "+v"(acc[1][1][2][1]), "+v"(acc[1][1][3][0]), "+v"(acc[1][1][3][1]) :: "memory");
        }
        if constexpr (!Epi::AFTER_DRAIN) { E(acc, cur, wr, wc, fr, fq); S.done(cur); }
        if (!has_next) break;
#pragma unroll
        for (int a = 0; a < 2; ++a)
#pragma unroll
            for (int b = 0; b < 2; ++b)
#pragma unroll
                for (int m = 0; m < 4; ++m)
#pragma unroll
                    for (int n = 0; n < 2; ++n) acc[a][b][m][n] = (f32x4){0.f, 0.f, 0.f, 0.f};
        cur = nxt; cA = nA; cB = nB; ++ui;
        if constexpr (ALIGN_EPI) { if (wr == 1) PG8_BAR; }
    }
    PG8_WAIT_V(0);
    if constexpr (!ALIGN_EPI) { if (wr == 0) PG8_BAR; }
    PG8_BAR;
    if constexpr (Epi::AFTER_DRAIN) { E.fused(acc, cur, wr, wc, fr, fq, lds, wid, lane); S.done(cur); }
#undef PG8_SA
#undef PG8_SB
#undef PG8_STAGE
#undef PG8_LDA
#undef PG8_LDB
#undef PG8_MMA
#undef PG8_LD16
#undef PG8_WAIT_V
#undef PG8_WAIT_L
#undef PG8_BAR
#undef PG8_SCHED
}
}

namespace att {
typedef unsigned short bf16;
using bf16x8 = __attribute__((ext_vector_type(8))) short;
using s16x4  = __attribute__((ext_vector_type(4))) short;
using f32x16 = __attribute__((ext_vector_type(16))) float;
using u32x4  = __attribute__((ext_vector_type(4))) unsigned;
constexpr int NW = 8, QBLK = 32, KVBLK = 64, DV = 128;
constexpr float THR = 8.f;
constexpr int SHM_V = KVBLK * DV * 2;
#define ATT_SBAR() __builtin_amdgcn_sched_barrier(0)
#ifndef ATT_IGLP_OPT
#define ATT_IGLP_OPT -1
#endif
#if ATT_IGLP_OPT >= 0
#define ATT_IGLP() __builtin_amdgcn_iglp_opt(ATT_IGLP_OPT)
#else
#define ATT_IGLP() do {} while (0)
#endif
__device__ __forceinline__ int crow(int r, int hi) { return (r & 3) + 8 * (r >> 2) + 4 * hi; }
__device__ __forceinline__ unsigned cvtpk(float lo, float hi) { unsigned r; asm volatile("v_cvt_pk_bf16_f32 %0, %1, %2" : "=v"(r) : "v"(lo), "v"(hi)); return r; }
template <int DQ> struct Cst { static constexpr float SCALE = (DQ == 128) ? 0.088388347648318440f : 0.072168783648703220f; static constexpr int SHM_K = KVBLK * DQ * 2, ROWB = DQ * 2; };

template <int DQ>
__device__ __forceinline__ void partialSM(f32x16& p0, f32x16& p1, float& m_reg, float& mn, float& alpha) {
  constexpr float SCALE = Cst<DQ>::SCALE, C = SCALE * 1.4426950408889634f;
  float pmax = p0[0];
#pragma unroll
  for (int r = 1; r < 16; ++r) pmax = fmaxf(pmax, p0[r]);
#pragma unroll
  for (int r = 0; r < 16; ++r) pmax = fmaxf(pmax, p1[r]);
  { auto rr = __builtin_amdgcn_permlane32_swap(__float_as_uint(pmax), __float_as_uint(pmax), false, false);
    pmax = fmaxf(__uint_as_float(rr[0]), __uint_as_float(rr[1])); }
  if (__builtin_expect(__all(pmax - m_reg <= THR / SCALE), 1)) { mn = m_reg; alpha = 1.f; }
  else { mn = fmaxf(m_reg, pmax); alpha = __builtin_amdgcn_exp2f((m_reg - mn) * C); m_reg = mn; }
  const float mnC = -mn * C;
  { typedef float f32x2_ __attribute__((ext_vector_type(2))); const f32x2_ C2 = {C, C}, M2 = {mnC, mnC};
#pragma unroll
    for (int i = 0; i < 8; ++i) { f32x2_ a = {p0[2 * i], p0[2 * i + 1]}, b = {p1[2 * i], p1[2 * i + 1]}; a = a * C2 + M2; b = b * C2 + M2; p0[2 * i] = a.x; p0[2 * i + 1] = a.y; p1[2 * i] = b.x; p1[2 * i + 1] = b.y; } }
#pragma unroll
  for (int r = 0; r < 16; ++r) p0[r] = __builtin_amdgcn_exp2f(p0[r]);
}
__device__ __forceinline__ void finishSM(f32x16& p0, f32x16& p1, float alpha, float& l_reg, bf16x8& pa0, bf16x8& pa1, bf16x8& pa2, bf16x8& pa3) {
#pragma unroll
  for (int r = 0; r < 16; ++r) p1[r] = __builtin_amdgcn_exp2f(p1[r]);
  float ps;
  { typedef float f32x2_ __attribute__((ext_vector_type(2))); f32x2_ s0 = {0.f, 0.f}, s1 = {0.f, 0.f};
#pragma unroll
    for (int i = 0; i < 8; ++i) { const f32x2_ a = {p0[2 * i], p0[2 * i + 1]}; s0 += a; }
#pragma unroll
    for (int i = 0; i < 8; ++i) { const f32x2_ b = {p1[2 * i], p1[2 * i + 1]}; s1 += b; }
    s0 += s1; ps = s0.x + s0.y; }
  { auto rr = __builtin_amdgcn_permlane32_swap(__float_as_uint(ps), __float_as_uint(ps), false, false);
    ps = __uint_as_float(rr[0]) + __uint_as_float(rr[1]); }
  l_reg = l_reg * alpha + ps;
#define ATT_PK4(P, BASE, OUT) do { unsigned a0 = cvtpk(P[BASE + 0], P[BASE + 1]), a1 = cvtpk(P[BASE + 2], P[BASE + 3]);   \
    unsigned b0 = cvtpk(P[BASE + 4], P[BASE + 5]), b1 = cvtpk(P[BASE + 6], P[BASE + 7]);                              \
    auto r0 = __builtin_amdgcn_permlane32_swap(a0, b0, false, false); auto r1 = __builtin_amdgcn_permlane32_swap(a1, b1, false, false); \
    u32x4 w = {r0[0], r1[0], r0[1], r1[1]}; OUT = *reinterpret_cast<bf16x8*>(&w); } while (0)
  ATT_PK4(p0, 0, pa0); ATT_PK4(p0, 8, pa1); ATT_PK4(p1, 0, pa2); ATT_PK4(p1, 8, pa3);
#undef ATT_PK4
}
template <int DQ, int NREG>
__device__ __forceinline__ void qkt(f32x16& p0, f32x16& p1, const char* Ks, const bf16x8* qr, const char* qpark, int r32, int hi) {
  constexpr int ROWB = Cst<DQ>::ROWB;
  p0 = f32x16{}; p1 = f32x16{};
#pragma unroll
  for (int d0 = 0; d0 < DQ / 16; ++d0) { const int cb = (d0 * 16 + hi * 8) * 2;
    bf16x8 b0 = *reinterpret_cast<const bf16x8*>(Ks + (r32 * ROWB + (cb ^ ((r32 & 7) << 4))));
    bf16x8 b1 = *reinterpret_cast<const bf16x8*>(Ks + ((32 + r32) * ROWB + (cb ^ ((r32 & 7) << 4))));
    bf16x8 q; if constexpr (true) { if (d0 < NREG) q = qr[d0 < NREG ? d0 : 0]; else q = *reinterpret_cast<const bf16x8*>(qpark + (d0 - NREG) * 1024); }
    p0 = __builtin_amdgcn_mfma_f32_32x32x16_bf16(b0, q, p0, 0, 0, 0);
    p1 = __builtin_amdgcn_mfma_f32_32x32x16_bf16(b1, q, p1, 0, 0, 0); }
}
__device__ __forceinline__ int v_st(int k, int c) { const int kk = (k & ~0xC) | ((k & 4) << 1) | ((k & 8) >> 1); return ((kk >> 3) * 4 + (c >> 5)) * 512 + ((kk & 7) * 32 + (c & 31)) * 2; }
__device__ __forceinline__ int v_rd_base(int lane) { return ((lane & 3) << 3) | (((lane >> 2) & 3) << 6) | (((lane >> 4) & 1) << 5) | (((lane >> 5) & 1) << 8); }
constexpr int v_rd_off(int d0, int ks, int half) { return d0 * 512 + ks * 4096 + half * 2048; }
template <int OFF> __device__ __forceinline__ s16x4 tr_read(int vb) {
  s16x4 r; asm volatile("ds_read_b64_tr_b16 %0, %1 offset:%2" : "=&v"(r) : "v"(vb), "i"(OFF) : "memory"); return r;
}
template <int D0> __device__ __forceinline__ void pv_one(f32x16& od, int vb, bf16x8 pa0, bf16x8 pa1, bf16x8 pa2, bf16x8 pa3) {
  const s16x4 l0 = tr_read<v_rd_off(D0, 0, 0)>(vb), h0 = tr_read<v_rd_off(D0, 0, 1)>(vb), l1 = tr_read<v_rd_off(D0, 1, 0)>(vb), h1 = tr_read<v_rd_off(D0, 1, 1)>(vb);
  const s16x4 l2 = tr_read<v_rd_off(D0, 2, 0)>(vb), h2 = tr_read<v_rd_off(D0, 2, 1)>(vb), l3 = tr_read<v_rd_off(D0, 3, 0)>(vb), h3 = tr_read<v_rd_off(D0, 3, 1)>(vb);
  asm volatile("s_waitcnt lgkmcnt(0)" ::: "memory"); ATT_SBAR();
#define ATT_PK(L, H) (bf16x8){L[0], L[1], L[2], L[3], H[0], H[1], H[2], H[3]}
  od = __builtin_amdgcn_mfma_f32_32x32x16_bf16(pa0, ATT_PK(l0, h0), od, 0, 0, 0);
  od = __builtin_amdgcn_mfma_f32_32x32x16_bf16(pa1, ATT_PK(l1, h1), od, 0, 0, 0);
  od = __builtin_amdgcn_mfma_f32_32x32x16_bf16(pa2, ATT_PK(l2, h2), od, 0, 0, 0);
  od = __builtin_amdgcn_mfma_f32_32x32x16_bf16(pa3, ATT_PK(l3, h3), od, 0, 0, 0);
#undef ATT_PK
}
__device__ __forceinline__ void pv_d0(f32x16* o, int vb, bf16x8 pa0, bf16x8 pa1, bf16x8 pa2, bf16x8 pa3) {
  pv_one<0>(o[0], vb, pa0, pa1, pa2, pa3); pv_one<1>(o[1], vb, pa0, pa1, pa2, pa3); pv_one<2>(o[2], vb, pa0, pa1, pa2, pa3); pv_one<3>(o[3], vb, pa0, pa1, pa2, pa3);
}
__device__ __forceinline__ void natten_mod(f32x16& p0, f32x16& p1, int kr, int rq, int qc, const float* biasT, int hi) {
  const int r0 = min(max(rq - 4, 0), 56), c0 = min(max(qc - 8, 0), 48);
  const float NEG = -__builtin_inff();
  if (kr < r0 || kr >= r0 + 8) {
#pragma unroll
    for (int r = 0; r < 16; ++r) { p0[r] = NEG; p1[r] = NEG; }
  } else {
    const float* bl = biasT + (kr - rq + 7) * 128 + (63 - qc + 4 * hi);
    const int t = 4 * hi - c0;
#pragma unroll
    for (int r = 0; r < 16; ++r) {
      const int kcc = (r & 3) + 8 * (r >> 2);
      const bool ok0 = (unsigned)(t + kcc) < 16u, ok1 = (unsigned)(t + kcc + 32) < 16u;
      const float b0 = bl[kcc], b1 = bl[kcc + 32];
      p0[r] = ok0 ? p0[r] + b0 : NEG; p1[r] = ok1 ? p1[r] + b1 : NEG;
      if ((r & 3) == 3) __builtin_amdgcn_sched_barrier(0);
    }
  }
}

template <int DQ, int LDQ, int LDK, int LDV, int LDO, int MODE, int SDEPTH, int NREG>
__device__ __forceinline__ void attn_body(const bf16* __restrict__ Qb, const bf16* __restrict__ Kh, const bf16* __restrict__ Vh, bf16* __restrict__ Ob, const int NT, char* lds,
                                          const int rq0, const int kr_lo, const float* biasT) {
  constexpr int SHM_K = Cst<DQ>::SHM_K, ROWB = Cst<DQ>::ROWB;
  int tid_ = threadIdx.x; asm volatile("" : "+v"(tid_));
  const int tid = tid_, wid = tid >> 6, lane = tid & 63, r32 = lane & 31, hi = lane >> 5;
  char* V_lds = lds; char* K_lds = lds + 2 * SHM_V;
  float* ws = (float*)(lds + 2 * SHM_V + 2 * SHM_K) + wid * 64; float* li_l = ws; float* al_l = ws + 32;
  float m_reg = -1e30f, l_reg = 0; f32x16 o[4] = {}; bf16x8 qr[NREG > 0 ? NREG : 1];
  const bf16* Qw = Qb + (long)(wid * QBLK + r32) * LDQ + hi * 8;
  char* qpark = lds + 2 * SHM_V + 2 * SHM_K + NW * 64 * 4 + wid * ((DQ / 16 - NREG) * 1024) + hi * 512 + r32 * 16;
#pragma unroll
  for (int d0 = 0; d0 < DQ / 16; ++d0) { const bf16x8 qv = *reinterpret_cast<const bf16x8*>(Qw + d0 * 16); if (d0 < NREG) qr[d0 < NREG ? d0 : 0] = qv; else *reinterpret_cast<bf16x8*>(qpark + (d0 - NREG) * 1024) = qv; }
  const int nrq = rq0 + (wid >> 1), nqc = (wid & 1) * 32 + r32;
  const int sr = tid >> 4, sc = (tid & 15) * 8, vst0 = v_st(sr, sc), vst1 = v_st(32 + sr, sc);
  const int kr3 = tid >> 3, kc3 = 128 + (tid & 7) * 8;
  const int vb0 = (int)(uintptr_t)V_lds + v_rd_base(lane);
  struct { bf16x8 vs0, vs1, ks0, ks1, ks2; } sr_[SDEPTH];
#define ATT_LD8(p) (*reinterpret_cast<const bf16x8*>(p))
#define ATT_SLOAD(i, k0) do { sr_[i].vs0 = ATT_LD8(&Vh[(long)((k0) + sr) * LDV + sc]); sr_[i].vs1 = ATT_LD8(&Vh[(long)((k0) + 32 + sr) * LDV + sc]); \
    sr_[i].ks0 = ATT_LD8(&Kh[(long)((k0) + sr) * LDK + sc]); sr_[i].ks1 = ATT_LD8(&Kh[(long)((k0) + 32 + sr) * LDK + sc]); \
    if constexpr (DQ == 192) sr_[i].ks2 = ATT_LD8(&Kh[(long)((k0) + kr3) * LDK + kc3]); } while (0)
#define ATT_SWRITE(b, i) do { *(bf16x8*)(V_lds + (b) * SHM_V + vst0) = sr_[i].vs0;          \
    *(bf16x8*)(V_lds + (b) * SHM_V + vst1) = sr_[i].vs1; const int kc = sc * 2;               \
    *(bf16x8*)(K_lds + (b) * SHM_K + sr * ROWB + (kc ^ ((sr & 7) << 4))) = sr_[i].ks0;                       \
    *(bf16x8*)(K_lds + (b) * SHM_K + (32 + sr) * ROWB + (kc ^ ((sr & 7) << 4))) = sr_[i].ks1; \
    if constexpr (DQ == 192) *(bf16x8*)(K_lds + (b) * SHM_K + kr3 * ROWB + ((kc3 * 2) ^ ((kr3 & 7) << 4))) = sr_[i].ks2; } while (0)
#define ATT_SWAIT() do { if constexpr (SDEPTH == 2) { if constexpr (DQ == 192) asm volatile("s_waitcnt vmcnt(5)" ::: "memory"); else asm volatile("s_waitcnt vmcnt(4)" ::: "memory"); } \
    else asm volatile("s_waitcnt vmcnt(0)" ::: "memory"); } while (0)
#define ATT_RESC(a) do { if (__any((a) < 1.f)) { if (hi == 0) al_l[r32] = (a); asm volatile("s_waitcnt lgkmcnt(0)" ::: "memory"); \
    _Pragma("unroll") for (int d = 0; d < 4; ++d) _Pragma("unroll") for (int r = 0; r < 16; ++r) o[d][r] *= al_l[crow(r, hi)]; } } while (0)
#define ATT_MOD(P0, P1, J) do { if constexpr (MODE == 1) natten_mod(P0, P1, kr_lo + (J), nrq, nqc, biasT, hi); } while (0)
  f32x16 pA0, pA1, pB0, pB1; float mnA, mnB, alA, alB; bf16x8 pa0, pa1, pa2, pa3;
  constexpr int SE = 0, SO = SDEPTH - 1;
  ATT_SLOAD(SE, 0); asm volatile("s_waitcnt vmcnt(0)" ::: "memory"); ATT_SWRITE(0, SE); __syncthreads();
  qkt<DQ, NREG>(pA0, pA1, K_lds, qr, qpark, r32, hi); ATT_MOD(pA0, pA1, 0); partialSM<DQ>(pA0, pA1, m_reg, mnA, alA);
  ATT_SLOAD(SO, KVBLK); if constexpr (SDEPTH == 2) { if (2 < NT) ATT_SLOAD(SE, 2 * KVBLK); }
  ATT_SWAIT(); ATT_SWRITE(1, SO); __syncthreads();
  for (int j = 1; j + 1 < NT; j += 2) {
    ATT_SBAR(); ATT_IGLP(); qkt<DQ, NREG>(pB0, pB1, K_lds + SHM_K, qr, qpark, r32, hi); ATT_MOD(pB0, pB1, j);
    finishSM(pA0, pA1, alA, l_reg, pa0, pa1, pa2, pa3); ATT_SBAR();
    ATT_SLOAD(SO, (j + SDEPTH) * KVBLK); ATT_SBAR();
    pv_d0(o, vb0, pa0, pa1, pa2, pa3); partialSM<DQ>(pB0, pB1, m_reg, mnB, alB);
    __syncthreads(); ATT_SWAIT(); ATT_SWRITE(0, SE);
    ATT_RESC(alB); __syncthreads();
    ATT_SBAR(); ATT_IGLP(); qkt<DQ, NREG>(pA0, pA1, K_lds, qr, qpark, r32, hi); ATT_MOD(pA0, pA1, j + 1);
    finishSM(pB0, pB1, alB, l_reg, pa0, pa1, pa2, pa3); ATT_SBAR();
    if (SDEPTH == 1 || j + 3 < NT) ATT_SLOAD(SE, (j + 1 + SDEPTH) * KVBLK); ATT_SBAR();
    pv_d0(o, vb0 + SHM_V, pa0, pa1, pa2, pa3); partialSM<DQ>(pA0, pA1, m_reg, mnA, alA);
    __syncthreads(); ATT_SWAIT(); ATT_SWRITE(1, SO);
    ATT_RESC(alA); __syncthreads();
  }
  ATT_SBAR(); qkt<DQ, NREG>(pB0, pB1, K_lds + SHM_K, qr, qpark, r32, hi); ATT_MOD(pB0, pB1, NT - 1);
  finishSM(pA0, pA1, alA, l_reg, pa0, pa1, pa2, pa3); ATT_SBAR();
  pv_d0(o, vb0, pa0, pa1, pa2, pa3); partialSM<DQ>(pB0, pB1, m_reg, mnB, alB);
  __syncthreads(); ATT_RESC(alB);
  finishSM(pB0, pB1, alB, l_reg, pa0, pa1, pa2, pa3); ATT_SBAR();
  pv_d0(o, vb0 + SHM_V, pa0, pa1, pa2, pa3);
  if (hi == 0) li_l[r32] = l_reg; asm volatile("s_waitcnt lgkmcnt(0)" ::: "memory");
  float rli[16];
#pragma unroll
  for (int r = 0; r < 16; ++r) rli[r] = __builtin_amdgcn_rcpf(li_l[crow(r, hi)]);
  bf16* Ow = Ob + (long)(wid * QBLK) * LDO;
#pragma unroll
  for (int r = 0; r < 16; ++r) { const int orow = crow(r, hi);
#pragma unroll
    for (int d0 = 0; d0 < 4; d0 += 1) { const unsigned w = cvtpk(o[d0][r] * rli[r], 0.f); Ow[(long)orow * LDO + d0 * 32 + r32] = (bf16)(w & 0xffffu); } }
#undef ATT_LD8
#undef ATT_SLOAD
#undef ATT_SWRITE
#undef ATT_SWAIT
#undef ATT_RESC
#undef ATT_MOD
}

template <int DQ, int LDQ, int LDK, int LDV, int LDO, int MODE, int SD, int NREG>
__device__ __forceinline__ void attn_body3(const bf16* __restrict__ Qb, const bf16* __restrict__ Kh, const bf16* __restrict__ Vh, bf16* __restrict__ Ob, const int NT, char* lds,
                                           const int rq0, const int kr_lo, const float* biasT) {
  constexpr int SHM_K = Cst<DQ>::SHM_K, ROWB = Cst<DQ>::ROWB;
  int tid_ = threadIdx.x; asm volatile("" : "+v"(tid_));
  const int tid = tid_, wid = tid >> 6, lane = tid & 63, r32 = lane & 31, hi = lane >> 5;
  char* V_lds = lds; char* K_lds = lds + 3 * SHM_V;
  float* ws = (float*)(lds + 3 * SHM_V + 3 * SHM_K) + wid * 64; float* li_l = ws; float* al_l = ws + 32;
  float m_reg = -1e30f, l_reg = 0; f32x16 o[4] = {}; bf16x8 qr[NREG > 0 ? NREG : 1];
  const bf16* Qw = Qb + (long)(wid * QBLK + r32) * LDQ + hi * 8;
  char* qpark = lds + 3 * SHM_V + 3 * SHM_K + NW * 64 * 4 + wid * ((DQ / 16 - NREG) * 1024) + hi * 512 + r32 * 16;
#pragma unroll
  for (int d0 = 0; d0 < DQ / 16; ++d0) { const bf16x8 qv = *reinterpret_cast<const bf16x8*>(Qw + d0 * 16); if (d0 < NREG) qr[d0 < NREG ? d0 : 0] = qv; else *reinterpret_cast<bf16x8*>(qpark + (d0 - NREG) * 1024) = qv; }
  const int nrq = rq0 + (wid >> 1), nqc = (wid & 1) * 32 + r32;
  const int sr = tid >> 4, sc = (tid & 15) * 8, vst0 = v_st(sr, sc), vst1 = v_st(32 + sr, sc);
  const int kr3 = tid >> 3, kc3 = 128 + (tid & 7) * 8;
  const int vb0 = (int)(uintptr_t)V_lds + v_rd_base(lane);
  struct { bf16x8 vs0, vs1; } sr_[SD];
  const __amdgpu_buffer_rsrc_t rK = __builtin_amdgcn_make_buffer_rsrc((void*)Kh, 0, 0x7fffffff, 0x00020000), rV = __builtin_amdgcn_make_buffer_rsrc((void*)Vh, 0, 0x7fffffff, 0x00020000);
  const int vo_v = (sr * LDV + sc) * 2; (void)kr3; (void)kc3;
#define ATT_LD8(p) (*reinterpret_cast<const bf16x8*>(p))
#define ATT_BL(R, VO, SO) __builtin_bit_cast(bf16x8, __builtin_amdgcn_raw_buffer_load_b128(R, VO, SO, 0))
#define ATT_SLOAD(i, k0) do { const int sv_ = (k0) * (LDV * 2);    \
    sr_[i].vs0 = ATT_BL(rV, vo_v, sv_); sr_[i].vs1 = ATT_BL(rV, vo_v + 32 * LDV * 2, sv_); } while (0)
#define ATT_SWRITE(b, i) do { const int b_ = (b); *(bf16x8*)(V_lds + b_ * SHM_V + vst0) = sr_[i].vs0; *(bf16x8*)(V_lds + b_ * SHM_V + vst1) = sr_[i].vs1; } while (0)
  constexpr int NKD = SHM_K / 8192, CPR = ROWB / 16;
  const int widu = __builtin_amdgcn_readfirstlane(wid);
  int vofk[NKD];
#pragma unroll
  for (int i_ = 0; i_ < NKD; ++i_) { const int P = (widu * NKD + i_) * 64 + lane, r_ = P / CPR, cp_ = P - r_ * CPR; vofk[i_] = r_ * (LDK * 2) + ((cp_ ^ (r_ & 7)) << 4); }
  const unsigned kl0 = (unsigned)(uintptr_t)K_lds + (unsigned)widu * (NKD * 1024);
#define ATT_KDMA(b, j) do { const int sk_ = (j) * (KVBLK * LDK * 2); const unsigned kd_ = kl0 + (unsigned)(b) * SHM_K; \
    _Pragma("unroll") for (int i_ = 0; i_ < NKD; ++i_) __builtin_amdgcn_raw_ptr_buffer_load_lds(rK, (__attribute__((address_space(3))) void*)(kd_ + i_ * 1024), 16, vofk[i_], sk_, 0, 0); } while (0)
  int vofv[2];
#pragma unroll
  for (int i_ = 0; i_ < 2; ++i_) { const int P = (widu * 2 + i_) * 64 + lane, s_ = P >> 5, q_ = P & 31, kk_ = (s_ >> 2) * 8 + (q_ >> 2), c_ = (s_ & 3) * 32 + (q_ & 3) * 8;
    const int k_ = (kk_ & ~0xC) | ((kk_ & 4) << 1) | ((kk_ & 8) >> 1); vofv[i_] = k_ * (LDV * 2) + c_ * 2; }
  const unsigned vl0 = (unsigned)(uintptr_t)V_lds + (unsigned)widu * 2048u;
#define ATT_VDMA(b, j) do { const int sv_ = (j) * (KVBLK * LDV * 2); const unsigned vd_ = vl0 + (unsigned)(b) * SHM_V; \
    _Pragma("unroll") for (int i_ = 0; i_ < 2; ++i_) __builtin_amdgcn_raw_ptr_buffer_load_lds(rV, (__attribute__((address_space(3))) void*)(vd_ + i_ * 1024), 16, vofv[i_], sv_, 0, 0); } while (0)
#define ATT_KWAIT(vloads) do { if (vloads) asm volatile("s_waitcnt vmcnt(2)" ::: "memory"); else asm volatile("s_waitcnt vmcnt(0)" ::: "memory"); } while (0)
#define ATT_RESC(a) do { if (__any((a) < 1.f)) { if (hi == 0) al_l[r32] = (a); asm volatile("s_waitcnt lgkmcnt(0)" ::: "memory"); \
    _Pragma("unroll") for (int d = 0; d < 4; ++d) _Pragma("unroll") for (int r = 0; r < 16; ++r) o[d][r] *= al_l[crow(r, hi)]; } } while (0)
#define ATT_MOD(P0, P1, J) do { if constexpr (MODE == 1) natten_mod(P0, P1, kr_lo + (J), nrq, nqc, biasT, hi); } while (0)
#define ATT_SET(x) ((SD == 2) ? ((x) & 1) : 0)
  f32x16 pA0, pA1, pB0, pB1; float mnA, mnB, alA, alB; bf16x8 pa0, pa1, pa2, pa3;
  if (__builtin_amdgcn_readfirstlane(tid) >= 256) __builtin_amdgcn_s_setprio(1);
  ATT_KDMA(0, 0); ATT_VDMA(0, 0); asm volatile("s_waitcnt vmcnt(0)" ::: "memory");
  __syncthreads();
  ATT_VDMA(1, 1); ATT_KDMA(1, 1);
  ATT_SBAR(); qkt<DQ, NREG>(pA0, pA1, K_lds, qr, qpark, r32, hi); ATT_MOD(pA0, pA1, 0); ATT_SBAR();
  ATT_SBAR(); partialSM<DQ>(pA0, pA1, m_reg, mnA, alA);
  ATT_KWAIT(false); __syncthreads();
  int bt = 1;
  for (int t = 1; t + 1 < NT; t += 2) {
    const int bn = (bt == 2) ? 0 : bt + 1, bp = (bt == 0) ? 2 : bt - 1;
    ATT_VDMA(bn, t + 1); ATT_KDMA(bn, t + 1);
    ATT_SBAR(); qkt<DQ, NREG>(pB0, pB1, K_lds + bt * SHM_K, qr, qpark, r32, hi); ATT_MOD(pB0, pB1, t);
    finishSM(pA0, pA1, alA, l_reg, pa0, pa1, pa2, pa3); ATT_SBAR();
    ATT_SBAR();
    pv_d0(o, vb0 + bp * SHM_V, pa0, pa1, pa2, pa3); partialSM<DQ>(pB0, pB1, m_reg, mnB, alB);
    ATT_RESC(alB); ATT_KWAIT(false); __syncthreads();
    if (t + 2 < NT) { ATT_VDMA(bp, t + 2); ATT_KDMA(bp, t + 2); }
    ATT_SBAR(); qkt<DQ, NREG>(pA0, pA1, K_lds + bn * SHM_K, qr, qpark, r32, hi); ATT_MOD(pA0, pA1, t + 1);
    finishSM(pB0, pB1, alB, l_reg, pa0, pa1, pa2, pa3); ATT_SBAR();
    ATT_SBAR();
    pv_d0(o, vb0 + bt * SHM_V, pa0, pa1, pa2, pa3); partialSM<DQ>(pA0, pA1, m_reg, mnA, alA);
    ATT_RESC(alA); ATT_KWAIT(false); __syncthreads();
    bt = bp;
  }
  {
    const int bp = (bt == 0) ? 2 : bt - 1;
    ATT_SBAR(); qkt<DQ, NREG>(pB0, pB1, K_lds + bt * SHM_K, qr, qpark, r32, hi); ATT_MOD(pB0, pB1, NT - 1);
    finishSM(pA0, pA1, alA, l_reg, pa0, pa1, pa2, pa3); ATT_SBAR();
    pv_d0(o, vb0 + bp * SHM_V, pa0, pa1, pa2, pa3); partialSM<DQ>(pB0, pB1, m_reg, mnB, alB);
    ATT_RESC(alB);
    finishSM(pB0, pB1, alB, l_reg, pa0, pa1, pa2, pa3); ATT_SBAR();
    pv_d0(o, vb0 + bt * SHM_V, pa0, pa1, pa2, pa3);
  }
  if (hi == 0) li_l[r32] = l_reg; asm volatile("s_waitcnt lgkmcnt(0)" ::: "memory");
  float rli[16];
#pragma unroll
  for (int r = 0; r < 16; ++r) rli[r] = __builtin_amdgcn_rcpf(li_l[crow(r, hi)]);
  bf16* Ow = Ob + (long)(wid * QBLK) * LDO;
#pragma unroll
  for (int r = 0; r < 16; ++r) { const int orow = crow(r, hi);
#pragma unroll
    for (int d0 = 0; d0 < 4; d0 += 1) { const unsigned w = cvtpk(o[d0][r] * rli[r], 0.f); Ow[(long)orow * LDO + d0 * 32 + r32] = (bf16)(w & 0xffffu); } }
  __builtin_amdgcn_s_setprio(0);
  __syncthreads();
#undef ATT_LD8
#undef ATT_BL
#undef ATT_SLOAD
#undef ATT_SWRITE
#undef ATT_KDMA
#undef ATT_VDMA
#undef ATT_KWAIT
#undef ATT_RESC
#undef ATT_MOD
#undef ATT_SET
}

template <int DQ, int LDQ, int LDK, int LDV, int LDO, int NTS, int SD, int NREG>
__device__ __forceinline__ void attn_body3s(const bf16* __restrict__ Qb, const bf16* __restrict__ Kh, const bf16* __restrict__ Vh, bf16* __restrict__ Ob, char* lds) {
  static_assert((NTS - 4) % 6 == 0 && NTS >= 4, "tile count");
  constexpr int SHM_K = Cst<DQ>::SHM_K, ROWB = Cst<DQ>::ROWB;
  int tid_ = threadIdx.x; asm volatile("" : "+v"(tid_));
  const int tid = tid_, wid = tid >> 6, lane = tid & 63, r32 = lane & 31, hi = lane >> 5;
  char* V_lds = lds; char* K_lds = lds + 3 * SHM_V;
  float* ws = (float*)(lds + 3 * SHM_V + 3 * SHM_K) + wid * 64; float* li_l = ws; float* al_l = ws + 32;
  float m_reg = -1e30f, l_reg = 0; f32x16 o[4] = {}; bf16x8 qr[NREG > 0 ? NREG : 1];
  const bf16* Qw = Qb + (long)(wid * QBLK + r32) * LDQ + hi * 8;
  char* qpark = lds + 3 * SHM_V + 3 * SHM_K + NW * 64 * 4 + wid * ((DQ / 16 - NREG) * 1024) + hi * 512 + r32 * 16;
#pragma unroll
  for (int d0 = 0; d0 < DQ / 16; ++d0) { const bf16x8 qv = *reinterpret_cast<const bf16x8*>(Qw + d0 * 16); if (d0 < NREG) qr[d0 < NREG ? d0 : 0] = qv; else *reinterpret_cast<bf16x8*>(qpark + (d0 - NREG) * 1024) = qv; }
  const int sr = tid >> 4, sc = (tid & 15) * 8, vst0 = v_st(sr, sc), vst1 = v_st(32 + sr, sc);
  const int kr3 = tid >> 3, kc3 = 128 + (tid & 7) * 8;
  const int vb0 = (int)(uintptr_t)V_lds + v_rd_base(lane);
  struct { bf16x8 vs0, vs1, ks0, ks1, ks2; } sr_[SD];
  const __amdgpu_buffer_rsrc_t rK = __builtin_amdgcn_make_buffer_rsrc((void*)Kh, 0, 0x7fffffff, 0x00020000), rV = __builtin_amdgcn_make_buffer_rsrc((void*)Vh, 0, 0x7fffffff, 0x00020000);
  const int vo_v = (sr * LDV + sc) * 2, vo_k = (sr * LDK + sc) * 2, vo_k3 = (kr3 * LDK + kc3) * 2; (void)vo_k3;
#define ATT_LD8(p) (*reinterpret_cast<const bf16x8*>(p))
#define ATT_BL(R, VO, SO) __builtin_bit_cast(bf16x8, __builtin_amdgcn_raw_buffer_load_b128(R, VO, SO, 0))
#define ATT_SLOAD(i, k0) do { const int sv_ = (k0) * (LDV * 2), sk_ = (k0) * (LDK * 2);    \
    sr_[i].vs0 = ATT_BL(rV, vo_v, sv_); sr_[i].vs1 = ATT_BL(rV, vo_v + 32 * LDV * 2, sv_); \
    sr_[i].ks0 = ATT_BL(rK, vo_k, sk_); sr_[i].ks1 = ATT_BL(rK, vo_k + 32 * LDK * 2, sk_); \
    if constexpr (DQ == 192) sr_[i].ks2 = ATT_BL(rK, vo_k3, sk_); } while (0)
#define ATT_SWRITE(b, i) do { *(bf16x8*)(V_lds + (b) * SHM_V + vst0) = sr_[i].vs0;          \
    *(bf16x8*)(V_lds + (b) * SHM_V + vst1) = sr_[i].vs1; const int kc = sc * 2;               \
    *(bf16x8*)(K_lds + (b) * SHM_K + sr * ROWB + (kc ^ ((sr & 7) << 4))) = sr_[i].ks0;                       \
    *(bf16x8*)(K_lds + (b) * SHM_K + (32 + sr) * ROWB + (kc ^ ((sr & 7) << 4))) = sr_[i].ks1; \
    if constexpr (DQ == 192) *(bf16x8*)(K_lds + (b) * SHM_K + kr3 * ROWB + ((kc3 * 2) ^ ((kr3 & 7) << 4))) = sr_[i].ks2; } while (0)
#define ATT_RESC(a) do { if (__any((a) < 1.f)) { if (hi == 0) al_l[r32] = (a); asm volatile("s_waitcnt lgkmcnt(0)" ::: "memory"); \
    _Pragma("unroll") for (int d = 0; d < 4; ++d) _Pragma("unroll") for (int r = 0; r < 16; ++r) o[d][r] *= al_l[crow(r, hi)]; } } while (0)
#define ATT_SET(x) ((SD == 2) ? ((x) & 1) : 0)
#define ATT_TILE(C0, C1, mnC, alC, P0, P1, alP, BC, BN, BP, PAR, T) do {                                                         \
    if ((T) + 1 < NTS) ATT_SWRITE(BN, ATT_SET(PAR));                                                                              \
    ATT_SBAR(); qkt<DQ, NREG>(C0, C1, K_lds + (BC) * SHM_K, qr, qpark, r32, hi);                                                  \
    finishSM(P0, P1, alP, l_reg, pa0, pa1, pa2, pa3); ATT_SBAR();                                                                 \
    if ((T) + 1 + SD < NTS) ATT_SLOAD(ATT_SET(PAR), ((T) + 1 + SD) * KVBLK);                                                      \
    ATT_SBAR(); pv_d0(o, vb0 + (BP) * SHM_V, pa0, pa1, pa2, pa3); partialSM<DQ>(C0, C1, m_reg, mnC, alC);                         \
    ATT_RESC(alC); __syncthreads(); } while (0)
  f32x16 pA0, pA1, pB0, pB1; float mnA, mnB, alA, alB; bf16x8 pa0, pa1, pa2, pa3;
  ATT_SLOAD(0, 0); asm volatile("s_waitcnt vmcnt(0)" ::: "memory"); ATT_SWRITE(0, 0);
  ATT_SLOAD(ATT_SET(1), KVBLK); if constexpr (SD == 2) ATT_SLOAD(0, 2 * KVBLK);
  __syncthreads();
  ATT_SWRITE(1, ATT_SET(1));
  ATT_SBAR(); qkt<DQ, NREG>(pA0, pA1, K_lds, qr, qpark, r32, hi); ATT_SBAR();
  ATT_SLOAD(ATT_SET(1 + SD), (1 + SD) * KVBLK);
  ATT_SBAR(); partialSM<DQ>(pA0, pA1, m_reg, mnA, alA);
  __syncthreads();
  for (int t = 1; t + 5 < NTS; t += 6) {
    ATT_TILE(pB0, pB1, mnB, alB, pA0, pA1, alA, 1, 2, 0, 0, t);
    ATT_TILE(pA0, pA1, mnA, alA, pB0, pB1, alB, 2, 0, 1, 1, t + 1);
    ATT_TILE(pB0, pB1, mnB, alB, pA0, pA1, alA, 0, 1, 2, 0, t + 2);
    ATT_TILE(pA0, pA1, mnA, alA, pB0, pB1, alB, 1, 2, 0, 1, t + 3);
    ATT_TILE(pB0, pB1, mnB, alB, pA0, pA1, alA, 2, 0, 1, 0, t + 4);
    ATT_TILE(pA0, pA1, mnA, alA, pB0, pB1, alB, 0, 1, 2, 1, t + 5);
  }
  ATT_TILE(pB0, pB1, mnB, alB, pA0, pA1, alA, 1, 2, 0, 0, NTS - 3);
  ATT_TILE(pA0, pA1, mnA, alA, pB0, pB1, alB, 2, 0, 1, 1, NTS - 2);
  {
    ATT_SBAR(); qkt<DQ, NREG>(pB0, pB1, K_lds, qr, qpark, r32, hi);
    finishSM(pA0, pA1, alA, l_reg, pa0, pa1, pa2, pa3); ATT_SBAR();
    pv_d0(o, vb0 + 2 * SHM_V, pa0, pa1, pa2, pa3); partialSM<DQ>(pB0, pB1, m_reg, mnB, alB);
    ATT_RESC(alB);
    finishSM(pB0, pB1, alB, l_reg, pa0, pa1, pa2, pa3); ATT_SBAR();
    pv_d0(o, vb0, pa0, pa1, pa2, pa3);
  }
  if (hi == 0) li_l[r32] = l_reg; asm volatile("s_waitcnt lgkmcnt(0)" ::: "memory");
  float rli[16];
#pragma unroll
  for (int r = 0; r < 16; ++r) rli[r] = __builtin_amdgcn_rcpf(li_l[crow(r, hi)]);
  bf16* Ow = Ob + (long)(wid * QBLK) * LDO;
#pragma unroll
  for (int r = 0; r < 16; ++r) { const int orow = crow(r, hi);
#pragma unroll
    for (int d0 = 0; d0 < 4; d0 += 1) { const unsigned w = cvtpk(o[d0][r] * rli[r], 0.f); Ow[(long)orow * LDO + d0 * 32 + r32] = (bf16)(w & 0xffffu); } }
  __syncthreads();
#undef ATT_TILE
#undef ATT_LD8
#undef ATT_BL
#undef ATT_SLOAD
#undef ATT_SWRITE
#undef ATT_RESC
#undef ATT_SET
}
}
#ifndef ATT_RING3
#define ATT_RING3 7
#endif
#if ATT_RING3 & 1
#define ATT_BODY_C attn_body3
#else
#define ATT_BODY_C attn_body
#endif
#if ATT_RING3 & 2
#define ATT_BODY_B attn_body3
#else
#define ATT_BODY_B attn_body
#endif
#if ATT_RING3 & 4
#define ATT_BODY_A attn_body3
#else
#define ATT_BODY_A attn_body
#endif

#ifndef PH_MASK
#define PH_MASK 0xFFFFFFFFu
#endif
#define PHON(k) (((PH_MASK) >> (k)) & 1u)
#ifndef REP_MASK
#define REP_MASK 0u
#endif
#define REP(k) (((REP_MASK) >> (k)) & 1u)
#ifndef FFN_F8
#define FFN_F8 7
#endif
#ifndef MOE_CVT_IN_ATTN
#define MOE_CVT_IN_ATTN 3
#endif
#ifndef WOUT_F8
#define WOUT_F8 0
#endif
constexpr bool F8WO = WOUT_F8 != 0;
constexpr bool F8DG = (FFN_F8 & 1) != 0, F8DD = (FFN_F8 & 4) != 0, F8M = (FFN_F8 & 2) != 0;
constexpr float SC_H = 4.f, SC_ACT = 8.f, SC_W = 256.f;
constexpr int NWAVES = 8;
constexpr int DM = 2048, BATCH = 4, SEQ = 4096, NTOK = BATCH * SEQ, DEPTH = 2;
constexpr int DIN = 3904, DINP = 4096;
constexpr int DFF = 5632, NE = 8, DFE = 7168;
constexpr int PC_QA = 0, PC_KA = 512, PC_VA = 1024, PC_QB = 1536, PC_KB = 2560, PC_VB = 2816, PC_CQ = 3072, PC_CKV = 3584, PC_KPE = 3840;
constexpr float EPS = 1e-6f;
constexpr int MAXTILES = 136;
constexpr int MAXSLOTS = MAXTILES * 256;

constexpr size_t MiB = 1u << 20;
constexpr size_t WS_CTL = 0, CTL_ZERO_BYTES = 1 * MiB;
constexpr size_t WS_WIN = 1 * MiB;
constexpr size_t WS_WUQ = WS_WIN + 32 * MiB;
constexpr size_t WS_WUKV = WS_WUQ + 2 * MiB;
constexpr size_t WS_WOUT = WS_WUKV + 1 * MiB;
constexpr size_t WS_WGU = WS_WOUT + 16 * MiB;
constexpr size_t WS_WD = WS_WGU + 44 * MiB;
constexpr size_t WS_WEGU = WS_WD + 22 * MiB;
constexpr size_t WS_WED = WS_WEGU + 448 * MiB;
constexpr size_t WS_H = WS_WED + 224 * MiB;
constexpr size_t WS_ACT0 = WS_H + 64 * MiB;
constexpr size_t WS_PROJ = WS_ACT0;
constexpr size_t WS_QA = WS_PROJ + 128 * MiB;
constexpr size_t WS_KA = WS_QA + 16 * MiB;
constexpr size_t WS_QB = WS_KA + 16 * MiB;
constexpr size_t WS_KB = WS_QB + 32 * MiB;
constexpr size_t WS_CQN = WS_KB + 8 * MiB;
constexpr size_t WS_CKVN = WS_CQN + 16 * MiB;
constexpr size_t WS_KPE = WS_CKVN + 8 * MiB;
constexpr size_t WS_QCR = WS_KPE + 2 * MiB;
constexpr size_t WS_KVR = WS_QCR + 24 * MiB;
constexpr size_t WS_QC = WS_KVR + 32 * MiB;
constexpr size_t WS_KC = WS_QC + 24 * MiB;
constexpr size_t WS_O = WS_KC + 24 * MiB;
constexpr size_t WS_ON = WS_O + 64 * MiB;
constexpr size_t WS_ATT_END = WS_ON + 64 * MiB;
constexpr size_t WS_ACT = WS_ACT0;
constexpr size_t WS_HG = WS_ACT0;
constexpr size_t WS_ACTM = WS_HG + 136 * MiB;
constexpr size_t WS_Y = WS_ACTM + 476 * MiB;
constexpr size_t WS_RGATE = WS_Y + 136 * MiB;
constexpr size_t WS_TOKE = WS_RGATE + 1 * MiB;
constexpr size_t WS_TOKP = WS_TOKE + 1 * MiB;
constexpr size_t WS_TOKW = WS_TOKP + 1 * MiB;
constexpr size_t WS_END = WS_TOKW + 1 * MiB;
constexpr size_t WS_XB = WS_END;
constexpr size_t WS_END2 = WS_XB + 64 * MiB;
constexpr size_t WS_PART = WS_END2;
constexpr size_t WS_END3 = WS_PART + 64 * MiB;
constexpr size_t WS_DUMMY = WS_END3;
static_assert(WS_ATT_END <= WS_END, "map");
constexpr int CW_CNT = 64;
constexpr int CW_CQ = 128;
constexpr int CW_AQ = 8192;
constexpr int CW_BAR = 4096;

constexpr int RING_BYTES = 131072;
constexpr int LDS_BYTES = 163840;
constexpr int MISC_OFF = LDS_BYTES - 256;

#define GAS __attribute__((address_space(1)))
#define LAS __attribute__((address_space(3)))
typedef unsigned short bf16;
typedef unsigned v4u __attribute__((ext_vector_type(4)));
typedef unsigned v2u __attribute__((ext_vector_type(2)));
typedef float f32x4 __attribute__((ext_vector_type(4)));
typedef float f32x2 __attribute__((ext_vector_type(2)));
__device__ __forceinline__ unsigned pk2(float lo, float hi) { unsigned r; asm volatile("v_cvt_pk_bf16_f32 %0, %1, %2" : "=v"(r) : "v"(lo), "v"(hi)); return r; }
__device__ __forceinline__ float bf_lo(unsigned w) { return __uint_as_float(w << 16); }
__device__ __forceinline__ float bf_hi(unsigned w) { return __uint_as_float(w & 0xffff0000u); }
#define WS_DPP_STEP(v, CTRL) do { const int x_ = __builtin_bit_cast(int, v); v += __builtin_bit_cast(float, __builtin_amdgcn_update_dpp(x_, x_, CTRL, 0xF, 0xF, false)); } while (0)
__device__ __forceinline__ float row16_sum(float v) { WS_DPP_STEP(v, 0xB1); WS_DPP_STEP(v, 0x4E); WS_DPP_STEP(v, 0x141); WS_DPP_STEP(v, 0x140); return v; }
__device__ __forceinline__ float wave_sum(float v) {
    v = row16_sum(v);
    { auto rr = __builtin_amdgcn_permlane16_swap(__float_as_uint(v), __float_as_uint(v), false, false); v = __uint_as_float(rr[0]) + __uint_as_float(rr[1]); }
    { auto rr = __builtin_amdgcn_permlane32_swap(__float_as_uint(v), __float_as_uint(v), false, false); v = __uint_as_float(rr[0]) + __uint_as_float(rr[1]); }
    return v;
}
__device__ __forceinline__ float rsq(float x) { return __builtin_amdgcn_rsqf(x); }
#define XB_TMO      128
#define XB_XCNT(j)  (256  + 64 * (j))
#define XB_XSUB(j)  (1280 + 64 * (j))
#define XB_XGEN(j)  (2304 + 64 * (j))
#define XB_TOP      3328
#define XB_TOPGEN   3392
#define XCD_BAR_WORDS 3456
#define XB_SPIN_CAP (1u << 18)

__device__ __forceinline__ unsigned xb_ld(unsigned* p)              { return __hip_atomic_load(p, __ATOMIC_RELAXED, __HIP_MEMORY_SCOPE_AGENT); }
__device__ __forceinline__ unsigned xb_add(unsigned* p, unsigned v) { return __hip_atomic_fetch_add(p, v, __ATOMIC_RELAXED, __HIP_MEMORY_SCOPE_AGENT); }
__device__ __forceinline__ unsigned xb_xcc_id() { return (unsigned)__builtin_amdgcn_s_getreg((3 << 11) | 20) & 0xFu; }
#define XB_SPIN(cond, bar) do { unsigned _sp = 0; while (cond) { __builtin_amdgcn_s_sleep(1); \
    if ((++_sp & 255u) == 0u) { if (xb_ld(&(bar)[XB_TMO])) break; if (_sp > XB_SPIN_CAP) { atomicAdd(&(bar)[XB_TMO], 1u); break; } } } } while (0)

struct XcdBarrier {
    unsigned* bar; unsigned x;
    volatile LAS unsigned* st;
};

__device__ __forceinline__ XcdBarrier xcd_barrier_post(unsigned* bar, volatile LAS unsigned* st) {
    XcdBarrier b; b.bar = bar; b.x = xb_xcc_id(); b.st = st;
    if (threadIdx.x == 0) (void)xb_add(&bar[XB_XCNT(b.x)], 1u);
    return b;
}
__device__ __forceinline__ void xcd_barrier_complete(unsigned* bar, unsigned x, unsigned& nloc, unsigned& nx) {
    const unsigned G = gridDim.x * gridDim.y * gridDim.z;
    unsigned sum, cnt, mine, sp = 0u;
    for (;;) {
        sum = 0u; cnt = 0u; mine = 0u;
#pragma unroll
        for (unsigned j = 0; j < 16; ++j) { const unsigned c = xb_ld(&bar[XB_XCNT(j)]); sum += c; cnt += (c > 0u) ? 1u : 0u; mine = (j == x) ? c : mine; }
        if (sum == G) break;
        __builtin_amdgcn_s_sleep(1);
        if ((++sp & 255u) == 0u) { if (xb_ld(&bar[XB_TMO])) break; if (sp > XB_SPIN_CAP) { atomicAdd(&bar[XB_TMO], 1u); break; } }
    }
    nloc = mine > 0u ? mine : 1u; nx = cnt > 0u ? cnt : 1u;
}

__device__ __forceinline__ void xcd_barrier(const XcdBarrier& b) {
    asm volatile("s_waitcnt vmcnt(0)" ::: "memory");
    __syncthreads();
    if (threadIdx.x == 0) {
        unsigned* bar = b.bar;
        __builtin_amdgcn_s_waitcnt(0);
        unsigned nloc = b.st[0], nx = b.st[1];
        if (nloc == 0u) { xcd_barrier_complete(bar, b.x, nloc, nx); b.st[0] = nloc; b.st[1] = nx; }
        const unsigned old = xb_add(&bar[XB_XSUB(b.x)], 1u);
        const unsigned gen = old / nloc;
        if (old + 1u == (gen + 1u) * nloc) {
            __builtin_amdgcn_fence(__ATOMIC_RELEASE, "agent");
            asm volatile("s_waitcnt vmcnt(0)" ::: "memory");
            const unsigned og = xb_add(&bar[XB_TOP], 1u);
            const unsigned tg = og / nx;
            if (og + 1u == (tg + 1u) * nx) xb_add(&bar[XB_TOPGEN], 1u);
            else XB_SPIN(xb_ld(&bar[XB_TOPGEN]) == tg, bar);
            __builtin_amdgcn_fence(__ATOMIC_ACQUIRE, "agent");
            xb_add(&bar[XB_XGEN(b.x)], 1u);
            asm volatile("s_waitcnt vmcnt(0)" ::: "memory");
        } else {
            XB_SPIN(xb_ld(&bar[XB_XGEN(b.x)]) == gen, bar);
            __builtin_amdgcn_fence(__ATOMIC_ACQUIRE, "agent");
            asm volatile("s_waitcnt vmcnt(0)" ::: "memory");
        }
    }
    __syncthreads();
}

struct Args { const float* in[26]; float* out; unsigned char* ws; int ph_lo, ph_hi; };
enum { I_X = 0, I_MIXN, I_WIN, I_RPB, I_QNA, I_KNA, I_QNB, I_KNB, I_CQN, I_CKVN, I_WUQ, I_WUKV, I_QNC, I_KNC, I_ONA, I_ONB, I_ONC, I_WOUT, I_FFNN, I_WG, I_WU, I_WDN, I_ROUTER, I_WEG, I_WEU, I_WED };
struct Frame {
    LAS unsigned char* lds; unsigned char* ws; unsigned* ctl;
    int wave, G, bid, gw, ngw;
};

__device__ __forceinline__ void transpose_item(const float* __restrict__ W, int K, int N, bf16* __restrict__ WT, int row_off, int mode, LAS float* scr, int item, int lane) {
    (void)scr;
    const int nblk = N >> 5, kb = item / nblk, nb = item - kb * nblk, k0 = kb << 6, n0 = nb << 5; const int c = lane >> 3, q = lane & 7;
    const float* p = W + (size_t)(k0 + 8 * c) * N + n0 + 4 * q;
    f32x4 v[8];
#pragma unroll
    for (int i = 0; i < 8; ++i) v[i] = *(const f32x4*)(p + (size_t)i * N);
    const int drow0 = (mode == 0) ? (row_off + n0) : (row_off + (n0 >> 7) * 256 + (mode - 1) * 128 + (n0 & 127));
    bf16* d = WT + (size_t)(drow0 + 4 * q) * K + k0 + 8 * c;
#pragma unroll
    for (int j = 0; j < 4; ++j) { v4u o; o.x = pk2(v[0][j], v[1][j]); o.y = pk2(v[2][j], v[3][j]); o.z = pk2(v[4][j], v[5][j]); o.w = pk2(v[6][j], v[7][j]); *(v4u*)(d + (size_t)j * K) = o; }
}

__device__ __forceinline__ unsigned pk4_fp8(float a, float b, float c, float d) { unsigned w = 0u; w = __builtin_amdgcn_cvt_pk_fp8_f32(a, b, w, false); w = __builtin_amdgcn_cvt_pk_fp8_f32(c, d, w, true); return w; }
__device__ __forceinline__ void transpose_item_f8(const float* __restrict__ W, int K, int N, unsigned char* __restrict__ WT, int row_off, int mode, float wsc, LAS float* scr, int item, int lane) {
    (void)scr;
    const int nblk = N >> 5, kb = item / nblk, nb = item - kb * nblk, k0 = kb << 7, n0 = nb << 5; const int c = lane >> 3, q = lane & 7;
    const float* p = W + (size_t)(k0 + 16 * c) * N + n0 + 4 * q;
    f32x4 v[16];
#pragma unroll
    for (int i = 0; i < 16; ++i) v[i] = *(const f32x4*)(p + (size_t)i * N);
    const int drow0 = (mode == 0) ? (row_off + n0) : (row_off + (n0 >> 7) * 256 + (mode - 1) * 128 + (n0 & 127));
    unsigned char* d = WT + (size_t)(drow0 + 4 * q) * K + k0 + 16 * c;
#pragma unroll
    for (int j = 0; j < 4; ++j) {
        v4u o; o.x = pk4_fp8(v[0][j] * wsc, v[1][j] * wsc, v[2][j] * wsc, v[3][j] * wsc); o.y = pk4_fp8(v[4][j] * wsc, v[5][j] * wsc, v[6][j] * wsc, v[7][j] * wsc);
        o.z = pk4_fp8(v[8][j] * wsc, v[9][j] * wsc, v[10][j] * wsc, v[11][j] * wsc); o.w = pk4_fp8(v[12][j] * wsc, v[13][j] * wsc, v[14][j] * wsc, v[15][j] * wsc);
        *(v4u*)(d + (size_t)j * K) = o; }
}

template <bool SRCB>
__device__ __forceinline__ void load_row32(const void* __restrict__ row, int lane, float (&v)[4][8]) {
    if constexpr (SRCB) { const v4u* p = (const v4u*)row + lane;
#pragma unroll
        for (int j = 0; j < 4; ++j) { const v4u w = p[64 * j]; v[j][0] = bf_lo(w.x); v[j][1] = bf_hi(w.x); v[j][2] = bf_lo(w.y); v[j][3] = bf_hi(w.y); v[j][4] = bf_lo(w.z); v[j][5] = bf_hi(w.z); v[j][6] = bf_lo(w.w); v[j][7] = bf_hi(w.w); }
    } else { const f32x4* p = (const f32x4*)row + 2 * lane;
#pragma unroll
        for (int j = 0; j < 4; ++j) { const f32x4 a = p[128 * j], b = p[128 * j + 1]; v[j][0] = a[0]; v[j][1] = a[1]; v[j][2] = a[2]; v[j][3] = a[3]; v[j][4] = b[0]; v[j][5] = b[1]; v[j][6] = b[2]; v[j][7] = b[3]; }
    }
}
__device__ __forceinline__ void load_gain32(const float* __restrict__ gain, int lane, float osc, float (&g)[4][8]) {
    const f32x4* p = (const f32x4*)gain + 2 * lane;
#pragma unroll
    for (int j = 0; j < 4; ++j) { const f32x4 a = p[128 * j], b = p[128 * j + 1]; g[j][0] = a[0] * osc; g[j][1] = a[1] * osc; g[j][2] = a[2] * osc; g[j][3] = a[3] * osc; g[j][4] = b[0] * osc; g[j][5] = b[1] * osc; g[j][6] = b[2] * osc; g[j][7] = b[3] * osc; }
}
template <bool F8OUT, bool SRCB>
__device__ __forceinline__ void phase_rmsnorm(const Frame& F, const void* __restrict__ src, const float* __restrict__ gain, void* __restrict__ dstv, float osc) {
    int tid_ = threadIdx.x; asm volatile("" : "+v"(tid_)); const int tid = tid_, lane = tid & 63; (void)tid; (void)lane;
    float g[4][8]; load_gain32(gain, lane, osc, g);
    for (int m = F.gw; m < NTOK; m += F.ngw) {
        float v[4][8]; load_row32<SRCB>((const unsigned char*)src + (size_t)m * DM * (SRCB ? 2 : 4), lane, v); float s = 0.f;
#pragma unroll
        for (int j = 0; j < 4; ++j)
#pragma unroll
            for (int i = 0; i < 8; ++i) s += v[j][i] * v[j][i];
        const float rstd = rsq(wave_sum(s) * (1.f / DM) + EPS);
        if constexpr (F8OUT) { v2u* o8 = (v2u*)((unsigned char*)dstv + (size_t)m * DM) + lane;
#pragma unroll
            for (int j = 0; j < 4; ++j) { v2u w; w.x = pk4_fp8(v[j][0] * rstd * g[j][0], v[j][1] * rstd * g[j][1], v[j][2] * rstd * g[j][2], v[j][3] * rstd * g[j][3]);
                w.y = pk4_fp8(v[j][4] * rstd * g[j][4], v[j][5] * rstd * g[j][5], v[j][6] * rstd * g[j][6], v[j][7] * rstd * g[j][7]); o8[64 * j] = w; }
        } else { v4u* o16 = (v4u*)((bf16*)dstv + (size_t)m * DM) + lane;
#pragma unroll
            for (int j = 0; j < 4; ++j) { v4u w; w.x = pk2(v[j][0] * rstd * g[j][0], v[j][1] * rstd * g[j][1]); w.y = pk2(v[j][2] * rstd * g[j][2], v[j][3] * rstd * g[j][3]);
                w.z = pk2(v[j][4] * rstd * g[j][4], v[j][5] * rstd * g[j][5]); w.w = pk2(v[j][6] * rstd * g[j][6], v[j][7] * rstd * g[j][7]); o16[64 * j] = w; } }
    }
}

__device__ __forceinline__ float rope_apply(float v, float c, float s, float sgn) {
    auto rr = __builtin_amdgcn_permlane16_swap(__float_as_uint(v), __float_as_uint(v), false, false);
    const float p = __uint_as_float(sgn > 0.f ? rr[0] : rr[1]); return v * c + sgn * p * s; }
__device__ __forceinline__ void sincos_rev(float ang, float& s, float& c) { const float r = ang * 0.15915494309189535f; const float f = r - floorf(r); s = __builtin_amdgcn_sinf(f); c = __builtin_amdgcn_cosf(f); }

__device__ __forceinline__ void phase_postproj(const Frame& F, const Args& a, int l) {
    int tid_ = threadIdx.x; asm volatile("" : "+v"(tid_)); const int tid = tid_, lane = tid & 63; (void)tid; (void)lane;
    const bf16* PROJ = (const bf16*)(F.ws + WS_PROJ);
    bf16* QA = (bf16*)(F.ws + WS_QA); bf16* KA = (bf16*)(F.ws + WS_KA); bf16* QB = (bf16*)(F.ws + WS_QB); bf16* KB = (bf16*)(F.ws + WS_KB);
    bf16* CQN = (bf16*)(F.ws + WS_CQN); bf16* CKVN = (bf16*)(F.ws + WS_CKVN); bf16* KPE = (bf16*)(F.ws + WS_KPE);
    const f32x2 gqa = ((const f32x2*)(a.in[I_QNA] + l * 128))[lane], gka = ((const f32x2*)(a.in[I_KNA] + l * 128))[lane];
    const f32x2 gqb = ((const f32x2*)(a.in[I_QNB] + l * 128))[lane], gkb = ((const f32x2*)(a.in[I_KNB] + l * 128))[lane];
    const f32x4 gcq0 = ((const f32x4*)(a.in[I_CQN] + l * 512))[2 * lane], gcq1 = ((const f32x4*)(a.in[I_CQN] + l * 512))[2 * lane + 1];
    const f32x4 gckv = ((const f32x4*)(a.in[I_CKVN] + l * 256))[lane];
    const float gkpe = a.in[I_KNC][l * 192 + 128 + lane];
    constexpr float LOG2T = 13.287712379549449f;
    const int q = lane & 15;
    const float f128a = __builtin_amdgcn_exp2f(-(float)(2 * q) * (LOG2T / 32.f)), f128b = __builtin_amdgcn_exp2f(-(float)(2 * q + 1) * (LOG2T / 32.f));
    const float f64 = __builtin_amdgcn_exp2f(-(float)q * (LOG2T / 16.f));
    const float sgn = (lane & 16) ? 1.f : -1.f;
    for (int t = F.gw; t < NTOK; t += F.ngw) {
        const int pos = t & (SEQ - 1); const float p = (float)((lane & 32) ? (pos & 63) : (pos >> 6));
        float s0, c0, s1, c1, s2, c2; sincos_rev(p * f128a, s0, c0); sincos_rev(p * f128b, s1, c1); sincos_rev(p * f64, s2, c2);
        const bf16* pr = PROJ + (size_t)t * DINP;
        unsigned hv[18];
#pragma unroll
        for (int i = 0; i < 8; ++i) hv[i] = ((const unsigned*)(pr + i * 128))[lane];
#pragma unroll
        for (int i = 8; i < 18; ++i) hv[i] = ((const unsigned*)(pr + PC_QB + (i - 8) * 128))[lane];
        const v4u cqv = ((const v4u*)(pr + PC_CQ))[lane]; const v2u ckvv = ((const v2u*)(pr + PC_CKV))[lane]; const unsigned kpev = (unsigned)pr[PC_KPE + lane];
#pragma unroll
        for (int i = 0; i < 18; ++i) {
            float v0 = bf_lo(hv[i]), v1 = bf_hi(hv[i]);
            const float rstd = rsq(wave_sum(v0 * v0 + v1 * v1) * (1.f / 128.f) + EPS);
            const f32x2 g = (i < 4) ? gqa : (i < 8) ? gka : (i < 16) ? gqb : gkb;
            v0 = v0 * rstd * g[0]; v1 = v1 * rstd * g[1];
            if (i >= 8) { v0 = rope_apply(v0, c0, s0, sgn); v1 = rope_apply(v1, c1, s1, sgn); }
            bf16* dst = (i < 4) ? (QA + (size_t)t * 512 + i * 128) : (i < 8) ? (KA + (size_t)t * 512 + (i - 4) * 128) : (i < 16) ? (QB + (size_t)t * 1024 + (i - 8) * 128) : (KB + (size_t)t * 256 + (i - 16) * 128);
            ((unsigned*)dst)[lane] = pk2(v0, v1);
        }
        {
            float x[8] = {bf_lo(cqv.x), bf_hi(cqv.x), bf_lo(cqv.y), bf_hi(cqv.y), bf_lo(cqv.z), bf_hi(cqv.z), bf_lo(cqv.w), bf_hi(cqv.w)}; float s = 0.f;
#pragma unroll
            for (int i = 0; i < 8; ++i) s += x[i] * x[i];
            const float rstd = rsq(wave_sum(s) * (1.f / 512.f) + EPS);
            v4u w; w.x = pk2(x[0] * rstd * gcq0[0], x[1] * rstd * gcq0[1]); w.y = pk2(x[2] * rstd * gcq0[2], x[3] * rstd * gcq0[3]);
            w.z = pk2(x[4] * rstd * gcq1[0], x[5] * rstd * gcq1[1]); w.w = pk2(x[6] * rstd * gcq1[2], x[7] * rstd * gcq1[3]);
            ((v4u*)(CQN + (size_t)t * 512))[lane] = w;
        }
        {
            const float x0 = bf_lo(ckvv.x), x1 = bf_hi(ckvv.x), x2 = bf_lo(ckvv.y), x3 = bf_hi(ckvv.y);
            const float rstd = rsq(wave_sum((x0 * x0 + x1 * x1) + (x2 * x2 + x3 * x3)) * (1.f / 256.f) + EPS);
            v2u w; w.x = pk2(x0 * rstd * gckv[0], x1 * rstd * gckv[1]); w.y = pk2(x2 * rstd * gckv[2], x3 * rstd * gckv[3]);
            ((v2u*)(CKVN + (size_t)t * 256))[lane] = w;
        }
        {
            float x = bf_lo(kpev);
            const float rstd = rsq(wave_sum(x * x) * (1.f / 64.f) + EPS);
            x = rope_apply(x * rstd * gkpe, c2, s2, sgn);
            KPE[(size_t)t * 64 + lane] = (bf16)(pk2(x, 0.f) & 0xffffu);
        }
    }
}

__device__ __forceinline__ void phase_postmla(const Frame& F, const Args& a, int l) {
    int tid_ = threadIdx.x; asm volatile("" : "+v"(tid_)); const int tid = tid_, lane = tid & 63; (void)tid; (void)lane;
    const bf16* QCR = (const bf16*)(F.ws + WS_QCR); const bf16* KVR = (const bf16*)(F.ws + WS_KVR); const bf16* KPE = (const bf16*)(F.ws + WS_KPE);
    bf16* QC = (bf16*)(F.ws + WS_QC); bf16* KC = (bf16*)(F.ws + WS_KC);
    const f32x2 gqn = ((const f32x2*)(a.in[I_QNC] + l * 192))[lane], gkn = ((const f32x2*)(a.in[I_KNC] + l * 192))[lane];
    const float gqpe = a.in[I_QNC][l * 192 + 128 + lane];
    constexpr float LOG2T = 13.287712379549449f;
    const float f64 = __builtin_amdgcn_exp2f(-(float)(lane & 15) * (LOG2T / 16.f));
    const float sgn = (lane & 16) ? 1.f : -1.f;
    for (int t = F.gw; t < NTOK; t += F.ngw) {
        const int pos = t & (SEQ - 1); const float p = (float)((lane & 32) ? (pos & 63) : (pos >> 6));
        float s2, c2; sincos_rev(p * f64, s2, c2);
        const bf16* qr = QCR + (size_t)t * 768; const bf16* kr = KVR + (size_t)t * 1024;
        unsigned qn[4], kn[4]; unsigned qp[4];
#pragma unroll
        for (int h = 0; h < 4; ++h) { qn[h] = ((const unsigned*)(qr + h * 192))[lane]; qp[h] = (unsigned)qr[h * 192 + 128 + lane]; kn[h] = ((const unsigned*)(kr + h * 256))[lane]; }
        const bf16 kpe = KPE[(size_t)t * 64 + lane];
#pragma unroll
        for (int h = 0; h < 4; ++h) {
            { float v0 = bf_lo(qn[h]), v1 = bf_hi(qn[h]); const float rstd = rsq(wave_sum(v0 * v0 + v1 * v1) * (1.f / 128.f) + EPS);
              ((unsigned*)(QC + (size_t)t * 768 + h * 192))[lane] = pk2(v0 * rstd * gqn[0], v1 * rstd * gqn[1]); }
            { float x = bf_lo(qp[h]); const float rstd = rsq(wave_sum(x * x) * (1.f / 64.f) + EPS); x = rope_apply(x * rstd * gqpe, c2, s2, sgn);
              QC[(size_t)t * 768 + h * 192 + 128 + lane] = (bf16)(pk2(x, 0.f) & 0xffffu); }
            { float v0 = bf_lo(kn[h]), v1 = bf_hi(kn[h]); const float rstd = rsq(wave_sum(v0 * v0 + v1 * v1) * (1.f / 128.f) + EPS);
              ((unsigned*)(KC + (size_t)t * 768 + h * 192))[lane] = pk2(v0 * rstd * gkn[0], v1 * rstd * gkn[1]); }
            KC[(size_t)t * 768 + h * 192 + 128 + lane] = kpe;
        }
    }
}

__device__ __forceinline__ void phase_groupnorm(const Frame& F, const Args& a, int l) {
    int tid_ = threadIdx.x; asm volatile("" : "+v"(tid_)); const int tid = tid_, lane = tid & 63; (void)tid; (void)lane;
    const bf16* O = (const bf16*)(F.ws + WS_O); bf16* ON = (bf16*)(F.ws + WS_ON);
    f32x4 g[4][2];
    { const f32x4* ga = (const f32x4*)(a.in[I_ONA] + l * 512); const f32x4* gb = (const f32x4*)(a.in[I_ONB] + l * 1024); const f32x4* gc = (const f32x4*)(a.in[I_ONC] + l * 512);
      g[0][0] = ga[2 * lane]; g[0][1] = ga[2 * lane + 1]; g[1][0] = gb[2 * lane]; g[1][1] = gb[2 * lane + 1]; g[2][0] = gb[128 + 2 * lane]; g[2][1] = gb[128 + 2 * lane + 1]; g[3][0] = gc[2 * lane]; g[3][1] = gc[2 * lane + 1]; }
    for (int t = F.gw; t < NTOK; t += F.ngw) {
        const v4u* orow = (const v4u*)(O + (size_t)t * DM) + lane; float x[4][8]; float ss[4];
#pragma unroll
        for (int j = 0; j < 4; ++j) { const v4u w = orow[64 * j]; x[j][0] = bf_lo(w.x); x[j][1] = bf_hi(w.x); x[j][2] = bf_lo(w.y); x[j][3] = bf_hi(w.y); x[j][4] = bf_lo(w.z); x[j][5] = bf_hi(w.z); x[j][6] = bf_lo(w.w); x[j][7] = bf_hi(w.w);
            float s = 0.f;
#pragma unroll
            for (int i = 0; i < 8; ++i) s += x[j][i] * x[j][i];
            ss[j] = s; }
        const float ra = rsq(wave_sum(ss[0]) * (1.f / 512.f) + EPS), rb = rsq(wave_sum(ss[1] + ss[2]) * (1.f / 1024.f) + EPS), rc = rsq(wave_sum(ss[3]) * (1.f / 512.f) + EPS);
        if constexpr (F8WO) { v2u* nrow8 = (v2u*)((unsigned char*)ON + (size_t)t * DM) + lane;
#pragma unroll
            for (int j = 0; j < 4; ++j) { const float r = ((j == 0) ? ra : (j == 3) ? rc : rb) * SC_H; v2u w;
                w.x = pk4_fp8(x[j][0] * r * g[j][0][0], x[j][1] * r * g[j][0][1], x[j][2] * r * g[j][0][2], x[j][3] * r * g[j][0][3]);
                w.y = pk4_fp8(x[j][4] * r * g[j][1][0], x[j][5] * r * g[j][1][1], x[j][6] * r * g[j][1][2], x[j][7] * r * g[j][1][3]); nrow8[64 * j] = w; }
            continue; }
        v4u* nrow = (v4u*)(ON + (size_t)t * DM) + lane;
#pragma unroll
        for (int j = 0; j < 4; ++j) { const float r = (j == 0) ? ra : (j == 3) ? rc : rb; v4u w;
            w.x = pk2(x[j][0] * r * g[j][0][0], x[j][1] * r * g[j][0][1]); w.y = pk2(x[j][2] * r * g[j][0][2], x[j][3] * r * g[j][0][3]);
            w.z = pk2(x[j][4] * r * g[j][1][0], x[j][5] * r * g[j][1][1]); w.w = pk2(x[j][6] * r * g[j][1][2], x[j][7] * r * g[j][1][3]); nrow[64 * j] = w; }
    }
}

constexpr int ROUTER_LDS = 0;
constexpr int MOE_LDS_CNT = 65536;
constexpr int MOE_LDS_REC = 65536 + 64;
template <bool F8OUT, bool SRCB>
__device__ __forceinline__ void phase_ffnnorm_route(const Frame& F, const Args& a, const void* __restrict__ src, const float* __restrict__ gain, void* __restrict__ dstv, float osc) {
    int tid_ = threadIdx.x; asm volatile("" : "+v"(tid_)); const int tid = tid_, lane = tid & 63; (void)tid; (void)lane;
    LAS float* rt = (LAS float*)(F.lds + ROUTER_LDS); LAS unsigned* lcnt = (LAS unsigned*)(F.lds + MOE_LDS_CNT); LAS int* rec = (LAS int*)(F.lds + MOE_LDS_REC);
    const float* router = a.in[I_ROUTER];
    for (int t = tid; t < DM * NE / 4; t += NWAVES * 64) { const int k = t >> 1, half = t & 1; ((LAS f32x4*)rt)[half * 2048 + (((k >> 9) * 8 + (k & 7)) * 64 + ((k >> 3) & 63))] = ((const f32x4*)router)[t]; }
    if (tid < 16) lcnt[tid] = 0u;
    __syncthreads();
    const int t0 = (int)(((long)F.bid * NTOK) / F.G), t1 = (int)(((long)(F.bid + 1) * NTOK) / F.G);
    float g[4][8]; load_gain32(gain, lane, 1.f, g);
    float v[4][8], vn[4][8];
    if (t0 + F.wave < t1) load_row32<SRCB>((const unsigned char*)src + (size_t)(t0 + F.wave) * DM * (SRCB ? 2 : 4), lane, vn);
    for (int m = t0 + F.wave; m < t1; m += NWAVES) {
#pragma unroll
        for (int j = 0; j < 4; ++j)
#pragma unroll
            for (int i = 0; i < 8; ++i) v[j][i] = vn[j][i];
        if (m + NWAVES < t1) load_row32<SRCB>((const unsigned char*)src + (size_t)(m + NWAVES) * DM * (SRCB ? 2 : 4), lane, vn);
        float s = 0.f;
#pragma unroll
        for (int j = 0; j < 4; ++j)
#pragma unroll
            for (int i = 0; i < 8; ++i) s += v[j][i] * v[j][i];
        const float rstd = rsq(wave_sum(s) * (1.f / DM) + EPS);
        v4u* o16 = (v4u*)((bf16*)dstv + (size_t)m * DM) + lane; v2u* o8 = (v2u*)((unsigned char*)dstv + (size_t)m * DM) + lane;
        float lg[8] = {0.f, 0.f, 0.f, 0.f, 0.f, 0.f, 0.f, 0.f};
#pragma unroll
        for (int j = 0; j < 4; ++j) {
            float h[8];
#pragma unroll
            for (int i = 0; i < 8; ++i) h[i] = v[j][i] * rstd * g[j][i];
            if constexpr (F8OUT) { v2u w; w.x = pk4_fp8(h[0] * osc, h[1] * osc, h[2] * osc, h[3] * osc); w.y = pk4_fp8(h[4] * osc, h[5] * osc, h[6] * osc, h[7] * osc); o8[64 * j] = w; }
            else { v4u w; w.x = pk2(h[0], h[1]); w.y = pk2(h[2], h[3]); w.z = pk2(h[4], h[5]); w.w = pk2(h[6], h[7]); o16[64 * j] = w; }
#pragma unroll
            for (int i = 0; i < 8; ++i) { const f32x4 r0 = ((const LAS f32x4*)rt)[(j * 8 + i) * 64 + lane], r1 = ((const LAS f32x4*)rt)[2048 + (j * 8 + i) * 64 + lane];
                lg[0] += h[i] * r0[0]; lg[1] += h[i] * r0[1]; lg[2] += h[i] * r0[2]; lg[3] += h[i] * r0[3]; lg[4] += h[i] * r1[0]; lg[5] += h[i] * r1[1]; lg[6] += h[i] * r1[2]; lg[7] += h[i] * r1[3]; }
        }
#pragma unroll
        for (int e = 0; e < 8; ++e) lg[e] = wave_sum(lg[e]);
        int e0 = 0; float v0 = lg[0];
#pragma unroll
        for (int e = 1; e < 8; ++e) if (lg[e] > v0) { v0 = lg[e]; e0 = e; }
        int e1 = -1; float v1 = -3.0e38f;
#pragma unroll
        for (int e = 0; e < 8; ++e) if (e != e0 && lg[e] > v1) { v1 = lg[e]; e1 = e; }
        const float ex = __expf(v1 - v0), w0 = 1.f / (1.f + ex), w1 = ex * w0;
        if (lane == 0) { const int li = m - t0; const unsigned p0 = atomicAdd((unsigned*)&lcnt[e0], 1u), p1 = atomicAdd((unsigned*)&lcnt[e1], 1u);
            rec[li * 6 + 0] = e0; rec[li * 6 + 1] = e1; rec[li * 6 + 2] = (int)p0; rec[li * 6 + 3] = (int)p1; ((LAS float*)rec)[li * 6 + 4] = w0; ((LAS float*)rec)[li * 6 + 5] = w1; }
    }
    __syncthreads();
    if (tid < 8) lcnt[8 + tid] = __hip_atomic_fetch_add(F.ctl + CW_CNT + tid, lcnt[tid], __ATOMIC_RELAXED, __HIP_MEMORY_SCOPE_AGENT);
    __syncthreads();
    int* toke = (int*)(F.ws + WS_TOKE); int* tokp = (int*)(F.ws + WS_TOKP); float* tokw = (float*)(F.ws + WS_TOKW);
    for (int i = tid; i < (t1 - t0) * 2; i += NWAVES * 64) { const int li = i >> 1, k = i & 1, e = rec[li * 6 + k];
        toke[(size_t)(t0 + li) * 2 + k] = e; tokp[(size_t)(t0 + li) * 2 + k] = rec[li * 6 + 2 + k] + (int)lcnt[8 + e]; tokw[(size_t)(t0 + li) * 2 + k] = ((LAS float*)rec)[li * 6 + 4 + k]; }
    __syncthreads();
}
__device__ __forceinline__ void moe_tiles(const Frame& F, int (&tb)[9], int (&cnt)[8]) {
    int acc = 0;
#pragma unroll
    for (int e = 0; e < 8; ++e) { cnt[e] = (int)__hip_atomic_load(F.ctl + CW_CNT + e, __ATOMIC_RELAXED, __HIP_MEMORY_SCOPE_AGENT); tb[e] = acc; acc += (cnt[e] + 255) >> 8; }
    tb[8] = acc;
}
template <bool F8ROWS>
__device__ __forceinline__ void phase_gather(const Frame& F) {
    int tid_ = threadIdx.x; asm volatile("" : "+v"(tid_)); const int tid = tid_, lane = tid & 63; (void)tid; (void)lane;
    int tb[9], cnt[8]; moe_tiles(F, tb, cnt);
    constexpr int RBYTES = F8ROWS ? DM : 2 * DM, NCH = RBYTES / 1024;
    const unsigned char* H = (const unsigned char*)(F.ws + WS_H); unsigned char* HG = (unsigned char*)(F.ws + WS_HG); float* rg = (float*)(F.ws + WS_RGATE);
    const int* toke = (const int*)(F.ws + WS_TOKE); int* tokp = (int*)(F.ws + WS_TOKP); const float* tokw = (const float*)(F.ws + WS_TOKW);
    constexpr int GB = 4;
    for (int t0 = F.gw; t0 < NTOK; t0 += GB * F.ngw) {
        v4u v[GB][NCH]; int ee[GB][2], pp[GB][2]; float ww[GB][2];
#pragma unroll
        for (int b = 0; b < GB; ++b) { const int t = t0 + b * F.ngw; if (t < NTOK) { const v4u* hr = (const v4u*)(H + (size_t)t * RBYTES) + lane;
#pragma unroll
            for (int j = 0; j < NCH; ++j) v[b][j] = hr[64 * j];
#pragma unroll
            for (int k = 0; k < 2; ++k) { ee[b][k] = toke[(size_t)t * 2 + k]; pp[b][k] = tokp[(size_t)t * 2 + k]; ww[b][k] = tokw[(size_t)t * 2 + k]; } } }
#pragma unroll
        for (int b = 0; b < GB; ++b) { const int t = t0 + b * F.ngw; if (t < NTOK) {
#pragma unroll
            for (int k = 0; k < 2; ++k) { const int e = ee[b][k], p = pp[b][k]; int base = 0;
#pragma unroll
                for (int q = 0; q < 8; ++q) base = (q == e) ? tb[q] : base;
                const int slot = base * 256 + p; v4u* dr = (v4u*)(HG + (size_t)slot * RBYTES) + lane;
#pragma unroll
                for (int j = 0; j < NCH; ++j) dr[64 * j] = v[b][j];
                if (lane == 0) { rg[slot] = ww[b][k]; tokp[(size_t)t * 2 + k] = slot; } } } }
    }
#pragma unroll
    for (int e = 0; e < 8; ++e) { const int r0 = tb[e] * 256 + cnt[e], r1 = tb[e + 1] * 256;
        for (int r = r0 + F.gw; r < r1; r += F.ngw) { v4u* dr = (v4u*)(HG + (size_t)r * RBYTES) + lane; const v4u z = {0u, 0u, 0u, 0u};
#pragma unroll
            for (int j = 0; j < NCH; ++j) dr[64 * j] = z;
            if (lane == 0) rg[r] = 0.f; } }
}
__device__ __forceinline__ void phase_tailsum(const Frame& F) {
    int tid_ = threadIdx.x; asm volatile("" : "+v"(tid_)); const int tid = tid_;
    int tb[9], cnt[8]; moe_tiles(F, tb, cnt);
    const int nun = tb[8] * (DM / 256), nfull = (F.G == 256 && F8M) ? (nun / 256) * 256 : nun; if (nfull >= nun) return;
    pg8::StaticOrder S; S.init(tb[8] * 256, DM, F.G, 0);
    const float* P = (const float*)(F.ws + WS_PART); const float* rg = (const float*)(F.ws + WS_RGATE); bf16* Y = (bf16*)(F.ws + WS_Y);
    const float isc = F8M ? 1.f / (SC_ACT * SC_W) : 1.f;
    const int nsp = 4;
    const int nchunk = (nun - nfull) * 8192;
    for (int i = F.bid * NWAVES * 64 + tid; i < nchunk; i += F.G * NWAVES * 64) {
        const int j = i >> 13, r = (i >> 5) & 255, cc = (i & 31) * 8, ent = nfull + j;
        pg8::Unit u; S.c = ent % F.G; S.next(ent / F.G, u);
        const float* p = P + (size_t)(nsp * j) * 65536 + (size_t)r * 256 + cc; f32x4 a = {0.f, 0.f, 0.f, 0.f}, b = {0.f, 0.f, 0.f, 0.f};
        for (int s = 0; s < nsp; ++s) { a += *(const f32x4*)(p + (size_t)s * 65536); b += *(const f32x4*)(p + (size_t)s * 65536 + 4); }
        const int row = u.pm * 256 + r; const float sc = rg[row] * isc;
        v4u w; w.x = pk2(a[0] * sc, a[1] * sc); w.y = pk2(a[2] * sc, a[3] * sc); w.z = pk2(b[0] * sc, b[1] * sc); w.w = pk2(b[2] * sc, b[3] * sc);
        *(v4u*)(Y + (size_t)row * DM + u.pn * 256 + cc) = w;
    }
}
template <bool XBF>
__device__ __forceinline__ void phase_combine(const Frame& F, const void* __restrict__ xsrc, float* __restrict__ out) {
    int tid_ = threadIdx.x; asm volatile("" : "+v"(tid_)); const int tid = tid_, lane = tid & 63; (void)tid; (void)lane;
    const bf16* Y = (const bf16*)(F.ws + WS_Y); const int* tokp = (const int*)(F.ws + WS_TOKP);
    for (int t = F.gw; t < NTOK; t += F.ngw) {
        const int s0 = tokp[(size_t)t * 2], s1 = tokp[(size_t)t * 2 + 1];
        const v4u* y0 = (const v4u*)(Y + (size_t)s0 * DM) + lane; const v4u* y1 = (const v4u*)(Y + (size_t)s1 * DM) + lane;
        float x[4][8]; load_row32<XBF>((const unsigned char*)xsrc + (size_t)t * DM * (XBF ? 2 : 4), lane, x);
        f32x4* xr = (f32x4*)(out + (size_t)t * DM) + 2 * lane;
#pragma unroll
        for (int j = 0; j < 4; ++j) { const v4u p = y0[64 * j], q = y1[64 * j]; f32x4 xa, xb;
            xa[0] = x[j][0] + bf_lo(p.x) + bf_lo(q.x); xa[1] = x[j][1] + bf_hi(p.x) + bf_hi(q.x); xa[2] = x[j][2] + bf_lo(p.y) + bf_lo(q.y); xa[3] = x[j][3] + bf_hi(p.y) + bf_hi(q.y);
            xb[0] = x[j][4] + bf_lo(p.z) + bf_lo(q.z); xb[1] = x[j][5] + bf_hi(p.z) + bf_hi(q.z); xb[2] = x[j][6] + bf_lo(p.w) + bf_lo(q.w); xb[3] = x[j][7] + bf_hi(p.w) + bf_hi(q.w);
            xr[128 * j] = xa; xr[128 * j + 1] = xb; }
    }
}

__device__ __forceinline__ void convert_experts(const Frame& F, const Args& args, int e_lo, int e_hi, int w, int nw);
__device__ __forceinline__ void phase_attention(const Frame& F, const Args& a, int l) {
    int tid_ = threadIdx.x; asm volatile("" : "+v"(tid_)); const int tid = tid_, lane = tid & 63; (void)tid; (void)lane;
    const bf16* PROJ = (const bf16*)(F.ws + WS_PROJ);
    const bf16* QA = (const bf16*)(F.ws + WS_QA); const bf16* KA = (const bf16*)(F.ws + WS_KA); const bf16* QB = (const bf16*)(F.ws + WS_QB); const bf16* KB = (const bf16*)(F.ws + WS_KB);
    const bf16* KVR = (const bf16*)(F.ws + WS_KVR); const bf16* QC = (const bf16*)(F.ws + WS_QC); const bf16* KC = (const bf16*)(F.ws + WS_KC);
    bf16* O = (bf16*)(F.ws + WS_O);
    char* L = (char*)F.lds;
    const int cslot = (MOE_CVT_IN_ATTN == 1) ? ((F.bid >> 3) & 3) : -1; bool cvt_done = (MOE_CVT_IN_ATTN != 1);
#ifndef ATT_PP
#define ATT_PP 0
#endif
#ifndef ATT_STATIC
#define ATT_STATIC 0
#endif
#if ATT_STATIC
#define ATT_C3(q, k, v, o) att::attn_body3s<192, 768, 768, 1024, 2048, SEQ / 64, 1, 8>(q, k, v, o, L)
#define ATT_B3(q, k, v, o) att::attn_body3s<128, 1024, 256, 4096, 2048, SEQ / 64, 2, 8>(q, k, v, o, L)
#else
#if ATT_PP & 1
#define ATT_C3(q, k, v, o) att::attn_body_pp<192, 768, 768, 1024, 2048, 0, 8>(q, k, v, o, SEQ / 64, L, 0, 0, nullptr)
#else
#define ATT_C3(q, k, v, o) att::attn_body3<192, 768, 768, 1024, 2048, 0, 1, 12>(q, k, v, o, SEQ / 64, L, 0, 0, nullptr)
#endif
#if ATT_PP & 2
#define ATT_B3(q, k, v, o) att::attn_body_pp<128, 1024, 256, 4096, 2048, 0, 8>(q, k, v, o, SEQ / 64, L, 0, 0, nullptr)
#else
#define ATT_B3(q, k, v, o) att::attn_body3<128, 1024, 256, 4096, 2048, 0, 2, 8>(q, k, v, o, SEQ / 64, L, 0, 0, nullptr)
#endif
#endif
#define ATT_CVT() do { __syncthreads(); convert_experts(F, a, 4 * l, 4 * l + 4, F.gw, F.ngw); __syncthreads(); cvt_done = true; } while (0)
    if (cslot == 0) ATT_CVT();
    if (PHON(16)) for (int Lu = F.bid; Lu < 256; Lu += F.G) {
        const int id = (Lu & 7) * 32 + (Lu >> 3), b = id >> 6, h = (id >> 4) & 3, qb = id & 15; const size_t tq = (size_t)b * SEQ + qb * 256, tk = (size_t)b * SEQ;
        #if ATT_RING3 & 1
        ATT_C3(QC + tq * 768 + h * 192, KC + tk * 768 + h * 192, KVR + tk * 1024 + h * 256 + 128, O + tq * DM + 1536 + h * 128);
#else
        att::attn_body<192, 768, 768, 1024, 2048, 0, 1, 8>(QC + tq * 768 + h * 192, KC + tk * 768 + h * 192, KVR + tk * 1024 + h * 256 + 128, O + tq * DM + 1536 + h * 128, SEQ / 64, L, 0, 0, nullptr);
#endif
    }
    if (cslot == 1) ATT_CVT();
    if (PHON(17)) for (int Lu = F.bid; Lu < 512; Lu += F.G) {
        if (cslot == 2 && !cvt_done && Lu != F.bid) ATT_CVT();
        const int id = (Lu & 7) * 64 + (Lu >> 3), b = id >> 7, kvh = (id >> 6) & 1, g = (id >> 4) & 3, qb = id & 15, h = kvh * 4 + g; const size_t tq = (size_t)b * SEQ + qb * 256, tk = (size_t)b * SEQ;
        #if ATT_RING3 & 2
        ATT_B3(QB + tq * 1024 + h * 128, KB + tk * 256 + kvh * 128, PROJ + tk * DINP + PC_VB + kvh * 128, O + tq * DM + 512 + h * 128);
#else
        att::attn_body<128, 1024, 256, 4096, 2048, 0, 2, 8>(QB + tq * 1024 + h * 128, KB + tk * 256 + kvh * 128, PROJ + tk * DINP + PC_VB + kvh * 128, O + tq * DM + 512 + h * 128, SEQ / 64, L, 0, 0, nullptr);
#endif
    }
    float* biasT = (float*)(L + 136 * 1024);
    if (!cvt_done && cslot == 3) ATT_CVT();
    if (PHON(18)) {
        LAS int* claim = (LAS int*)(F.lds + 160 * 1024 - 512);
        const int home = (int)(xb_xcc_id() & 7u);
        for (int li = 0; li < 8; ++li) {
            const int list = (home + li) & 7;
            for (;;) {
                __syncthreads();
                if (tid == 0) claim[0] = (int)__hip_atomic_fetch_add(F.ctl + CW_AQ + 64 * (8 * l + list), 1u, __ATOMIC_RELAXED, __HIP_MEMORY_SCOPE_AGENT);
                __syncthreads();
                const int idx = claim[0]; if (idx >= 32) break;
                const int id = list * 32 + idx, b = id >> 6, h = (id >> 4) & 3, rb = id & 15; const size_t tq = (size_t)b * SEQ + rb * 256;
                int lo = min(max(rb * 4 - 4, 0), 56), hi = min(max(rb * 4 + 3 - 4, 0), 56) + 8;
                if ((hi - lo) & 1) { if (hi < 64) ++hi; else --lo; }
                const float* rpb = a.in[I_RPB] + ((size_t)l * 4 + h) * 465;
                for (int i = tid; i < 15 * 128; i += NWAVES * 64) { const int bi = i >> 7, bj = (i & 127) - 48; biasT[i] = (bj >= 0 && bj < 31) ? rpb[bi * 31 + bj] * 11.313708498984761f : 0.f; }
                __syncthreads();
                const size_t tk = (size_t)b * SEQ + lo * 64;
                #if ATT_PP & 4
                att::attn_body_pp<128, 512, 512, 4096, 2048, 1, 4>(QA + tq * 512 + h * 128, KA + tk * 512 + h * 128, PROJ + tk * DINP + PC_VA + h * 128, O + tq * DM + h * 128, hi - lo, L, rb * 4, lo, biasT);
#else
                att::ATT_BODY_A<128, 512, 512, 4096, 2048, 1, 1, 8>(QA + tq * 512 + h * 128, KA + tk * 512 + h * 128, PROJ + tk * DINP + PC_VA + h * 128, O + tq * DM + h * 128, hi - lo, L, rb * 4, lo, biasT);
#endif
            }
        }
    }
    if (!cvt_done) ATT_CVT();
#undef ATT_CVT
}

constexpr int NPHASE = 25;

__device__ __forceinline__ void tr8_decode(const Args& args, unsigned char* ws, int e_lo, int gi, const float*& W, unsigned char*& WT, int& K, int& N, int& mode, int& item) {
    const int m = gi / 3584; item = gi - m * 3584; const int e = e_lo + m / 3, kind = m - (m / 3) * 3;
    if (kind == 2) { W = args.in[I_WED] + (size_t)e * DFE * DM; WT = ws + WS_WED + (size_t)e * DM * DFE; K = DFE; N = DM; mode = 0; }
    else { W = (kind == 0 ? args.in[I_WEG] : args.in[I_WEU]) + (size_t)e * DM * DFE; WT = ws + WS_WEGU + (size_t)e * 2 * DFE * DM; K = DM; N = DFE; mode = 1 + kind; }
}
__device__ __forceinline__ void tr8_load(const float* __restrict__ W, int N, int item, int lane, f32x4 (&v)[16]) {
    const int nblk = N >> 5, kb = item / nblk, nb = item - kb * nblk, k0 = kb << 7, n0 = nb << 5; const int c = lane >> 3, q = lane & 7;
    const float* p = W + (size_t)(k0 + 16 * c) * N + n0 + 4 * q;
#pragma unroll
    for (int i = 0; i < 16; ++i) v[i] = __builtin_nontemporal_load((const f32x4*)(p + (size_t)i * N));
}
__device__ __forceinline__ void tr8_store(unsigned char* __restrict__ WT, int K, int N, int mode, int item, int lane, float wsc, LAS float* scr, const f32x4 (&v)[16]) {
    (void)scr;
    const int nblk = N >> 5, kb = item / nblk, nb = item - kb * nblk, k0 = kb << 7, n0 = nb << 5; const int c = lane >> 3, q = lane & 7;
    const int drow0 = (mode == 0) ? n0 : ((n0 >> 7) * 256 + (mode - 1) * 128 + (n0 & 127));
    unsigned char* p = WT + (size_t)(drow0 + 4 * q) * K + k0 + 16 * c;
#pragma unroll
    for (int j = 0; j < 4; ++j) {
        v4u o; o.x = pk4_fp8(v[0][j] * wsc, v[1][j] * wsc, v[2][j] * wsc, v[3][j] * wsc); o.y = pk4_fp8(v[4][j] * wsc, v[5][j] * wsc, v[6][j] * wsc, v[7][j] * wsc);
        o.z = pk4_fp8(v[8][j] * wsc, v[9][j] * wsc, v[10][j] * wsc, v[11][j] * wsc); o.w = pk4_fp8(v[12][j] * wsc, v[13][j] * wsc, v[14][j] * wsc, v[15][j] * wsc);
        *(v4u*)(p + (size_t)j * K) = o; }
}
__device__ __forceinline__ void convert_experts(const Frame& F, const Args& args, int e_lo, int e_hi, int w, int nw) {
    int tid_ = threadIdx.x; asm volatile("" : "+v"(tid_)); const int lane = tid_ & 63;
    LAS float* scr = (LAS float*)(F.lds + F.wave * 18432);
    if constexpr (F8M) {
        const int total = (e_hi - e_lo) * 3 * 3584;
        f32x4 va[16], vb[16], vc[16]; const float* W; unsigned char* WT; int K, N, mode, item;
#define TR8_LD(buf, gx) do { if ((gx) < total) { tr8_decode(args, F.ws, e_lo, (gx), W, WT, K, N, mode, item); tr8_load(W, N, item, lane, buf); } } while (0)
#define TR8_ST(buf, gx) do { tr8_decode(args, F.ws, e_lo, (gx), W, WT, K, N, mode, item); tr8_store(WT, K, N, mode, item, lane, SC_W, scr, buf); } while (0)
        int gi = w;
        TR8_LD(va, gi); TR8_LD(vb, gi + nw);
        while (gi < total) {
            TR8_LD(vc, gi + 2 * nw); TR8_ST(va, gi); gi += nw; if (gi >= total) break;
            TR8_LD(va, gi + 2 * nw); TR8_ST(vb, gi); gi += nw; if (gi >= total) break;
            TR8_LD(vb, gi + 2 * nw); TR8_ST(vc, gi); gi += nw;
        }
#undef TR8_LD
#undef TR8_ST
    } else {
        int it = w;
#define TR_RUNB(Wp, Kk, Nn, Dp, ROFF, MODE) do { const int cnt_ = ((Kk) >> 6) * ((Nn) >> 5); while (it < cnt_) { transpose_item((Wp), (Kk), (Nn), (Dp), (ROFF), (MODE), scr, it, lane); it += nw; } it -= cnt_; } while (0)
        for (int e = e_lo; e < e_hi; ++e) {
            TR_RUNB(args.in[I_WEG] + (size_t)e * DM * DFE, DM, DFE, (bf16*)(F.ws + WS_WEGU) + (size_t)e * 2 * DFE * DM, 0, 1);
            TR_RUNB(args.in[I_WEU] + (size_t)e * DM * DFE, DM, DFE, (bf16*)(F.ws + WS_WEGU) + (size_t)e * 2 * DFE * DM, 0, 2);
            TR_RUNB(args.in[I_WED] + (size_t)e * DFE * DM, DFE, DM, (bf16*)(F.ws + WS_WED) + (size_t)e * DM * DFE, 0, 0);
        }
#undef TR_RUNB
    }
}
constexpr int CVT_TOTAL = NE * 3 * 3584;
constexpr int CVT_GU_ITEMS = NE * 2 * 3584;
__device__ __forceinline__ void cvt_queue_item(const Frame& F, const Args& args, int gi, int lane) {
    if (gi >= CVT_TOTAL) return;
    const float* W; unsigned char* WT; int K, N, mode, item;
    if (gi < CVT_GU_ITEMS) { const int m = gi / 3584, e = m >> 1, kind = m & 1; item = gi - m * 3584;
        W = (kind == 0 ? args.in[I_WEG] : args.in[I_WEU]) + (size_t)e * DM * DFE; WT = F.ws + WS_WEGU + (size_t)e * 2 * DFE * DM; K = DM; N = DFE; mode = 1 + kind; }
    else { const int r = gi - CVT_GU_ITEMS, e = r / 3584; item = r - e * 3584; W = args.in[I_WED] + (size_t)e * DFE * DM; WT = F.ws + WS_WED + (size_t)e * DM * DFE; K = DFE; N = DM; mode = 0; }
    f32x4 v[16]; tr8_load(W, N, item, lane, v); tr8_store(WT, K, N, mode, item, lane, SC_W, nullptr, v);
}
__device__ __forceinline__ void xcd_barrier_w(const XcdBarrier& b, const Frame& F, const Args& args, volatile LAS unsigned* bx) {
    asm volatile("s_waitcnt vmcnt(0)" ::: "memory");
    __syncthreads();
    int tid_ = threadIdx.x; asm volatile("" : "+v"(tid_)); const int lane = tid_ & 63;
    if (threadIdx.x == 0) {
        unsigned* bar = b.bar;
        __builtin_amdgcn_s_waitcnt(0);
        unsigned nloc = b.st[0], nx = b.st[1];
        if (nloc == 0u) { xcd_barrier_complete(bar, b.x, nloc, nx); b.st[0] = nloc; b.st[1] = nx; }
        const unsigned old = xb_add(&bar[XB_XSUB(b.x)], 1u);
        const unsigned gen = old / nloc;
        if (old + 1u == (gen + 1u) * nloc) {
            __builtin_amdgcn_fence(__ATOMIC_RELEASE, "agent");
            asm volatile("s_waitcnt vmcnt(0)" ::: "memory");
            const unsigned og = xb_add(&bar[XB_TOP], 1u);
            const unsigned tg = og / nx;
            if (og + 1u == (tg + 1u) * nx) xb_add(&bar[XB_TOPGEN], 1u);
            else XB_SPIN(xb_ld(&bar[XB_TOPGEN]) == tg, bar);
            __builtin_amdgcn_fence(__ATOMIC_ACQUIRE, "agent");
            xb_add(&bar[XB_XGEN(b.x)], 1u);
            asm volatile("s_waitcnt vmcnt(0)" ::: "memory");
            bx[0] = 1u;
        } else { bx[0] = 0u; bx[2] = gen; }
    }
    __syncthreads();
    unsigned spins = 0u; bool dry = false;
    while (bx[0] == 0u) {
        __syncthreads();
        if (threadIdx.x == 0) {
            unsigned* bar = b.bar;
            bool rel = xb_ld(&bar[XB_XGEN(b.x)]) != bx[2];
            if (!rel && ((++spins & 63u) == 0u)) { if (xb_ld(&bar[XB_TMO])) rel = true; else if (spins > (XB_SPIN_CAP >> 1)) { atomicAdd(&bar[XB_TMO], 1u); rel = true; } }
            if (rel) { __builtin_amdgcn_fence(__ATOMIC_ACQUIRE, "agent"); asm volatile("s_waitcnt vmcnt(0)" ::: "memory"); bx[0] = 1u; }
            else if (!dry) { const unsigned c = xb_add(F.ctl + CW_CQ, 8u); bx[1] = c; dry = c >= (unsigned)CVT_TOTAL; }
            else { bx[1] = (unsigned)CVT_TOTAL; __builtin_amdgcn_s_sleep(2); }
        }
        __syncthreads();
        if (bx[0] == 0u) cvt_queue_item(F, args, (int)bx[1] + F.wave, lane);
    }
    __syncthreads();
}
__device__ __forceinline__ void cvt_drain(const Frame& F, const Args& args, volatile LAS unsigned* bx, int limit) {
    int tid_ = threadIdx.x; asm volatile("" : "+v"(tid_)); const int lane = tid_ & 63;
    for (;;) {
        __syncthreads();
        if (threadIdx.x == 0) { const unsigned c = xb_ld(F.ctl + CW_CQ); bx[1] = (c >= (unsigned)limit) ? 0xFFFFFFFFu : xb_add(F.ctl + CW_CQ, 8u); }
        __syncthreads();
        const unsigned base = bx[1]; if (base >= (unsigned)CVT_TOTAL) break;
        cvt_queue_item(F, args, (int)base + F.wave, lane);
        if (base >= (unsigned)limit) break;
    }
    __syncthreads();
}
__device__ __forceinline__ void phase_prologue(const Frame& F, const Args& args) {
    int tid_ = threadIdx.x; asm volatile("" : "+v"(tid_)); const int tid = tid_, lane = tid & 63;
    LAS float* scr = (LAS float*)(F.lds + F.wave * 16896);
    int it = F.gw; const int nw = F.ngw;
#define TR_RUN(Wp, Kk, Nn, Dp, ROFF, MODE) do { const int cnt_ = ((Kk) >> 6) * ((Nn) >> 5); while (it < cnt_) { transpose_item((Wp), (Kk), (Nn), (Dp), (ROFF), (MODE), scr, it, lane); it += nw; } it -= cnt_; } while (0)
#define TR_RUN8(Wp, Kk, Nn, Dp, ROFF, MODE) do { const int cnt_ = ((Kk) >> 7) * ((Nn) >> 5); while (it < cnt_) { transpose_item_f8((Wp), (Kk), (Nn), (Dp), (ROFF), (MODE), SC_W, scr, it, lane); it += nw; } it -= cnt_; } while (0)
    for (int l = 0; l < DEPTH; ++l) {
        TR_RUN(args.in[I_WIN] + (size_t)l * DM * DIN, DM, DIN, (bf16*)(F.ws + WS_WIN) + (size_t)l * DINP * DM, 0, 0);
        TR_RUN(args.in[I_WUQ] + (size_t)l * 512 * 768, 512, 768, (bf16*)(F.ws + WS_WUQ) + (size_t)l * 768 * 512, 0, 0);
        TR_RUN(args.in[I_WUKV] + (size_t)l * 256 * 1024, 256, 1024, (bf16*)(F.ws + WS_WUKV) + (size_t)l * 1024 * 256, 0, 0);
        if constexpr (F8WO) TR_RUN8(args.in[I_WOUT] + (size_t)l * DM * DM, DM, DM, (unsigned char*)(F.ws + WS_WOUT) + (size_t)l * DM * DM, 0, 0);
        else TR_RUN(args.in[I_WOUT] + (size_t)l * DM * DM, DM, DM, (bf16*)(F.ws + WS_WOUT) + (size_t)l * DM * DM, 0, 0);
    }
    if constexpr (F8DG) {
        TR_RUN8(args.in[I_WG], DM, DFF, (unsigned char*)(F.ws + WS_WGU), 0, 1);
        TR_RUN8(args.in[I_WU], DM, DFF, (unsigned char*)(F.ws + WS_WGU), 0, 2);
    } else {
        TR_RUN(args.in[I_WG], DM, DFF, (bf16*)(F.ws + WS_WGU), 0, 1);
        TR_RUN(args.in[I_WU], DM, DFF, (bf16*)(F.ws + WS_WGU), 0, 2);
    }
    if constexpr (F8DD) TR_RUN8(args.in[I_WDN], DFF, DM, (unsigned char*)(F.ws + WS_WD), 0, 0);
    else TR_RUN(args.in[I_WDN], DFF, DM, (bf16*)(F.ws + WS_WD), 0, 0);
#undef TR_RUN
#undef TR_RUN8
    for (int l = 0; l < DEPTH; ++l) { v4u* z = (v4u*)((bf16*)(F.ws + WS_WIN) + ((size_t)l * DINP + DIN) * DM); const v4u zz = {0u, 0u, 0u, 0u};
        for (int i = F.bid * NWAVES * 64 + tid; i < (DINP - DIN) * DM / 8; i += F.G * NWAVES * 64) z[i] = zz; }
    if (MOE_CVT_IN_ATTN == 0 || (MOE_CVT_IN_ATTN >= 2 && !F8M)) convert_experts(F, args, 0, NE, F.gw, F.ngw);
    phase_rmsnorm<false, false>(F, args.in[I_X], args.in[I_MIXN], F.ws + WS_H, 1.f);
}

__global__ void __launch_bounds__(NWAVES * 64, 2) mega_fwd(Args args) {
    extern __shared__ __attribute__((aligned(16))) unsigned char lds_raw[];
    Frame F;
    F.lds = (LAS unsigned char*)lds_raw; F.ws = args.ws; F.ctl = (unsigned*)(args.ws + WS_CTL);
    F.wave = __builtin_amdgcn_readfirstlane((int)threadIdx.x >> 6);
    F.G = gridDim.x; F.bid = blockIdx.x; F.gw = F.bid * NWAVES + F.wave; F.ngw = F.G * NWAVES;
    volatile LAS unsigned* MISC = (volatile LAS unsigned*)(F.lds + MISC_OFF);
    if (threadIdx.x < 64) MISC[threadIdx.x] = 0u;
    __syncthreads();
    XcdBarrier bar = xcd_barrier_post(F.ctl + CW_BAR, MISC + 8);
    const int lo = args.ph_lo, hi = args.ph_hi;
#define IN(k) (lo <= (k) && (k) < hi)
#if defined(PROBE_WHAT)
    unsigned long long pb_acc = 0ull, pb_t0 = 0ull, pb_cyc = 0ull, pb_c0 = 0ull;
#define PB_START(id) do { if ((id) == PROBE_WHAT) { pb_t0 = __builtin_amdgcn_s_memrealtime(); pb_c0 = __builtin_amdgcn_s_memtime(); } } while (0)
#define PB_STOP(id) do { if ((id) == PROBE_WHAT) { pb_acc += __builtin_amdgcn_s_memrealtime() - pb_t0; pb_cyc += __builtin_amdgcn_s_memtime() - pb_c0; } } while (0)
#else
#define PB_START(id) do {} while (0)
#define PB_STOP(id) do {} while (0)
#endif
#define SEAM_CLASS(k) (((k) == 1 || (k) == 3 || (k) == 7 || (k) == 9 || (k) == 10 || (k) == 12 || (k) == 14 || (k) == 18 || (k) == 21 || (k) == 22) ? 20 : (((k) == 5 || (k) == 16) ? 21 : 22))
#ifndef DRAIN2
#define DRAIN2 1
#endif
#define SEAM(k) do { if (IN(k) && IN((k) + 1)) { PB_START(1); PB_START(SEAM_CLASS(k)); if (MOE_CVT_IN_ATTN == 3 && F8M && (k) < (DRAIN2 ? 21 : 19)) xcd_barrier_w(bar, F, args, MISC + 16); else xcd_barrier(bar); PB_STOP(SEAM_CLASS(k)); PB_STOP(1); } } while (0)
    float* out = args.out;
    bf16* XB = (bf16*)(F.ws + WS_XB);
    LAS unsigned char* ring = F.lds;

    if (PHON(0) && IN(0)) { PB_START(58); phase_prologue(F, args); PB_STOP(58); }
    SEAM(0);

#pragma nounroll
    for (int l = 0; l < DEPTH; ++l) {
        const int P = 11 * l;
        if (PHON(1) && IN(P + 1)) { PB_START(30); PB_START(60);
            pg8::Gemm g{F.ws + WS_H, (const bf16*)(F.ws + WS_WIN) + (size_t)l * DINP * DM, NTOK, DINP, DM, 0}; pg8::StaticOrder S; S.init(NTOK, DINP, F.G, F.bid);
            pg8::EpiBf16 E{(bf16*)(F.ws + WS_PROJ), DINP};
            pg8::gemm_phase<pg8::EpiBf16, pg8::StaticOrder, true, true>(ring, g, S, E, F.ws); PB_STOP(30); PB_STOP(60);
        }
        SEAM(P + 1);
        if (PHON(2) && IN(P + 2)) { PB_START(50); phase_postproj(F, args, l); PB_STOP(50); }
        SEAM(P + 2);
        if (PHON(3) && IN(P + 3)) { PB_START(61);
            { pg8::Gemm g{F.ws + WS_CQN, (const bf16*)(F.ws + WS_WUQ) + (size_t)l * 768 * 512, NTOK, 768, 512, 0}; pg8::StaticOrder S; S.init(NTOK, 768, F.G, F.bid);
              pg8::EpiBf16 E{(bf16*)(F.ws + WS_QCR), 768}; pg8::gemm_phase<pg8::EpiBf16, pg8::StaticOrder, true, true>(ring, g, S, E, F.ws); }
            { pg8::Gemm g{F.ws + WS_CKVN, (const bf16*)(F.ws + WS_WUKV) + (size_t)l * 1024 * 256, NTOK, 1024, 256, 0}; pg8::StaticOrder S; S.init(NTOK, 1024, F.G, F.bid);
              pg8::EpiBf16 E{(bf16*)(F.ws + WS_KVR), 1024}; pg8::gemm_phase<pg8::EpiBf16, pg8::StaticOrder, true, true>(ring, g, S, E, F.ws); }
            PB_STOP(61);
        }
        SEAM(P + 3);
        if (PHON(4) && IN(P + 4)) { PB_START(51); phase_postmla(F, args, l); PB_STOP(51); }
        SEAM(P + 4);
        if (PHON(5) && IN(P + 5)) { PB_START(2); PB_START(32); phase_attention(F, args, l); __syncthreads(); PB_STOP(32); PB_STOP(2); }
        SEAM(P + 5);
        if (PHON(6) && IN(P + 6)) { PB_START(52); phase_groupnorm(F, args, l); PB_STOP(52); }
        SEAM(P + 6);
        if (PHON(7) && IN(P + 7)) { PB_START(62);
            pg8::Gemm g{F.ws + WS_ON, F.ws + WS_WOUT + (size_t)l * DM * DM * (F8WO ? 1 : 2), NTOK, DM, DM, 0}; pg8::StaticOrder S; S.init(NTOK, DM, F.G, F.bid);
            constexpr float isc = F8WO ? 1.f / (SC_H * SC_W) : 1.f;
            if (l == 0) { pg8::EpiResBf16<false> E{args.in[I_X], XB, DM, isc}; pg8::gemm_phase<pg8::EpiResBf16<false>, pg8::StaticOrder, true, true, F8WO>(ring, g, S, E, F.ws); }
            else { pg8::EpiResBf16<true> E{XB, XB, DM, isc}; pg8::gemm_phase<pg8::EpiResBf16<true>, pg8::StaticOrder, true, true, F8WO>(ring, g, S, E, F.ws); }
            PB_STOP(62);
        }
        SEAM(P + 7);
        if (l == 0) {
            if (PHON(8) && IN(P + 8)) { PB_START(53); phase_rmsnorm<F8DG, true>(F, XB, args.in[I_FFNN] + (size_t)l * DM, F.ws + WS_H, F8DG ? SC_H : 1.f); PB_STOP(53); }
            SEAM(P + 8);
            if (PHON(9) && IN(P + 9)) { PB_START(63);
                pg8::Gemm g{F.ws + WS_H, F.ws + WS_WGU, NTOK, 2 * DFF, DM, 0}; pg8::StaticOrder S; S.init(NTOK, 2 * DFF, F.G, F.bid);
                constexpr float isc = F8DG ? 1.f / (SC_H * SC_W) : 1.f;
                if constexpr (F8DD) { pg8::EpiSwigluF8 E{F.ws + WS_ACT, DFF, SC_ACT, isc}; pg8::gemm_phase<pg8::EpiSwigluF8, pg8::StaticOrder, true, true, F8DG>(ring, g, S, E, F.ws); }
                else { pg8::EpiSwiglu E{(bf16*)(F.ws + WS_ACT), DFF, isc}; pg8::gemm_phase<pg8::EpiSwiglu, pg8::StaticOrder, true, true, F8DG>(ring, g, S, E, F.ws); }
                PB_STOP(63);
            }
            SEAM(P + 9);
            if (PHON(10) && IN(P + 10)) { PB_START(64);
                pg8::Gemm g{F.ws + WS_ACT, F.ws + WS_WD, NTOK, DM, DFF, 0}; pg8::StaticOrder S; S.init(NTOK, DM, F.G, F.bid);
                pg8::EpiResBf16<true> E{XB, XB, DM, F8DD ? 1.f / (SC_ACT * SC_W) : 1.f};
                pg8::gemm_phase<pg8::EpiResBf16<true>, pg8::StaticOrder, true, true, F8DD>(ring, g, S, E, F.ws); PB_STOP(64);
            }
            SEAM(P + 10);
            if (PHON(8) && IN(P + 11)) { PB_START(53); phase_rmsnorm<false, true>(F, XB, args.in[I_MIXN] + (size_t)(l + 1) * DM, F.ws + WS_H, 1.f); PB_STOP(53); }
            SEAM(P + 11);
        } else {
            if (PHON(11) && IN(P + 8) && MOE_CVT_IN_ATTN == 3 && F8M) cvt_drain(F, args, MISC + 16, DRAIN2 ? CVT_GU_ITEMS : CVT_TOTAL);
            if (PHON(11) && IN(P + 8)) { PB_START(54); phase_ffnnorm_route<F8M, true>(F, args, XB, args.in[I_FFNN] + (size_t)l * DM, F.ws + WS_H, SC_H); PB_STOP(54); }
            SEAM(P + 8);
            if (PHON(12) && IN(P + 9)) { PB_START(55); phase_gather<F8M>(F); PB_STOP(55); }
            SEAM(P + 9);
            if (PHON(13) && IN(P + 10)) { PB_START(31); PB_START(65);
                int tb[9], cnt[8]; moe_tiles(F, tb, cnt);
                pg8::Gemm g{F.ws + WS_HG, F.ws + WS_WEGU, tb[8] * 256, 2 * DFE, DM, 0}; pg8::GroupedOrder S; S.init(tb[8] * 256, 2 * DFE, F.G, F.bid);
#pragma unroll
                for (int k = 0; k < 7; ++k) S.tb[k] = tb[k + 1];
                S.nct = 2 * DFE / 256; S.lim = 0;
                if constexpr (F8M) { pg8::EpiSwigluF8 E{F.ws + WS_ACTM, DFE, SC_ACT, 1.f / (SC_H * SC_W)}; pg8::gemm_phase<pg8::EpiSwigluF8, pg8::GroupedOrder, true, true, true>(ring, g, S, E, F.ws); }
                else { pg8::EpiSwiglu E{(bf16*)(F.ws + WS_ACTM), DFE, 1.f}; pg8::gemm_phase<pg8::EpiSwiglu, pg8::GroupedOrder, true, true, false>(ring, g, S, E, F.ws); }
                PB_STOP(31); PB_STOP(65);
                if (DRAIN2 && MOE_CVT_IN_ATTN == 3 && F8M) cvt_drain(F, args, MISC + 16, CVT_TOTAL);
            }
            SEAM(P + 10);
            if (PHON(14) && IN(P + 11)) { PB_START(66);
                int tb[9], cnt[8]; moe_tiles(F, tb, cnt);
                const int nun = tb[8] * (DM / 256), nfull = (F.G == 256 && F8M) ? (nun / 256) * 256 : nun;
                { pg8::Gemm g{F.ws + WS_ACTM, F.ws + WS_WED, tb[8] * 256, DM, DFE, 0}; pg8::GroupedOrder S; S.init(tb[8] * 256, DM, F.G, F.bid);
#pragma unroll
                  for (int k = 0; k < 7; ++k) S.tb[k] = tb[k + 1];
                  S.nct = DM / 256; S.lim = nfull;
                  pg8::EpiScaleBf16 E{(bf16*)(F.ws + WS_Y), DM, (const float*)(F.ws + WS_RGATE), F8M ? 1.f / (SC_ACT * SC_W) : 1.f};
                  pg8::gemm_phase<pg8::EpiScaleBf16, pg8::GroupedOrder, true, true, F8M>(ring, g, S, E, F.ws); }
                if (nfull < nun) { const int nsp = 4;
                  pg8::Gemm g{F.ws + WS_ACTM, F.ws + WS_WED, tb[8] * 256, DM, DFE, DFE / 128 / nsp}; pg8::GroupedTail S; S.init(tb[8] * 256, DM, F.G, F.bid);
#pragma unroll
                  for (int k = 0; k < 7; ++k) S.tb[k] = tb[k + 1];
                  S.nct = DM / 256; S.lim = nfull; S.nsp = nsp; S.kslice = DFE / nsp;
                  pg8::EpiPartF32 E{(float*)(F.ws + WS_PART)};
                  pg8::gemm_phase<pg8::EpiPartF32, pg8::GroupedTail, true, true, F8M>(ring, g, S, E, F.ws); }
                PB_STOP(66);
            }
            SEAM(P + 11);
            if (PHON(14) && IN(P + 12)) { PB_START(56); phase_tailsum(F); PB_STOP(56); }
            SEAM(P + 12);
            if (PHON(15) && IN(P + 13)) { PB_START(57); phase_combine<true>(F, XB, out); PB_STOP(57); }
        }
    }
#if defined(PROBE_WHAT)
    if (blockIdx.x == PROBE_BLOCK && threadIdx.x < 64) { const unsigned long long t0 = __builtin_amdgcn_s_memrealtime(); const unsigned long long spin = (PROBE_WHAT >= 30 && PROBE_WHAT < 50) ? (pb_acc ? (pb_cyc * 100ull / pb_acc) * 50ull : 0ull) : (unsigned long long)PROBE_AMP * pb_acc;
        while (__builtin_amdgcn_s_memrealtime() - t0 < spin) __builtin_amdgcn_s_sleep(8); }
#endif
#undef IN
#undef SEAM
}

extern "C" void kernel_launch(void* const* d_in, const int* in_sizes, int n_in, void* d_out, int out_size, void* d_ws, size_t ws_size, hipStream_t stream) {
    static int grid = 0;
    if (grid == 0) {
        if (n_in != 26 || in_sizes[0] != NTOK * DM || out_size != NTOK * DM || ws_size < WS_END3) { fprintf(stderr, "kernel_launch: unexpected shapes (n_in %d, in0 %d, out %d, ws %zu < %zu)\n", n_in, n_in > 0 ? in_sizes[0] : -1, out_size, ws_size, (size_t)WS_END3); grid = -1; return; }
        int dev = 0, cus = 0, per_cu = 0;
        if (hipGetDevice(&dev) != hipSuccess || hipDeviceGetAttribute(&cus, hipDeviceAttributeMultiprocessorCount, dev) != hipSuccess) { grid = -1; return; }
        if (hipFuncSetAttribute((const void*)mega_fwd, hipFuncAttributeMaxDynamicSharedMemorySize, LDS_BYTES) != hipSuccess) { fprintf(stderr, "kernel_launch: hipFuncSetAttribute failed\n"); grid = -1; return; }
        if (hipOccupancyMaxActiveBlocksPerMultiprocessor(&per_cu, (const void*)mega_fwd, NWAVES * 64, LDS_BYTES) != hipSuccess || per_cu < 1) fprintf(stderr, "kernel_launch: occupancy query reports %d\n", per_cu);
        (void)hipGetLastError();
        grid = cus;
    }
    if (grid < 0) return;
    if (hipMemsetAsync((char*)d_ws + WS_CTL, 0, CTL_ZERO_BYTES, stream) != hipSuccess) return;
    Args a{};
    for (int i = 0; i < 26; ++i) a.in[i] = (const float*)d_in[i];
    a.out = (float*)d_out; a.ws = (unsigned char*)d_ws;
#ifndef MK_SPLIT
    a.ph_lo = 0; a.ph_hi = NPHASE;
    hipLaunchKernelGGL(mega_fwd, dim3(grid), dim3(NWAVES * 64), LDS_BYTES, stream, a);
#else
    for (int p = 0; p < NPHASE; ++p) { a.ph_lo = p; a.ph_hi = p + 1; hipLaunchKernelGGL(mega_fwd, dim3(grid), dim3(NWAVES * 64), LDS_BYTES, stream, a); }
#endif
}
```
